# Optimizing an MI355X kernel written in HIP

```python
import math
import jax
import jax.numpy as jnp
from jax import lax
import numpy as np

D_MODEL = 2048
BATCH = 1
SEQ = 8192
DEPTH = 4
DEC_BATCH = 16
DEC_SEQ = 64
PAST_LEN = 1024

CHUNK = 64
N_META = 16
N_BRANCH = 3
MIX_W = D_MODEL // 2
SSD_HEADDIM = 64
SSD_HEADS = MIX_W // SSD_HEADDIM
SSD_GROUPS = 2
SSD_HPG = SSD_HEADS // SSD_GROUPS
SSD_STATE = 128
SSD_CONV_W = 4
SSD_CONV_CH = MIX_W + 2 * SSD_GROUPS * SSD_STATE
HG_DK = 128
HG_HEADS = MIX_W // HG_DK
HG_DV = MIX_W // HG_HEADS
RET_HEADS = 8
RET_DV = MIX_W // RET_HEADS
RET_DK = RET_DV // 2
ROPE_BASE = 10000.0
FFN_HIDDEN = -(-(8 * D_MODEL) // (3 * 256)) * 256
EPS = 1e-6
F_FLOOR = 1e-30

IN_SIZES = (MIX_W, SSD_CONV_CH, SSD_HEADS,
            HG_HEADS * HG_DK, HG_HEADS * HG_DK, HG_HEADS * HG_DV, MIX_W,
            RET_HEADS * RET_DK, RET_HEADS * RET_DK, RET_HEADS * RET_DV, MIX_W,
            N_BRANCH * D_MODEL)
IN_COLS = sum(IN_SIZES)

kernel_name = 'hybrid_ssd_hgrn2_retention_stream_step'


def _rms(v, gain=None):
    vf = v.astype(jnp.float32)
    out = vf * lax.rsqrt(jnp.mean(vf * vf, axis=-1, keepdims=True) + EPS)
    if gain is not None:
        out = out * gain.astype(jnp.float32)
    return out


def _rotary(t, pos):
    half = t.shape[-1] // 2
    inv = ROPE_BASE ** (-jnp.arange(half, dtype=jnp.float32) / half)
    ang = pos[:, None] * inv[None, :]
    cos = jnp.cos(ang)[None, :, None, :]
    sin = jnp.sin(ang)[None, :, None, :]
    t1, t2 = t[..., :half], t[..., half:]
    return jnp.concatenate([t1 * cos - t2 * sin, t2 * cos + t1 * sin], axis=-1)


def _masked_exp(seg, mask):
    return jnp.where(mask, jnp.exp(jnp.where(mask, seg, 0.0)), 0.0)


def _chunk_scan(step, state, xs, block):
    def to_chunks(a):
        b, n = a.shape[0], a.shape[1]
        a = a.reshape((b, n // block, block) + a.shape[2:])
        return jnp.moveaxis(a, 1, 0)
    state, ys = lax.scan(step, state, tuple(to_chunks(a) for a in xs))
    ys = jnp.moveaxis(ys, 0, 1)
    return state, ys.reshape((ys.shape[0], ys.shape[1] * ys.shape[2]) + ys.shape[3:])


def _run_segments(step, state, xs, segs):
    outs = []
    start = 0
    for length, block in segs:
        part = tuple(a[:, start:start + length] for a in xs)
        state, y = _chunk_scan(step, state, part, block)
        outs.append(y)
        start += length
    return state, jnp.concatenate(outs, axis=1)


def _ssd_step(S, inp):
    x, bm, cm, dt, a = inp
    q = x.shape[1]
    mask = jnp.tril(jnp.ones((q, q), dtype=bool))[None, :, :, None, None]
    cum = jnp.cumsum(a, axis=1)
    seg = cum[:, :, None] - cum[:, None, :]
    decay = _masked_exp(seg, mask)
    cb = jnp.einsum('btgn,bsgn->btsg', cm, bm)
    y = jnp.einsum('btsg,btsgh,bsghp->btghp', cb, decay, x * dt[..., None])
    y = y + jnp.einsum('btgn,bghpn->btghp', cm, S) * jnp.exp(cum)[..., None]
    w = jnp.exp(cum[:, -1:] - cum) * dt
    S = S * jnp.exp(cum[:, -1])[..., None, None] + jnp.einsum('bsgh,bsghp,bsgn->bghpn', w, x, bm)
    return S, y


def _hgrn_step(S, inp):
    q, k, v, lg = inp
    n = q.shape[1]
    mask = jnp.tril(jnp.ones((n, n), dtype=bool))[None, :, :, None, None]
    cum = jnp.cumsum(lg, axis=1)
    seg = cum[:, :, None] - cum[:, None, :]
    decay = _masked_exp(seg, mask)
    att = jnp.einsum('bthk,bshk,btshk->bhts', q, k, decay)
    o = jnp.einsum('bhts,bshv->bthv', att, v) + jnp.einsum('bthk,bhkv->bthv', q * jnp.exp(cum), S)
    S = S * jnp.exp(cum[:, -1])[..., None] + jnp.einsum('bshk,bshv->bhkv', k * jnp.exp(cum[:, -1:] - cum), v)
    return S, o


def _retention_step(log_gamma):
    def step(S, inp):
        q, k, v = inp
        n = q.shape[1]
        idx = jnp.arange(n, dtype=jnp.float32)
        mask = (idx[:, None] >= idx[None, :])[None]
        decay = _masked_exp((idx[:, None] - idx[None, :])[None] * log_gamma[:, None, None], mask)
        att = jnp.einsum('bthk,bshk->bhts', q, k) * decay[None]
        inner = jnp.exp((idx + 1.0)[:, None] * log_gamma[None, :])
        o = jnp.einsum('bhts,bshv->bthv', att, v) + jnp.einsum('bthk,bhkv->bthv', q * inner[:, :, None], S)
        tail = jnp.exp((n - 1.0 - idx)[:, None] * log_gamma[None, :])
        S = S * jnp.exp(n * log_gamma)[:, None, None] + jnp.einsum('bshk,bshv->bhkv', k * tail[:, :, None], v)
        return S, o
    return step


def _layer(x, pos, segs, conv_st, ssm_st, hg_st, ret_st, lb,
           norm_mix, w_in, conv_w, conv_b, dt_bias, a_log, d_skip, ssd_norm, hg_norm,
           w_branch, w_out, norm_ffn, w_gate, w_up, w_down):
    f32 = jnp.float32
    b, l, _ = x.shape
    h = _rms(x, norm_mix).astype(x.dtype)
    proj = h @ w_in
    splits = [int(s) for s in np.cumsum(IN_SIZES)[:-1]]
    (z, xbc, dt_raw, hq, hf, hi, hgate, rq, rk, rv, rgate, gate_logits) = jnp.split(proj, splits, axis=-1)

    ext = jnp.concatenate([conv_st.astype(xbc.dtype), xbc], axis=1)
    conv = conv_b + sum(ext[:, k:k + l] * conv_w[k] for k in range(SSD_CONV_W))
    new_conv = ext[:, -(SSD_CONV_W - 1):]
    conv = jax.nn.silu(conv.astype(f32))
    xs, bm, cm = jnp.split(conv, [MIX_W, MIX_W + SSD_GROUPS * SSD_STATE], axis=-1)
    xs = xs.reshape(b, l, SSD_GROUPS, SSD_HPG, SSD_HEADDIM)
    bm = bm.reshape(b, l, SSD_GROUPS, SSD_STATE)
    cm = cm.reshape(b, l, SSD_GROUPS, SSD_STATE)
    dt = jax.nn.softplus(dt_raw.astype(f32) + dt_bias.astype(f32)).reshape(b, l, SSD_GROUPS, SSD_HPG)
    a = dt * (-jnp.exp(a_log.astype(f32))).reshape(SSD_GROUPS, SSD_HPG)
    s0 = ssm_st.astype(f32).reshape(b, SSD_GROUPS, SSD_HPG, SSD_HEADDIM, SSD_STATE)
    new_ssm, y = _run_segments(_ssd_step, s0, (xs, bm, cm, dt, a), segs)
    y = y + xs * d_skip.astype(f32).reshape(SSD_GROUPS, SSD_HPG)[:, :, None]
    y = y.reshape(b, l, MIX_W) * jax.nn.silu(z.astype(f32))
    y_ssd = _rms(y.reshape(b, l, SSD_GROUPS, MIX_W // SSD_GROUPS)).reshape(b, l, MIX_W) * ssd_norm.astype(f32)
    new_ssm = new_ssm.reshape(b, SSD_HEADS, SSD_HEADDIM, SSD_STATE)

    q = jax.nn.silu(hq.astype(f32)).reshape(b, l, HG_HEADS, HG_DK)
    fg = hf.astype(f32).reshape(b, l, HG_HEADS, HG_DK)
    lbh = lb.reshape(HG_HEADS, HG_DK)
    f_gate = lbh + (1.0 - lbh) * jax.nn.sigmoid(fg)
    lg = jnp.log(jnp.maximum(f_gate, F_FLOOR))
    kk = (1.0 - lbh) * jax.nn.sigmoid(-fg)
    vv = hi.astype(f32).reshape(b, l, HG_HEADS, HG_DV)
    new_hg, o = _run_segments(_hgrn_step, hg_st.astype(f32), (q, kk, vv, lg), segs)
    y_hg = _rms(o, hg_norm.reshape(HG_HEADS, HG_DV)).reshape(b, l, MIX_W) * jax.nn.silu(hgate.astype(f32))

    log_gamma = jnp.log1p(-jnp.exp2(-5.0 - jnp.arange(RET_HEADS, dtype=f32)))
    rqh = _rotary(rq.astype(f32).reshape(b, l, RET_HEADS, RET_DK), pos)
    rkh = _rotary(rk.astype(f32).reshape(b, l, RET_HEADS, RET_DK), pos) * (RET_DK ** -0.5)
    rvh = rv.astype(f32).reshape(b, l, RET_HEADS, RET_DV)
    new_ret, o = _run_segments(_retention_step(log_gamma), ret_st.astype(f32), (rqh, rkh, rvh), segs)
    y_ret = _rms(o).reshape(b, l, MIX_W) * jax.nn.silu(rgate.astype(f32))

    br = jnp.stack([y_ssd, y_hg, y_ret], axis=2).astype(x.dtype)
    gates = jax.nn.sigmoid(gate_logits.reshape(b, l, N_BRANCH, D_MODEL))
    per_branch = jnp.einsum('blcm,cmd->blcd', br, w_branch)
    mixed = jnp.sum(per_branch * gates, axis=2)
    x = x + mixed @ w_out

    h2 = _rms(x, norm_ffn).astype(x.dtype)
    x = x + (jax.nn.silu(h2 @ w_gate) * (h2 @ w_up)) @ w_down
    return x, new_conv, new_ssm, new_hg, new_ret


def setup_inputs(seed: int = 0) -> dict:
    key = jax.random.key(seed)
    ks = jax.random.split(key, 24)
    f32 = jnp.float32

    def nrm(k, shape, scale):
        return jax.random.normal(k, shape, f32) * scale

    dt0 = jnp.exp(jax.random.uniform(ks[11], (DEPTH, SSD_HEADS), f32, math.log(1e-3), math.log(1e-1)))
    return {
        'x_prompt': nrm(ks[0], (BATCH, SEQ, D_MODEL), 1.0),
        'x_sample': nrm(ks[1], (DEC_BATCH, DEC_SEQ, D_MODEL), 1.0),
        'state_conv': nrm(ks[2], (DEPTH, DEC_BATCH, SSD_CONV_W - 1, SSD_CONV_CH), 1.0),
        'state_ssm': nrm(ks[3], (DEPTH, DEC_BATCH, SSD_HEADS, SSD_HEADDIM, SSD_STATE), 0.1),
        'state_hgrn': nrm(ks[4], (DEPTH, DEC_BATCH, HG_HEADS, HG_DK, HG_DV), 0.3),
        'state_ret': nrm(ks[5], (DEPTH, DEC_BATCH, RET_HEADS, RET_DK, RET_DV), 0.3),
        'meta_tokens': nrm(ks[6], (N_META, D_MODEL), 1.0),
        'norm_mix': 1.0 + nrm(ks[7], (DEPTH, D_MODEL), 0.02),
        'w_in': nrm(ks[8], (DEPTH, D_MODEL, IN_COLS), D_MODEL ** -0.5),
        'ssd_conv_w': nrm(ks[9], (DEPTH, SSD_CONV_W, SSD_CONV_CH), SSD_CONV_W ** -0.5),
        'ssd_conv_b': nrm(ks[10], (DEPTH, SSD_CONV_CH), 0.01),
        'ssd_dt_bias': dt0 + jnp.log(-jnp.expm1(-dt0)),
        'ssd_a_log': jnp.log(jax.random.uniform(ks[12], (DEPTH, SSD_HEADS), f32, 1.0, 16.0)),
        'ssd_d': 1.0 + nrm(ks[13], (DEPTH, SSD_HEADS), 0.1),
        'ssd_norm': 1.0 + nrm(ks[14], (DEPTH, MIX_W), 0.02),
        'hg_lower': nrm(ks[15], (DEPTH, HG_HEADS * HG_DK), 0.1),
        'hg_norm': 1.0 + nrm(ks[16], (DEPTH, HG_HEADS * HG_DV), 0.02),
        'w_branch': nrm(ks[17], (DEPTH, N_BRANCH, MIX_W, D_MODEL), MIX_W ** -0.5),
        'w_out': nrm(ks[18], (DEPTH, D_MODEL, D_MODEL), D_MODEL ** -0.5),
        'norm_ffn': 1.0 + nrm(ks[19], (DEPTH, D_MODEL), 0.02),
        'w_ffn_gate': nrm(ks[20], (DEPTH, D_MODEL, FFN_HIDDEN), D_MODEL ** -0.5),
        'w_ffn_up': nrm(ks[21], (DEPTH, D_MODEL, FFN_HIDDEN), D_MODEL ** -0.5),
        'w_ffn_down': nrm(ks[22], (DEPTH, FFN_HIDDEN, D_MODEL), FFN_HIDDEN ** -0.5),
        'norm_final': 1.0 + nrm(ks[23], (D_MODEL,), 0.02),
    }


def reference(x_prompt, x_sample, state_conv, state_ssm, state_hgrn, state_ret,
              meta_tokens, norm_mix, w_in, ssd_conv_w, ssd_conv_b, ssd_dt_bias, ssd_a_log, ssd_d,
              ssd_norm, hg_lower, hg_norm, w_branch, w_out, norm_ffn, w_ffn_gate, w_ffn_up,
              w_ffn_down, norm_final):
    f32 = jnp.float32
    lb_p = jax.nn.softmax(hg_lower.astype(f32), axis=0)
    lbs = jnp.cumsum(lb_p, axis=0) - lb_p[0]

    bp, sp = x_prompt.shape[0], x_prompt.shape[1]
    meta = jnp.broadcast_to(meta_tokens[None].astype(x_prompt.dtype), (bp, N_META, D_MODEL))
    xp = jnp.concatenate([meta, x_prompt], axis=1)
    pos_p = jnp.concatenate([jnp.arange(-N_META, 0, dtype=f32), jnp.arange(sp, dtype=f32)])
    segs_p = ((N_META, N_META), (sp, CHUNK))
    ss = x_sample.shape[1]
    xs = x_sample
    pos_s = PAST_LEN + jnp.arange(ss, dtype=f32)
    segs_s = ((ss, ss),)

    conv_p, ssm_p, hg_p, ret_p = [], [], [], []
    conv_s, ssm_s, hg_s, ret_s = [], [], [], []
    for i in range(DEPTH):
        weights = (norm_mix[i], w_in[i], ssd_conv_w[i], ssd_conv_b[i], ssd_dt_bias[i], ssd_a_log[i],
                   ssd_d[i], ssd_norm[i], hg_norm[i], w_branch[i], w_out[i], norm_ffn[i],
                   w_ffn_gate[i], w_ffn_up[i], w_ffn_down[i])
        xp, c1, s1, h1, r1 = _layer(
            xp, pos_p, segs_p,
            jnp.zeros((bp, SSD_CONV_W - 1, SSD_CONV_CH), xp.dtype),
            jnp.zeros((bp, SSD_HEADS, SSD_HEADDIM, SSD_STATE), f32),
            jnp.zeros((bp, HG_HEADS, HG_DK, HG_DV), f32),
            jnp.zeros((bp, RET_HEADS, RET_DK, RET_DV), f32),
            lbs[i], *weights)
        xs, c2, s2, h2, r2 = _layer(
            xs, pos_s, segs_s, state_conv[i], state_ssm[i], state_hgrn[i], state_ret[i],
            lbs[i], *weights)
        conv_p.append(c1); ssm_p.append(s1); hg_p.append(h1); ret_p.append(r1)
        conv_s.append(c2); ssm_s.append(s2); hg_s.append(h2); ret_s.append(r2)

    y_prompt = _rms(xp, norm_final).astype(x_prompt.dtype)[:, N_META:]
    y_sample = _rms(xs, norm_final).astype(x_sample.dtype)
    return (y_prompt, y_sample,
            jnp.stack(conv_p), jnp.stack(ssm_p), jnp.stack(hg_p), jnp.stack(ret_p),
            jnp.stack(conv_s), jnp.stack(ssm_s), jnp.stack(hg_s), jnp.stack(ret_s))
```

```cpp
#include <hip/hip_runtime.h>
#include <cstdio>
#include <cstdint>
namespace pg8 {
#define PG8_LAS __attribute__((address_space(3)))
typedef unsigned short bf16_t;
typedef short bf16x8 __attribute__((ext_vector_type(8)));
typedef float f32x4 __attribute__((ext_vector_type(4)));
typedef unsigned u32x4 __attribute__((ext_vector_type(4)));
constexpr int BM = 256, BK = 64, HALF = 128, HTB = HALF * BK * 2  , STAGE_BYTES = 8 * HTB, NXCD = 8, WGM = 8;

__host__ __device__ __forceinline__ int lds_byte(int r, int c) { const int st = (r >> 4) * 2 + (c >> 5), rr = r & 15, cc = c & 31, ob = rr * 64 + cc * 2; return st * 1024 + (ob ^ (((ob >> 9) & 1) << 5)); }
__host__ __device__ __forceinline__ void stage_rc(int b, int& R, int& C) { const int st = b / 1024, sb = b % 1024, swz = sb ^ (((sb >> 9) & 1) << 5); R = (st >> 1) * 16 + swz / 64; C = (st & 1) * 32 + (swz % 64) / 2; }
__host__ __device__ __forceinline__ int perm32(int rho) { const int n = rho >> 4, i = rho & 15; return 8 * (i >> 2) + 4 * n + (i & 3); }

struct Unit { int pm, pn, pc; };
struct Gemm { const bf16_t* A; const bf16_t* Bt; int M, N, K; size_t csA, csB; };

struct StaticOrder {
    int nM, nN, nwg, G, c;
    __host__ __device__ void init(int M, int N, int G_, int c_) { nM = M / BM; nN = N / BM; nwg = nM * nN; G = G_; c = c_; }
    __host__ __device__ bool next(int i, Unit& u) const {
        const long L = (long)i * G + c; if (L >= nwg) return false;
        int wgid = (int)L; { const int q = nwg / NXCD, r = nwg % NXCD, xcd = wgid % NXCD, off = wgid / NXCD; wgid = (xcd < r ? xcd * (q + 1) : r * (q + 1) + (xcd - r) * q) + off; }
        const int nig = WGM * nN, gid = wgid / nig, fm = gid * WGM, gsz = (nM - fm) < WGM ? (nM - fm) : WGM;
        u.pm = fm + ((wgid % nig) % gsz); u.pn = (wgid % nig) / gsz; u.pc = 0; return true;
    }
    __device__ __forceinline__ void a_ready(const Unit&) const {}
    __device__ __forceinline__ void done(const Unit&) const {}
};

__device__ __forceinline__ unsigned cvt_pk_bf16(float lo, float hi) { unsigned r; asm volatile("v_cvt_pk_bf16_f32 %0, %1, %2" : "=v"(r) : "v"(lo), "v"(hi)); return r; }

template <class Epi, class Sched, bool ALIGN_EPI = false, bool SP2 = false>
__device__ __forceinline__ void gemm_phase(PG8_LAS unsigned char* lds, const Gemm g, const Sched& S, const Epi& E, const int tid) {
    const int wid = __builtin_amdgcn_readfirstlane(tid >> 6), lane = tid & 63, wr = wid >> 2, wc = wid & 3, fr = lane & 15, fq = lane >> 4;
    const int K = g.K, nt = K / BK;
    unsigned voffA[2], voffB[2];
#pragma unroll
    for (int i = 0; i < 2; ++i) { int R, C; stage_rc(tid * 16 + i * 8192, R, C); const int Rb = Epi::PERM ? ((R & ~31) + perm32(R & 31)) : R;
        voffA[i] = (unsigned)(R * K + C) * 2u; voffB[i] = (unsigned)(Rb * K + C) * 2u; }
    const size_t kstep = (size_t)(BK * 2);
    const size_t hstep = (size_t)HALF * K * 2;
    const size_t tstep = 2 * hstep;
    const unsigned ldsw = (unsigned)wid * 1024u;
    const int aoff = lds_byte(wr * 64 + fr, fq * 8), boff = lds_byte(wc * 32 + fr, fq * 8);
#define PG8_SA(b, h) (((b) * 2 + (h)) * HTB)
#define PG8_SB(b, h) ((4 + (b) * 2 + (h)) * HTB)
#define PG8_STAGE(bufoff, gbase, voff) do { _Pragma("unroll") for (int _i = 0; _i < 2; ++_i) \
        __builtin_amdgcn_global_load_lds((const unsigned*)((const char*)(gbase) + (voff)[_i]), (PG8_LAS unsigned*)(lds + (bufoff) + ldsw + _i * 8192), 16, 0, 0); } while (0)
#define PG8_LDA(dst, b, h) do { _Pragma("unroll") for (int m = 0; m < 4; ++m) _Pragma("unroll") for (int k = 0; k < 2; ++k) dst[m][k] = *(const PG8_LAS bf16x8*)(lds + PG8_SA(b, h) + aoff + m * 2048 + k * 1024); } while (0)
#define PG8_LDB(dst, b, h) do { _Pragma("unroll") for (int n = 0; n < 2; ++n) _Pragma("unroll") for (int k = 0; k < 2; ++k) dst[n][k] = *(const PG8_LAS bf16x8*)(lds + PG8_SB(b, h) + boff + n * 2048 + k * 1024); } while (0)
#define PG8_MMA(ai, bj, At, Bt) do { __builtin_amdgcn_s_setprio(1); _Pragma("unroll") for (int m = 0; m < 4; ++m) _Pragma("unroll") for (int n = 0; n < 2; ++n) _Pragma("unroll") for (int k = 0; k < 2; ++k) \
        acc[ai][bj][m][n] = __builtin_amdgcn_mfma_f32_16x16x32_bf16(Bt[n][k], At[m][k], acc[ai][bj][m][n], 0, 0, 0); __builtin_amdgcn_s_setprio(0); } while (0)
#define PG8_WAIT_V(n) asm volatile("s_waitcnt vmcnt(" #n ")" ::: "memory")
#define PG8_WAIT_L(n) asm volatile("s_waitcnt lgkmcnt(" #n ")" ::: "memory")
#define PG8_BAR __builtin_amdgcn_s_barrier()
#define PG8_SCHED __builtin_amdgcn_sched_barrier(0)
    Unit cur, nxt; int ui = 0;
    if (!S.next(0, cur)) return;
    f32x4 acc[2][2][4][2];
#pragma unroll
    for (int a = 0; a < 2; ++a)
#pragma unroll
        for (int b = 0; b < 2; ++b)
#pragma unroll
            for (int m = 0; m < 4; ++m)
#pragma unroll
                for (int n = 0; n < 2; ++n) acc[a][b][m][n] = (f32x4){0.f, 0.f, 0.f, 0.f};
    bf16x8 At[4][2], B0[2][2], B1[2][2];
    const char* cA = (const char*)g.A + (size_t)cur.pm * tstep + (size_t)cur.pc * g.csA; const char* cB = (const char*)g.Bt + (size_t)cur.pn * tstep + (size_t)cur.pc * g.csB;
    S.a_ready(cur);
    if constexpr (SP2) {
        PG8_STAGE(PG8_SB(0, 0), cB, voffB); PG8_STAGE(PG8_SB(0, 1), cB + hstep, voffB); PG8_STAGE(PG8_SA(0, 0), cA, voffA); PG8_STAGE(PG8_SA(0, 1), cA + hstep, voffA);
        if (wr == 1) PG8_BAR;
        PG8_WAIT_V(2); PG8_BAR;
        PG8_STAGE(PG8_SB(1, 0), cB + kstep, voffB); PG8_STAGE(PG8_SA(1, 0), cA + kstep, voffA); PG8_STAGE(PG8_SB(1, 1), cB + hstep + kstep, voffB);
        PG8_WAIT_V(6); PG8_BAR;
    } else {
        PG8_STAGE(PG8_SB(0, 0), cB, voffB); PG8_STAGE(PG8_SA(0, 0), cA, voffA); PG8_STAGE(PG8_SB(0, 1), cB + hstep, voffB); PG8_STAGE(PG8_SA(0, 1), cA + hstep, voffA);
        if (wr == 1) PG8_BAR;
        PG8_WAIT_V(4); PG8_BAR;
        PG8_STAGE(PG8_SB(1, 0), cB + kstep, voffB); PG8_STAGE(PG8_SA(1, 0), cA + kstep, voffA); PG8_STAGE(PG8_SB(1, 1), cB + hstep + kstep, voffB);
        PG8_WAIT_V(6); PG8_BAR;
    }
    for (;;) {
        const bool has_next = S.next(ui + 1, nxt);
        const char* nA = has_next ? (const char*)g.A + (size_t)nxt.pm * tstep + (size_t)nxt.pc * g.csA : cA; const char* nB = has_next ? (const char*)g.Bt + (size_t)nxt.pn * tstep + (size_t)nxt.pc * g.csB : cB;
        for (int t = 0; t < nt; t += 2) {
            const bool last = (t == nt - 2);
            const char* a1 = cA + (size_t)(t + 1) * kstep;
            const char* a2 = last ? nA : cA + (size_t)(t + 2) * kstep; const char* b2 = last ? nB : cB + (size_t)(t + 2) * kstep;
            const char* a3 = a2 + kstep; const char* b3 = b2 + kstep;
            if (last && has_next) S.a_ready(nxt);
            if constexpr (SP2) {
            PG8_LDB(B0, 0, 0); PG8_LDB(B1, 0, 1); PG8_SCHED; PG8_LDA(At, 0, 0); PG8_STAGE(PG8_SA(1, 1), a1 + hstep, voffA);
            PG8_WAIT_V(8); PG8_WAIT_L(0); PG8_BAR; PG8_MMA(0, 0, At, B0); PG8_MMA(0, 1, At, B1); PG8_BAR; PG8_SCHED;
            PG8_LDA(At, 0, 1); PG8_STAGE(PG8_SB(0, 0), b2, voffB); PG8_STAGE(PG8_SB(0, 1), b2 + hstep, voffB); PG8_STAGE(PG8_SA(0, 0), a2, voffA);
            PG8_WAIT_V(8); PG8_WAIT_L(0); PG8_BAR; PG8_MMA(1, 0, At, B0); PG8_MMA(1, 1, At, B1); PG8_BAR; PG8_SCHED;
            PG8_LDB(B0, 1, 0); PG8_LDB(B1, 1, 1); PG8_SCHED; PG8_LDA(At, 1, 0); PG8_STAGE(PG8_SA(0, 1), a2 + hstep, voffA);
            PG8_WAIT_V(8); PG8_WAIT_L(0); PG8_BAR; PG8_MMA(0, 0, At, B0); PG8_MMA(0, 1, At, B1); PG8_BAR; PG8_SCHED;
            PG8_LDA(At, 1, 1); PG8_STAGE(PG8_SB(1, 0), b3, voffB); PG8_STAGE(PG8_SB(1, 1), b3 + hstep, voffB); PG8_STAGE(PG8_SA(1, 0), a3, voffA);
            PG8_WAIT_V(8); PG8_WAIT_L(0); PG8_BAR; PG8_MMA(1, 0, At, B0); PG8_MMA(1, 1, At, B1); PG8_BAR; PG8_SCHED;
            } else {
            PG8_LDB(B0, 0, 0); PG8_SCHED; PG8_LDA(At, 0, 0); PG8_STAGE(PG8_SA(1, 1), a1 + hstep, voffA);
            PG8_WAIT_L(8); PG8_BAR; PG8_WAIT_L(0); PG8_MMA(0, 0, At, B0); PG8_BAR; PG8_SCHED;
            PG8_LDB(B1, 0, 1); PG8_STAGE(PG8_SB(0, 0), b2, voffB);
            PG8_BAR; PG8_WAIT_L(0); PG8_MMA(0, 1, At, B1); PG8_BAR;
            PG8_LDA(At, 0, 1); PG8_STAGE(PG8_SA(0, 0), a2, voffA);
            PG8_BAR; PG8_WAIT_L(0); PG8_MMA(1, 0, At, B0); PG8_BAR; PG8_SCHED;
            PG8_STAGE(PG8_SB(0, 1), b2 + hstep, voffB);
            PG8_WAIT_V(6); PG8_BAR; PG8_MMA(1, 1, At, B1); PG8_BAR;
            PG8_LDB(B0, 1, 0); PG8_SCHED; PG8_LDA(At, 1, 0); PG8_STAGE(PG8_SA(0, 1), a2 + hstep, voffA);
            PG8_WAIT_L(8); PG8_BAR; PG8_WAIT_L(0); PG8_MMA(0, 0, At, B0); PG8_BAR; PG8_SCHED;
            PG8_LDB(B1, 1, 1); PG8_STAGE(PG8_SB(1, 0), b3, voffB);
            PG8_BAR; PG8_WAIT_L(0); PG8_MMA(0, 1, At, B1); PG8_BAR;
            PG8_LDA(At, 1, 1); PG8_STAGE(PG8_SA(1, 0), a3, voffA);
            PG8_BAR; PG8_WAIT_L(0); PG8_MMA(1, 0, At, B0); PG8_BAR; PG8_SCHED;
            PG8_STAGE(PG8_SB(1, 1), b3 + hstep, voffB);
            PG8_WAIT_V(6); PG8_BAR; PG8_MMA(1, 1, At, B1); PG8_BAR;
            }
        }
        if constexpr (ALIGN_EPI) { if (wr == 0) PG8_BAR; }
        if constexpr (!Epi::AFTER_DRAIN) { E(acc, cur, wr, wc, fr, fq); S.done(cur); }
        if (!has_next) break;
#pragma unroll
        for (int a = 0; a < 2; ++a)
#pragma unroll
            for (int b = 0; b < 2; ++b)
#pragma unroll
                for (int m = 0; m < 4; ++m)
#pragma unroll
                    for (int n = 0; n < 2; ++n) acc[a][b][m][n] = (f32x4){0.f, 0.f, 0.f, 0.f};
        cur = nxt; cA = nA; cB = nB; ++ui;
        if constexpr (ALIGN_EPI) { if (wr == 1) PG8_BAR; }
    }
    PG8_WAIT_V(0);
    if constexpr (!ALIGN_EPI) { if (wr == 0) PG8_BAR; }
    PG8_BAR;
    if constexpr (Epi::AFTER_DRAIN) { E.fused(acc, cur, wr, wc, fr, fq, lds, wid, lane); S.done(cur); }
#undef PG8_SA
#undef PG8_SB
#undef PG8_STAGE
#undef PG8_LDA
#undef PG8_LDB
#undef PG8_MMA
#undef PG8_WAIT_V
#undef PG8_WAIT_L
#undef PG8_BAR
#undef PG8_SCHED
}
}


constexpr int D = 2048, NL = 4, FFN = 5632, NPROJ = 15872, INCOLS = 15888;
constexpr int MR = 9280, MP = 9472, NCH = 145, NCHP = 129;
constexpr int ROW_P0 = 64, ROW_S0 = 8256, NNULL = 48;
constexpr int STATE_N = 327680, ST_SSD = 0, ST_HG = 131072, ST_RET = 262144;
constexpr int GAM_N = 1040;
constexpr float EPS = 1e-6f;
constexpr size_t O_YP = 0, O_YS = 16777216, O_CONVP = O_YS + 2097152, O_SSMP = O_CONVP + 18432, O_HGP = O_SSMP + 524288, O_RETP = O_HGP + 524288,
                 O_CONVS = O_RETP + 262144, O_SSMS = O_CONVS + 294912, O_HGS = O_SSMS + 8388608, O_RETS = O_HGS + 8388608, O_END = O_RETS + 4194304;

constexpr size_t MiB = 1u << 20;
constexpr size_t al(size_t x) { return (x + MiB - 1) / MiB * MiB; }
constexpr size_t WS_CTL = 0, CTL_ZERO_BYTES = 1 * MiB;
constexpr size_t SZ_WIN = (size_t)NPROJ * D * 2, SZ_WBR = (size_t)3 * D * 1024 * 2, SZ_WOUT = (size_t)D * D * 2, SZ_WGU = (size_t)2 * FFN * D * 2, SZ_WDN = (size_t)D * FFN * 2, SZ_WDT = (size_t)16 * D * 2;
constexpr size_t LW_IN = 0, LW_BR = LW_IN + al(SZ_WIN), LW_OUT = LW_BR + al(SZ_WBR), LW_GU = LW_OUT + al(SZ_WOUT), LW_DN = LW_GU + al(SZ_WGU), LW_DT = LW_DN + al(SZ_WDN), LW_SIZE = LW_DT + al(SZ_WDT);
constexpr size_t WS_W = 1 * MiB;
constexpr size_t WS_X = WS_W + 4 * LW_SIZE;
constexpr size_t WS_H = WS_X + al((size_t)MP * D * 4);
constexpr size_t WS_ZS = WS_H + al((size_t)MP * D * 2);
constexpr size_t WS_XBC = WS_ZS + al((size_t)MP * 1024 * 2);
constexpr size_t WS_HQ = WS_XBC + al((size_t)MP * 1536 * 2);
constexpr size_t WS_LG = WS_HQ + al((size_t)MP * 1024 * 2);
constexpr size_t WS_KK = WS_LG + al((size_t)MP * 1024 * 4);
constexpr size_t WS_HV = WS_KK + al((size_t)MP * 1024 * 2);
constexpr size_t WS_HG = WS_HV + al((size_t)MP * 1024 * 2);
constexpr size_t WS_RQ = WS_HG + al((size_t)MP * 1024 * 2);
constexpr size_t WS_RK = WS_RQ + al((size_t)MP * 512 * 2);
constexpr size_t WS_RV = WS_RK + al((size_t)MP * 512 * 2);
constexpr size_t WS_RG = WS_RV + al((size_t)MP * 1024 * 2);
constexpr size_t WS_GT = WS_RG + al((size_t)MP * 1024 * 2);
constexpr size_t WS_DT = WS_GT + al((size_t)MP * 6144 * 2);
constexpr size_t WS_CUM = WS_DT + al((size_t)MP * 16 * 4);
constexpr size_t WS_U = WS_CUM + al((size_t)MP * 16 * 4);
constexpr size_t WS_SB = WS_U + al((size_t)NCH * STATE_N * 4);
constexpr size_t WS_GAM = WS_SB + al((size_t)NCH * STATE_N * 2);
constexpr size_t WS_BR = WS_GAM + al((size_t)NCH * GAM_N * 4);
constexpr size_t WS_TMP = WS_BR + al((size_t)3 * MP * 1024 * 2);
constexpr size_t WS_MIX = WS_TMP + al((size_t)MP * D * 4);
constexpr size_t WS_HID = WS_MIX + al((size_t)MP * D * 2);
constexpr size_t WS_ROPE = WS_HID + al((size_t)MP * FFN * 2);
constexpr size_t WS_LBS = WS_ROPE + al((size_t)MP * 32 * 8);
constexpr size_t WS_END = WS_LBS + 1 * MiB;
constexpr int CW_BAR = 4096;

constexpr int RING_BYTES = 131072;
constexpr int LDSCTL_OFF = 147456 - 512, LDS_BYTES = 147456;
constexpr int NWAVES = 8, NTHR = 512;

#define GAS __attribute__((address_space(1)))
#define LAS __attribute__((address_space(3)))
typedef unsigned short bf16;
typedef unsigned v4u __attribute__((ext_vector_type(4)));
typedef unsigned v2u __attribute__((ext_vector_type(2)));
typedef float f32x4 __attribute__((ext_vector_type(4)));
typedef float f32x2 __attribute__((ext_vector_type(2)));
typedef short bf16x8 __attribute__((ext_vector_type(8)));
typedef GAS unsigned gu32;
#define RLX_AGENT __ATOMIC_RELAXED, __HIP_MEMORY_SCOPE_AGENT

__device__ __forceinline__ unsigned f2bf(float f) { unsigned u = __builtin_bit_cast(unsigned, f); return (u + 0x7fffu + ((u >> 16) & 1u)) >> 16; }
typedef __bf16 bf16v2 __attribute__((ext_vector_type(2)));
__device__ __forceinline__ unsigned pk2(float lo, float hi) { const f32x2 v = {lo, hi}; return __builtin_bit_cast(unsigned, __builtin_convertvector(v, bf16v2)); }
__device__ __forceinline__ float bf2f(unsigned short b) { return __builtin_bit_cast(float, ((unsigned)b) << 16); }
__device__ __forceinline__ float bflo(unsigned w) { return __builtin_bit_cast(float, w << 16); }
__device__ __forceinline__ float bfhi(unsigned w) { return __builtin_bit_cast(float, w & 0xffff0000u); }
__device__ __forceinline__ float fsigmoid(float v) { return __builtin_amdgcn_rcpf(1.0f + __expf(-v)); }
__device__ __forceinline__ float fsilu(float v) { return v * fsigmoid(v); }
__device__ __forceinline__ f32x4 mfma16(bf16x8 a, bf16x8 b, f32x4 c) { return __builtin_amdgcn_mfma_f32_16x16x32_bf16(a, b, c, 0, 0, 0); }
__device__ __forceinline__ float wave_sum(float v) {
#pragma unroll
    for (int o = 1; o < 64; o <<= 1) v += __shfl_xor(v, o);
    return v;
}
#define LDS_WAIT() asm volatile("s_waitcnt lgkmcnt(0)" ::: "memory")
#define XB_TMO      128
#define XB_XCNT(j)  (256  + 64 * (j))
#define XB_XSUB(j)  (1280 + 64 * (j))
#define XB_XGEN(j)  (2304 + 64 * (j))
#define XB_TOP      3328
#define XB_TOPGEN   3392
#define XCD_BAR_WORDS 3456
#define XB_SPIN_CAP (1u << 18)

__device__ __forceinline__ unsigned xb_ld(unsigned* p)              { return __hip_atomic_load(p, __ATOMIC_RELAXED, __HIP_MEMORY_SCOPE_AGENT); }
__device__ __forceinline__ unsigned xb_add(unsigned* p, unsigned v) { return __hip_atomic_fetch_add(p, v, __ATOMIC_RELAXED, __HIP_MEMORY_SCOPE_AGENT); }
__device__ __forceinline__ unsigned xb_xcc_id() { return (unsigned)__builtin_amdgcn_s_getreg((3 << 11) | 20) & 0xFu; }
#define XB_SPIN(cond, bar) do { unsigned _sp = 0; while (cond) { __builtin_amdgcn_s_sleep(1); \
    if ((++_sp & 255u) == 0u) { if (xb_ld(&(bar)[XB_TMO])) break; if (_sp > XB_SPIN_CAP) { atomicAdd(&(bar)[XB_TMO], 1u); break; } } } } while (0)

struct XcdBarrier {
    unsigned* bar; unsigned x;
    volatile LAS unsigned* st;
};

__device__ __forceinline__ XcdBarrier xcd_barrier_post(unsigned* bar, volatile LAS unsigned* st) {
    XcdBarrier b; b.bar = bar; b.x = xb_xcc_id(); b.st = st;
    if (threadIdx.x == 0) (void)xb_add(&bar[XB_XCNT(b.x)], 1u);
    return b;
}
__device__ __forceinline__ void xcd_barrier_complete(unsigned* bar, unsigned x, unsigned& nloc, unsigned& nx) {
    const unsigned G = gridDim.x * gridDim.y * gridDim.z;
    unsigned sum, cnt, mine, sp = 0u;
    for (;;) {
        sum = 0u; cnt = 0u; mine = 0u;
#pragma unroll
        for (unsigned j = 0; j < 16; ++j) { const unsigned c = xb_ld(&bar[XB_XCNT(j)]); sum += c; cnt += (c > 0u) ? 1u : 0u; mine = (j == x) ? c : mine; }
        if (sum == G) break;
        __builtin_amdgcn_s_sleep(1);
        if ((++sp & 255u) == 0u) { if (xb_ld(&bar[XB_TMO])) break; if (sp > XB_SPIN_CAP) { atomicAdd(&bar[XB_TMO], 1u); break; } }
    }
    nloc = mine > 0u ? mine : 1u; nx = cnt > 0u ? cnt : 1u;
}

__device__ __forceinline__ void xcd_barrier(const XcdBarrier& b) {
    asm volatile("s_waitcnt vmcnt(0)" ::: "memory");
    __syncthreads();
    if (threadIdx.x == 0) {
        unsigned* bar = b.bar;
        __builtin_amdgcn_s_waitcnt(0);
        unsigned nloc = b.st[0], nx = b.st[1];
        if (nloc == 0u) { xcd_barrier_complete(bar, b.x, nloc, nx); b.st[0] = nloc; b.st[1] = nx; }
        const unsigned old = xb_add(&bar[XB_XSUB(b.x)], 1u);
        const unsigned gen = old / nloc;
        if (old + 1u == (gen + 1u) * nloc) {
            __builtin_amdgcn_fence(__ATOMIC_RELEASE, "agent");
            asm volatile("s_waitcnt vmcnt(0)" ::: "memory");
            const unsigned og = xb_add(&bar[XB_TOP], 1u);
            const unsigned tg = og / nx;
            if (og + 1u == (tg + 1u) * nx) xb_add(&bar[XB_TOPGEN], 1u);
            else XB_SPIN(xb_ld(&bar[XB_TOPGEN]) == tg, bar);
            __builtin_amdgcn_fence(__ATOMIC_ACQUIRE, "agent");
            xb_add(&bar[XB_XGEN(b.x)], 1u);
            asm volatile("s_waitcnt vmcnt(0)" ::: "memory");
        } else {
            XB_SPIN(xb_ld(&bar[XB_XGEN(b.x)]) == gen, bar);
            __builtin_amdgcn_fence(__ATOMIC_ACQUIRE, "agent");
            asm volatile("s_waitcnt vmcnt(0)" ::: "memory");
        }
    }
    __syncthreads();
}


typedef const f32x4 (&AccRef)[2][2][4][2];

struct EpiProj {
    static constexpr bool PERM = true, AFTER_DRAIN = false;
    unsigned char* ws; int layer;
    template <int T> __device__ __forceinline__ void run(AccRef acc, bf16* dst, int pitch, int row0, int col0) const {
        const float* lbs = (const float*)(ws + WS_LBS) + layer * 1024; float* LG = (float*)(ws + WS_LG); const f32x2* rope = (const f32x2*)(ws + WS_ROPE);
        f32x4 lb[2][2];
        if (T == 3) {
#pragma unroll
            for (int bj = 0; bj < 2; ++bj) { lb[bj][0] = *(const f32x4*)(lbs + col0 + bj * 128); lb[bj][1] = *(const f32x4*)(lbs + col0 + bj * 128 + 4); }
        }
#pragma unroll
        for (int ai = 0; ai < 2; ++ai)
#pragma unroll
            for (int m = 0; m < 4; ++m) {
                const int row = row0 + ai * 128 + m * 16;
#pragma unroll
                for (int bj = 0; bj < 2; ++bj) {
                    const int col = col0 + bj * 128;
                    f32x4 v0 = acc[ai][bj][m][0], v1 = acc[ai][bj][m][1];
                    if (T == 1) {
#pragma unroll
                        for (int e = 0; e < 4; ++e) { v0[e] = fsilu(v0[e]); v1[e] = fsilu(v1[e]); }
                    }
                    if (T == 2) {
#pragma unroll
                        for (int e = 0; e < 4; ++e) { v0[e] = fsigmoid(v0[e]); v1[e] = fsigmoid(v1[e]); }
                    }
                    if (T == 3) {
                        f32x4 l0, l1;
#pragma unroll
                        for (int e = 0; e < 4; ++e) {
                            { const float b = lb[bj][0][e], fg = v0[e], s = fsigmoid(fg), sn = fsigmoid(-fg); l0[e] = __logf(fmaxf(b + (1.0f - b) * s, 1e-30f)); v0[e] = (1.0f - b) * sn; }
                            { const float b = lb[bj][1][e], fg = v1[e], s = fsigmoid(fg), sn = fsigmoid(-fg); l1[e] = __logf(fmaxf(b + (1.0f - b) * s, 1e-30f)); v1[e] = (1.0f - b) * sn; }
                        }
                        float* lp = LG + (size_t)row * 1024 + col;
                        *(f32x4*)lp = l0; *(f32x4*)(lp + 4) = l1;
                    }
                    if (T == 4 || T == 5) {
                        const int j = (col & 63) >> 3;
                        const f32x4* rp = (const f32x4*)(rope + (size_t)row * 32 + 4 * j);
                        const f32x4 cs0 = rp[0], cs1 = rp[1];
                        const float c[4] = {cs0[0], cs0[2], cs1[0], cs1[2]}, s[4] = {cs0[1], cs0[3], cs1[1], cs1[3]};
                        const float sc = (T == 5) ? 0.125f : 1.0f;
#pragma unroll
                        for (int e = 0; e < 4; ++e) { const float a = v0[e], b = v1[e]; v0[e] = (a * c[e] - b * s[e]) * sc; v1[e] = (b * c[e] + a * s[e]) * sc; }
                    }
                    v4u w; w.x = pk2(v0[0], v0[1]); w.y = pk2(v0[2], v0[3]); w.z = pk2(v1[0], v1[1]); w.w = pk2(v1[2], v1[3]);
                    *(v4u*)(dst + (size_t)row * pitch + col) = w;
                }
            }
    }
    __device__ __forceinline__ void operator()(AccRef acc, const pg8::Unit& u, int wr, int wc, int fr, int fq) const {
        const int pn = u.pn, row0 = u.pm * 256 + wr * 64 + fr, cl = wc * 32 + 8 * fq;
        if (pn < 4) run<1>(acc, (bf16*)(ws + WS_ZS), 1024, row0, (pn - 0) * 256 + cl);
        else if (pn < 10) run<0>(acc, (bf16*)(ws + WS_XBC), 1536, row0, (pn - 4) * 256 + cl);
        else if (pn < 14) run<1>(acc, (bf16*)(ws + WS_HQ), 1024, row0, (pn - 10) * 256 + cl);
        else if (pn < 18) run<3>(acc, (bf16*)(ws + WS_KK), 1024, row0, (pn - 14) * 256 + cl);
        else if (pn < 22) run<0>(acc, (bf16*)(ws + WS_HV), 1024, row0, (pn - 18) * 256 + cl);
        else if (pn < 26) run<1>(acc, (bf16*)(ws + WS_HG), 1024, row0, (pn - 22) * 256 + cl);
        else if (pn < 28) run<4>(acc, (bf16*)(ws + WS_RQ), 512, row0, (pn - 26) * 256 + cl);
        else if (pn < 30) run<5>(acc, (bf16*)(ws + WS_RK), 512, row0, (pn - 28) * 256 + cl);
        else if (pn < 34) run<0>(acc, (bf16*)(ws + WS_RV), 1024, row0, (pn - 30) * 256 + cl);
        else if (pn < 38) run<1>(acc, (bf16*)(ws + WS_RG), 1024, row0, (pn - 34) * 256 + cl);
        else run<2>(acc, (bf16*)(ws + WS_GT), 6144, row0, (pn - 38) * 256 + cl);
    }
};

struct EpiBranch {
    static constexpr bool PERM = true, AFTER_DRAIN = false;
    float* TMP; bf16* MIX; const bf16* GT;
    __device__ __forceinline__ void operator()(AccRef acc, const pg8::Unit& u, int wr, int wc, int fr, int fq) const {
        const int row0 = u.pm * 256 + wr * 64 + fr, col0 = u.pn * 256 + wc * 32 + 8 * fq, pc = u.pc;
#pragma unroll
        for (int ai = 0; ai < 2; ++ai)
#pragma unroll
            for (int m = 0; m < 4; ++m) {
                const int row = row0 + ai * 128 + m * 16;
#pragma unroll
                for (int bj = 0; bj < 2; ++bj) {
                    const int col = col0 + bj * 128;
                    const v4u g = *(const v4u*)(GT + (size_t)row * 6144 + pc * 2048 + col);
                    f32x4 v0 = acc[ai][bj][m][0], v1 = acc[ai][bj][m][1];
                    v0[0] *= bflo(g.x); v0[1] *= bfhi(g.x); v0[2] *= bflo(g.y); v0[3] *= bfhi(g.y);
                    v1[0] *= bflo(g.z); v1[1] *= bfhi(g.z); v1[2] *= bflo(g.w); v1[3] *= bfhi(g.w);
                    float* tp = TMP + (size_t)row * D + col;
                    if (pc > 0) { v0 += *(const f32x4*)tp; v1 += *(const f32x4*)(tp + 4); }
                    if (pc < 2) { *(f32x4*)tp = v0; *(f32x4*)(tp + 4) = v1; }
                    else { v4u w; w.x = pk2(v0[0], v0[1]); w.y = pk2(v0[2], v0[3]); w.z = pk2(v1[0], v1[1]); w.w = pk2(v1[2], v1[3]); *(v4u*)(MIX + (size_t)row * D + col) = w; }
                }
            }
    }
};

struct EpiResid {
    static constexpr bool PERM = false, AFTER_DRAIN = false;
    float* X;
    __device__ __forceinline__ void operator()(AccRef acc, const pg8::Unit& u, int wr, int wc, int fr, int fq) const {
        const int row0 = u.pm * 256 + wr * 64 + fr, col0 = u.pn * 256 + wc * 32 + 4 * fq;
#pragma unroll
        for (int ai = 0; ai < 2; ++ai)
#pragma unroll
            for (int m = 0; m < 4; ++m) {
                float* rowp = X + (size_t)(row0 + ai * 128 + m * 16) * D + col0;
#pragma unroll
                for (int bj = 0; bj < 2; ++bj)
#pragma unroll
                    for (int n = 0; n < 2; ++n) { f32x4* p = (f32x4*)(rowp + bj * 128 + n * 16); *p = *p + acc[ai][bj][m][n]; }
            }
    }
};

struct EpiSwiglu {
    static constexpr bool PERM = true, AFTER_DRAIN = false;
    bf16* HID;
    __device__ __forceinline__ void operator()(AccRef acc, const pg8::Unit& u, int wr, int wc, int fr, int fq) const {
        const int row0 = u.pm * 256 + wr * 64 + fr, col0 = u.pn * 128 + wc * 32 + 8 * fq;
#pragma unroll
        for (int ai = 0; ai < 2; ++ai)
#pragma unroll
            for (int m = 0; m < 4; ++m) {
                const int row = row0 + ai * 128 + m * 16;
                f32x4 g0 = acc[ai][0][m][0], g1 = acc[ai][0][m][1]; const f32x4 u0 = acc[ai][1][m][0], u1 = acc[ai][1][m][1];
#pragma unroll
                for (int e = 0; e < 4; ++e) { g0[e] = fsilu(g0[e]) * u0[e]; g1[e] = fsilu(g1[e]) * u1[e]; }
                v4u w; w.x = pk2(g0[0], g0[1]); w.y = pk2(g0[2], g0[3]); w.z = pk2(g1[0], g1[1]); w.w = pk2(g1[2], g1[3]);
                *(v4u*)(HID + (size_t)row * FFN + col0) = w;
            }
    }
};

struct BranchOrder {
    pg8::StaticOrder S;
    __device__ void init(int M, int N, int G, int c) { S.init(M, N, G, c); }
    __device__ bool next(int i, pg8::Unit& u) const { const int t = i / 3, pc = i - 3 * t; if (!S.next(t, u)) return false; u.pc = pc; return true; }
    __device__ __forceinline__ void a_ready(const pg8::Unit&) const {}
    __device__ __forceinline__ void done(const pg8::Unit&) const {}
};

struct Args { const float* in[24]; float* out; unsigned char* ws; int l_lo, l_hi, ph_lo, ph_hi, do_pro, do_fin, use_bar, pad; };
enum { I_XP = 0, I_XS, I_SCONV, I_SSSM, I_SHG, I_SRET, I_META, I_NMIX, I_WIN, I_CONVW, I_CONVB, I_DTB, I_ALOG, I_DSKIP, I_SSDN, I_HGLOW, I_HGN, I_WBR, I_WOUT, I_NFFN, I_WG, I_WU, I_WD, I_NFIN };

typedef const __attribute__((address_space(4))) Args* ArgsP;
#define AREF const __attribute__((address_space(4))) Args&
struct Ctx {
    LAS unsigned char* lds; int tid, lane, wave, vcu, G;
    ArgsP a; unsigned char* ws;
};

template <class F> __device__ __forceinline__ void tr_item(const float* W, int ldw, bf16* WT, int K, int k0, int n0, LAS float* scr, int lane, F srccol) {
    const int sc = srccol(n0 + (lane & 31));
#pragma unroll 8
    for (int i = 0; i < 32; ++i) { const int kk = 2 * i + (lane >> 5); scr[kk * 33 + (lane & 31)] = W[(size_t)(k0 + kk) * ldw + sc]; }
    LDS_WAIT(); asm volatile("" ::: "memory");
    const int c = lane & 7;
#pragma unroll
    for (int j = 0; j < 4; ++j) { const int n = (lane >> 3) + 8 * j; const LAS float* s = scr + (8 * c) * 33 + n;
        v4u o; o.x = pk2(s[0 * 33], s[1 * 33]); o.y = pk2(s[2 * 33], s[3 * 33]); o.z = pk2(s[4 * 33], s[5 * 33]); o.w = pk2(s[6 * 33], s[7 * 33]);
        *(v4u*)(WT + (size_t)(n0 + n) * K + k0 + 8 * c) = o; }
    LDS_WAIT(); asm volatile("" ::: "memory");
}
__device__ __forceinline__ int win_src(int n) {
    if (n >= 6656 && n < 7680) { const int p = n & 63, j = p >> 3, nn = (p >> 2) & 1, e = p & 3; n = (n & ~63) + 32 * nn + 4 * j + e; }
    return n < 2560 ? n : n + 16;
}
__device__ __forceinline__ int ret_dim(int p) { return 32 * ((p >> 2) & 1) + 4 * (p >> 3) + (p & 3); }

__device__ __forceinline__ void p0_prologue(const Ctx& C) {
    AREF A = *C.a; unsigned char* ws = C.ws;
    LAS float* scr = (LAS float*)(C.lds + C.wave * 16384);
    const int gw = C.vcu * NWAVES + C.wave, NGW = C.G * NWAVES;
    constexpr int I_IN = 32 * 496, I_BR = 3 * 16 * 64, I_OUT = 32 * 64, I_GU = 32 * 352, I_DN = 88 * 64, I_L = I_IN + I_BR + I_OUT + I_GU + I_DN;
    for (int it = gw; it < NL * I_L; it += NGW) {
        const int l = it / I_L; int r = it - l * I_L; unsigned char* lw = ws + WS_W + (size_t)l * LW_SIZE;
        if (r < I_IN) { const int kb = r / 496, nb = r - kb * 496; tr_item(A.in[I_WIN] + (size_t)l * D * INCOLS, INCOLS, (bf16*)(lw + LW_IN), D, 64 * kb, 32 * nb, scr, C.lane, [](int n) { return win_src(n); }); continue; } r -= I_IN;
        if (r < I_BR) { const int c = r / 1024, rr = r - c * 1024, kb = rr / 64, nb = rr - kb * 64;
            tr_item(A.in[I_WBR] + ((size_t)l * 3 + c) * 1024 * D, D, (bf16*)(lw + LW_BR) + (size_t)c * D * 1024, 1024, 64 * kb, 32 * nb, scr, C.lane, [](int n) { return n; }); continue; } r -= I_BR;
        if (r < I_OUT) { const int kb = r / 64, nb = r - kb * 64; tr_item(A.in[I_WOUT] + (size_t)l * D * D, D, (bf16*)(lw + LW_OUT), D, 64 * kb, 32 * nb, scr, C.lane, [](int n) { return n; }); continue; } r -= I_OUT;
        if (r < I_GU) { const int kb = r / 352, nb = r - kb * 352, n0 = 32 * nb, t = n0 >> 8, w = n0 & 255; const float* src = (w < 128 ? A.in[I_WG] : A.in[I_WU]) + (size_t)l * D * FFN; const int sbase = 128 * t + (w & 127) - n0;
            tr_item(src, FFN, (bf16*)(lw + LW_GU), D, 64 * kb, n0, scr, C.lane, [sbase](int n) { return n + sbase; }); continue; } r -= I_GU;
        { const int kb = r / 64, nb = r - kb * 64; tr_item(A.in[I_WD] + (size_t)l * FFN * D, D, (bf16*)(lw + LW_DN), FFN, 64 * kb, 32 * nb, scr, C.lane, [](int n) { return n; }); }
    }
    const int gt = C.vcu * NTHR + C.tid, NGT = C.G * NTHR;
    for (int i = gt; i < NL * 16 * D; i += NGT) { const int l = i / (16 * D), r = i - l * 16 * D, h = r / D, k = r - h * D;
        ((bf16*)(ws + WS_W + (size_t)l * LW_SIZE + LW_DT))[r] = (bf16)f2bf(A.in[I_WIN][((size_t)l * D + k) * INCOLS + 2560 + h]); }
    for (int m = gw; m < MP; m += NGW) {
        const float* src = nullptr;
        if (m >= NNULL && m < ROW_P0) src = A.in[I_META] + (size_t)(m - NNULL) * D;
        else if (m >= ROW_P0 && m < ROW_S0) src = A.in[I_XP] + (size_t)(m - ROW_P0) * D;
        else if (m >= ROW_S0 && m < MR) src = A.in[I_XS] + (size_t)(m - ROW_S0) * D;
        f32x4* dst = (f32x4*)(ws + WS_X + (size_t)m * D * 4) + C.lane;
#pragma unroll
        for (int j = 0; j < 8; ++j) dst[64 * j] = src ? ((const f32x4*)src)[C.lane + 64 * j] : (f32x4){0.f, 0.f, 0.f, 0.f};
    }
    for (int i = gt; i < MP * 32; i += NGT) {
        const int row = i >> 5, fi = i & 31;
        const int pos = row < ROW_S0 ? row - ROW_P0 : (row < MR ? 1024 + ((row - ROW_S0) & 63) : 0);
        const double inv = exp(-(double)fi * (9.210340371976184 / 32.0));
        const double ang = (double)pos * inv, n = rint(ang * 0.15915494309189535), r = fma(-n, 6.283185307179586, ang) - n * 2.4492935982947064e-16;
        const double r2 = r * r; double s = 0.0, c = 0.0;
#pragma unroll
        for (int k = 14; k >= 1; --k) { s = (s + 1.0) * (-r2 / (double)((2 * k) * (2 * k + 1))); c = (c + 1.0) * (-r2 / (double)((2 * k - 1) * (2 * k))); }
        ((f32x2*)(ws + WS_ROPE))[i] = (f32x2){(float)(c + 1.0), (float)((s + 1.0) * r)};
    }
    for (int i = gt; i < 1024; i += NGT) {
        const float* hl = A.in[I_HGLOW]; const float v0 = hl[i], v1 = hl[1024 + i], v2 = hl[2048 + i], v3 = hl[3072 + i], mx = fmaxf(fmaxf(v0, v1), fmaxf(v2, v3));
        const float e0 = expf(v0 - mx), e1 = expf(v1 - mx), e2 = expf(v2 - mx), e3 = expf(v3 - mx), inv = 1.0f / (e0 + e1 + e2 + e3);
        float* lb = (float*)(ws + WS_LBS); lb[i] = 0.f; lb[1024 + i] = e1 * inv; lb[2048 + i] = (e1 + e2) * inv; lb[3072 + i] = (e1 + e2 + e3) * inv;
    }
    for (int i = gt; i < 3 * (MP - MR) * 1024 / 8; i += NGT) { const int c = i / ((MP - MR) * 128), r = i - c * (MP - MR) * 128;
        ((v4u*)(ws + WS_BR + ((size_t)c * MP + MR) * 1024 * 2))[r] = (v4u){0u, 0u, 0u, 0u}; }
}

__device__ __forceinline__ void norm_phase(const Ctx& C, const float* X, const float* gain, bf16* H) {
    const int gw = C.vcu * NWAVES + C.wave, NGW = C.G * NWAVES;
    f32x4 gn[8];
#pragma unroll
    for (int j = 0; j < 8; ++j) gn[j] = ((const f32x4*)gain)[C.lane + 64 * j];
    for (int m = gw; m < MP; m += NGW) {
        const f32x4* xr = (const f32x4*)(X + (size_t)m * D) + C.lane;
        f32x4 v[8]; float s = 0.f;
#pragma unroll
        for (int j = 0; j < 8; ++j) { v[j] = xr[64 * j]; s += (v[j][0] * v[j][0] + v[j][1] * v[j][1]) + (v[j][2] * v[j][2] + v[j][3] * v[j][3]); }
        const float rs = rsqrtf(wave_sum(s) * (1.0f / D) + EPS);
        v2u* o = (v2u*)(H + (size_t)m * D) + C.lane;
#pragma unroll
        for (int j = 0; j < 8; ++j) { const f32x4 y = v[j] * rs * gn[j]; v2u w; w.x = pk2(y[0], y[1]); w.y = pk2(y[2], y[3]); o[64 * j] = w; }
    }
}
__device__ __forceinline__ void final_phase(const Ctx& C, const float* X, const float* gain, float* out) {
    const int gw = C.vcu * NWAVES + C.wave, NGW = C.G * NWAVES;
    f32x4 gn[8];
#pragma unroll
    for (int j = 0; j < 8; ++j) gn[j] = ((const f32x4*)gain)[C.lane + 64 * j];
    for (int m = ROW_P0 + gw; m < MR; m += NGW) {
        const f32x4* xr = (const f32x4*)(X + (size_t)m * D) + C.lane;
        f32x4 v[8]; float s = 0.f;
#pragma unroll
        for (int j = 0; j < 8; ++j) { v[j] = xr[64 * j]; s += (v[j][0] * v[j][0] + v[j][1] * v[j][1]) + (v[j][2] * v[j][2] + v[j][3] * v[j][3]); }
        const float rs = rsqrtf(wave_sum(s) * (1.0f / D) + EPS);
        f32x4* o = (f32x4*)(out + (m < ROW_S0 ? O_YP + (size_t)(m - ROW_P0) * D : O_YS + (size_t)(m - ROW_S0) * D)) + C.lane;
#pragma unroll
        for (int j = 0; j < 8; ++j) o[64 * j] = v[j] * rs * gn[j];
    }
}

__device__ __forceinline__ bf16x8 ldsfrag(const LAS unsigned char* base, int row, int pitchB, int kel) { return *(const LAS bf16x8*)(base + row * pitchB + kel * 2); }
__device__ __forceinline__ float ret_lgam(int h) { return log1pf(-exp2f(-5.0f - (float)h)); }
__device__ __forceinline__ float softplusf(float v) { return v > 20.0f ? v : log1pf(expf(v)); }
struct ConvSrc {
    const bf16* XBC; const float* sconv; int c, r0;
    __device__ __forceinline__ float at(int t, int ch) const {
        if (t >= 0) return bf2f(XBC[(size_t)(r0 + t) * 1536 + ch]);
        if (c == 0) return 0.f;
        if (c < NCHP) return bf2f(XBC[(size_t)(r0 + t) * 1536 + ch]);
        return sconv[((size_t)(c - NCHP) * 3 + (3 + t)) * 1536 + ch];
    }
};

__device__ __forceinline__ void m1_ssd(const Ctx& C, int l, int c, int g) {
    AREF A = *C.a; unsigned char* ws = C.ws; const int tid = C.tid, lane = C.lane, w = C.wave, r0 = 64 * c;
    LAS unsigned char* XT = C.lds; LAS unsigned char* BT = C.lds + 73728;
    LAS float* DTP = (LAS float*)(C.lds + 92160); LAS float* SDT = (LAS float*)(C.lds + 124928); LAS float* SCUM = (LAS float*)(C.lds + 129024);
    const bf16* H = (const bf16*)(ws + WS_H); const bf16* WDT = (const bf16*)(ws + WS_W + (size_t)l * LW_SIZE + LW_DT);
    const int l15 = lane & 15, l4 = lane >> 4;
    {
        f32x4 acc[4];
#pragma unroll
        for (int rb = 0; rb < 4; ++rb) acc[rb] = (f32x4){0.f, 0.f, 0.f, 0.f};
#pragma unroll 2
        for (int ks = 0; ks < 8; ++ks) {
            const int ko = 256 * w + 32 * ks + 8 * l4;
            const bf16x8 bf = *(const bf16x8*)(WDT + (size_t)l15 * D + ko);
#pragma unroll
            for (int rb = 0; rb < 4; ++rb) { const bf16x8 af = *(const bf16x8*)(H + (size_t)(r0 + 16 * rb + l15) * D + ko); acc[rb] = mfma16(af, bf, acc[rb]); }
        }
#pragma unroll
        for (int rb = 0; rb < 4; ++rb)
#pragma unroll
            for (int e = 0; e < 4; ++e) DTP[(w * 64 + 16 * rb + 4 * l4 + e) * 16 + l15] = acc[rb][e];
    }
    __syncthreads();
#pragma unroll
    for (int q = 0; q < 2; ++q) {
        const int idx = tid + 512 * q, row = idx >> 4, hd = idx & 15; float raw = 0.f;
#pragma unroll
        for (int ww = 0; ww < 8; ++ww) raw += DTP[(ww * 64 + row) * 16 + hd];
        float dt = softplusf(raw + A.in[I_DTB][l * 16 + hd]);
        if (r0 + row < NNULL) dt = 0.f;
        SDT[idx] = dt; SCUM[idx] = -dt * expf(A.in[I_ALOG][l * 16 + hd]);
    }
    __syncthreads();
#pragma unroll
    for (int q = 0; q < 2; ++q) {
        const int hd = 2 * w + q; float v = SCUM[lane * 16 + hd];
#pragma unroll
        for (int o = 1; o < 64; o <<= 1) { const float t = __shfl_up(v, o); if (lane >= o) v += t; }
        SCUM[lane * 16 + hd] = v;
    }
    __syncthreads();
    { const int row = tid >> 3, hd = 8 * g + (tid & 7);
      ((float*)(ws + WS_DT))[(size_t)(r0 + row) * 16 + hd] = SDT[row * 16 + hd]; ((float*)(ws + WS_CUM))[(size_t)(r0 + row) * 16 + hd] = SCUM[row * 16 + hd]; }
    const ConvSrc cs{(const bf16*)(ws + WS_XBC), A.in[I_SCONV] + (size_t)l * 16 * 3 * 1536, c, r0};
    const float* cw = A.in[I_CONVW] + (size_t)l * 4 * 1536; const float* cb = A.in[I_CONVB] + (size_t)l * 1536;
    {
        const int ch = 512 * g + tid, hd = 8 * g + (tid >> 6);
        const float w0 = cw[ch], w1 = cw[1536 + ch], w2 = cw[2 * 1536 + ch], w3 = cw[3 * 1536 + ch], bias = cb[ch], clast = SCUM[63 * 16 + hd];
        float p3 = cs.at(-3, ch), p2 = cs.at(-2, ch), p1 = cs.at(-1, ch);
        for (int t0 = 0; t0 < 64; t0 += 8) {
            float val[8];
#pragma unroll
            for (int tt = 0; tt < 8; ++tt) { const int t = t0 + tt; const float cur = cs.at(t, ch), v = bias + w0 * p3 + w1 * p2 + w2 * p1 + w3 * cur;
                val[tt] = fsilu(v) * (expf(clast - SCUM[t * 16 + hd]) * SDT[t * 16 + hd]); p3 = p2; p2 = p1; p1 = cur; }
            v4u o; o.x = pk2(val[0], val[1]); o.y = pk2(val[2], val[3]); o.z = pk2(val[4], val[5]); o.w = pk2(val[6], val[7]);
            *(LAS v4u*)(XT + tid * 144 + t0 * 2) = o;
        }
    }
    {
        const int col = tid & 127, seg = tid >> 7, ch = 1024 + 128 * g + col, t0 = 16 * seg;
        const float w0 = cw[ch], w1 = cw[1536 + ch], w2 = cw[2 * 1536 + ch], w3 = cw[3 * 1536 + ch], bias = cb[ch];
        float p3 = cs.at(t0 - 3, ch), p2 = cs.at(t0 - 2, ch), p1 = cs.at(t0 - 1, ch); float val[16];
#pragma unroll
        for (int tt = 0; tt < 16; ++tt) { const float cur = cs.at(t0 + tt, ch); val[tt] = fsilu(bias + w0 * p3 + w1 * p2 + w2 * p1 + w3 * cur); p3 = p2; p2 = p1; p1 = cur; }
        v4u o; o.x = pk2(val[0], val[1]); o.y = pk2(val[2], val[3]); o.z = pk2(val[4], val[5]); o.w = pk2(val[6], val[7]); *(LAS v4u*)(BT + col * 144 + t0 * 2) = o;
        o.x = pk2(val[8], val[9]); o.y = pk2(val[10], val[11]); o.z = pk2(val[12], val[13]); o.w = pk2(val[14], val[15]); *(LAS v4u*)(BT + col * 144 + t0 * 2 + 16) = o;
    }
    __syncthreads();
    {
        const int hd = 8 * g + w; float* U = (float*)(ws + WS_U) + (size_t)c * STATE_N + ST_SSD + (size_t)hd * 8192;
#pragma unroll 1
        for (int pi = 0; pi < 4; ++pi) {
            const bf16x8 a0 = ldsfrag(XT, 64 * w + 16 * pi + l15, 144, 8 * l4), a1 = ldsfrag(XT, 64 * w + 16 * pi + l15, 144, 32 + 8 * l4);
#pragma unroll
            for (int nj = 0; nj < 8; ++nj) {
                f32x4 acc = (f32x4){0.f, 0.f, 0.f, 0.f};
                acc = mfma16(ldsfrag(BT, 16 * nj + l15, 144, 8 * l4), a0, acc); acc = mfma16(ldsfrag(BT, 16 * nj + l15, 144, 32 + 8 * l4), a1, acc);
                *(f32x4*)(U + (16 * pi + l15) * 128 + 16 * nj + 4 * l4) = acc;
            }
        }
        if (tid < 8) ((float*)(ws + WS_GAM))[(size_t)c * GAM_N + 8 * g + tid] = expf(SCUM[63 * 16 + 8 * g + tid]);
    }
}

__device__ __forceinline__ void m1_hg(const Ctx& C, int l, int c, int h) {
    unsigned char* ws = C.ws; const int tid = C.tid, lane = C.lane, w = C.wave, r0 = 64 * c, l15 = lane & 15, l4 = lane >> 4;
    LAS unsigned char* KT = C.lds; LAS unsigned char* VT = C.lds + 18432; LAS float* SEG = (LAS float*)(C.lds + 36864);
    const int col = tid & 127, seg = tid >> 7; const size_t base = (size_t)(r0 + 16 * seg) * 1024 + 128 * h + col;
    const float* LG = (const float*)(ws + WS_LG) + base; const bf16* KK = (const bf16*)(ws + WS_KK) + base; const bf16* HV = (const bf16*)(ws + WS_HV) + base;
    float cum[16], kk[16], vv[16];
#pragma unroll
    for (int i = 0; i < 16; ++i) { cum[i] = LG[(size_t)i * 1024]; kk[i] = bf2f(KK[(size_t)i * 1024]); vv[i] = bf2f(HV[(size_t)i * 1024]); }
#pragma unroll
    for (int i = 1; i < 16; ++i) cum[i] += cum[i - 1];
    SEG[seg * 128 + col] = cum[15];
    __syncthreads();
    float off = 0.f, tot = 0.f;
#pragma unroll
    for (int s = 0; s < 4; ++s) { const float t = SEG[s * 128 + col]; tot += t; if (s < seg) off += t; }
#pragma unroll
    for (int i = 0; i < 16; ++i) kk[i] *= expf(tot - (cum[i] + off));
    { v4u o; o.x = pk2(kk[0], kk[1]); o.y = pk2(kk[2], kk[3]); o.z = pk2(kk[4], kk[5]); o.w = pk2(kk[6], kk[7]); *(LAS v4u*)(KT + col * 144 + seg * 32) = o;
      o.x = pk2(kk[8], kk[9]); o.y = pk2(kk[10], kk[11]); o.z = pk2(kk[12], kk[13]); o.w = pk2(kk[14], kk[15]); *(LAS v4u*)(KT + col * 144 + seg * 32 + 16) = o;
      o.x = pk2(vv[0], vv[1]); o.y = pk2(vv[2], vv[3]); o.z = pk2(vv[4], vv[5]); o.w = pk2(vv[6], vv[7]); *(LAS v4u*)(VT + col * 144 + seg * 32) = o;
      o.x = pk2(vv[8], vv[9]); o.y = pk2(vv[10], vv[11]); o.z = pk2(vv[12], vv[13]); o.w = pk2(vv[14], vv[15]); *(LAS v4u*)(VT + col * 144 + seg * 32 + 16) = o; }
    if (seg == 0) ((float*)(ws + WS_GAM))[(size_t)c * GAM_N + 16 + 128 * h + col] = expf(tot);
    __syncthreads();
    {
        float* U = (float*)(ws + WS_U) + (size_t)c * STATE_N + ST_HG + (size_t)h * 16384;
        const bf16x8 a0 = ldsfrag(VT, 16 * w + l15, 144, 8 * l4), a1 = ldsfrag(VT, 16 * w + l15, 144, 32 + 8 * l4);
#pragma unroll
        for (int kj = 0; kj < 8; ++kj) {
            f32x4 acc = (f32x4){0.f, 0.f, 0.f, 0.f};
            acc = mfma16(ldsfrag(KT, 16 * kj + l15, 144, 8 * l4), a0, acc); acc = mfma16(ldsfrag(KT, 16 * kj + l15, 144, 32 + 8 * l4), a1, acc);
            *(f32x4*)(U + (16 * w + l15) * 128 + 16 * kj + 4 * l4) = acc;
        }
    }
}

__device__ __forceinline__ void m1_ret(const Ctx& C, int l, int c, int h) {
    unsigned char* ws = C.ws; const int tid = C.tid, lane = C.lane, w = C.wave, r0 = 64 * c, l15 = lane & 15, l4 = lane >> 4;
    LAS unsigned char* KT = C.lds; LAS unsigned char* VT = C.lds + 9216;
    const float lg = ret_lgam(h);
    {   const int kp = tid & 63, s8 = tid >> 6; const bf16* RK = (const bf16*)(ws + WS_RK) + (size_t)(r0 + 8 * s8) * 512 + 64 * h + kp; float v[8];
#pragma unroll
        for (int i = 0; i < 8; ++i) v[i] = bf2f(RK[(size_t)i * 512]) * expf((float)(63 - (8 * s8 + i)) * lg);
        v4u o; o.x = pk2(v[0], v[1]); o.y = pk2(v[2], v[3]); o.z = pk2(v[4], v[5]); o.w = pk2(v[6], v[7]); *(LAS v4u*)(KT + kp * 144 + s8 * 16) = o; }
    {   const int col = tid & 127, seg = tid >> 7; const bf16* RV = (const bf16*)(ws + WS_RV) + (size_t)(r0 + 16 * seg) * 1024 + 128 * h + col; float vv[16];
#pragma unroll
        for (int i = 0; i < 16; ++i) vv[i] = bf2f(RV[(size_t)i * 1024]);
        v4u o; o.x = pk2(vv[0], vv[1]); o.y = pk2(vv[2], vv[3]); o.z = pk2(vv[4], vv[5]); o.w = pk2(vv[6], vv[7]); *(LAS v4u*)(VT + col * 144 + seg * 32) = o;
        o.x = pk2(vv[8], vv[9]); o.y = pk2(vv[10], vv[11]); o.z = pk2(vv[12], vv[13]); o.w = pk2(vv[14], vv[15]); *(LAS v4u*)(VT + col * 144 + seg * 32 + 16) = o; }
    __syncthreads();
    {   float* U = (float*)(ws + WS_U) + (size_t)c * STATE_N + ST_RET + (size_t)h * 8192;
        const bf16x8 a0 = ldsfrag(VT, 16 * w + l15, 144, 8 * l4), a1 = ldsfrag(VT, 16 * w + l15, 144, 32 + 8 * l4);
#pragma unroll
        for (int kj = 0; kj < 4; ++kj) {
            f32x4 acc = (f32x4){0.f, 0.f, 0.f, 0.f};
            acc = mfma16(ldsfrag(KT, 16 * kj + l15, 144, 8 * l4), a0, acc); acc = mfma16(ldsfrag(KT, 16 * kj + l15, 144, 32 + 8 * l4), a1, acc);
            *(f32x4*)(U + (16 * w + l15) * 64 + 16 * kj + 4 * l4) = acc;
        }
    }
}

__device__ __forceinline__ void m1_phase(const Ctx& C0, int l) {
    for (int it = C0.vcu; it < NCH * 18; it += C0.G) {
        Ctx C = C0; { int t_ = C0.tid; asm volatile("" : "+v"(t_)); C.tid = t_; C.lane = t_ & 63; C.wave = __builtin_amdgcn_readfirstlane(t_ >> 6); }
        const int c = it / 18, k = it - 18 * c;
        if (k < 2) m1_ssd(C, l, c, k); else if (k < 10) m1_hg(C, l, c, k - 2); else m1_ret(C, l, c, k - 10);
        __syncthreads();
    }
}

struct StIdx { int kind, h; size_t outoff; int ostride; };
__device__ __forceinline__ void m2_elem(int idx, int& kind, int& h, int& o0, int& ostr) {
    if (idx < ST_HG) { kind = 0; h = idx >> 13; o0 = idx; ostr = 1; }
    else if (idx < ST_RET) { const int r = idx - ST_HG; kind = 1; h = r >> 14; const int v = (r >> 7) & 127, k = r & 127; o0 = h * 16384 + k * 128 + v; ostr = 128; }
    else { const int r = idx - ST_RET; kind = 2; h = r >> 13; const int v = (r >> 6) & 127, kp = r & 63; o0 = h * 8192 + ret_dim(kp) * 128 + v; ostr = 128; }
}
__device__ __forceinline__ void m2_phase(const Ctx& C, int l) {
    AREF A = *C.a; unsigned char* ws = C.ws; float* out = A.out;
    const int gt = C.vcu * NTHR + C.tid, NGT = C.G * NTHR;
    const float* U = (const float*)(ws + WS_U); const float* GAM = (const float*)(ws + WS_GAM); bf16* SB = (bf16*)(ws + WS_SB);
    for (int e4 = gt; e4 < STATE_N / 4; e4 += NGT) {
        const int idx = 4 * e4; int kind, h, o0, ostr; m2_elem(idx, kind, h, o0, ostr);
        const float gret = expf(64.0f * ret_lgam(h));
        const int goff = kind == 0 ? h : 16 + 128 * h + (idx & 127);
        f32x4 S = (f32x4){0.f, 0.f, 0.f, 0.f};
#pragma unroll 4
        for (int c = 0; c < NCHP; ++c) {
            const f32x4 u = *(const f32x4*)(U + (size_t)c * STATE_N + idx);
            f32x4 gm;
            if (kind == 0) { const float t = GAM[(size_t)c * GAM_N + goff]; gm = (f32x4){t, t, t, t}; }
            else if (kind == 1) gm = *(const f32x4*)(GAM + (size_t)c * GAM_N + goff);
            else gm = (f32x4){gret, gret, gret, gret};
            v2u sb; sb.x = pk2(S[0], S[1]); sb.y = pk2(S[2], S[3]); *(v2u*)(SB + (size_t)c * STATE_N + idx) = sb;
            S = S * gm + u;
        }
        float* o = out + (kind == 0 ? O_SSMP + (size_t)l * 131072 : kind == 1 ? O_HGP + (size_t)l * 131072 : O_RETP + (size_t)l * 65536);
        if (kind == 0) *(f32x4*)(o + o0) = S; else { o[o0] = S[0]; o[o0 + ostr] = S[1]; o[o0 + 2 * ostr] = S[2]; o[o0 + 3 * ostr] = S[3]; }
    }
    for (int j = gt; j < 16 * (STATE_N / 4); j += NGT) {
        const int b = j / (STATE_N / 4), idx = 4 * (j - b * (STATE_N / 4)), c = NCHP + b; int kind, h, o0, ostr; m2_elem(idx, kind, h, o0, ostr);
        const float* sin_ = kind == 0 ? A.in[I_SSSM] + ((size_t)l * 16 + b) * 131072 : kind == 1 ? A.in[I_SHG] + ((size_t)l * 16 + b) * 131072 : A.in[I_SRET] + ((size_t)l * 16 + b) * 65536;
        f32x4 S;
        if (kind == 0) S = *(const f32x4*)(sin_ + o0); else S = (f32x4){sin_[o0], sin_[o0 + ostr], sin_[o0 + 2 * ostr], sin_[o0 + 3 * ostr]};
        v2u sb; sb.x = pk2(S[0], S[1]); sb.y = pk2(S[2], S[3]); *(v2u*)(SB + (size_t)c * STATE_N + idx) = sb;
        const f32x4 u = *(const f32x4*)(U + (size_t)c * STATE_N + idx);
        f32x4 gm;
        if (kind == 0) { const float t = GAM[(size_t)c * GAM_N + h]; gm = (f32x4){t, t, t, t}; }
        else if (kind == 1) gm = *(const f32x4*)(GAM + (size_t)c * GAM_N + 16 + 128 * h + (idx & 127));
        else { const float t = expf(64.0f * ret_lgam(h)); gm = (f32x4){t, t, t, t}; }
        S = S * gm + u;
        float* o = out + (kind == 0 ? O_SSMS + ((size_t)l * 16 + b) * 131072 : kind == 1 ? O_HGS + ((size_t)l * 16 + b) * 131072 : O_RETS + ((size_t)l * 16 + b) * 65536);
        if (kind == 0) *(f32x4*)(o + o0) = S; else { o[o0] = S[0]; o[o0 + ostr] = S[1]; o[o0 + 2 * ostr] = S[2]; o[o0 + 3 * ostr] = S[3]; }
    }
    const bf16* XBC = (const bf16*)(ws + WS_XBC);
    for (int i = gt; i < 17 * 4608; i += NGT) {
        const int s = i / 4608, r = i - s * 4608, jrow = r / 1536, ch = r - jrow * 1536;
        if (s == 0) out[O_CONVP + (size_t)l * 4608 + r] = bf2f(XBC[(size_t)(ROW_S0 - 3 + jrow) * 1536 + ch]);
        else out[O_CONVS + ((size_t)l * 16 + (s - 1)) * 4608 + r] = bf2f(XBC[(size_t)(ROW_S0 + 64 * (s - 1) + 61 + jrow) * 1536 + ch]);
    }
}

__device__ __forceinline__ v2u pk4(const f32x4 v) { v2u w; w.x = pk2(v[0], v[1]); w.y = pk2(v[2], v[3]); return w; }

__device__ __forceinline__ void m3_ssd(const Ctx& C, int l, int c, int g) {
    AREF A = *C.a; unsigned char* ws = C.ws; const int tid = C.tid, lane = C.lane, w = C.wave, r0 = 64 * c, l15 = lane & 15, l4 = lane >> 4;
    LAS unsigned char* XT = C.lds; LAS unsigned char* BM = C.lds + 73728; LAS unsigned char* CM = C.lds + 91136;
    LAS float* CBS = (LAS float*)(C.lds + 108544); LAS float* SDT = (LAS float*)(C.lds + 125952); LAS float* SCUM = (LAS float*)(C.lds + 128000); LAS float* SSQ = (LAS float*)(C.lds + 130048);
    { const int row = tid >> 3, hh = tid & 7; SDT[tid] = ((const float*)(ws + WS_DT))[(r0 + row) * 16 + 8 * g + hh]; SCUM[tid] = ((const float*)(ws + WS_CUM))[(r0 + row) * 16 + 8 * g + hh]; }
    const ConvSrc cs{(const bf16*)(ws + WS_XBC), A.in[I_SCONV] + (size_t)l * 16 * 3 * 1536, c, r0};
    const float* cw = A.in[I_CONVW] + (size_t)l * 4 * 1536; const float* cb = A.in[I_CONVB] + (size_t)l * 1536;
    {
        const int ch = 512 * g + tid;
        const float w0 = cw[ch], w1 = cw[1536 + ch], w2 = cw[2 * 1536 + ch], w3 = cw[3 * 1536 + ch], bias = cb[ch];
        float p3 = cs.at(-3, ch), p2 = cs.at(-2, ch), p1 = cs.at(-1, ch);
#pragma unroll 1
        for (int t0 = 0; t0 < 64; t0 += 8) {
            float val[8];
#pragma unroll
            for (int tt = 0; tt < 8; ++tt) { const float cur = cs.at(t0 + tt, ch); val[tt] = fsilu(bias + w0 * p3 + w1 * p2 + w2 * p1 + w3 * cur); p3 = p2; p2 = p1; p1 = cur; }
            v4u o; o.x = pk2(val[0], val[1]); o.y = pk2(val[2], val[3]); o.z = pk2(val[4], val[5]); o.w = pk2(val[6], val[7]);
            *(LAS v4u*)(XT + tid * 144 + t0 * 2) = o;
        }
    }
    {
        const int col = tid & 255, seg = tid >> 8, t0 = 32 * seg, ch = col < 128 ? 1024 + 128 * g + col : 1280 + 128 * g + (col - 128);
        LAS unsigned char* dst = (col < 128 ? BM : CM) + (col & 127) * 2;
        const float w0 = cw[ch], w1 = cw[1536 + ch], w2 = cw[2 * 1536 + ch], w3 = cw[3 * 1536 + ch], bias = cb[ch];
        float p3 = cs.at(t0 - 3, ch), p2 = cs.at(t0 - 2, ch), p1 = cs.at(t0 - 1, ch);
#pragma unroll 8
        for (int tt = 0; tt < 32; ++tt) { const float cur = cs.at(t0 + tt, ch); *(LAS bf16*)(dst + (t0 + tt) * 272) = (bf16)f2bf(fsilu(bias + w0 * p3 + w1 * p2 + w2 * p1 + w3 * cur)); p3 = p2; p2 = p1; p1 = cur; }
    }
    __syncthreads();
    {
        const int i = w >> 1;
#pragma unroll
        for (int jj = 0; jj < 2; ++jj) { const int j = 2 * (w & 1) + jj;
            if (j <= i) { f32x4 acc = (f32x4){0.f, 0.f, 0.f, 0.f};
#pragma unroll
                for (int ks = 0; ks < 4; ++ks) acc = mfma16(ldsfrag(BM, 16 * j + l15, 272, 32 * ks + 8 * l4), ldsfrag(CM, 16 * i + l15, 272, 32 * ks + 8 * l4), acc);
                *(LAS f32x4*)(CBS + (16 * i + l15) * 68 + 16 * j + 4 * l4) = acc; } }
    }
    __syncthreads();
    const int hd = 8 * g + w; const float dskip = A.in[I_DSKIP][l * 16 + hd];
    const bf16* SB = (const bf16*)(ws + WS_SB) + (size_t)c * STATE_N + ST_SSD + (size_t)hd * 8192;
    const bf16* ZS = (const bf16*)(ws + WS_ZS) + (size_t)r0 * 1024 + 512 * g + 64 * w;
    v2u Y[4][4]; float ssq[4];
#pragma unroll
    for (int i = 0; i < 4; ++i) {
        const int t = 16 * i + l15; const float ct = SCUM[t * 8 + w], ec = expf(ct);
        bf16x8 att[2];
#pragma unroll
        for (int ks = 0; ks < 2; ++ks) {
            if (ks == 1 && i < 2) { att[ks] = (bf16x8){0, 0, 0, 0, 0, 0, 0, 0}; continue; }
            float v[8];
#pragma unroll
            for (int jj = 0; jj < 8; ++jj) { const int s = 32 * ks + 8 * l4 + jj; const float x = CBS[t * 68 + s] * (expf(ct - SCUM[s * 8 + w]) * SDT[s * 8 + w]); v[jj] = s <= t ? x : 0.f; }
            v4u o; o.x = pk2(v[0], v[1]); o.y = pk2(v[2], v[3]); o.z = pk2(v[4], v[5]); o.w = pk2(v[6], v[7]); att[ks] = __builtin_bit_cast(bf16x8, o);
        }
        bf16x8 cf[4];
#pragma unroll
        for (int ks = 0; ks < 4; ++ks) cf[ks] = ldsfrag(CM, t, 272, 32 * ks + 8 * l4);
        ssq[i] = 0.f;
#pragma unroll
        for (int pb = 0; pb < 4; ++pb) {
            f32x4 yi = (f32x4){0.f, 0.f, 0.f, 0.f}, yn = (f32x4){0.f, 0.f, 0.f, 0.f};
            yi = mfma16(ldsfrag(XT, 64 * w + 16 * pb + l15, 144, 8 * l4), att[0], yi);
            if (i >= 2) yi = mfma16(ldsfrag(XT, 64 * w + 16 * pb + l15, 144, 32 + 8 * l4), att[1], yi);
#pragma unroll
            for (int ks = 0; ks < 4; ++ks) yn = mfma16(*(const bf16x8*)(SB + (unsigned)((16 * pb + l15) * 128 + 32 * ks + 8 * l4)), cf[ks], yn);
            const int p0 = 16 * pb + 4 * l4;
            const v2u zz = *(const v2u*)(ZS + (unsigned)(t * 1024 + p0));
            const float z[4] = {bflo(zz.x), bfhi(zz.x), bflo(zz.y), bfhi(zz.y)};
            f32x4 y;
#pragma unroll
            for (int e = 0; e < 4; ++e) { y[e] = (yi[e] + ec * yn[e] + dskip * bf2f(*(const LAS bf16*)(XT + (64 * w + p0 + e) * 144 + t * 2))) * z[e]; ssq[i] += y[e] * y[e]; }
            Y[i][pb] = pk4(y);
            __builtin_amdgcn_sched_barrier(0);
        }
    }
#pragma unroll
    for (int i = 0; i < 4; ++i) { float s = ssq[i]; s += __shfl_xor(s, 16); s += __shfl_xor(s, 32); if (l4 == 0) SSQ[w * 64 + 16 * i + l15] = s; }
    __syncthreads();
    {   const float* gn = A.in[I_SSDN] + (size_t)l * 1024 + 512 * g + 64 * w; bf16* BR = (bf16*)(ws + WS_BR) + (size_t)r0 * 1024 + 512 * g + 64 * w;
#pragma unroll
        for (int i = 0; i < 4; ++i) { const int t = 16 * i + l15; float tot = 0.f;
#pragma unroll
            for (int ww = 0; ww < 8; ++ww) tot += SSQ[ww * 64 + t];
            const float rs = rsqrtf(tot * (1.0f / 512.0f) + EPS);
#pragma unroll
            for (int pb = 0; pb < 4; ++pb) { const int p0 = 16 * pb + 4 * l4; const f32x4 gv = *(const f32x4*)(gn + p0); const v2u yy = Y[i][pb]; const f32x4 yf = (f32x4){bflo(yy.x), bfhi(yy.x), bflo(yy.y), bfhi(yy.y)}; *(v2u*)(BR + (unsigned)(t * 1024 + p0)) = pk4(yf * rs * gv); } }
    }
}

__device__ __forceinline__ void m3_hg(const Ctx& C, int l, int c, int h) {
    AREF A = *C.a; unsigned char* ws = C.ws; const int tid = C.tid, lane = C.lane, w = C.wave, r0 = 64 * c, l15 = lane & 15, l4 = lane >> 4;
    LAS unsigned char* QT = C.lds; LAS unsigned char* KT = C.lds + 17408; LAS unsigned char* QH = C.lds + 34816; LAS unsigned char* VT = C.lds + 52224; LAS unsigned char* ATT = C.lds + 70656;
    LAS float* SEG = (LAS float*)(C.lds + 79872); LAS float* SSQ = (LAS float*)(C.lds + 81920);
    {
        const int col = tid & 127, seg = tid >> 7; const size_t base = (size_t)(r0 + 16 * seg) * 1024 + 128 * h + col;
        const float* LG = (const float*)(ws + WS_LG) + base; const bf16* KK = (const bf16*)(ws + WS_KK) + base; const bf16* HV = (const bf16*)(ws + WS_HV) + base; const bf16* HQ = (const bf16*)(ws + WS_HQ) + base;
        float cum[16], kk[16], vv[16], qq[16];
#pragma unroll
        for (int i = 0; i < 16; ++i) { cum[i] = LG[i * 1024]; kk[i] = bf2f(KK[i * 1024]); vv[i] = bf2f(HV[i * 1024]); qq[i] = bf2f(HQ[i * 1024]); }
#pragma unroll
        for (int i = 1; i < 16; ++i) cum[i] += cum[i - 1];
        SEG[seg * 128 + col] = cum[15];
        __syncthreads();
        float off = 0.f;
#pragma unroll
        for (int s = 0; s < 4; ++s) { if (s < seg) off += SEG[s * 128 + col]; }
        const float R = SEG[col] + SEG[128 + col];
#pragma unroll
        for (int i = 0; i < 16; ++i) { const float cu = cum[i] + off; const int row = 16 * seg + i;
            *(LAS bf16*)(QT + row * 272 + col * 2) = (bf16)f2bf(qq[i] * expf(fminf(cu - R, 80.f)));
            *(LAS bf16*)(KT + row * 272 + col * 2) = (bf16)f2bf(kk[i] * expf(fminf(R - cu, 80.f)));
            *(LAS bf16*)(QH + row * 272 + col * 2) = (bf16)f2bf(qq[i] * expf(cu)); }
        v4u o; o.x = pk2(vv[0], vv[1]); o.y = pk2(vv[2], vv[3]); o.z = pk2(vv[4], vv[5]); o.w = pk2(vv[6], vv[7]); *(LAS v4u*)(VT + col * 144 + seg * 32) = o;
        o.x = pk2(vv[8], vv[9]); o.y = pk2(vv[10], vv[11]); o.z = pk2(vv[12], vv[13]); o.w = pk2(vv[14], vv[15]); *(LAS v4u*)(VT + col * 144 + seg * 32 + 16) = o;
    }
    __syncthreads();
    const int i = w >> 1, t = 16 * i + l15;
#pragma unroll
    for (int jj = 0; jj < 2; ++jj) { const int j = 2 * (w & 1) + jj; f32x4 acc = (f32x4){0.f, 0.f, 0.f, 0.f};
        if (j <= i) {
#pragma unroll
            for (int ks = 0; ks < 4; ++ks) acc = mfma16(ldsfrag(KT, 16 * j + l15, 272, 32 * ks + 8 * l4), ldsfrag(QT, t, 272, 32 * ks + 8 * l4), acc); }
#pragma unroll
        for (int e = 0; e < 4; ++e) { const int s = 16 * j + 4 * l4 + e; acc[e] = (j <= i && s <= t) ? acc[e] : 0.f; }
        *(LAS v2u*)(ATT + t * 144 + (16 * j + 4 * l4) * 2) = pk4(acc); }
    __syncthreads();
    const bf16* SB = (const bf16*)(ws + WS_SB) + (size_t)c * STATE_N + ST_HG + (size_t)h * 16384;
    f32x4 O[4]; float ssq = 0.f;
#pragma unroll
    for (int b4 = 0; b4 < 4; ++b4) { const int vb = 4 * (w & 1) + b4; f32x4 acc = (f32x4){0.f, 0.f, 0.f, 0.f};
        acc = mfma16(ldsfrag(VT, 16 * vb + l15, 144, 8 * l4), ldsfrag(ATT, t, 144, 8 * l4), acc);
        if (i >= 2) acc = mfma16(ldsfrag(VT, 16 * vb + l15, 144, 32 + 8 * l4), ldsfrag(ATT, t, 144, 32 + 8 * l4), acc);
#pragma unroll
        for (int ks = 0; ks < 4; ++ks) acc = mfma16(*(const bf16x8*)(SB + (unsigned)((16 * vb + l15) * 128 + 32 * ks + 8 * l4)), ldsfrag(QH, t, 272, 32 * ks + 8 * l4), acc);
        O[b4] = acc; ssq += (acc[0] * acc[0] + acc[1] * acc[1]) + (acc[2] * acc[2] + acc[3] * acc[3]); }
    ssq += __shfl_xor(ssq, 16); ssq += __shfl_xor(ssq, 32); if (l4 == 0) SSQ[(w & 1) * 64 + t] = ssq;
    __syncthreads();
    {   const float* gn = A.in[I_HGN] + (size_t)l * 1024 + 128 * h; const bf16* HG = (const bf16*)(ws + WS_HG) + (size_t)r0 * 1024 + 128 * h; bf16* BR = (bf16*)(ws + WS_BR) + ((size_t)MP + r0) * 1024 + 128 * h;
        const float rs = rsqrtf((SSQ[t] + SSQ[64 + t]) * (1.0f / 128.0f) + EPS);
#pragma unroll
        for (int b4 = 0; b4 < 4; ++b4) { const int v0 = 16 * (4 * (w & 1) + b4) + 4 * l4; const v2u gg = *(const v2u*)(HG + (unsigned)(t * 1024 + v0)); const f32x4 gv = *(const f32x4*)(gn + v0);
            const f32x4 gt = (f32x4){bflo(gg.x), bfhi(gg.x), bflo(gg.y), bfhi(gg.y)};
            *(v2u*)(BR + (unsigned)(t * 1024 + v0)) = pk4(O[b4] * rs * gv * gt); }
    }
}

__device__ __forceinline__ void m3_ret(const Ctx& C, int l, int c, int h) {
    unsigned char* ws = C.ws; const int tid = C.tid, lane = C.lane, w = C.wave, r0 = 64 * c, l15 = lane & 15, l4 = lane >> 4;
    LAS unsigned char* VT = C.lds; LAS unsigned char* ATT = C.lds + 18432; LAS float* SSQ = (LAS float*)(C.lds + 27648);
    const float lg = ret_lgam(h);
    {   const int col = tid & 127, seg = tid >> 7; const bf16* RV = (const bf16*)(ws + WS_RV) + (size_t)(r0 + 16 * seg) * 1024 + 128 * h + col; float vv[16];
#pragma unroll
        for (int i = 0; i < 16; ++i) vv[i] = bf2f(RV[i * 1024]);
        v4u o; o.x = pk2(vv[0], vv[1]); o.y = pk2(vv[2], vv[3]); o.z = pk2(vv[4], vv[5]); o.w = pk2(vv[6], vv[7]); *(LAS v4u*)(VT + col * 144 + seg * 32) = o;
        o.x = pk2(vv[8], vv[9]); o.y = pk2(vv[10], vv[11]); o.z = pk2(vv[12], vv[13]); o.w = pk2(vv[14], vv[15]); *(LAS v4u*)(VT + col * 144 + seg * 32 + 16) = o; }
    const int i = w >> 1, t = 16 * i + l15;
    const bf16* RQ = (const bf16*)(ws + WS_RQ) + (size_t)r0 * 512 + 64 * h; const bf16* RK = (const bf16*)(ws + WS_RK) + (size_t)r0 * 512 + 64 * h;
    const bf16x8 q0 = *(const bf16x8*)(RQ + (unsigned)(t * 512 + 8 * l4)), q1 = *(const bf16x8*)(RQ + (unsigned)(t * 512 + 32 + 8 * l4));
#pragma unroll
    for (int jj = 0; jj < 2; ++jj) { const int j = 2 * (w & 1) + jj; f32x4 acc = (f32x4){0.f, 0.f, 0.f, 0.f};
        if (j <= i) { acc = mfma16(*(const bf16x8*)(RK + (unsigned)((16 * j + l15) * 512 + 8 * l4)), q0, acc); acc = mfma16(*(const bf16x8*)(RK + (unsigned)((16 * j + l15) * 512 + 32 + 8 * l4)), q1, acc); }
#pragma unroll
        for (int e = 0; e < 4; ++e) { const int s = 16 * j + 4 * l4 + e; acc[e] = (j <= i && s <= t) ? acc[e] * expf((float)(t - s) * lg) : 0.f; }
        *(LAS v2u*)(ATT + t * 144 + (16 * j + 4 * l4) * 2) = pk4(acc); }
    __syncthreads();
    const bf16* SB = (const bf16*)(ws + WS_SB) + (size_t)c * STATE_N + ST_RET + (size_t)h * 8192;
    const float inner = expf((float)(t + 1) * lg);
    f32x4 O[4]; float ssq = 0.f;
#pragma unroll
    for (int b4 = 0; b4 < 4; ++b4) { const int vb = 4 * (w & 1) + b4; f32x4 acc = (f32x4){0.f, 0.f, 0.f, 0.f}, acs = (f32x4){0.f, 0.f, 0.f, 0.f};
        acc = mfma16(ldsfrag(VT, 16 * vb + l15, 144, 8 * l4), ldsfrag(ATT, t, 144, 8 * l4), acc);
        if (i >= 2) acc = mfma16(ldsfrag(VT, 16 * vb + l15, 144, 32 + 8 * l4), ldsfrag(ATT, t, 144, 32 + 8 * l4), acc);
        acs = mfma16(*(const bf16x8*)(SB + (unsigned)((16 * vb + l15) * 64 + 8 * l4)), q0, acs); acs = mfma16(*(const bf16x8*)(SB + (unsigned)((16 * vb + l15) * 64 + 32 + 8 * l4)), q1, acs);
        acc = acc + acs * inner;
        O[b4] = acc; ssq += (acc[0] * acc[0] + acc[1] * acc[1]) + (acc[2] * acc[2] + acc[3] * acc[3]); }
    ssq += __shfl_xor(ssq, 16); ssq += __shfl_xor(ssq, 32); if (l4 == 0) SSQ[(w & 1) * 64 + t] = ssq;
    __syncthreads();
    {   const bf16* RG = (const bf16*)(ws + WS_RG) + (size_t)r0 * 1024 + 128 * h; bf16* BR = (bf16*)(ws + WS_BR) + ((size_t)2 * MP + r0) * 1024 + 128 * h;
        const float rs = rsqrtf((SSQ[t] + SSQ[64 + t]) * (1.0f / 128.0f) + EPS);
#pragma unroll
        for (int b4 = 0; b4 < 4; ++b4) { const int v0 = 16 * (4 * (w & 1) + b4) + 4 * l4; const v2u gg = *(const v2u*)(RG + (unsigned)(t * 1024 + v0));
            const f32x4 gt = (f32x4){bflo(gg.x), bfhi(gg.x), bflo(gg.y), bfhi(gg.y)};
            *(v2u*)(BR + (unsigned)(t * 1024 + v0)) = pk4(O[b4] * rs * gt); }
    }
}

__device__ __forceinline__ void m3_phase(const Ctx& C0, int l) {
    for (int it = C0.vcu; it < NCH * 18; it += C0.G) {
        Ctx C = C0; { int t_ = C0.tid; asm volatile("" : "+v"(t_)); C.tid = t_; C.lane = t_ & 63; C.wave = __builtin_amdgcn_readfirstlane(t_ >> 6); }
        const int c = it / 18, k = it - 18 * c;
        if (k < 2) m3_ssd(C, l, c, k); else if (k < 10) m3_hg(C, l, c, k - 2); else m3_ret(C, l, c, k - 10);
        __syncthreads();
    }
}

enum { PH_NORM1 = 0, PH_GEMM1, PH_M1, PH_M2, PH_M3, PH_GEMM2, PH_GEMM3, PH_NORM2, PH_GU, PH_DOWN, PH_N };

__global__ void __launch_bounds__(NTHR, 2) trunk_fwd(Args args) {
    extern __shared__ __attribute__((aligned(16))) unsigned char lds_raw[];
    Ctx C; C.lds = (LAS unsigned char*)lds_raw; C.tid = threadIdx.x; C.lane = C.tid & 63; C.wave = __builtin_amdgcn_readfirstlane(C.tid >> 6);
    const int wave0 = C.wave;
    C.G = gridDim.x; { const int bx = blockIdx.x; C.vcu = (C.G % 8 == 0) ? (bx % 8) * (C.G / 8) + bx / 8 : bx; }
    ArgsP ap = (ArgsP)__builtin_amdgcn_kernarg_segment_ptr();
    C.a = ap; C.ws = ap->ws;
    unsigned char* ws = ap->ws; const int use_bar = ap->use_bar;
    for (int u = C.tid; u < (LDS_BYTES - LDSCTL_OFF) / 4; u += NTHR) ((LAS unsigned*)(C.lds + LDSCTL_OFF))[u] = 0u;
    __syncthreads();
    XcdBarrier bar; bar.bar = (unsigned*)(ws + WS_CTL) + CW_BAR; bar.x = 0; bar.st = nullptr;
    if (use_bar) bar = xcd_barrier_post((unsigned*)(ws + WS_CTL) + CW_BAR, (volatile LAS unsigned*)(C.lds + LDSCTL_OFF));
#define GRID_BAR() do { if (use_bar) { bar.bar = (unsigned*)(ws + WS_CTL) + CW_BAR; xcd_barrier(bar); } } while (0)
#define FRESH() do { int w0_ = wave0; asm volatile("" : "+s"(w0_)); int t_ = w0_ * 64 + (int)__builtin_amdgcn_mbcnt_hi(~0u, __builtin_amdgcn_mbcnt_lo(~0u, 0u)); asm volatile("" : "+v"(t_)); C.tid = t_; C.lane = t_ & 63; C.wave = __builtin_amdgcn_readfirstlane(t_ >> 6); \
        int g_ = gridDim.x; asm volatile("" : "+s"(g_)); C.G = g_; int b_ = blockIdx.x; asm volatile("" : "+s"(b_)); bx = b_; C.vcu = (C.G % 8 == 0) ? (b_ % 8) * (C.G / 8) + b_ / 8 : b_; \
        ArgsP a_ = (ArgsP)__builtin_amdgcn_kernarg_segment_ptr(); asm volatile("" : "+s"(a_)); ap = a_; C.a = a_; unsigned char* w_ = a_->ws; ws = w_; C.ws = w_; X = (float*)(ws + WS_X); H = (bf16*)(ws + WS_H); lw = ws + WS_W + (size_t)l * LW_SIZE; } while (0)
#define IN(k) (ap->ph_lo <= (k) && (k) < ap->ph_hi)

    if (ap->do_pro) { p0_prologue(C); GRID_BAR(); }

    float* X = (float*)(ws + WS_X); bf16* H = (bf16*)(ws + WS_H); int bx = blockIdx.x; unsigned char* lw = ws;
    const int l_hi = ap->l_hi;
    for (int l = ap->l_lo; l < l_hi; ++l) {
        if (IN(PH_NORM1)) { asm volatile("; MARK_PH_NORM1"); FRESH(); norm_phase(C, X, ap->in[I_NMIX] + (size_t)l * D, H); GRID_BAR(); }
        if (IN(PH_GEMM1)) { asm volatile("; MARK_PH_GEMM1"); FRESH();
            pg8::Gemm g{H, (const bf16*)(lw + LW_IN), MP, NPROJ, D, 0, 0}; pg8::StaticOrder S; S.init(MP, NPROJ, C.G, bx);
            EpiProj E{ws, l};
            pg8::gemm_phase<EpiProj, pg8::StaticOrder, true, true>(C.lds, g, S, E, C.tid);
            GRID_BAR();
        }
        if (IN(PH_M1)) { asm volatile("; MARK_PH_M1"); FRESH(); m1_phase(C, l); GRID_BAR(); }
        if (IN(PH_M2)) { asm volatile("; MARK_PH_M2"); FRESH(); m2_phase(C, l); GRID_BAR(); }
        if (IN(PH_M3)) { asm volatile("; MARK_PH_M3"); FRESH(); m3_phase(C, l); GRID_BAR(); }
        if (IN(PH_GEMM2)) { asm volatile("; MARK_PH_GEMM2"); FRESH();
            pg8::Gemm g{(const bf16*)(ws + WS_BR), (const bf16*)(lw + LW_BR), MP, D, 1024, (size_t)MP * 1024 * 2, (size_t)D * 1024 * 2}; BranchOrder S; S.init(MP, D, C.G, bx);
            EpiBranch E{(float*)(ws + WS_TMP), (bf16*)(ws + WS_MIX), (const bf16*)(ws + WS_GT)};
            pg8::gemm_phase<EpiBranch, BranchOrder, true, true>(C.lds, g, S, E, C.tid);
            GRID_BAR();
        }
        if (IN(PH_GEMM3)) { asm volatile("; MARK_PH_GEMM3"); FRESH();
            pg8::Gemm g{(const bf16*)(ws + WS_MIX), (const bf16*)(lw + LW_OUT), MP, D, D, 0, 0}; pg8::StaticOrder S; S.init(MP, D, C.G, bx);
            EpiResid E{X};
            pg8::gemm_phase<EpiResid, pg8::StaticOrder, true, true>(C.lds, g, S, E, C.tid);
            GRID_BAR();
        }
        if (IN(PH_NORM2)) { asm volatile("; MARK_PH_NORM2"); FRESH(); norm_phase(C, X, ap->in[I_NFFN] + (size_t)l * D, H); GRID_BAR(); }
        if (IN(PH_GU)) { asm volatile("; MARK_PH_GU"); FRESH();
            pg8::Gemm g{H, (const bf16*)(lw + LW_GU), MP, 2 * FFN, D, 0, 0}; pg8::StaticOrder S; S.init(MP, 2 * FFN, C.G, bx);
            EpiSwiglu E{(bf16*)(ws + WS_HID)};
            pg8::gemm_phase<EpiSwiglu, pg8::StaticOrder, true, true>(C.lds, g, S, E, C.tid);
            GRID_BAR();
        }
        if (IN(PH_DOWN)) { asm volatile("; MARK_PH_DOWN"); FRESH();
            pg8::Gemm g{(const bf16*)(ws + WS_HID), (const bf16*)(lw + LW_DN), MP, D, FFN, 0, 0}; pg8::StaticOrder S; S.init(MP, D, C.G, bx);
            EpiResid E{X};
            pg8::gemm_phase<EpiResid, pg8::StaticOrder, true, true>(C.lds, g, S, E, C.tid);
            GRID_BAR();
        }
    }
    if (ap->do_fin) { const int l = 0; FRESH(); final_phase(C, X, ap->in[I_NFIN], ap->out); }
#undef IN
#undef GRID_BAR
#undef FRESH
}


__global__ void probe_dump(const unsigned short* src, size_t n_src, float* out, size_t n_out) {
    for (size_t i = (size_t)blockIdx.x * blockDim.x + threadIdx.x; i < n_out; i += (size_t)gridDim.x * blockDim.x) {
        const size_t j = (i * 4 + (i & 3)) % n_src; out[i] = __builtin_bit_cast(float, ((unsigned)src[j]) << 16) * 1e-3f + 1.0f; }
}
#ifndef MK_REPS
#define MK_REPS 1
#endif
#ifndef MK_ONE_LAUNCH
#define MK_ONE_LAUNCH 1
#endif
extern "C" void kernel_launch(void* const* d_in, const int* in_sizes, int n_in, void* d_out, int out_size, void* d_ws, size_t ws_size, hipStream_t stream) {
    static int grid = 0;
    if (grid == 0) {
        if (n_in != 24 || (size_t)out_size != O_END || ws_size < WS_END) { fprintf(stderr, "kernel_launch: unexpected shapes (n_in %d, out %d, ws %zu, need %zu)\n", n_in, out_size, ws_size, (size_t)WS_END); grid = -1; return; }
        int dev = 0, cus = 0, per_cu = 0;
        if (hipGetDevice(&dev) != hipSuccess || hipDeviceGetAttribute(&cus, hipDeviceAttributeMultiprocessorCount, dev) != hipSuccess) { grid = -1; return; }
        if (hipFuncSetAttribute((const void*)trunk_fwd, hipFuncAttributeMaxDynamicSharedMemorySize, LDS_BYTES) != hipSuccess) { fprintf(stderr, "kernel_launch: hipFuncSetAttribute failed\n"); grid = -1; return; }
        if (hipOccupancyMaxActiveBlocksPerMultiprocessor(&per_cu, (const void*)trunk_fwd, NTHR, LDS_BYTES) != hipSuccess || per_cu < 1) fprintf(stderr, "kernel_launch: occupancy query reports %d\n", per_cu);
        (void)hipGetLastError();
        grid = cus;
    }
    if (grid < 0) return;
    (void)hipMemsetAsync((char*)d_ws + WS_CTL, 0, CTL_ZERO_BYTES, stream);
    Args a{};
    for (int i = 0; i < 24; ++i) a.in[i] = (const float*)d_in[i];
    a.out = (float*)d_out; a.ws = (unsigned char*)d_ws;
#if MK_ONE_LAUNCH
    a.l_lo = 0; a.l_hi = NL; a.ph_lo = 0; a.ph_hi = PH_N; a.do_pro = 1; a.do_fin = 1; a.use_bar = 1; a.pad = 0;
    hipLaunchKernelGGL(trunk_fwd, dim3(grid), dim3(NTHR), LDS_BYTES, stream, a);
#else
    for (int rep = 0; rep < MK_REPS; ++rep) {
    a.use_bar = 0; a.pad = 0;
    a.l_lo = 0; a.l_hi = 0; a.ph_lo = 0; a.ph_hi = 0; a.do_pro = 1; a.do_fin = 0;
    hipLaunchKernelGGL(trunk_fwd, dim3(grid), dim3(NTHR), LDS_BYTES, stream, a);
    a.do_pro = 0;
#ifdef PROBE_NPH
    { int cnt = 0; for (int l = 0; l < NL && cnt < PROBE_NPH; ++l) for (int ph = 0; ph < PH_N && cnt < PROBE_NPH; ++ph, ++cnt) { a.l_lo = l; a.l_hi = l + 1; a.ph_lo = ph; a.ph_hi = ph + 1; hipLaunchKernelGGL(trunk_fwd, dim3(grid), dim3(NTHR), LDS_BYTES, stream, a); } }
    probe_dump<<<2048, 256, 0, stream>>>((const unsigned short*)((char*)d_ws + PROBE_LO), (size_t)(PROBE_HI - PROBE_LO) / 2, (float*)d_out, (size_t)O_END);
    return;
#endif
    for (int l = 0; l < NL; ++l) for (int ph = 0; ph < PH_N; ++ph) { a.l_lo = l; a.l_hi = l + 1; a.ph_lo = ph; a.ph_hi = ph + 1; hipLaunchKernelGGL(trunk_fwd, dim3(grid), dim3(NTHR), LDS_BYTES, stream, a); }
    a.l_lo = 0; a.l_hi = 0; a.ph_lo = 0; a.ph_hi = 0; a.do_fin = 1;
    hipLaunchKernelGGL(trunk_fwd, dim3(grid), dim3(NTHR), LDS_BYTES, stream, a);
    }
#endif
    const hipError_t le = hipPeekAtLastError();
    if (le != hipSuccess) fprintf(stderr, "kernel_launch: launch failed: %s\n", hipGetErrorName(le));
}
```

```cpp
#include <hip/hip_runtime.h>
#include <cstdio>
#include <cstdint>
#ifndef PG8_WGM
#define PG8_WGM 8
#endif
namespace pg8 {
#define PG8_LAS __attribute__((address_space(3)))
typedef unsigned short bf16_t;
typedef short bf16x8 __attribute__((ext_vector_type(8)));
typedef float f32x4 __attribute__((ext_vector_type(4)));
typedef unsigned u32x4 __attribute__((ext_vector_type(4)));
constexpr int BM = 256, BK = 64, HALF = 128, HTB = HALF * BK * 2  , STAGE_BYTES = 8 * HTB, NXCD = 8, WGM = PG8_WGM;

__host__ __device__ __forceinline__ int lds_byte(int r, int c) { const int st = (r >> 4) * 2 + (c >> 5), rr = r & 15, cc = c & 31, ob = rr * 64 + cc * 2; return st * 1024 + (ob ^ (((ob >> 9) & 1) << 5)); }
__host__ __device__ __forceinline__ void stage_rc(int b, int& R, int& C) { const int st = b / 1024, sb = b % 1024, swz = sb ^ (((sb >> 9) & 1) << 5); R = (st >> 1) * 16 + swz / 64; C = (st & 1) * 32 + (swz % 64) / 2; }
__host__ __device__ __forceinline__ int perm32(int rho) { const int n = rho >> 4, i = rho & 15; return 8 * (i >> 2) + 4 * n + (i & 3); }

struct Unit { int pm, pn, pc; };
struct Gemm { const bf16_t* A; const bf16_t* Bt; int M, N, K; size_t csA, csB; };

struct StaticOrder {
    int nM, nN, nwg, G, c;
    __host__ __device__ void init(int M, int N, int G_, int c_) { nM = M / BM; nN = N / BM; nwg = nM * nN; G = G_; c = c_; }
    __host__ __device__ bool next(int i, Unit& u) const {
        const long L = (long)i * G + c; if (L >= nwg) return false;
        int wgid = (int)L; { const int q = nwg / NXCD, r = nwg % NXCD, xcd = wgid % NXCD, off = wgid / NXCD; wgid = (xcd < r ? xcd * (q + 1) : r * (q + 1) + (xcd - r) * q) + off; }
        const int nig = WGM * nN, gid = wgid / nig, fm = gid * WGM, gsz = (nM - fm) < WGM ? (nM - fm) : WGM;
        u.pm = fm + ((wgid % nig) % gsz); u.pn = (wgid % nig) / gsz; u.pc = 0; return true;
    }
    __device__ __forceinline__ void a_ready(const Unit&) const {}
    __device__ __forceinline__ void done(const Unit&) const {}
};

__device__ __forceinline__ unsigned cvt_pk_bf16(float lo, float hi) { unsigned r; asm volatile("v_cvt_pk_bf16_f32 %0, %1, %2" : "=v"(r) : "v"(lo), "v"(hi)); return r; }

template <class Epi, class Sched, bool ALIGN_EPI = false, bool SP2 = false>
__device__ __forceinline__ void gemm_phase(PG8_LAS unsigned char* lds, const Gemm g, const Sched& S, const Epi& E, const int tid) {
    const int wid = __builtin_amdgcn_readfirstlane(tid >> 6), lane = tid & 63, wr = wid >> 2, wc = wid & 3, fr = lane & 15, fq = lane >> 4;
    const int K = g.K, nt = K / BK;
    unsigned voffA[2], voffB[2];
#pragma unroll
    for (int i = 0; i < 2; ++i) { int R, C; stage_rc(tid * 16 + i * 8192, R, C); const int Rb = Epi::PERM ? ((R & ~31) + perm32(R & 31)) : R;
        voffA[i] = (unsigned)(R * K + C) * 2u; voffB[i] = (unsigned)(Rb * K + C) * 2u; }
    const size_t kstep = (size_t)(BK * 2);
    const size_t hstep = (size_t)HALF * K * 2;
    const size_t tstep = 2 * hstep;
    const unsigned ldsw = (unsigned)wid * 1024u;
    const int aoff = lds_byte(wr * 64 + fr, fq * 8), boff = lds_byte(wc * 32 + fr, fq * 8);
#define PG8_SA(b, h) (((b) * 2 + (h)) * HTB)
#define PG8_SB(b, h) ((4 + (b) * 2 + (h)) * HTB)
#define PG8_STAGE(bufoff, gbase, voff) do { _Pragma("unroll") for (int _i = 0; _i < 2; ++_i) \
        __builtin_amdgcn_global_load_lds((const unsigned*)((const char*)(gbase) + (voff)[_i]), (PG8_LAS unsigned*)(lds + (bufoff) + ldsw + _i * 8192), 16, 0, 0); } while (0)
#define PG8_LDA(dst, b, h) do { _Pragma("unroll") for (int m = 0; m < 4; ++m) _Pragma("unroll") for (int k = 0; k < 2; ++k) dst[m][k] = *(const PG8_LAS bf16x8*)(lds + PG8_SA(b, h) + aoff + m * 2048 + k * 1024); } while (0)
#define PG8_LDB(dst, b, h) do { _Pragma("unroll") for (int n = 0; n < 2; ++n) _Pragma("unroll") for (int k = 0; k < 2; ++k) dst[n][k] = *(const PG8_LAS bf16x8*)(lds + PG8_SB(b, h) + boff + n * 2048 + k * 1024); } while (0)
#define PG8_MMA(ai, bj, At, Bt) do { __builtin_amdgcn_s_setprio(1); _Pragma("unroll") for (int m = 0; m < 4; ++m) _Pragma("unroll") for (int n = 0; n < 2; ++n) _Pragma("unroll") for (int k = 0; k < 2; ++k) \
        acc[ai][bj][m][n] = __builtin_amdgcn_mfma_f32_16x16x32_bf16(Bt[n][k], At[m][k], acc[ai][bj][m][n], 0, 0, 0); __builtin_amdgcn_s_setprio(0); } while (0)
#define PG8_WAIT_V(n) asm volatile("s_waitcnt vmcnt(" #n ")" ::: "memory")
#define PG8_WAIT_L(n) asm volatile("s_waitcnt lgkmcnt(" #n ")" ::: "memory")
#define PG8_BAR __builtin_amdgcn_s_barrier()
#define PG8_SCHED __builtin_amdgcn_sched_barrier(0)
    Unit cur, nxt; int ui = 0;
    if (!S.next(0, cur)) return;
    f32x4 acc[2][2][4][2];
#pragma unroll
    for (int a = 0; a < 2; ++a)
#pragma unroll
        for (int b = 0; b < 2; ++b)
#pragma unroll
            for (int m = 0; m < 4; ++m)
#pragma unroll
                for (int n = 0; n < 2; ++n) acc[a][b][m][n] = (f32x4){0.f, 0.f, 0.f, 0.f};
    bf16x8 At[4][2], B0[2][2], B1[2][2];
    const char* cA = (const char*)g.A + (size_t)cur.pm * tstep + (size_t)cur.pc * g.csA; const char* cB = (const char*)g.Bt + (size_t)cur.pn * tstep + (size_t)cur.pc * g.csB;
    S.a_ready(cur);
    if constexpr (SP2) {
        PG8_STAGE(PG8_SB(0, 0), cB, voffB); PG8_STAGE(PG8_SB(0, 1), cB + hstep, voffB); PG8_STAGE(PG8_SA(0, 0), cA, voffA); PG8_STAGE(PG8_SA(0, 1), cA + hstep, voffA);
        if (wr == 1) PG8_BAR;
        PG8_WAIT_V(2); PG8_BAR;
        PG8_STAGE(PG8_SB(1, 0), cB + kstep, voffB); PG8_STAGE(PG8_SA(1, 0), cA + kstep, voffA); PG8_STAGE(PG8_SB(1, 1), cB + hstep + kstep, voffB);
        PG8_WAIT_V(6); PG8_BAR;
    } else {
        PG8_STAGE(PG8_SB(0, 0), cB, voffB); PG8_STAGE(PG8_SA(0, 0), cA, voffA); PG8_STAGE(PG8_SB(0, 1), cB + hstep, voffB); PG8_STAGE(PG8_SA(0, 1), cA + hstep, voffA);
        if (wr == 1) PG8_BAR;
        PG8_WAIT_V(4); PG8_BAR;
        PG8_STAGE(PG8_SB(1, 0), cB + kstep, voffB); PG8_STAGE(PG8_SA(1, 0), cA + kstep, voffA); PG8_STAGE(PG8_SB(1, 1), cB + hstep + kstep, voffB);
        PG8_WAIT_V(6); PG8_BAR;
    }
    for (;;) {
        const bool has_next = S.next(ui + 1, nxt);
        const char* nA = has_next ? (const char*)g.A + (size_t)nxt.pm * tstep + (size_t)nxt.pc * g.csA : cA; const char* nB = has_next ? (const char*)g.Bt + (size_t)nxt.pn * tstep + (size_t)nxt.pc * g.csB : cB;
        for (int t = 0; t < nt; t += 2) {
            const bool last = (t == nt - 2);
            const char* a1 = cA + (size_t)(t + 1) * kstep;
            const char* a2 = last ? nA : cA + (size_t)(t + 2) * kstep; const char* b2 = last ? nB : cB + (size_t)(t + 2) * kstep;
            const char* a3 = a2 + kstep; const char* b3 = b2 + kstep;
            if (last && has_next) S.a_ready(nxt);
            if constexpr (SP2) {
            PG8_LDB(B0, 0, 0); PG8_LDB(B1, 0, 1); PG8_SCHED; PG8_LDA(At, 0, 0); PG8_STAGE(PG8_SA(1, 1), a1 + hstep, voffA);
            PG8_WAIT_V(8); PG8_WAIT_L(0); PG8_BAR; PG8_MMA(0, 0, At, B0); PG8_MMA(0, 1, At, B1); PG8_BAR; PG8_SCHED;
            PG8_LDA(At, 0, 1); PG8_STAGE(PG8_SB(0, 0), b2, voffB); PG8_STAGE(PG8_SB(0, 1), b2 + hstep, voffB); PG8_STAGE(PG8_SA(0, 0), a2, voffA);
            PG8_WAIT_V(8); PG8_WAIT_L(0); PG8_BAR; PG8_MMA(1, 0, At, B0); PG8_MMA(1, 1, At, B1); PG8_BAR; PG8_SCHED;
            PG8_LDB(B0, 1, 0); PG8_LDB(B1, 1, 1); PG8_SCHED; PG8_LDA(At, 1, 0); PG8_STAGE(PG8_SA(0, 1), a2 + hstep, voffA);
            PG8_WAIT_V(8); PG8_WAIT_L(0); PG8_BAR; PG8_MMA(0, 0, At, B0); PG8_MMA(0, 1, At, B1); PG8_BAR; PG8_SCHED;
            PG8_LDA(At, 1, 1); PG8_STAGE(PG8_SB(1, 0), b3, voffB); PG8_STAGE(PG8_SB(1, 1), b3 + hstep, voffB); PG8_STAGE(PG8_SA(1, 0), a3, voffA);
            PG8_WAIT_V(8); PG8_WAIT_L(0); PG8_BAR; PG8_MMA(1, 0, At, B0); PG8_MMA(1, 1, At, B1); PG8_BAR; PG8_SCHED;
            } else {
            PG8_LDB(B0, 0, 0); PG8_SCHED; PG8_LDA(At, 0, 0); PG8_STAGE(PG8_SA(1, 1), a1 + hstep, voffA);
            PG8_WAIT_L(8); PG8_BAR; PG8_WAIT_L(0); PG8_MMA(0, 0, At, B0); PG8_BAR; PG8_SCHED;
            PG8_LDB(B1, 0, 1); PG8_STAGE(PG8_SB(0, 0), b2, voffB);
            PG8_BAR; PG8_WAIT_L(0); PG8_MMA(0, 1, At, B1); PG8_BAR;
            PG8_LDA(At, 0, 1); PG8_STAGE(PG8_SA(0, 0), a2, voffA);
            PG8_BAR; PG8_WAIT_L(0); PG8_MMA(1, 0, At, B0); PG8_BAR; PG8_SCHED;
            PG8_STAGE(PG8_SB(0, 1), b2 + hstep, voffB);
            PG8_WAIT_V(6); PG8_BAR; PG8_MMA(1, 1, At, B1); PG8_BAR;
            PG8_LDB(B0, 1, 0); PG8_SCHED; PG8_LDA(At, 1, 0); PG8_STAGE(PG8_SA(0, 1), a2 + hstep, voffA);
            PG8_WAIT_L(8); PG8_BAR; PG8_WAIT_L(0); PG8_MMA(0, 0, At, B0); PG8_BAR; PG8_SCHED;
            PG8_LDB(B1, 1, 1); PG8_STAGE(PG8_SB(1, 0), b3, voffB);
            PG8_BAR; PG8_WAIT_L(0); PG8_MMA(0, 1, At, B1); PG8_BAR;
            PG8_LDA(At, 1, 1); PG8_STAGE(PG8_SA(1, 0), a3, voffA);
            PG8_BAR; PG8_WAIT_L(0); PG8_MMA(1, 0, At, B0); PG8_BAR; PG8_SCHED;
            PG8_STAGE(PG8_SB(1, 1), b3 + hstep, voffB);
            PG8_WAIT_V(6); PG8_BAR; PG8_MMA(1, 1, At, B1); PG8_BAR;
            }
        }
        if constexpr (ALIGN_EPI) { if (wr == 0) PG8_BAR; }
        if constexpr (!Epi::AFTER_DRAIN) { E(acc, cur, wr, wc, fr, fq); S.done(cur); }
        if (!has_next) break;
#pragma unroll
        for (int a = 0; a < 2; ++a)
#pragma unroll
            for (int b = 0; b < 2; ++b)
#pragma unroll
                for (int m = 0; m < 4; ++m)
#pragma unroll
                    for (int n = 0; n < 2; ++n) acc[a][b][m][n] = (f32x4){0.f, 0.f, 0.f, 0.f};
        cur = nxt; cA = nA; cB = nB; ++ui;
        if constexpr (ALIGN_EPI) { if (wr == 1) PG8_BAR; }
    }
    PG8_WAIT_V(0);
    if constexpr (!ALIGN_EPI) { if (wr == 0) PG8_BAR; }
    PG8_BAR;
    if constexpr (Epi::AFTER_DRAIN) { E.fused(acc, cur, wr, wc, fr, fq, lds, wid, lane); S.done(cur); }
#undef PG8_SA
#undef PG8_SB
#undef PG8_STAGE
#undef PG8_LDA
#undef PG8_LDB
#undef PG8_MMA
#undef PG8_WAIT_V
#undef PG8_WAIT_L
#undef PG8_BAR
#undef PG8_SCHED
}
}


constexpr int D = 2048, NL = 4, FFN = 5632, NPROJ = 15872, INCOLS = 15888;
constexpr int MR = 9280, MP = 9472, NCH = 145, NCHP = 129;
constexpr int ROW_P0 = 64, ROW_S0 = 8256, NNULL = 48;
constexpr int STATE_N = 327680, ST_SSD = 0, ST_HG = 131072, ST_RET = 262144;
constexpr int GAM_N = 1040;
constexpr float EPS = 1e-6f;
constexpr size_t O_YP = 0, O_YS = 16777216, O_CONVP = O_YS + 2097152, O_SSMP = O_CONVP + 18432, O_HGP = O_SSMP + 524288, O_RETP = O_HGP + 524288,
                 O_CONVS = O_RETP + 262144, O_SSMS = O_CONVS + 294912, O_HGS = O_SSMS + 8388608, O_RETS = O_HGS + 8388608, O_END = O_RETS + 4194304;

constexpr size_t MiB = 1u << 20;
constexpr size_t al(size_t x) { return (x + MiB - 1) / MiB * MiB; }
constexpr size_t WS_CTL = 0, CTL_ZERO_BYTES = 1 * MiB;
constexpr size_t SZ_WIN = (size_t)NPROJ * D * 2, SZ_WBR = (size_t)3 * D * 1024 * 2, SZ_WOUT = (size_t)D * D * 2, SZ_WGU = (size_t)2 * FFN * D * 2, SZ_WDN = (size_t)D * FFN * 2, SZ_WDT = (size_t)16 * D * 2;
constexpr size_t LW_IN = 0, LW_BR = LW_IN + al(SZ_WIN), LW_OUT = LW_BR + al(SZ_WBR), LW_GU = LW_OUT + al(SZ_WOUT), LW_DN = LW_GU + al(SZ_WGU), LW_DT = LW_DN + al(SZ_WDN), LW_SIZE = LW_DT + al(SZ_WDT);
constexpr size_t WS_W = 1 * MiB;
constexpr size_t WS_X = WS_W + 4 * LW_SIZE;
constexpr size_t WS_H = WS_X + al((size_t)MP * D * 4);
constexpr size_t WS_ZS = WS_H + al((size_t)MP * D * 2);
constexpr size_t WS_XBC = WS_ZS + al((size_t)MP * 1024 * 2);
constexpr size_t WS_HQ = WS_XBC + al((size_t)MP * 1536 * 2);
constexpr size_t WS_LG = WS_HQ + al((size_t)MP * 1024 * 2);
constexpr size_t WS_KK = WS_LG + al((size_t)MP * 1024 * 4);
constexpr size_t WS_HV = WS_KK + al((size_t)MP * 1024 * 2);
constexpr size_t WS_HG = WS_HV + al((size_t)MP * 1024 * 2);
constexpr size_t WS_RQ = WS_HG + al((size_t)MP * 1024 * 2);
constexpr size_t WS_RK = WS_RQ + al((size_t)MP * 512 * 2);
constexpr size_t WS_RV = WS_RK + al((size_t)MP * 512 * 2);
constexpr size_t WS_RG = WS_RV + al((size_t)MP * 1024 * 2);
constexpr size_t WS_GT = WS_RG + al((size_t)MP * 1024 * 2);
constexpr size_t WS_DT = WS_GT + al((size_t)MP * 6144 * 2);
constexpr size_t WS_CUM = WS_DT + al((size_t)MP * 16 * 4);
constexpr size_t WS_U = WS_CUM + al((size_t)MP * 16 * 4);
constexpr size_t WS_SB = WS_U + al((size_t)NCH * STATE_N * 4);
constexpr size_t WS_GAM = WS_SB + al((size_t)NCH * STATE_N * 2);
constexpr size_t WS_BR = WS_GAM + al((size_t)NCH * GAM_N * 4);
constexpr size_t WS_TMP = WS_BR + al((size_t)3 * MP * 1024 * 2);
constexpr size_t WS_MIX = WS_TMP + al((size_t)MP * D * 4);
constexpr size_t WS_HID = WS_MIX + al((size_t)MP * D * 2);
constexpr size_t WS_ROPE = WS_HID + al((size_t)MP * FFN * 2);
constexpr size_t WS_LBS = WS_ROPE + al((size_t)MP * 32 * 8);
constexpr size_t WS_AV = WS_LBS + 1 * MiB;
constexpr size_t WS_XTG = WS_AV + al((size_t)MP * 16 * 4);
constexpr size_t WS_BCG = WS_XTG + al((size_t)NCH * 1024 * 64 * 2);
constexpr size_t WS_END = WS_BCG + al((size_t)MP * 512 * 2);
constexpr int CW_BAR = 4096, CW_QUEUE = 16384;

constexpr int RING_BYTES = 131072;
constexpr int LDSCTL_OFF = 147456 - 512, LDS_BYTES = 147456;
constexpr int NWAVES = 8, NTHR = 512;

#define GAS __attribute__((address_space(1)))
#define LAS __attribute__((address_space(3)))
typedef unsigned short bf16;
typedef unsigned v4u __attribute__((ext_vector_type(4)));
typedef unsigned v2u __attribute__((ext_vector_type(2)));
typedef float f32x4 __attribute__((ext_vector_type(4)));
typedef float f32x2 __attribute__((ext_vector_type(2)));
typedef short bf16x8 __attribute__((ext_vector_type(8)));
typedef GAS unsigned gu32;
#define RLX_AGENT __ATOMIC_RELAXED, __HIP_MEMORY_SCOPE_AGENT

__device__ __forceinline__ unsigned f2bf(float f) { unsigned u = __builtin_bit_cast(unsigned, f); return (u + 0x7fffu + ((u >> 16) & 1u)) >> 16; }
typedef __bf16 bf16v2 __attribute__((ext_vector_type(2)));
__device__ __forceinline__ unsigned pk2(float lo, float hi) { const f32x2 v = {lo, hi}; return __builtin_bit_cast(unsigned, __builtin_convertvector(v, bf16v2)); }
__device__ __forceinline__ float bf2f(unsigned short b) { return __builtin_bit_cast(float, ((unsigned)b) << 16); }
__device__ __forceinline__ float bflo(unsigned w) { return __builtin_bit_cast(float, w << 16); }
__device__ __forceinline__ float bfhi(unsigned w) { return __builtin_bit_cast(float, w & 0xffff0000u); }
__device__ __forceinline__ float fsigmoid(float v) { return __builtin_amdgcn_rcpf(1.0f + __expf(-v)); }
__device__ __forceinline__ float fsilu(float v) { return v * fsigmoid(v); }
__device__ __forceinline__ f32x4 mfma16(bf16x8 a, bf16x8 b, f32x4 c) { return __builtin_amdgcn_mfma_f32_16x16x32_bf16(a, b, c, 0, 0, 0); }
__device__ __forceinline__ float wave_sum(float v) {
#pragma unroll
    for (int o = 1; o < 64; o <<= 1) v += __shfl_xor(v, o);
    return v;
}
#define LDS_WAIT() asm volatile("s_waitcnt lgkmcnt(0)" ::: "memory")
#define LBAR() do { asm volatile("s_waitcnt lgkmcnt(0)" ::: "memory"); __builtin_amdgcn_s_barrier(); asm volatile("" ::: "memory"); } while (0)
#define XB_TMO      128
#define XB_XCNT(j)  (256  + 64 * (j))
#define XB_XSUB(j)  (1280 + 64 * (j))
#define XB_XGEN(j)  (2304 + 64 * (j))
#define XB_TOP      3328
#define XB_TOPGEN   3392
#define XCD_BAR_WORDS 3456
#define XB_SPIN_CAP (1u << 18)

__device__ __forceinline__ unsigned xb_ld(unsigned* p)              { return __hip_atomic_load(p, __ATOMIC_RELAXED, __HIP_MEMORY_SCOPE_AGENT); }
__device__ __forceinline__ unsigned xb_add(unsigned* p, unsigned v) { return __hip_atomic_fetch_add(p, v, __ATOMIC_RELAXED, __HIP_MEMORY_SCOPE_AGENT); }
__device__ __forceinline__ unsigned xb_xcc_id() { return (unsigned)__builtin_amdgcn_s_getreg((3 << 11) | 20) & 0xFu; }
#define XB_SPIN(cond, bar) do { unsigned _sp = 0; while (cond) { __builtin_amdgcn_s_sleep(1); \
    if ((++_sp & 255u) == 0u) { if (xb_ld(&(bar)[XB_TMO])) break; if (_sp > XB_SPIN_CAP) { atomicAdd(&(bar)[XB_TMO], 1u); break; } } } } while (0)

struct XcdBarrier {
    unsigned* bar; unsigned x;
    volatile LAS unsigned* st;
};

__device__ __forceinline__ XcdBarrier xcd_barrier_post(unsigned* bar, volatile LAS unsigned* st) {
    XcdBarrier b; b.bar = bar; b.x = xb_xcc_id(); b.st = st;
    if (threadIdx.x == 0) (void)xb_add(&bar[XB_XCNT(b.x)], 1u);
    return b;
}
__device__ __forceinline__ void xcd_barrier_complete(unsigned* bar, unsigned x, unsigned& nloc, unsigned& nx) {
    const unsigned G = gridDim.x * gridDim.y * gridDim.z;
    unsigned sum, cnt, mine, sp = 0u;
    for (;;) {
        sum = 0u; cnt = 0u; mine = 0u;
#pragma unroll
        for (unsigned j = 0; j < 16; ++j) { const unsigned c = xb_ld(&bar[XB_XCNT(j)]); sum += c; cnt += (c > 0u) ? 1u : 0u; mine = (j == x) ? c : mine; }
        if (sum == G) break;
        __builtin_amdgcn_s_sleep(1);
        if ((++sp & 255u) == 0u) { if (xb_ld(&bar[XB_TMO])) break; if (sp > XB_SPIN_CAP) { atomicAdd(&bar[XB_TMO], 1u); break; } }
    }
    nloc = mine > 0u ? mine : 1u; nx = cnt > 0u ? cnt : 1u;
}

__device__ __forceinline__ void xcd_barrier(const XcdBarrier& b) {
    asm volatile("s_waitcnt vmcnt(0)" ::: "memory");
    __syncthreads();
    if (threadIdx.x == 0) {
        unsigned* bar = b.bar;
        __builtin_amdgcn_s_waitcnt(0);
        unsigned nloc = b.st[0], nx = b.st[1];
        if (nloc == 0u) { xcd_barrier_complete(bar, b.x, nloc, nx); b.st[0] = nloc; b.st[1] = nx; }
        const unsigned old = xb_add(&bar[XB_XSUB(b.x)], 1u);
        const unsigned gen = old / nloc;
        if (old + 1u == (gen + 1u) * nloc) {
            __builtin_amdgcn_fence(__ATOMIC_RELEASE, "agent");
            asm volatile("s_waitcnt vmcnt(0)" ::: "memory");
            const unsigned og = xb_add(&bar[XB_TOP], 1u);
            const unsigned tg = og / nx;
            if (og + 1u == (tg + 1u) * nx) xb_add(&bar[XB_TOPGEN], 1u);
            else XB_SPIN(xb_ld(&bar[XB_TOPGEN]) == tg, bar);
            __builtin_amdgcn_fence(__ATOMIC_ACQUIRE, "agent");
            xb_add(&bar[XB_XGEN(b.x)], 1u);
            asm volatile("s_waitcnt vmcnt(0)" ::: "memory");
        } else {
            XB_SPIN(xb_ld(&bar[XB_XGEN(b.x)]) == gen, bar);
            __builtin_amdgcn_fence(__ATOMIC_ACQUIRE, "agent");
            asm volatile("s_waitcnt vmcnt(0)" ::: "memory");
        }
    }
    __syncthreads();
}


typedef const f32x4 (&AccRef)[2][2][4][2];

struct EpiProj {
    static constexpr bool PERM = true, AFTER_DRAIN = false;
    unsigned char* ws; int layer;
    template <int T> __device__ __forceinline__ void run(AccRef acc, bf16* dst, int pitch, int row0, int col0) const {
        const float* lbs = (const float*)(ws + WS_LBS) + layer * 1024; float* LG = (float*)(ws + WS_LG); const f32x2* rope = (const f32x2*)(ws + WS_ROPE);
        f32x4 lb[2][2];
        if (T == 3) {
#pragma unroll
            for (int bj = 0; bj < 2; ++bj) { lb[bj][0] = *(const f32x4*)(lbs + col0 + bj * 128); lb[bj][1] = *(const f32x4*)(lbs + col0 + bj * 128 + 4); }
        }
#pragma unroll
        for (int ai = 0; ai < 2; ++ai)
#pragma unroll
            for (int m = 0; m < 4; ++m) {
                const int row = row0 + ai * 128 + m * 16;
#pragma unroll
                for (int bj = 0; bj < 2; ++bj) {
                    const int col = col0 + bj * 128;
                    f32x4 v0 = acc[ai][bj][m][0], v1 = acc[ai][bj][m][1];
                    if (T == 1) {
#pragma unroll
                        for (int e = 0; e < 4; ++e) { v0[e] = fsilu(v0[e]); v1[e] = fsilu(v1[e]); }
                    }
                    if (T == 2) {
#pragma unroll
                        for (int e = 0; e < 4; ++e) { v0[e] = fsigmoid(v0[e]); v1[e] = fsigmoid(v1[e]); }
                    }
                    if (T == 3) {
                        f32x4 l0, l1;
#pragma unroll
                        for (int e = 0; e < 4; ++e) {
                            { const float b = lb[bj][0][e], fg = v0[e], s = fsigmoid(fg), sn = fsigmoid(-fg); l0[e] = __logf(fmaxf(b + (1.0f - b) * s, 1e-30f)); v0[e] = (1.0f - b) * sn; }
                            { const float b = lb[bj][1][e], fg = v1[e], s = fsigmoid(fg), sn = fsigmoid(-fg); l1[e] = __logf(fmaxf(b + (1.0f - b) * s, 1e-30f)); v1[e] = (1.0f - b) * sn; }
                        }
                        float* lp = LG + (size_t)row * 1024 + col;
                        *(f32x4*)lp = l0; *(f32x4*)(lp + 4) = l1;
                    }
                    if (T == 4 || T == 5) {
                        const int j = (col & 63) >> 3;
                        const f32x4* rp = (const f32x4*)(rope + (size_t)row * 32 + 4 * j);
                        const f32x4 cs0 = rp[0], cs1 = rp[1];
                        const float c[4] = {cs0[0], cs0[2], cs1[0], cs1[2]}, s[4] = {cs0[1], cs0[3], cs1[1], cs1[3]};
                        const float sc = (T == 5) ? 0.125f : 1.0f;
#pragma unroll
                        for (int e = 0; e < 4; ++e) { const float a = v0[e], b = v1[e]; v0[e] = (a * c[e] - b * s[e]) * sc; v1[e] = (b * c[e] + a * s[e]) * sc; }
                    }
                    v4u w; w.x = pk2(v0[0], v0[1]); w.y = pk2(v0[2], v0[3]); w.z = pk2(v1[0], v1[1]); w.w = pk2(v1[2], v1[3]);
                    *(v4u*)(dst + (size_t)row * pitch + col) = w;
                }
            }
    }
    __device__ __forceinline__ void operator()(AccRef acc, const pg8::Unit& u, int wr, int wc, int fr, int fq) const {
        const int pn = u.pn, row0 = u.pm * 256 + wr * 64 + fr, cl = wc * 32 + 8 * fq;
        if (pn < 4) run<1>(acc, (bf16*)(ws + WS_ZS), 1024, row0, (pn - 0) * 256 + cl);
        else if (pn < 10) run<0>(acc, (bf16*)(ws + WS_XBC), 1536, row0, (pn - 4) * 256 + cl);
        else if (pn < 14) run<1>(acc, (bf16*)(ws + WS_HQ), 1024, row0, (pn - 10) * 256 + cl);
        else if (pn < 18) run<3>(acc, (bf16*)(ws + WS_KK), 1024, row0, (pn - 14) * 256 + cl);
        else if (pn < 22) run<0>(acc, (bf16*)(ws + WS_HV), 1024, row0, (pn - 18) * 256 + cl);
        else if (pn < 26) run<1>(acc, (bf16*)(ws + WS_HG), 1024, row0, (pn - 22) * 256 + cl);
        else if (pn < 28) run<4>(acc, (bf16*)(ws + WS_RQ), 512, row0, (pn - 26) * 256 + cl);
        else if (pn < 30) run<5>(acc, (bf16*)(ws + WS_RK), 512, row0, (pn - 28) * 256 + cl);
        else if (pn < 34) run<0>(acc, (bf16*)(ws + WS_RV), 1024, row0, (pn - 30) * 256 + cl);
        else if (pn < 38) run<1>(acc, (bf16*)(ws + WS_RG), 1024, row0, (pn - 34) * 256 + cl);
        else run<2>(acc, (bf16*)(ws + WS_GT), 6144, row0, (pn - 38) * 256 + cl);
    }
};

struct EpiBranch {
    static constexpr bool PERM = true, AFTER_DRAIN = false;
    bf16* TMP; bf16* MIX; const bf16* GT;
    __device__ __forceinline__ void operator()(AccRef acc, const pg8::Unit& u, int wr, int wc, int fr, int fq) const {
        const int row0 = u.pm * 256 + wr * 64 + fr, col0 = u.pn * 256 + wc * 32 + 8 * fq, pc = u.pc;
#pragma unroll
        for (int ai = 0; ai < 2; ++ai)
#pragma unroll
            for (int m = 0; m < 4; ++m) {
                const int row = row0 + ai * 128 + m * 16;
#pragma unroll
                for (int bj = 0; bj < 2; ++bj) {
                    const int col = col0 + bj * 128;
                    const v4u g = *(const v4u*)(GT + (size_t)row * 6144 + pc * 2048 + col);
                    f32x4 v0 = acc[ai][bj][m][0], v1 = acc[ai][bj][m][1];
                    v0[0] *= bflo(g.x); v0[1] *= bfhi(g.x); v0[2] *= bflo(g.y); v0[3] *= bfhi(g.y);
                    v1[0] *= bflo(g.z); v1[1] *= bfhi(g.z); v1[2] *= bflo(g.w); v1[3] *= bfhi(g.w);
                    bf16* tp = TMP + (size_t)row * D + col;
                    if (pc > 0) { const v4u t = *(const v4u*)tp; v0[0] += bflo(t.x); v0[1] += bfhi(t.x); v0[2] += bflo(t.y); v0[3] += bfhi(t.y); v1[0] += bflo(t.z); v1[1] += bfhi(t.z); v1[2] += bflo(t.w); v1[3] += bfhi(t.w); }
                    if (pc < 2) { v4u w; w.x = pk2(v0[0], v0[1]); w.y = pk2(v0[2], v0[3]); w.z = pk2(v1[0], v1[1]); w.w = pk2(v1[2], v1[3]); *(v4u*)tp = w; }
                    else { v4u w; w.x = pk2(v0[0], v0[1]); w.y = pk2(v0[2], v0[3]); w.z = pk2(v1[0], v1[1]); w.w = pk2(v1[2], v1[3]); *(v4u*)(MIX + (size_t)row * D + col) = w; }
                }
            }
    }
};

struct EpiResid {
    static constexpr bool PERM = false, AFTER_DRAIN = false;
    float* X;
    __device__ __forceinline__ void operator()(AccRef acc, const pg8::Unit& u, int wr, int wc, int fr, int fq) const {
        const int row0 = u.pm * 256 + wr * 64 + fr, col0 = u.pn * 256 + wc * 32 + 4 * fq;
#pragma unroll
        for (int ai = 0; ai < 2; ++ai)
#pragma unroll
            for (int m = 0; m < 4; ++m) {
                float* rowp = X + (size_t)(row0 + ai * 128 + m * 16) * D + col0;
#pragma unroll
                for (int bj = 0; bj < 2; ++bj)
#pragma unroll
                    for (int n = 0; n < 2; ++n) { f32x4* p = (f32x4*)(rowp + bj * 128 + n * 16); *p = *p + acc[ai][bj][m][n]; }
            }
    }
};

struct EpiSwiglu {
    static constexpr bool PERM = true, AFTER_DRAIN = false;
    bf16* HID;
    __device__ __forceinline__ void operator()(AccRef acc, const pg8::Unit& u, int wr, int wc, int fr, int fq) const {
        const int row0 = u.pm * 256 + wr * 64 + fr, col0 = u.pn * 128 + wc * 32 + 8 * fq;
#pragma unroll
        for (int ai = 0; ai < 2; ++ai)
#pragma unroll
            for (int m = 0; m < 4; ++m) {
                const int row = row0 + ai * 128 + m * 16;
                f32x4 g0 = acc[ai][0][m][0], g1 = acc[ai][0][m][1]; const f32x4 u0 = acc[ai][1][m][0], u1 = acc[ai][1][m][1];
#pragma unroll
                for (int e = 0; e < 4; ++e) { g0[e] = fsilu(g0[e]) * u0[e]; g1[e] = fsilu(g1[e]) * u1[e]; }
                v4u w; w.x = pk2(g0[0], g0[1]); w.y = pk2(g0[2], g0[3]); w.z = pk2(g1[0], g1[1]); w.w = pk2(g1[2], g1[3]);
                *(v4u*)(HID + (size_t)row * FFN + col0) = w;
            }
    }
};

struct BranchOrder {
    pg8::StaticOrder S;
    __device__ void init(int M, int N, int G, int c) { S.init(M, N, G, c); }
    __device__ bool next(int i, pg8::Unit& u) const { const int t = i / 3, pc = i - 3 * t; if (!S.next(t, u)) return false; u.pc = pc; return true; }
    __device__ __forceinline__ void a_ready(const pg8::Unit&) const {}
    __device__ __forceinline__ void done(const pg8::Unit&) const {}
};

struct Args { const float* in[24]; float* out; unsigned char* ws; int l_lo, l_hi, ph_lo, ph_hi, do_pro, do_fin, use_bar, pad; };
enum { I_XP = 0, I_XS, I_SCONV, I_SSSM, I_SHG, I_SRET, I_META, I_NMIX, I_WIN, I_CONVW, I_CONVB, I_DTB, I_ALOG, I_DSKIP, I_SSDN, I_HGLOW, I_HGN, I_WBR, I_WOUT, I_NFFN, I_WG, I_WU, I_WD, I_NFIN };

typedef const __attribute__((address_space(4))) Args* ArgsP;
#define AREF const __attribute__((address_space(4))) Args&
struct Ctx {
    LAS unsigned char* lds; int tid, lane, wave, vcu, G;
    ArgsP a; unsigned char* ws;
};

template <class F> __device__ __forceinline__ void tr_item(const float* W, int ldw, bf16* WT, int K, int k0, int n0, LAS float* scr, int lane, F srccol) {
    const int sc = srccol(n0 + (lane & 31));
#pragma unroll 8
    for (int i = 0; i < 32; ++i) { const int kk = 2 * i + (lane >> 5); scr[kk * 33 + (lane & 31)] = W[(size_t)(k0 + kk) * ldw + sc]; }
    LDS_WAIT(); asm volatile("" ::: "memory");
    const int c = lane & 7;
#pragma unroll
    for (int j = 0; j < 4; ++j) { const int n = (lane >> 3) + 8 * j; const LAS float* s = scr + (8 * c) * 33 + n;
        v4u o; o.x = pk2(s[0 * 33], s[1 * 33]); o.y = pk2(s[2 * 33], s[3 * 33]); o.z = pk2(s[4 * 33], s[5 * 33]); o.w = pk2(s[6 * 33], s[7 * 33]);
        *(v4u*)(WT + (size_t)(n0 + n) * K + k0 + 8 * c) = o; }
    LDS_WAIT(); asm volatile("" ::: "memory");
}
__device__ __forceinline__ int win_src(int n) {
    if (n >= 6656 && n < 7680) { const int p = n & 63, j = p >> 3, nn = (p >> 2) & 1, e = p & 3; n = (n & ~63) + 32 * nn + 4 * j + e; }
    return n < 2560 ? n : n + 16;
}
__device__ __forceinline__ int ret_dim(int p) { return 32 * ((p >> 2) & 1) + 4 * (p >> 3) + (p & 3); }

__device__ __forceinline__ void p0_prologue(const Ctx& C) {
    AREF A = *C.a; unsigned char* ws = C.ws;
    LAS float* scr = (LAS float*)(C.lds + C.wave * 16384);
    const int gw = C.vcu * NWAVES + C.wave, NGW = C.G * NWAVES;
    constexpr int I_IN = 32 * 496, I_BR = 3 * 16 * 64, I_OUT = 32 * 64, I_GU = 32 * 352, I_DN = 88 * 64, I_L = I_IN + I_BR + I_OUT + I_GU + I_DN;
    for (int it = gw; it < NL * I_L; it += NGW) {
        const int l = it / I_L; int r = it - l * I_L; unsigned char* lw = ws + WS_W + (size_t)l * LW_SIZE;
        if (r < I_IN) { const int kb = r / 496, nb = r - kb * 496; tr_item(A.in[I_WIN] + (size_t)l * D * INCOLS, INCOLS, (bf16*)(lw + LW_IN), D, 64 * kb, 32 * nb, scr, C.lane, [](int n) { return win_src(n); }); continue; } r -= I_IN;
        if (r < I_BR) { const int c = r / 1024, rr = r - c * 1024, kb = rr / 64, nb = rr - kb * 64;
            tr_item(A.in[I_WBR] + ((size_t)l * 3 + c) * 1024 * D, D, (bf16*)(lw + LW_BR) + (size_t)c * D * 1024, 1024, 64 * kb, 32 * nb, scr, C.lane, [](int n) { return n; }); continue; } r -= I_BR;
        if (r < I_OUT) { const int kb = r / 64, nb = r - kb * 64; tr_item(A.in[I_WOUT] + (size_t)l * D * D, D, (bf16*)(lw + LW_OUT), D, 64 * kb, 32 * nb, scr, C.lane, [](int n) { return n; }); continue; } r -= I_OUT;
        if (r < I_GU) { const int kb = r / 352, nb = r - kb * 352, n0 = 32 * nb, t = n0 >> 8, w = n0 & 255; const float* src = (w < 128 ? A.in[I_WG] : A.in[I_WU]) + (size_t)l * D * FFN; const int sbase = 128 * t + (w & 127) - n0;
            tr_item(src, FFN, (bf16*)(lw + LW_GU), D, 64 * kb, n0, scr, C.lane, [sbase](int n) { return n + sbase; }); continue; } r -= I_GU;
        { const int kb = r / 64, nb = r - kb * 64; tr_item(A.in[I_WD] + (size_t)l * FFN * D, D, (bf16*)(lw + LW_DN), FFN, 64 * kb, 32 * nb, scr, C.lane, [](int n) { return n; }); }
    }
    const int gt = C.vcu * NTHR + C.tid, NGT = C.G * NTHR;
    for (int m = gw; m < MP; m += NGW) {
        const float* src = nullptr;
        if (m >= NNULL && m < ROW_P0) src = A.in[I_META] + (size_t)(m - NNULL) * D;
        else if (m >= ROW_P0 && m < ROW_S0) src = A.in[I_XP] + (size_t)(m - ROW_P0) * D;
        else if (m >= ROW_S0 && m < MR) src = A.in[I_XS] + (size_t)(m - ROW_S0) * D;
        f32x4* dst = (f32x4*)(ws + WS_X + (size_t)m * D * 4) + C.lane;
#pragma unroll
        for (int j = 0; j < 8; ++j) dst[64 * j] = src ? ((const f32x4*)src)[C.lane + 64 * j] : (f32x4){0.f, 0.f, 0.f, 0.f};
    }
    for (int i = gt; i < MP * 32; i += NGT) {
        const int row = i >> 5, fi = i & 31;
        const int pos = row < ROW_S0 ? row - ROW_P0 : (row < MR ? 1024 + ((row - ROW_S0) & 63) : 0);
        const double inv = exp(-(double)fi * (9.210340371976184 / 32.0));
        const double ang = (double)pos * inv, n = rint(ang * 0.15915494309189535), r = fma(-n, 6.283185307179586, ang) - n * 2.4492935982947064e-16;
        const double r2 = r * r; double s = 0.0, c = 0.0;
#pragma unroll
        for (int k = 14; k >= 1; --k) { s = (s + 1.0) * (-r2 / (double)((2 * k) * (2 * k + 1))); c = (c + 1.0) * (-r2 / (double)((2 * k - 1) * (2 * k))); }
        ((f32x2*)(ws + WS_ROPE))[i] = (f32x2){(float)(c + 1.0), (float)((s + 1.0) * r)};
    }
    for (int i = gt; i < 1024; i += NGT) {
        const float* hl = A.in[I_HGLOW]; const float v0 = hl[i], v1 = hl[1024 + i], v2 = hl[2048 + i], v3 = hl[3072 + i], mx = fmaxf(fmaxf(v0, v1), fmaxf(v2, v3));
        const float e0 = expf(v0 - mx), e1 = expf(v1 - mx), e2 = expf(v2 - mx), e3 = expf(v3 - mx), inv = 1.0f / (e0 + e1 + e2 + e3);
        float* lb = (float*)(ws + WS_LBS); lb[i] = 0.f; lb[1024 + i] = e1 * inv; lb[2048 + i] = (e1 + e2) * inv; lb[3072 + i] = (e1 + e2 + e3) * inv;
    }
    for (int i = gt; i < 3 * (MP - MR) * 1024 / 8; i += NGT) { const int c = i / ((MP - MR) * 128), r = i - c * (MP - MR) * 128;
        ((v4u*)(ws + WS_BR + ((size_t)c * MP + MR) * 1024 * 2))[r] = (v4u){0u, 0u, 0u, 0u}; }
}

__device__ __forceinline__ float softplusf(float v) { return v > 20.0f ? v : log1pf(expf(v)); }
template <bool WITH_DT> __device__ __forceinline__ void norm_phase(const Ctx& C, const float* X, const float* gain, bf16* H, int l) {
    const int gw = C.vcu * NWAVES + C.wave, NGW = C.G * NWAVES;
    LAS unsigned char* W16 = C.lds;
    float dtb = 0.f, aexp = 0.f;
    if (WITH_DT) {
        AREF A = *C.a; const float* wsrc = A.in[I_WIN] + (size_t)l * D * INCOLS + 2560;
#pragma unroll 4
        for (int i = C.tid; i < D * 4; i += NTHR) { const int k = i >> 2, q = i & 3; const f32x4 v = *(const f32x4*)(wsrc + (size_t)k * INCOLS + 4 * q);
#pragma unroll
            for (int e = 0; e < 4; ++e) *(LAS bf16*)(W16 + ((4 * q + e) * D + k) * 2) = (bf16)f2bf(v[e]); }
        { const int hd = ((C.lane >> 5) & 1) * 8 + ((C.lane >> 4) & 1) * 4 + ((C.lane >> 3) & 1) * 2 + ((C.lane >> 2) & 1); dtb = A.in[I_DTB][l * 16 + hd]; aexp = expf(A.in[I_ALOG][l * 16 + hd]); }
        LBAR();
    }
    f32x4 gn[8];
#pragma unroll
    for (int j = 0; j < 8; ++j) gn[j] = ((const f32x4*)gain)[C.lane + 64 * j];
    for (int m0 = gw; m0 < MP; m0 += 2 * NGW) {
        const int m1 = m0 + NGW; const bool has1 = m1 < MP;
        f32x4 v[2][8];
#pragma unroll
        for (int r = 0; r < 2; ++r) {
            const int m = r ? (has1 ? m1 : m0) : m0;
            const f32x4* xr = (const f32x4*)(X + (size_t)m * D) + C.lane; float s = 0.f;
#pragma unroll
            for (int j = 0; j < 8; ++j) { v[r][j] = xr[64 * j]; s += (v[r][j][0] * v[r][j][0] + v[r][j][1] * v[r][j][1]) + (v[r][j][2] * v[r][j][2] + v[r][j][3] * v[r][j][3]); }
            const float rs = rsqrtf(wave_sum(s) * (1.0f / D) + EPS);
            v2u* o = (v2u*)(H + (size_t)m * D) + C.lane;
#pragma unroll
            for (int j = 0; j < 8; ++j) { v[r][j] = v[r][j] * rs * gn[j]; v2u w; w.x = pk2(v[r][j][0], v[r][j][1]); w.y = pk2(v[r][j][2], v[r][j][3]); if (r == 0 || has1) o[64 * j] = w; }
        }
        if (WITH_DT) {
            float d[2][16];
#pragma unroll
            for (int hg = 0; hg < 4; ++hg) {
#pragma unroll
                for (int hh = 0; hh < 4; ++hh) { const int hd = 4 * hg + hh; float d0 = 0.f, d1 = 0.f;
#pragma unroll
                    for (int j = 0; j < 8; ++j) { const v2u ww = *(const LAS v2u*)(W16 + (hd * D + 4 * (C.lane + 64 * j)) * 2); const float w0 = bflo(ww.x), w1 = bfhi(ww.x), w2 = bflo(ww.y), w3 = bfhi(ww.y);
                        d0 += (v[0][j][0] * w0 + v[0][j][1] * w1) + (v[0][j][2] * w2 + v[0][j][3] * w3); d1 += (v[1][j][0] * w0 + v[1][j][1] * w1) + (v[1][j][2] * w2 + v[1][j][3] * w3); }
                    d[0][hd] = d0; d[1][hd] = d1; }
                __builtin_amdgcn_sched_barrier(0);
            }
            float tot[2];
#pragma unroll
            for (int r = 0; r < 2; ++r) {
#pragma unroll
                for (int n = 8, o = 32; n >= 1; n >>= 1, o >>= 1) {
                    const bool up = (C.lane & o) != 0;
#pragma unroll
                    for (int i2 = 0; i2 < n; ++i2) { const float keep = up ? d[r][i2 + n] : d[r][i2], send = up ? d[r][i2] : d[r][i2 + n]; d[r][i2] = keep + __shfl_xor(send, o); }
                }
                float t = d[r][0]; t += __shfl_xor(t, 2); t += __shfl_xor(t, 1); tot[r] = t;
            }
            const int hd = ((C.lane >> 5) & 1) * 8 + ((C.lane >> 4) & 1) * 4 + ((C.lane >> 3) & 1) * 2 + ((C.lane >> 2) & 1);
            if ((C.lane & 3) == 0) {
                { float dt = softplusf(tot[0] + dtb); if (m0 < NNULL) dt = 0.f; ((float*)(C.ws + WS_DT))[(size_t)m0 * 16 + hd] = dt; ((float*)(C.ws + WS_AV))[(size_t)m0 * 16 + hd] = -dt * aexp; }
                if (has1) { float dt = softplusf(tot[1] + dtb); if (m1 < NNULL) dt = 0.f; ((float*)(C.ws + WS_DT))[(size_t)m1 * 16 + hd] = dt; ((float*)(C.ws + WS_AV))[(size_t)m1 * 16 + hd] = -dt * aexp; }
            }
        }
    }
}
__device__ __forceinline__ void final_phase(const Ctx& C, const float* X, const float* gain, float* out) {
    const int gw = C.vcu * NWAVES + C.wave, NGW = C.G * NWAVES;
    f32x4 gn[8];
#pragma unroll
    for (int j = 0; j < 8; ++j) gn[j] = ((const f32x4*)gain)[C.lane + 64 * j];
    for (int m = ROW_P0 + gw; m < MR; m += NGW) {
        const f32x4* xr = (const f32x4*)(X + (size_t)m * D) + C.lane;
        f32x4 v[8]; float s = 0.f;
#pragma unroll
        for (int j = 0; j < 8; ++j) { v[j] = xr[64 * j]; s += (v[j][0] * v[j][0] + v[j][1] * v[j][1]) + (v[j][2] * v[j][2] + v[j][3] * v[j][3]); }
        const float rs = rsqrtf(wave_sum(s) * (1.0f / D) + EPS);
        f32x4* o = (f32x4*)(out + (m < ROW_S0 ? O_YP + (size_t)(m - ROW_P0) * D : O_YS + (size_t)(m - ROW_S0) * D)) + C.lane;
#pragma unroll
        for (int j = 0; j < 8; ++j) o[64 * j] = v[j] * rs * gn[j];
    }
}

__device__ __forceinline__ bf16x8 ldsfrag(const LAS unsigned char* base, int row, int pitchB, int kel) { return *(const LAS bf16x8*)(base + row * pitchB + kel * 2); }
__device__ __forceinline__ float ret_lgam(int h) { return log1pf(-exp2f(-5.0f - (float)h)); }
struct ConvSrc {
    const bf16* XBC; const float* sconv; int c, r0;
    __device__ __forceinline__ float at(int t, int ch) const {
        if (t >= 0) return bf2f(XBC[(size_t)(r0 + t) * 1536 + ch]);
        if (c == 0) return 0.f;
        if (c < NCHP) return bf2f(XBC[(size_t)(r0 + t) * 1536 + ch]);
        return sconv[((size_t)(c - NCHP) * 3 + (3 + t)) * 1536 + ch];
    }
};

__device__ __forceinline__ v2u pk4(const f32x4 v) { v2u w; w.x = pk2(v[0], v[1]); w.y = pk2(v[2], v[3]); return w; }
__device__ __forceinline__ f32x4 unpk4(const v2u w) { return (f32x4){bflo(w.x), bfhi(w.x), bflo(w.y), bfhi(w.y)}; }
__device__ __forceinline__ void m1_ssd(const Ctx& C, int l, int c, int g) {
    AREF A = *C.a; unsigned char* ws = C.ws; const int tid = C.tid, lane = C.lane, w = C.wave, r0 = 64 * c;
    LAS unsigned char* XT = C.lds; LAS unsigned char* BT = C.lds + 73728;
    LAS float* SDT = (LAS float*)(C.lds + 92160); LAS float* SCUM = (LAS float*)(C.lds + 94208);
    const int l15 = lane & 15, l4 = lane >> 4;
    const ConvSrc cs{(const bf16*)(ws + WS_XBC), A.in[I_SCONV] + (size_t)l * 16 * 3 * 1536, c, r0};
    const float* cw = A.in[I_CONVW] + (size_t)l * 4 * 1536; const float* cb = A.in[I_CONVB] + (size_t)l * 1536;
    const int chx = 512 * g + tid;
    float raw[67];
#pragma unroll
    for (int t = 0; t < 67; ++t) raw[t] = cs.at(t - 3, chx);
    const float xw0 = cw[chx], xw1 = cw[1536 + chx], xw2 = cw[2 * 1536 + chx], xw3 = cw[3 * 1536 + chx], xbias = cb[chx];
    {
        const int hd = 8 * g + w; const float dt = ((const float*)(ws + WS_DT))[(r0 + lane) * 16 + hd]; float v = ((const float*)(ws + WS_AV))[(r0 + lane) * 16 + hd];
#pragma unroll
        for (int o = 1; o < 64; o <<= 1) { const float t = __shfl_up(v, o); if (lane >= o) v += t; }
        SDT[lane * 8 + w] = dt; SCUM[lane * 8 + w] = v; ((float*)(ws + WS_CUM))[(r0 + lane) * 16 + hd] = v;
        if (lane == 63) ((float*)(ws + WS_GAM))[(size_t)c * GAM_N + hd] = expf(v);
    }
    LBAR();
    {
        const int hh = tid >> 6; const float clast = SCUM[63 * 8 + hh];
        bf16* xg = (bf16*)(ws + WS_XTG) + ((size_t)c * 1024 + chx) * 64;
#pragma unroll
        for (int t0 = 0; t0 < 64; t0 += 8) {
            float val[8], vw[8];
#pragma unroll
            for (int tt = 0; tt < 8; ++tt) { const int t = t0 + tt; val[tt] = fsilu(xbias + xw0 * raw[t] + xw1 * raw[t + 1] + xw2 * raw[t + 2] + xw3 * raw[t + 3]);
                vw[tt] = val[tt] * (__expf(clast - SCUM[t * 8 + hh]) * SDT[t * 8 + hh]); }
            v4u o; o.x = pk2(val[0], val[1]); o.y = pk2(val[2], val[3]); o.z = pk2(val[4], val[5]); o.w = pk2(val[6], val[7]); *(v4u*)(xg + t0) = o;
            o.x = pk2(vw[0], vw[1]); o.y = pk2(vw[2], vw[3]); o.z = pk2(vw[4], vw[5]); o.w = pk2(vw[6], vw[7]); *(LAS v4u*)(XT + tid * 144 + t0 * 2) = o;
        }
    }
    {
        const int col = tid & 255, seg = tid >> 8, t0 = 32 * seg, ch = col < 128 ? 1024 + 128 * g + col : 1280 + 128 * g + (col - 128);
        const float w0 = cw[ch], w1 = cw[1536 + ch], w2 = cw[2 * 1536 + ch], w3 = cw[3 * 1536 + ch], bias = cb[ch];
        float rb[35];
#pragma unroll
        for (int t = 0; t < 35; ++t) rb[t] = cs.at(t0 - 3 + t, ch);
        bf16* bg = (bf16*)(ws + WS_BCG) + (size_t)(r0 + t0) * 512 + 256 * g + col;
#pragma unroll
        for (int t8 = 0; t8 < 32; t8 += 8) { float val[8];
#pragma unroll
            for (int tt = 0; tt < 8; ++tt) { const int t = t8 + tt; val[tt] = fsilu(bias + w0 * rb[t] + w1 * rb[t + 1] + w2 * rb[t + 2] + w3 * rb[t + 3]); bg[(unsigned)(t * 512)] = (bf16)f2bf(val[tt]); }
            if (col < 128) { v4u o; o.x = pk2(val[0], val[1]); o.y = pk2(val[2], val[3]); o.z = pk2(val[4], val[5]); o.w = pk2(val[6], val[7]); *(LAS v4u*)(BT + col * 144 + (t0 + t8) * 2) = o; } }
    }
    LBAR();
    {
        const int hd = 8 * g + w; bf16* U = (bf16*)(ws + WS_U) + (size_t)c * STATE_N + ST_SSD + (size_t)hd * 8192;
#pragma unroll 1
        for (int pi = 0; pi < 4; ++pi) {
            const bf16x8 a0 = ldsfrag(XT, 64 * w + 16 * pi + l15, 144, 8 * l4), a1 = ldsfrag(XT, 64 * w + 16 * pi + l15, 144, 32 + 8 * l4);
#pragma unroll
            for (int nj = 0; nj < 8; ++nj) {
                f32x4 acc = (f32x4){0.f, 0.f, 0.f, 0.f};
                acc = mfma16(ldsfrag(BT, 16 * nj + l15, 144, 8 * l4), a0, acc); acc = mfma16(ldsfrag(BT, 16 * nj + l15, 144, 32 + 8 * l4), a1, acc);
                *(v2u*)(U + (16 * pi + l15) * 128 + 16 * nj + 4 * l4) = pk4(acc);
            }
        }
    }
}

__device__ __forceinline__ void m1_hg(const Ctx& C, int l, int c, int h) {
    unsigned char* ws = C.ws; const int tid = C.tid, lane = C.lane, w = C.wave, r0 = 64 * c, l15 = lane & 15, l4 = lane >> 4;
    LAS unsigned char* KT = C.lds; LAS unsigned char* VT = C.lds + 18432; LAS float* SEG = (LAS float*)(C.lds + 36864);
    const int col = tid & 127, seg = tid >> 7; const size_t base = (size_t)(r0 + 16 * seg) * 1024 + 128 * h + col;
    const float* LG = (const float*)(ws + WS_LG) + base; const bf16* KK = (const bf16*)(ws + WS_KK) + base; const bf16* HV = (const bf16*)(ws + WS_HV) + base;
    float cum[16], kk[16], vv[16];
#pragma unroll
    for (int i = 0; i < 16; ++i) { cum[i] = LG[(size_t)i * 1024]; kk[i] = bf2f(KK[(size_t)i * 1024]); vv[i] = bf2f(HV[(size_t)i * 1024]); }
#pragma unroll
    for (int i = 1; i < 16; ++i) cum[i] += cum[i - 1];
    SEG[seg * 128 + col] = cum[15];
    LBAR();
    float off = 0.f, tot = 0.f;
#pragma unroll
    for (int s = 0; s < 4; ++s) { const float t = SEG[s * 128 + col]; tot += t; if (s < seg) off += t; }
#pragma unroll
    for (int i = 0; i < 16; ++i) kk[i] *= __expf(tot - (cum[i] + off));
    { v4u o; o.x = pk2(kk[0], kk[1]); o.y = pk2(kk[2], kk[3]); o.z = pk2(kk[4], kk[5]); o.w = pk2(kk[6], kk[7]); *(LAS v4u*)(KT + col * 144 + seg * 32) = o;
      o.x = pk2(kk[8], kk[9]); o.y = pk2(kk[10], kk[11]); o.z = pk2(kk[12], kk[13]); o.w = pk2(kk[14], kk[15]); *(LAS v4u*)(KT + col * 144 + seg * 32 + 16) = o;
      o.x = pk2(vv[0], vv[1]); o.y = pk2(vv[2], vv[3]); o.z = pk2(vv[4], vv[5]); o.w = pk2(vv[6], vv[7]); *(LAS v4u*)(VT + col * 144 + seg * 32) = o;
      o.x = pk2(vv[8], vv[9]); o.y = pk2(vv[10], vv[11]); o.z = pk2(vv[12], vv[13]); o.w = pk2(vv[14], vv[15]); *(LAS v4u*)(VT + col * 144 + seg * 32 + 16) = o; }
    if (seg == 0) ((float*)(ws + WS_GAM))[(size_t)c * GAM_N + 16 + 128 * h + col] = expf(tot);
    LBAR();
    {
        bf16* U = (bf16*)(ws + WS_U) + (size_t)c * STATE_N + ST_HG + (size_t)h * 16384;
        const bf16x8 a0 = ldsfrag(VT, 16 * w + l15, 144, 8 * l4), a1 = ldsfrag(VT, 16 * w + l15, 144, 32 + 8 * l4);
        const bool nat = c >= NCHP;
#pragma unroll
        for (int kj = 0; kj < 8; ++kj) {
            f32x4 acc = (f32x4){0.f, 0.f, 0.f, 0.f}; const bf16x8 k0 = ldsfrag(KT, 16 * kj + l15, 144, 8 * l4), k1 = ldsfrag(KT, 16 * kj + l15, 144, 32 + 8 * l4);
            if (!nat) { acc = mfma16(k0, a0, acc); acc = mfma16(k1, a1, acc); *(v2u*)(U + (16 * w + l15) * 128 + 16 * kj + 4 * l4) = pk4(acc); }
            else { acc = mfma16(a0, k0, acc); acc = mfma16(a1, k1, acc); *(v2u*)(U + (16 * kj + l15) * 128 + 16 * w + 4 * l4) = pk4(acc); }
        }
    }
}

__device__ __forceinline__ void m1_ret(const Ctx& C, int l, int c, int h) {
    unsigned char* ws = C.ws; const int tid = C.tid, lane = C.lane, w = C.wave, r0 = 64 * c, l15 = lane & 15, l4 = lane >> 4;
    LAS unsigned char* KT = C.lds; LAS unsigned char* VT = C.lds + 9216;
    const float lg = ret_lgam(h);
    {   const int kp = tid & 63, s8 = tid >> 6; const bf16* RK = (const bf16*)(ws + WS_RK) + (size_t)(r0 + 8 * s8) * 512 + 64 * h + kp; float v[8];
#pragma unroll
        for (int i = 0; i < 8; ++i) v[i] = bf2f(RK[(size_t)i * 512]) * __expf((float)(63 - (8 * s8 + i)) * lg);
        v4u o; o.x = pk2(v[0], v[1]); o.y = pk2(v[2], v[3]); o.z = pk2(v[4], v[5]); o.w = pk2(v[6], v[7]); *(LAS v4u*)(KT + kp * 144 + s8 * 16) = o; }
    {   const int col = tid & 127, seg = tid >> 7; const bf16* RV = (const bf16*)(ws + WS_RV) + (size_t)(r0 + 16 * seg) * 1024 + 128 * h + col; float vv[16];
#pragma unroll
        for (int i = 0; i < 16; ++i) vv[i] = bf2f(RV[(size_t)i * 1024]);
        v4u o; o.x = pk2(vv[0], vv[1]); o.y = pk2(vv[2], vv[3]); o.z = pk2(vv[4], vv[5]); o.w = pk2(vv[6], vv[7]); *(LAS v4u*)(VT + col * 144 + seg * 32) = o;
        o.x = pk2(vv[8], vv[9]); o.y = pk2(vv[10], vv[11]); o.z = pk2(vv[12], vv[13]); o.w = pk2(vv[14], vv[15]); *(LAS v4u*)(VT + col * 144 + seg * 32 + 16) = o; }
    LBAR();
    {   bf16* U = (bf16*)(ws + WS_U) + (size_t)c * STATE_N + ST_RET + (size_t)h * 8192;
        const bf16x8 a0 = ldsfrag(VT, 16 * w + l15, 144, 8 * l4), a1 = ldsfrag(VT, 16 * w + l15, 144, 32 + 8 * l4);
        const bool nat = c >= NCHP;
#pragma unroll
        for (int kj = 0; kj < 4; ++kj) {
            f32x4 acc = (f32x4){0.f, 0.f, 0.f, 0.f}; const bf16x8 k0 = ldsfrag(KT, 16 * kj + l15, 144, 8 * l4), k1 = ldsfrag(KT, 16 * kj + l15, 144, 32 + 8 * l4);
            if (!nat) { acc = mfma16(k0, a0, acc); acc = mfma16(k1, a1, acc); *(v2u*)(U + (16 * w + l15) * 64 + 16 * kj + 4 * l4) = pk4(acc); }
            else { acc = mfma16(a0, k0, acc); acc = mfma16(a1, k1, acc); *(v2u*)(U + (16 * kj + l15) * 128 + 16 * w + 4 * l4) = pk4(acc); }
        }
    }
}

#ifndef REPI_M1_SSD
#define REPI_M1_SSD 1
#endif
#ifndef REPI_M1_HG
#define REPI_M1_HG 1
#endif
#ifndef REPI_M1_RET
#define REPI_M1_RET 1
#endif
__device__ __forceinline__ void m1_phase(const Ctx& C0, int l, int mask = 7) {
    constexpr int N_SSD = NCH * 2, N_HG = NCH * 8, N_IT = NCH * 18;
    unsigned* cnt = (unsigned*)(C0.ws + WS_CTL) + CW_QUEUE + 64 * (l * 8 + 0 * 4 + (mask == 7 ? 0 : 1));
    volatile LAS int* slot = (volatile LAS int*)(C0.lds + LDSCTL_OFF + 64);
    int nxt = 0;
    if (C0.tid == 0) { nxt = (int)__hip_atomic_fetch_add(cnt, 1u, __ATOMIC_RELAXED, __HIP_MEMORY_SCOPE_AGENT); slot[0] = nxt; }
    LBAR();
    int it = slot[0];
    while (it < N_IT) {
        if (C0.tid == 0) nxt = (int)__hip_atomic_fetch_add(cnt, 1u, __ATOMIC_RELAXED, __HIP_MEMORY_SCOPE_AGENT);
        Ctx C = C0; { int t_ = C0.tid; asm volatile("" : "+v"(t_)); C.tid = t_; C.lane = t_ & 63; C.wave = __builtin_amdgcn_readfirstlane(t_ >> 6); }
        if (it < N_SSD) { if (mask & 1) m1_ssd(C, l, it >> 1, it & 1); }
        else if (it < N_SSD + N_HG) { if (mask & 2) { const int j = it - N_SSD; m1_hg(C, l, j >> 3, j & 7); } }
        else { if (mask & 4) { const int j = it - N_SSD - N_HG; m1_ret(C, l, j >> 3, j & 7); } }
        LBAR();
        if (C0.tid == 0) slot[0] = nxt;
        LBAR();
        it = slot[0];
    }
}

struct StIdx { int kind, h; size_t outoff; int ostride; };
__device__ __forceinline__ void m2_elem(int idx, int& kind, int& h, int& o0, int& ostr) {
    if (idx < ST_HG) { kind = 0; h = idx >> 13; o0 = idx; ostr = 1; }
    else if (idx < ST_RET) { const int r = idx - ST_HG; kind = 1; h = r >> 14; const int v = (r >> 7) & 127, k = r & 127; o0 = h * 16384 + k * 128 + v; ostr = 128; }
    else { const int r = idx - ST_RET; kind = 2; h = r >> 13; const int v = (r >> 6) & 127, kp = r & 63; o0 = h * 8192 + ret_dim(kp) * 128 + v; ostr = 128; }
}
__device__ __forceinline__ void m2_sample_item(AREF A, unsigned char* ws, int l, int j) {
    float* out = A.out; const bf16* U = (const bf16*)(ws + WS_U); const float* GAM = (const float*)(ws + WS_GAM);
    const int b = j / (STATE_N / 4), idx = 4 * (j - b * (STATE_N / 4)), c = NCHP + b;
    const f32x4 u = unpk4(*(const v2u*)(U + (size_t)c * STATE_N + idx));
    if (idx < ST_HG) { const int h = idx >> 13; const size_t o = ((size_t)l * 16 + b) * 131072 + idx; const float t = GAM[(size_t)c * GAM_N + h];
        *(f32x4*)(out + O_SSMS + o) = *(const f32x4*)(A.in[I_SSSM] + o) * t + u; }
    else if (idx < ST_RET) { const int r = idx - ST_HG, h = r >> 14, k = (r >> 7) & 127; const size_t o = ((size_t)l * 16 + b) * 131072 + r; const float t = GAM[(size_t)c * GAM_N + 16 + 128 * h + k];
        *(f32x4*)(out + O_HGS + o) = *(const f32x4*)(A.in[I_SHG] + o) * t + u; }
    else { const int r = idx - ST_RET, h = r >> 13, kp = (r >> 7) & 63, v = r & 127; const size_t o = ((size_t)l * 16 + b) * 65536 + h * 8192 + ret_dim(kp) * 128 + v; const float t = expf(64.0f * ret_lgam(h));
        *(f32x4*)(out + O_RETS + o) = *(const f32x4*)(A.in[I_SRET] + o) * t + u; }
}
__device__ __forceinline__ void m2_phase(const Ctx& C, int l) {
    AREF A = *C.a; unsigned char* ws = C.ws; float* out = A.out;
    const bf16* U = (const bf16*)(ws + WS_U); const float* GAM = (const float*)(ws + WS_GAM); bf16* SB = (bf16*)(ws + WS_SB);
    constexpr int NCB = STATE_N / 4 / NTHR;
    const int nb_other = C.G - NCB;
    constexpr int NSI = 16 * (STATE_N / 4);
    const bool chain_wg = C.vcu < NCB || nb_other <= 0;
    if (chain_wg) {
      for (int e4 = C.vcu * NTHR + C.tid; e4 < STATE_N / 4; e4 += (nb_other > 0 ? NCB : C.G) * NTHR) {
        const int idx = 4 * e4; int kind, h, o0, ostr; m2_elem(idx, kind, h, o0, ostr);
        const float gret = expf(64.0f * ret_lgam(h));
        const int goff = kind == 0 ? h : 16 + 128 * h + (idx & 127);
        f32x4 S = (f32x4){0.f, 0.f, 0.f, 0.f};
        const bf16* up = U + idx; const float* gp = GAM + goff; bf16* sp = SB + idx;
#pragma unroll 1
        for (int c0 = 0; c0 < 128; c0 += 16) {
            v2u u[16]; f32x4 gm[16];
#pragma unroll
            for (int q = 0; q < 16; ++q) { u[q] = *(const v2u*)(up + (size_t)(c0 + q) * STATE_N);
                if (kind == 0) { const float t = gp[(size_t)(c0 + q) * GAM_N]; gm[q] = (f32x4){t, t, t, t}; }
                else if (kind == 1) gm[q] = *(const f32x4*)(gp + (size_t)(c0 + q) * GAM_N);
                else gm[q] = (f32x4){gret, gret, gret, gret}; }
#pragma unroll
            for (int q = 0; q < 16; ++q) { *(v2u*)(sp + (size_t)(c0 + q) * STATE_N) = pk4(S); S = S * gm[q] + unpk4(u[q]); }
        }
        {   const int c = 128; const f32x4 u = unpk4(*(const v2u*)(up + (size_t)c * STATE_N)); f32x4 gm;
            if (kind == 0) { const float t = gp[(size_t)c * GAM_N]; gm = (f32x4){t, t, t, t}; } else if (kind == 1) gm = *(const f32x4*)(gp + (size_t)c * GAM_N); else gm = (f32x4){gret, gret, gret, gret};
            *(v2u*)(sp + (size_t)c * STATE_N) = pk4(S); S = S * gm + u; }
        float* o = out + (kind == 0 ? O_SSMP + (size_t)l * 131072 : kind == 1 ? O_HGP + (size_t)l * 131072 : O_RETP + (size_t)l * 65536);
        if (kind == 0) *(f32x4*)(o + o0) = S; else { o[o0] = S[0]; o[o0 + ostr] = S[1]; o[o0 + 2 * ostr] = S[2]; o[o0 + 3 * ostr] = S[3]; }
      }
    }
    if (!chain_wg || nb_other <= 0) {
      const int ob = nb_other > 0 ? C.vcu - NCB : C.vcu, nob = nb_other > 0 ? nb_other : C.G;
      for (int j = ob * NTHR + C.tid; j < NSI; j += nob * NTHR) m2_sample_item(A, ws, l, j);
      const bf16* XBC = (const bf16*)(ws + WS_XBC);
      for (int i = ob * NTHR + C.tid; i < 17 * 4608; i += nob * NTHR) {
        const int s = i / 4608, r = i - s * 4608, jrow = r / 1536, ch = r - jrow * 1536;
        if (s == 0) out[O_CONVP + (size_t)l * 4608 + r] = bf2f(XBC[(size_t)(ROW_S0 - 3 + jrow) * 1536 + ch]);
        else out[O_CONVS + ((size_t)l * 16 + (s - 1)) * 4608 + r] = bf2f(XBC[(size_t)(ROW_S0 + 64 * (s - 1) + 61 + jrow) * 1536 + ch]);
      }
    }
}


__device__ __forceinline__ void m3_ssd(const Ctx& C, int l, int c, int g) {
    AREF A = *C.a; unsigned char* ws = C.ws; const int tid = C.tid, lane = C.lane, w = C.wave, r0 = 64 * c, l15 = lane & 15, l4 = lane >> 4;
    LAS float* CBS = (LAS float*)C.lds; LAS float* SDT = (LAS float*)(C.lds + 17408); LAS float* SCUM = (LAS float*)(C.lds + 19456); LAS float* SSQ = (LAS float*)(C.lds + 21504);
    LAS unsigned char* CM = C.lds + 23552;
    LAS unsigned char* ZT = C.lds + 40960;
    const bf16* BCG = (const bf16*)(ws + WS_BCG) + (size_t)r0 * 512 + 256 * g;
    const int hd = 8 * g + w;
    const bf16* SB = (const bf16*)(ws + WS_SB) + (size_t)c * STATE_N + ST_SSD + (size_t)hd * 8192;
    const float* S0 = A.in[I_SSSM] + ((size_t)l * 16 + (c >= NCHP ? c - NCHP : 0)) * 131072 + (size_t)hd * 8192;
    const bf16* XTG = (const bf16*)(ws + WS_XTG) + ((size_t)c * 1024 + 512 * g + 64 * w) * 64;
#define M3S_LOAD(SF, XF, PB) do { _Pragma("unroll") for (int ks_ = 0; ks_ < 4; ++ks_) { \
            if (c < NCHP) SF[ks_] = *(const bf16x8*)(SB + (unsigned)((16 * (PB) + l15) * 128 + 32 * ks_ + 8 * l4)); \
            else { const float* sp_ = S0 + (unsigned)((16 * (PB) + l15) * 128 + 32 * ks_ + 8 * l4); const f32x4 s0_ = *(const f32x4*)sp_, s1_ = *(const f32x4*)(sp_ + 4); \
                v4u o_; o_.x = pk2(s0_[0], s0_[1]); o_.y = pk2(s0_[2], s0_[3]); o_.z = pk2(s1_[0], s1_[1]); o_.w = pk2(s1_[2], s1_[3]); SF[ks_] = __builtin_bit_cast(bf16x8, o_); } } \
        XF[0] = *(const bf16x8*)(XTG + (unsigned)((16 * (PB) + l15) * 64 + 8 * l4)); XF[1] = *(const bf16x8*)(XTG + (unsigned)((16 * (PB) + l15) * 64 + 32 + 8 * l4)); } while (0)
    bf16x8 sfA[4], xfA[2], sfB[4], xfB[2];
    M3S_LOAD(sfA, xfA, 0);
    { const int row = tid >> 3, hh = tid & 7; SDT[tid] = ((const float*)(ws + WS_DT))[(r0 + row) * 16 + 8 * g + hh]; SCUM[tid] = ((const float*)(ws + WS_CUM))[(r0 + row) * 16 + 8 * g + hh]; }
    {
        const bf16* ZS = (const bf16*)(ws + WS_ZS) + (size_t)r0 * 1024 + 512 * g;
#pragma unroll
        for (int q = 0; q < 2; ++q) { const int ch = tid + 512 * q, row = ch >> 4, c8 = ch & 15; *(LAS v4u*)(CM + row * 272 + c8 * 16) = *(const v4u*)(BCG + (unsigned)(row * 512 + 128 + c8 * 8)); }
#pragma unroll
        for (int q = 0; q < 8; ++q) { const int ch = tid + 512 * q, row = ch >> 6, c8 = ch & 63; *(LAS v4u*)(ZT + row * 1040 + c8 * 16) = *(const v4u*)(ZS + (unsigned)(row * 1024 + c8 * 8)); }
    }
    {
        const int i = w >> 1;
#pragma unroll
        for (int jj = 0; jj < 2; ++jj) { const int j = 2 * (w & 1) + jj;
            if (j <= i) { f32x4 acc = (f32x4){0.f, 0.f, 0.f, 0.f};
#pragma unroll
                for (int ks = 0; ks < 4; ++ks) acc = mfma16(*(const bf16x8*)(BCG + (unsigned)((16 * j + l15) * 512 + 32 * ks + 8 * l4)), *(const bf16x8*)(BCG + (unsigned)((16 * i + l15) * 512 + 128 + 32 * ks + 8 * l4)), acc);
                *(LAS f32x4*)(CBS + (16 * i + l15) * 68 + 16 * j + 4 * l4) = acc; } }
    }
    LBAR();
    const float dskip = A.in[I_DSKIP][l * 16 + hd];
    v2u Y[4][4]; float ssq[4], ec[4];
    bf16x8 att[4][2];
#pragma unroll
    for (int i = 0; i < 4; ++i) {
        const int t = 16 * i + l15; const float ct = SCUM[t * 8 + w]; ec[i] = __expf(ct); ssq[i] = 0.f;
#pragma unroll
        for (int ks = 0; ks < 2; ++ks) {
            if (ks == 1 && i < 2) { att[i][ks] = (bf16x8){0, 0, 0, 0, 0, 0, 0, 0}; continue; }
            float v[8];
#pragma unroll
            for (int jj = 0; jj < 8; ++jj) { const int s = 32 * ks + 8 * l4 + jj; const float x = CBS[t * 68 + s] * (__expf(ct - SCUM[s * 8 + w]) * SDT[s * 8 + w]); v[jj] = s < t ? x : (s == t ? x + dskip : 0.f); }
            v4u o; o.x = pk2(v[0], v[1]); o.y = pk2(v[2], v[3]); o.z = pk2(v[4], v[5]); o.w = pk2(v[6], v[7]); att[i][ks] = __builtin_bit_cast(bf16x8, o);
        }
    }
#define M3S_BLOCK(SF, XF, PB) do { _Pragma("unroll") for (int i = 0; i < 4; ++i) { const int t = 16 * i + l15; \
            f32x4 yi = (f32x4){0.f, 0.f, 0.f, 0.f}, yn = (f32x4){0.f, 0.f, 0.f, 0.f}; \
            yi = mfma16(XF[0], att[i][0], yi); if (i >= 2) yi = mfma16(XF[1], att[i][1], yi); \
            _Pragma("unroll") for (int ks = 0; ks < 4; ++ks) yn = mfma16(SF[ks], ldsfrag(CM, t, 272, 32 * ks + 8 * l4), yn); \
            const f32x4 z = unpk4(*(const LAS v2u*)(ZT + t * 1040 + (64 * w + 16 * (PB) + 4 * l4) * 2)); \
            const f32x4 y = (yi + yn * ec[i]) * z; ssq[i] += (y[0] * y[0] + y[1] * y[1]) + (y[2] * y[2] + y[3] * y[3]); Y[i][PB] = pk4(y); } } while (0)
    M3S_LOAD(sfB, xfB, 1); M3S_BLOCK(sfA, xfA, 0); __builtin_amdgcn_sched_barrier(0);
    M3S_LOAD(sfA, xfA, 2); M3S_BLOCK(sfB, xfB, 1); __builtin_amdgcn_sched_barrier(0);
    M3S_LOAD(sfB, xfB, 3); M3S_BLOCK(sfA, xfA, 2); __builtin_amdgcn_sched_barrier(0);
    M3S_BLOCK(sfB, xfB, 3);
#undef M3S_LOAD
#undef M3S_BLOCK
#pragma unroll
    for (int i = 0; i < 4; ++i) { float s = ssq[i]; s += __shfl_xor(s, 16); s += __shfl_xor(s, 32); if (l4 == 0) SSQ[w * 64 + 16 * i + l15] = s; }
    LBAR();
    {   const float* gn = A.in[I_SSDN] + (size_t)l * 1024 + 512 * g + 64 * w; bf16* BR = (bf16*)(ws + WS_BR) + (size_t)r0 * 1024 + 512 * g + 64 * w;
#pragma unroll
        for (int i = 0; i < 4; ++i) { const int t = 16 * i + l15; float tot = 0.f;
#pragma unroll
            for (int ww = 0; ww < 8; ++ww) tot += SSQ[ww * 64 + t];
            const float rs = rsqrtf(tot * (1.0f / 512.0f) + EPS);
#pragma unroll
            for (int pb = 0; pb < 4; ++pb) { const int p0 = 16 * pb + 4 * l4; const f32x4 gv = *(const f32x4*)(gn + p0); *(v2u*)(BR + (unsigned)(t * 1024 + p0)) = pk4(unpk4(Y[i][pb]) * rs * gv); } }
    }
}

__device__ __forceinline__ void m3_hg(const Ctx& C, int l, int c, int h) {
    AREF A = *C.a; unsigned char* ws = C.ws; const int tid = C.tid, lane = C.lane, w = C.wave, r0 = 64 * c, l15 = lane & 15, l4 = lane >> 4;
    LAS unsigned char* QT = C.lds; LAS unsigned char* KT = C.lds + 17408; LAS unsigned char* QH = C.lds + 34816; LAS unsigned char* VT = C.lds + 52224; LAS unsigned char* ATT = C.lds + 70656;
    LAS float* SEG = (LAS float*)(C.lds + 79872); LAS float* SSQ = (LAS float*)(C.lds + 83968);
    LAS unsigned char* ST = C.lds + 84480;
    const int i = w >> 1, t = 16 * i + l15;
    const float* gn = A.in[I_HGN] + (size_t)l * 1024 + 128 * h; const bf16* HG = (const bf16*)(ws + WS_HG) + (size_t)r0 * 1024 + 128 * h;
    if (c < NCHP) { const bf16* SB = (const bf16*)(ws + WS_SB) + (size_t)c * STATE_N + ST_HG + (size_t)h * 16384;
#pragma unroll
        for (int q = 0; q < 4; ++q) { const int ch = tid + 512 * q, v = ch >> 4, k8 = ch & 15; *(LAS v4u*)(ST + v * 272 + k8 * 16) = *(const v4u*)(SB + v * 128 + k8 * 8); } }
    else { const float* S0 = A.in[I_SHG] + ((size_t)l * 16 + (c - NCHP)) * 131072 + (size_t)h * 16384;
#pragma unroll
        for (int q = 0; q < 8; ++q) { const int ch = tid + 512 * q, k = ch >> 5, v4 = (ch & 31) * 4; const f32x4 s = *(const f32x4*)(S0 + k * 128 + v4);
#pragma unroll
            for (int e = 0; e < 4; ++e) *(LAS bf16*)(ST + (v4 + e) * 272 + k * 2) = (bf16)f2bf(s[e]); } }
    v2u ggs[4]; f32x4 gvs[4];
#pragma unroll
    for (int b4 = 0; b4 < 4; ++b4) { const int vb = 4 * (w & 1) + b4; ggs[b4] = *(const v2u*)(HG + (unsigned)(t * 1024 + 16 * vb + 4 * l4)); gvs[b4] = *(const f32x4*)(gn + 16 * vb + 4 * l4); }
    {
        const int cp = tid & 63, seg = tid >> 6; const size_t base = (size_t)(r0 + 8 * seg) * 1024 + 128 * h + 2 * cp;
        const float* LG = (const float*)(ws + WS_LG) + base; const bf16* KK = (const bf16*)(ws + WS_KK) + base; const bf16* HV = (const bf16*)(ws + WS_HV) + base; const bf16* HQ = (const bf16*)(ws + WS_HQ) + base;
        f32x2 cum[8]; unsigned kk[8], vv[8], qq[8];
#pragma unroll
        for (int r = 0; r < 8; ++r) { cum[r] = *(const f32x2*)(LG + r * 1024); kk[r] = *(const unsigned*)(KK + r * 1024); vv[r] = *(const unsigned*)(HV + r * 1024); qq[r] = *(const unsigned*)(HQ + r * 1024); }
#pragma unroll
        for (int r = 1; r < 8; ++r) cum[r] = cum[r] + cum[r - 1];
        *(LAS f32x2*)(SEG + seg * 128 + 2 * cp) = cum[7];
        LBAR();
        f32x2 off = (f32x2){0.f, 0.f}, R = (f32x2){0.f, 0.f};
#pragma unroll
        for (int s = 0; s < 8; ++s) { const f32x2 sv = *(const LAS f32x2*)(SEG + s * 128 + 2 * cp); if (s < seg) off = off + sv; if (s < 4) R = R + sv; }
#pragma unroll
        for (int r = 0; r < 8; ++r) { const f32x2 cu = cum[r] + off; const int row = 8 * seg + r; const float q0 = bflo(qq[r]), q1 = bfhi(qq[r]), k0 = bflo(kk[r]), k1 = bfhi(kk[r]);
            *(LAS unsigned*)(QT + row * 272 + cp * 4) = pk2(q0 * __expf(fminf(cu[0] - R[0], 80.f)), q1 * __expf(fminf(cu[1] - R[1], 80.f)));
            *(LAS unsigned*)(KT + row * 272 + cp * 4) = pk2(k0 * __expf(fminf(R[0] - cu[0], 80.f)), k1 * __expf(fminf(R[1] - cu[1], 80.f)));
            *(LAS unsigned*)(QH + row * 272 + cp * 4) = pk2(q0 * __expf(cu[0]), q1 * __expf(cu[1])); }
        v4u o0, o1;
        o0.x = (vv[0] & 0xffffu) | (vv[1] << 16); o0.y = (vv[2] & 0xffffu) | (vv[3] << 16); o0.z = (vv[4] & 0xffffu) | (vv[5] << 16); o0.w = (vv[6] & 0xffffu) | (vv[7] << 16);
        o1.x = (vv[0] >> 16) | (vv[1] & 0xffff0000u); o1.y = (vv[2] >> 16) | (vv[3] & 0xffff0000u); o1.z = (vv[4] >> 16) | (vv[5] & 0xffff0000u); o1.w = (vv[6] >> 16) | (vv[7] & 0xffff0000u);
        *(LAS v4u*)(VT + (2 * cp) * 144 + seg * 16) = o0; *(LAS v4u*)(VT + (2 * cp + 1) * 144 + seg * 16) = o1;
    }
    LBAR();
#pragma unroll
    for (int jj = 0; jj < 2; ++jj) { const int j = 2 * (w & 1) + jj; f32x4 acc = (f32x4){0.f, 0.f, 0.f, 0.f};
        if (j <= i) {
#pragma unroll
            for (int ks = 0; ks < 4; ++ks) acc = mfma16(ldsfrag(KT, 16 * j + l15, 272, 32 * ks + 8 * l4), ldsfrag(QT, t, 272, 32 * ks + 8 * l4), acc); }
#pragma unroll
        for (int e = 0; e < 4; ++e) { const int s = 16 * j + 4 * l4 + e; acc[e] = (j <= i && s <= t) ? acc[e] : 0.f; }
        *(LAS v2u*)(ATT + t * 144 + (16 * j + 4 * l4) * 2) = pk4(acc); }
    LBAR();
    f32x4 O[4]; float ssq = 0.f;
#pragma unroll
    for (int b4 = 0; b4 < 4; ++b4) { const int vb = 4 * (w & 1) + b4; f32x4 acc = (f32x4){0.f, 0.f, 0.f, 0.f};
        acc = mfma16(ldsfrag(VT, 16 * vb + l15, 144, 8 * l4), ldsfrag(ATT, t, 144, 8 * l4), acc);
        if (i >= 2) acc = mfma16(ldsfrag(VT, 16 * vb + l15, 144, 32 + 8 * l4), ldsfrag(ATT, t, 144, 32 + 8 * l4), acc);
#pragma unroll
        for (int ks = 0; ks < 4; ++ks) acc = mfma16(ldsfrag(ST, 16 * vb + l15, 272, 32 * ks + 8 * l4), ldsfrag(QH, t, 272, 32 * ks + 8 * l4), acc);
        O[b4] = acc; ssq += (acc[0] * acc[0] + acc[1] * acc[1]) + (acc[2] * acc[2] + acc[3] * acc[3]); }
    ssq += __shfl_xor(ssq, 16); ssq += __shfl_xor(ssq, 32); if (l4 == 0) SSQ[(w & 1) * 64 + t] = ssq;
    LBAR();
    {   bf16* BR = (bf16*)(ws + WS_BR) + ((size_t)MP + r0) * 1024 + 128 * h;
        const float rs = rsqrtf((SSQ[t] + SSQ[64 + t]) * (1.0f / 128.0f) + EPS);
#pragma unroll
        for (int b4 = 0; b4 < 4; ++b4) { const int v0 = 16 * (4 * (w & 1) + b4) + 4 * l4; const v2u gg = ggs[b4];
            const f32x4 gt = (f32x4){bflo(gg.x), bfhi(gg.x), bflo(gg.y), bfhi(gg.y)};
            *(v2u*)(BR + (unsigned)(t * 1024 + v0)) = pk4(O[b4] * rs * gvs[b4] * gt); }
    }
}

__device__ __forceinline__ void m3_ret(const Ctx& C, int l, int c, int h) {
    AREF A = *C.a; unsigned char* ws = C.ws; const int tid = C.tid, lane = C.lane, w = C.wave, r0 = 64 * c, l15 = lane & 15, l4 = lane >> 4;
    LAS unsigned char* VT = C.lds; LAS unsigned char* ATT = C.lds + 18432; LAS float* SSQ = (LAS float*)(C.lds + 27648);
    const float lg = ret_lgam(h);
    const int i = w >> 1, t = 16 * i + l15;
    const bf16* RG = (const bf16*)(ws + WS_RG) + (size_t)r0 * 1024 + 128 * h;
    LAS unsigned char* ST = C.lds + 28160;
    if (c < NCHP) { const bf16* SB = (const bf16*)(ws + WS_SB) + (size_t)c * STATE_N + ST_RET + (size_t)h * 8192;
#pragma unroll
        for (int q = 0; q < 2; ++q) { const int ch = tid + 512 * q, v = ch >> 3, k8 = ch & 7; *(LAS v4u*)(ST + v * 144 + k8 * 16) = *(const v4u*)(SB + v * 64 + k8 * 8); } }
    else { const float* S0 = A.in[I_SRET] + ((size_t)l * 16 + (c - NCHP)) * 65536 + (size_t)h * 8192;
#pragma unroll
        for (int q = 0; q < 4; ++q) { const int ch = tid + 512 * q, d = ch >> 5, v4 = (ch & 31) * 4, kp = 8 * ((d & 31) >> 2) + 4 * (d >> 5) + (d & 3); const f32x4 s = *(const f32x4*)(S0 + d * 128 + v4);
#pragma unroll
            for (int e = 0; e < 4; ++e) *(LAS bf16*)(ST + (v4 + e) * 144 + kp * 2) = (bf16)f2bf(s[e]); } }
    v2u ggs[4];
#pragma unroll
    for (int b4 = 0; b4 < 4; ++b4) { const int vb = 4 * (w & 1) + b4; ggs[b4] = *(const v2u*)(RG + (unsigned)(t * 1024 + 16 * vb + 4 * l4)); }
    {   const int col = tid & 127, seg = tid >> 7; const bf16* RV = (const bf16*)(ws + WS_RV) + (size_t)(r0 + 16 * seg) * 1024 + 128 * h + col; float vv[16];
#pragma unroll
        for (int i = 0; i < 16; ++i) vv[i] = bf2f(RV[i * 1024]);
        v4u o; o.x = pk2(vv[0], vv[1]); o.y = pk2(vv[2], vv[3]); o.z = pk2(vv[4], vv[5]); o.w = pk2(vv[6], vv[7]); *(LAS v4u*)(VT + col * 144 + seg * 32) = o;
        o.x = pk2(vv[8], vv[9]); o.y = pk2(vv[10], vv[11]); o.z = pk2(vv[12], vv[13]); o.w = pk2(vv[14], vv[15]); *(LAS v4u*)(VT + col * 144 + seg * 32 + 16) = o; }
    const bf16* RQ = (const bf16*)(ws + WS_RQ) + (size_t)r0 * 512 + 64 * h; const bf16* RK = (const bf16*)(ws + WS_RK) + (size_t)r0 * 512 + 64 * h;
    const bf16x8 q0 = *(const bf16x8*)(RQ + (unsigned)(t * 512 + 8 * l4)), q1 = *(const bf16x8*)(RQ + (unsigned)(t * 512 + 32 + 8 * l4));
#pragma unroll
    for (int jj = 0; jj < 2; ++jj) { const int j = 2 * (w & 1) + jj; f32x4 acc = (f32x4){0.f, 0.f, 0.f, 0.f};
        if (j <= i) { acc = mfma16(*(const bf16x8*)(RK + (unsigned)((16 * j + l15) * 512 + 8 * l4)), q0, acc); acc = mfma16(*(const bf16x8*)(RK + (unsigned)((16 * j + l15) * 512 + 32 + 8 * l4)), q1, acc); }
#pragma unroll
        for (int e = 0; e < 4; ++e) { const int s = 16 * j + 4 * l4 + e; acc[e] = (j <= i && s <= t) ? acc[e] * __expf((float)(t - s) * lg) : 0.f; }
        *(LAS v2u*)(ATT + t * 144 + (16 * j + 4 * l4) * 2) = pk4(acc); }
    LBAR();
    const float inner = __expf((float)(t + 1) * lg);
    f32x4 O[4]; float ssq = 0.f;
#pragma unroll
    for (int b4 = 0; b4 < 4; ++b4) { const int vb = 4 * (w & 1) + b4; f32x4 acc = (f32x4){0.f, 0.f, 0.f, 0.f}, acs = (f32x4){0.f, 0.f, 0.f, 0.f};
        acc = mfma16(ldsfrag(VT, 16 * vb + l15, 144, 8 * l4), ldsfrag(ATT, t, 144, 8 * l4), acc);
        if (i >= 2) acc = mfma16(ldsfrag(VT, 16 * vb + l15, 144, 32 + 8 * l4), ldsfrag(ATT, t, 144, 32 + 8 * l4), acc);
        acs = mfma16(ldsfrag(ST, 16 * vb + l15, 144, 8 * l4), q0, acs); acs = mfma16(ldsfrag(ST, 16 * vb + l15, 144, 32 + 8 * l4), q1, acs);
        acc = acc + acs * inner;
        O[b4] = acc; ssq += (acc[0] * acc[0] + acc[1] * acc[1]) + (acc[2] * acc[2] + acc[3] * acc[3]); }
    ssq += __shfl_xor(ssq, 16); ssq += __shfl_xor(ssq, 32); if (l4 == 0) SSQ[(w & 1) * 64 + t] = ssq;
    LBAR();
    {   bf16* BR = (bf16*)(ws + WS_BR) + ((size_t)2 * MP + r0) * 1024 + 128 * h;
        const float rs = rsqrtf((SSQ[t] + SSQ[64 + t]) * (1.0f / 128.0f) + EPS);
#pragma unroll
        for (int b4 = 0; b4 < 4; ++b4) { const int v0 = 16 * (4 * (w & 1) + b4) + 4 * l4; const v2u gg = ggs[b4];
            const f32x4 gt = (f32x4){bflo(gg.x), bfhi(gg.x), bflo(gg.y), bfhi(gg.y)};
            *(v2u*)(BR + (unsigned)(t * 1024 + v0)) = pk4(O[b4] * rs * gt); }
    }
}

#ifndef REPI_M3_SSD
#define REPI_M3_SSD 1
#endif
#ifndef REPI_M3_HG
#define REPI_M3_HG 1
#endif
#ifndef REPI_M3_RET
#define REPI_M3_RET 1
#endif
__device__ __forceinline__ void m3_phase(const Ctx& C0, int l, int mask = 7) {
    constexpr int N_SSD = NCH * 2, N_HG = NCH * 8, N_IT = NCH * 18;
    unsigned* cnt = (unsigned*)(C0.ws + WS_CTL) + CW_QUEUE + 64 * (l * 8 + 1 * 4 + (mask == 7 ? 0 : 1));
    volatile LAS int* slot = (volatile LAS int*)(C0.lds + LDSCTL_OFF + 64);
    int nxt = 0;
    if (C0.tid == 0) { nxt = (int)__hip_atomic_fetch_add(cnt, 1u, __ATOMIC_RELAXED, __HIP_MEMORY_SCOPE_AGENT); slot[0] = nxt; }
    LBAR();
    int it = slot[0];
    while (it < N_IT) {
        if (C0.tid == 0) nxt = (int)__hip_atomic_fetch_add(cnt, 1u, __ATOMIC_RELAXED, __HIP_MEMORY_SCOPE_AGENT);
        Ctx C = C0; { int t_ = C0.tid; asm volatile("" : "+v"(t_)); C.tid = t_; C.lane = t_ & 63; C.wave = __builtin_amdgcn_readfirstlane(t_ >> 6); }
        if (it < N_SSD) { if (mask & 1) m3_ssd(C, l, it >> 1, it & 1); }
        else if (it < N_SSD + N_HG) { if (mask & 2) { const int j = it - N_SSD; m3_hg(C, l, j >> 3, j & 7); } }
        else { if (mask & 4) { const int j = it - N_SSD - N_HG; m3_ret(C, l, j >> 3, j & 7); } }
        LBAR();
        if (C0.tid == 0) slot[0] = nxt;
        LBAR();
        it = slot[0];
    }
}

enum { PH_NORM1 = 0, PH_GEMM1, PH_M1, PH_M2, PH_M3, PH_GEMM2, PH_GEMM3, PH_NORM2, PH_GU, PH_DOWN, PH_N };

#ifndef REP_P0
#define REP_P0 1
#endif
#ifndef REP_NORM
#define REP_NORM 1
#endif
#ifndef REP_G1
#define REP_G1 1
#endif
#ifndef REP_M1
#define REP_M1 1
#endif
#ifndef REP_M2
#define REP_M2 1
#endif
#ifndef REP_M3
#define REP_M3 1
#endif
#ifndef REP_G2
#define REP_G2 1
#endif
#ifndef REP_G3
#define REP_G3 1
#endif
#ifndef REP_GU
#define REP_GU 1
#endif
#ifndef REP_DN
#define REP_DN 1
#endif
#ifndef PROBE_MASK
#define PROBE_MASK 7
#endif
#ifndef G1_ALIGN
#define G1_ALIGN true
#endif
#ifndef REP_BAR
#define REP_BAR 1
#endif
__global__ void __launch_bounds__(NTHR, 2) trunk_fwd(Args args) {
    extern __shared__ __attribute__((aligned(16))) unsigned char lds_raw[];
    Ctx C; C.lds = (LAS unsigned char*)lds_raw; C.tid = threadIdx.x; C.lane = C.tid & 63; C.wave = __builtin_amdgcn_readfirstlane(C.tid >> 6);
    const int wave0 = C.wave;
    C.G = gridDim.x; { const int bx = blockIdx.x; C.vcu = (C.G % 8 == 0) ? (bx % 8) * (C.G / 8) + bx / 8 : bx; }
    ArgsP ap = (ArgsP)__builtin_amdgcn_kernarg_segment_ptr();
    C.a = ap; C.ws = ap->ws;
    unsigned char* ws = ap->ws; const int use_bar = ap->use_bar;
    for (int u = C.tid; u < (LDS_BYTES - LDSCTL_OFF) / 4; u += NTHR) ((LAS unsigned*)(C.lds + LDSCTL_OFF))[u] = 0u;
    __syncthreads();
    XcdBarrier bar; bar.bar = (unsigned*)(ws + WS_CTL) + CW_BAR; bar.x = 0; bar.st = nullptr;
    if (use_bar) bar = xcd_barrier_post((unsigned*)(ws + WS_CTL) + CW_BAR, (volatile LAS unsigned*)(C.lds + LDSCTL_OFF));
#define GRID_BAR() do { if (use_bar) for (int rb_ = 0; rb_ < REP_BAR; ++rb_) { bar.bar = (unsigned*)(ws + WS_CTL) + CW_BAR; xcd_barrier(bar); } } while (0)
#define FRESH() do { int w0_ = wave0; asm volatile("" : "+s"(w0_)); int t_ = w0_ * 64 + (int)__builtin_amdgcn_mbcnt_hi(~0u, __builtin_amdgcn_mbcnt_lo(~0u, 0u)); asm volatile("" : "+v"(t_)); C.tid = t_; C.lane = t_ & 63; C.wave = __builtin_amdgcn_readfirstlane(t_ >> 6); \
        int g_ = gridDim.x; asm volatile("" : "+s"(g_)); C.G = g_; int b_ = blockIdx.x; asm volatile("" : "+s"(b_)); bx = b_; C.vcu = (C.G % 8 == 0) ? (b_ % 8) * (C.G / 8) + b_ / 8 : b_; \
        ArgsP a_ = (ArgsP)__builtin_amdgcn_kernarg_segment_ptr(); asm volatile("" : "+s"(a_)); ap = a_; C.a = a_; unsigned char* w_ = a_->ws; ws = w_; C.ws = w_; X = (float*)(ws + WS_X); H = (bf16*)(ws + WS_H); lw = ws + WS_W + (size_t)l * LW_SIZE; } while (0)
#define IN(k) (ap->ph_lo <= (k) && (k) < ap->ph_hi)

    if (ap->do_pro) { for (int r_ = 0; r_ < REP_P0; ++r_) p0_prologue(C); GRID_BAR(); }

    float* X = (float*)(ws + WS_X); bf16* H = (bf16*)(ws + WS_H); int bx = blockIdx.x; unsigned char* lw = ws;
    const int l_hi = ap->l_hi;
    for (int l = ap->l_lo; l < l_hi; ++l) {
        if (IN(PH_NORM1)) for (int r_ = 0; r_ < REP_NORM; ++r_) { asm volatile("; MARK_PH_NORM1"); FRESH(); norm_phase<true>(C, X, ap->in[I_NMIX] + (size_t)l * D, H, l); GRID_BAR(); }
        if (IN(PH_GEMM1)) for (int r_ = 0; r_ < REP_G1; ++r_) { asm volatile("; MARK_PH_GEMM1"); FRESH();
            pg8::Gemm g{H, (const bf16*)(lw + LW_IN), MP, NPROJ, D, 0, 0}; pg8::StaticOrder S; S.init(MP, NPROJ, C.G, bx);
            EpiProj E{ws, l};
            pg8::gemm_phase<EpiProj, pg8::StaticOrder, G1_ALIGN, true>(C.lds, g, S, E, C.tid);
            GRID_BAR();
        }
        if (IN(PH_M1)) for (int r_ = 0; r_ < REP_M1; ++r_) { asm volatile("; MARK_PH_M1"); FRESH(); m1_phase(C, l, r_ == 0 ? 7 : PROBE_MASK); GRID_BAR(); }
        if (IN(PH_M2)) for (int r_ = 0; r_ < REP_M2; ++r_) { asm volatile("; MARK_PH_M2"); FRESH(); m2_phase(C, l); GRID_BAR(); }
        if (IN(PH_M3)) for (int r_ = 0; r_ < REP_M3; ++r_) { asm volatile("; MARK_PH_M3"); FRESH(); m3_phase(C, l, r_ == 0 ? 7 : PROBE_MASK); GRID_BAR(); }
        if (IN(PH_GEMM2)) for (int r_ = 0; r_ < REP_G2; ++r_) { asm volatile("; MARK_PH_GEMM2"); FRESH();
            pg8::Gemm g{(const bf16*)(ws + WS_BR), (const bf16*)(lw + LW_BR), MP, D, 1024, (size_t)MP * 1024 * 2, (size_t)D * 1024 * 2}; BranchOrder S; S.init(MP, D, C.G, bx);
            EpiBranch E{(bf16*)(ws + WS_TMP), (bf16*)(ws + WS_MIX), (const bf16*)(ws + WS_GT)};
            pg8::gemm_phase<EpiBranch, BranchOrder, true, true>(C.lds, g, S, E, C.tid);
            GRID_BAR();
        }
        if (IN(PH_GEMM3)) for (int r_ = 0; r_ < REP_G3; ++r_) { asm volatile("; MARK_PH_GEMM3"); FRESH();
            pg8::Gemm g{(const bf16*)(ws + WS_MIX), (const bf16*)(lw + LW_OUT), MP, D, D, 0, 0}; pg8::StaticOrder S; S.init(MP, D, C.G, bx);
            EpiResid E{r_ == 0 ? X : (float*)(ws + WS_TMP)};
            pg8::gemm_phase<EpiResid, pg8::StaticOrder, true, true>(C.lds, g, S, E, C.tid);
            GRID_BAR();
        }
        if (IN(PH_NORM2)) for (int r_ = 0; r_ < REP_NORM; ++r_) { asm volatile("; MARK_PH_NORM2"); FRESH(); norm_phase<false>(C, X, ap->in[I_NFFN] + (size_t)l * D, H, l); GRID_BAR(); }
        if (IN(PH_GU)) for (int r_ = 0; r_ < REP_GU; ++r_) { asm volatile("; MARK_PH_GU"); FRESH();
            pg8::Gemm g{H, (const bf16*)(lw + LW_GU), MP, 2 * FFN, D, 0, 0}; pg8::StaticOrder S; S.init(MP, 2 * FFN, C.G, bx);
            EpiSwiglu E{(bf16*)(ws + WS_HID)};
            pg8::gemm_phase<EpiSwiglu, pg8::StaticOrder, true, true>(C.lds, g, S, E, C.tid);
            GRID_BAR();
        }
        if (IN(PH_DOWN)) for (int r_ = 0; r_ < REP_DN; ++r_) { asm volatile("; MARK_PH_DOWN"); FRESH();
            pg8::Gemm g{(const bf16*)(ws + WS_HID), (const bf16*)(lw + LW_DN), MP, D, FFN, 0, 0}; pg8::StaticOrder S; S.init(MP, D, C.G, bx);
            EpiResid E{r_ == 0 ? X : (float*)(ws + WS_TMP)};
            pg8::gemm_phase<EpiResid, pg8::StaticOrder, true, true>(C.lds, g, S, E, C.tid);
            GRID_BAR();
        }
    }
    if (ap->do_fin) { const int l = 0; FRESH(); final_phase(C, X, ap->in[I_NFIN], ap->out); }
#undef IN
#undef GRID_BAR
#undef FRESH
}


__global__ void probe_dump(const unsigned short* src, size_t n_src, float* out, size_t n_out) {
    for (size_t i = (size_t)blockIdx.x * blockDim.x + threadIdx.x; i < n_out; i += (size_t)gridDim.x * blockDim.x) {
        const size_t j = (i * 4 + (i & 3)) % n_src; out[i] = __builtin_bit_cast(float, ((unsigned)src[j]) << 16) * 1e-3f + 1.0f; }
}
#ifndef MK_REPS
#define MK_REPS 1
#endif
#ifndef MK_ONE_LAUNCH
#define MK_ONE_LAUNCH 1
#endif
extern "C" void kernel_launch(void* const* d_in, const int* in_sizes, int n_in, void* d_out, int out_size, void* d_ws, size_t ws_size, hipStream_t stream) {
    static int grid = 0;
    if (grid == 0) {
        if (n_in != 24 || (size_t)out_size != O_END || ws_size < WS_END) { fprintf(stderr, "kernel_launch: unexpected shapes (n_in %d, out %d, ws %zu, need %zu)\n", n_in, out_size, ws_size, (size_t)WS_END); grid = -1; return; }
        int dev = 0, cus = 0, per_cu = 0;
        if (hipGetDevice(&dev) != hipSuccess || hipDeviceGetAttribute(&cus, hipDeviceAttributeMultiprocessorCount, dev) != hipSuccess) { grid = -1; return; }
        if (hipFuncSetAttribute((const void*)trunk_fwd, hipFuncAttributeMaxDynamicSharedMemorySize, LDS_BYTES) != hipSuccess) { fprintf(stderr, "kernel_launch: hipFuncSetAttribute failed\n"); grid = -1; return; }
        if (hipOccupancyMaxActiveBlocksPerMultiprocessor(&per_cu, (const void*)trunk_fwd, NTHR, LDS_BYTES) != hipSuccess || per_cu < 1) fprintf(stderr, "kernel_launch: occupancy query reports %d\n", per_cu);
        (void)hipGetLastError();
        grid = cus;
    }
    if (grid < 0) return;
    (void)hipMemsetAsync((char*)d_ws + WS_CTL, 0, CTL_ZERO_BYTES, stream);
    Args a{};
    for (int i = 0; i < 24; ++i) a.in[i] = (const float*)d_in[i];
    a.out = (float*)d_out; a.ws = (unsigned char*)d_ws;
#if MK_ONE_LAUNCH
    a.l_lo = 0; a.l_hi = NL; a.ph_lo = 0; a.ph_hi = PH_N; a.do_pro = 1; a.do_fin = 1; a.use_bar = 1; a.pad = 0;
    hipLaunchKernelGGL(trunk_fwd, dim3(grid), dim3(NTHR), LDS_BYTES, stream, a);
#else
    for (int rep = 0; rep < MK_REPS; ++rep) {
    a.use_bar = 0; a.pad = 0;
    a.l_lo = 0; a.l_hi = 0; a.ph_lo = 0; a.ph_hi = 0; a.do_pro = 1; a.do_fin = 0;
    hipLaunchKernelGGL(trunk_fwd, dim3(grid), dim3(NTHR), LDS_BYTES, stream, a);
    a.do_pro = 0;
#ifdef PROBE_NPH
    { int cnt = 0; for (int l = 0; l < NL && cnt < PROBE_NPH; ++l) for (int ph = 0; ph < PH_N && cnt < PROBE_NPH; ++ph, ++cnt) { a.l_lo = l; a.l_hi = l + 1; a.ph_lo = ph; a.ph_hi = ph + 1; hipLaunchKernelGGL(trunk_fwd, dim3(grid), dim3(NTHR), LDS_BYTES, stream, a); } }
    probe_dump<<<2048, 256, 0, stream>>>((const unsigned short*)((char*)d_ws + PROBE_LO), (size_t)(PROBE_HI - PROBE_LO) / 2, (float*)d_out, (size_t)O_END);
    return;
#endif
    for (int l = 0; l < NL; ++l) for (int ph = 0; ph < PH_N; ++ph) { a.l_lo = l; a.l_hi = l + 1; a.ph_lo = ph; a.ph_hi = ph + 1; hipLaunchKernelGGL(trunk_fwd, dim3(grid), dim3(NTHR), LDS_BYTES, stream, a); }
    a.l_lo = 0; a.l_hi = 0; a.ph_lo = 0; a.ph_hi = 0; a.do_fin = 1;
    hipLaunchKernelGGL(trunk_fwd, dim3(grid), dim3(NTHR), LDS_BYTES, stream, a);
    }
#endif
    const hipError_t le = hipPeekAtLastError();
    if (le != hipSuccess) fprintf(stderr, "kernel_launch: launch failed: %s\n", hipGetErrorName(le));
}
```

```cpp
#include <hip/hip_runtime.h>
#include <cstdio>
#include <cstdint>
#ifndef PG8_WGM
#define PG8_WGM 8
#endif
namespace pg8 {
#define PG8_LAS __attribute__((address_space(3)))
typedef unsigned short bf16_t;
typedef short bf16x8 __attribute__((ext_vector_type(8)));
typedef float f32x4 __attribute__((ext_vector_type(4)));
typedef unsigned u32x4 __attribute__((ext_vector_type(4)));
constexpr int BM = 256, BK = 64, HALF = 128, HTB = HALF * BK * 2  , STAGE_BYTES = 8 * HTB, NXCD = 8, WGM = PG8_WGM;

__host__ __device__ __forceinline__ int lds_byte(int r, int c) { const int st = (r >> 4) * 2 + (c >> 5), rr = r & 15, cc = c & 31, ob = rr * 64 + cc * 2; return st * 1024 + (ob ^ (((ob >> 9) & 1) << 5)); }
__host__ __device__ __forceinline__ void stage_rc(int b, int& R, int& C) { const int st = b / 1024, sb = b % 1024, swz = sb ^ (((sb >> 9) & 1) << 5); R = (st >> 1) * 16 + swz / 64; C = (st & 1) * 32 + (swz % 64) / 2; }
__host__ __device__ __forceinline__ int perm32(int rho) { const int n = rho >> 4, i = rho & 15; return 8 * (i >> 2) + 4 * n + (i & 3); }

struct Unit { int pm, pn, pc, k0, nt, kind, slab; };
struct Gemm { const bf16_t* A; const bf16_t* Bt; int M, N, K; size_t csA, csB; };

struct StaticOrder {
    int nM, nN, nwg, G, c, ntk;
    __host__ __device__ __forceinline__ void init(int M, int N, int G_, int c_, int K) { nM = M / BM; nN = N / BM; nwg = nM * nN; G = G_; c = c_; ntk = K / BK; }
    __host__ __device__ __forceinline__ void tile(int L, Unit& u) const {
        int wgid = L; { const int q = nwg / NXCD, r = nwg % NXCD, xcd = wgid % NXCD, off = wgid / NXCD; wgid = (xcd < r ? xcd * (q + 1) : r * (q + 1) + (xcd - r) * q) + off; }
        const int nig = WGM * nN, gid = wgid / nig, fm = gid * WGM, gsz = (nM - fm) < WGM ? (nM - fm) : WGM;
        u.pm = fm + ((wgid % nig) % gsz); u.pn = (wgid % nig) / gsz; u.pc = 0;
    }
    __host__ __device__ __forceinline__ void tile_seq(int wgid, Unit& u) const {
        const int nig = WGM * nN, gid = wgid / nig, fm = gid * WGM, gsz = (nM - fm) < WGM ? (nM - fm) : WGM;
        u.pm = fm + ((wgid % nig) % gsz); u.pn = (wgid % nig) / gsz; u.pc = 0;
    }
    __host__ __device__ __forceinline__ bool next(int i, Unit& u) const {
        const long L = (long)i * G + c; if (L >= nwg) return false;
        tile((int)L, u); u.k0 = 0; u.nt = ntk; u.kind = 0; u.slab = 0; return true;
    }
    __device__ __forceinline__ void a_ready(const Unit&) const {}
    __device__ __forceinline__ void done(const Unit&) const {}
};
struct StreamOrder {
    StaticOrder S; int P, lo, hi, r;
    __host__ __device__ __forceinline__ void init(int M, int N, int G, int rank, int K) { S.init(M, N, G, 0, K); P = K / (2 * BK); r = rank; const long W = (long)S.nwg * P; lo = (int)((W * rank) / G); hi = (int)((W * (rank + 1)) / G); }
    __host__ __device__ __forceinline__ bool next(int i, Unit& u) const {
        const int tail = (lo % P) ? P - lo % P : 0, head = hi % P, t0 = (lo + tail) / P, nfull = (hi - head) / P - t0;
        int k = i;
        if (head) { if (k == 0) { S.tile_seq(hi / P, u); u.k0 = 0; u.nt = 2 * head; u.kind = 1; u.slab = r; return true; } --k; }
        if (k < nfull) { S.tile_seq(t0 + k, u); u.k0 = 0; u.nt = 2 * P; u.kind = 0; u.slab = 0; return true; }
        k -= nfull;
        if (tail && k == 0) { S.tile_seq(lo / P, u); u.k0 = 2 * (P - tail); u.nt = 2 * tail; u.kind = 2; u.slab = r - 1; return true; }
        return false;
    }
    __device__ __forceinline__ void a_ready(const Unit&) const {}
    __device__ __forceinline__ void done(const Unit&) const {}
};

__device__ __forceinline__ unsigned cvt_pk_bf16(float lo, float hi) { unsigned r; asm volatile("v_cvt_pk_bf16_f32 %0, %1, %2" : "=v"(r) : "v"(lo), "v"(hi)); return r; }

template <class Epi, class Sched, bool ALIGN_EPI = false, bool SP2 = false>
__device__ __forceinline__ void gemm_phase(PG8_LAS unsigned char* lds, const Gemm g, const Sched& S, const Epi& E, const int tid) {
    const int wid = __builtin_amdgcn_readfirstlane(tid >> 6), lane = tid & 63, wr = wid >> 2, wc = wid & 3, fr = lane & 15, fq = lane >> 4;
    const int K = g.K;
    unsigned voffA[2], voffB[2];
#pragma unroll
    for (int i = 0; i < 2; ++i) { int R, C; stage_rc(tid * 16 + i * 8192, R, C); const int Rb = Epi::PERM ? ((R & ~31) + perm32(R & 31)) : R;
        voffA[i] = (unsigned)(R * K + C) * 2u; voffB[i] = (unsigned)(Rb * K + C) * 2u; }
    const size_t kstep = (size_t)(BK * 2);
    const size_t hstep = (size_t)HALF * K * 2;
    const size_t tstep = 2 * hstep;
    const unsigned ldsw = (unsigned)wid * 1024u;
    const int aoff = lds_byte(wr * 64 + fr, fq * 8), boff = lds_byte(wc * 32 + fr, fq * 8);
#define PG8_SA(b, h) (((b) * 2 + (h)) * HTB)
#define PG8_SB(b, h) ((4 + (b) * 2 + (h)) * HTB)
#define PG8_STAGE(bufoff, gbase, voff) do { _Pragma("unroll") for (int _i = 0; _i < 2; ++_i) \
        __builtin_amdgcn_global_load_lds((const unsigned*)((const char*)(gbase) + (voff)[_i]), (PG8_LAS unsigned*)(lds + (bufoff) + ldsw + _i * 8192), 16, 0, 0); } while (0)
#define PG8_LDA(dst, b, h) do { _Pragma("unroll") for (int m = 0; m < 4; ++m) _Pragma("unroll") for (int k = 0; k < 2; ++k) dst[m][k] = *(const PG8_LAS bf16x8*)(lds + PG8_SA(b, h) + aoff + m * 2048 + k * 1024); } while (0)
#define PG8_LDB(dst, b, h) do { _Pragma("unroll") for (int n = 0; n < 2; ++n) _Pragma("unroll") for (int k = 0; k < 2; ++k) dst[n][k] = *(const PG8_LAS bf16x8*)(lds + PG8_SB(b, h) + boff + n * 2048 + k * 1024); } while (0)
#define PG8_MMA(ai, bj, At, Bt) do { __builtin_amdgcn_s_setprio(1); _Pragma("unroll") for (int m = 0; m < 4; ++m) _Pragma("unroll") for (int n = 0; n < 2; ++n) _Pragma("unroll") for (int k = 0; k < 2; ++k) \
        acc[ai][bj][m][n] = __builtin_amdgcn_mfma_f32_16x16x32_bf16(Bt[n][k], At[m][k], acc[ai][bj][m][n], 0, 0, 0); __builtin_amdgcn_s_setprio(0); } while (0)
#define PG8_WAIT_V(n) asm volatile("s_waitcnt vmcnt(" #n ")" ::: "memory")
#define PG8_WAIT_L(n) asm volatile("s_waitcnt lgkmcnt(" #n ")" ::: "memory")
#define PG8_BAR __builtin_amdgcn_s_barrier()
#define PG8_SCHED __builtin_amdgcn_sched_barrier(0)
    Unit cur, nxt; int ui = 0;
    if (!S.next(0, cur)) return;
    f32x4 acc[2][2][4][2];
#pragma unroll
    for (int a = 0; a < 2; ++a)
#pragma unroll
        for (int b = 0; b < 2; ++b)
#pragma unroll
            for (int m = 0; m < 4; ++m)
#pragma unroll
                for (int n = 0; n < 2; ++n) acc[a][b][m][n] = (f32x4){0.f, 0.f, 0.f, 0.f};
    bf16x8 At[4][2], B0[2][2], B1[2][2];
    const char* cA = (const char*)g.A + (size_t)cur.pm * tstep + (size_t)cur.pc * g.csA + (size_t)cur.k0 * kstep; const char* cB = (const char*)g.Bt + (size_t)cur.pn * tstep + (size_t)cur.pc * g.csB + (size_t)cur.k0 * kstep;
    S.a_ready(cur);
    if constexpr (SP2) {
        PG8_STAGE(PG8_SB(0, 0), cB, voffB); PG8_STAGE(PG8_SB(0, 1), cB + hstep, voffB); PG8_STAGE(PG8_SA(0, 0), cA, voffA); PG8_STAGE(PG8_SA(0, 1), cA + hstep, voffA);
        if (wr == 1) PG8_BAR;
        PG8_WAIT_V(2); PG8_BAR;
        PG8_STAGE(PG8_SB(1, 0), cB + kstep, voffB); PG8_STAGE(PG8_SA(1, 0), cA + kstep, voffA); PG8_STAGE(PG8_SB(1, 1), cB + hstep + kstep, voffB);
        PG8_WAIT_V(6); PG8_BAR;
    } else {
        PG8_STAGE(PG8_SB(0, 0), cB, voffB); PG8_STAGE(PG8_SA(0, 0), cA, voffA); PG8_STAGE(PG8_SB(0, 1), cB + hstep, voffB); PG8_STAGE(PG8_SA(0, 1), cA + hstep, voffA);
        if (wr == 1) PG8_BAR;
        PG8_WAIT_V(4); PG8_BAR;
        PG8_STAGE(PG8_SB(1, 0), cB + kstep, voffB); PG8_STAGE(PG8_SA(1, 0), cA + kstep, voffA); PG8_STAGE(PG8_SB(1, 1), cB + hstep + kstep, voffB);
        PG8_WAIT_V(6); PG8_BAR;
    }
    for (;;) {
        const bool has_next = S.next(ui + 1, nxt);
        const char* nA = has_next ? (const char*)g.A + (size_t)nxt.pm * tstep + (size_t)nxt.pc * g.csA + (size_t)nxt.k0 * kstep : cA; const char* nB = has_next ? (const char*)g.Bt + (size_t)nxt.pn * tstep + (size_t)nxt.pc * g.csB + (size_t)nxt.k0 * kstep : cB;
        const int nt = cur.nt;
        for (int t = 0; t < nt; t += 2) {
            const bool last = (t == nt - 2);
            const char* a1 = cA + (size_t)(t + 1) * kstep;
            const char* a2 = last ? nA : cA + (size_t)(t + 2) * kstep; const char* b2 = last ? nB : cB + (size_t)(t + 2) * kstep;
            const char* a3 = a2 + kstep; const char* b3 = b2 + kstep;
            if (last && has_next) S.a_ready(nxt);
            if constexpr (SP2) {
            PG8_LDB(B0, 0, 0); PG8_LDB(B1, 0, 1); PG8_SCHED; PG8_LDA(At, 0, 0); PG8_STAGE(PG8_SA(1, 1), a1 + hstep, voffA);
            PG8_WAIT_V(8); PG8_WAIT_L(0); PG8_BAR; PG8_MMA(0, 0, At, B0); PG8_MMA(0, 1, At, B1); PG8_BAR; PG8_SCHED;
            PG8_LDA(At, 0, 1); PG8_STAGE(PG8_SB(0, 0), b2, voffB); PG8_STAGE(PG8_SB(0, 1), b2 + hstep, voffB); PG8_STAGE(PG8_SA(0, 0), a2, voffA);
            PG8_WAIT_V(8); PG8_WAIT_L(0); PG8_BAR; PG8_MMA(1, 0, At, B0); PG8_MMA(1, 1, At, B1); PG8_BAR; PG8_SCHED;
            PG8_LDB(B0, 1, 0); PG8_LDB(B1, 1, 1); PG8_SCHED; PG8_LDA(At, 1, 0); PG8_STAGE(PG8_SA(0, 1), a2 + hstep, voffA);
            PG8_WAIT_V(8); PG8_WAIT_L(0); PG8_BAR; PG8_MMA(0, 0, At, B0); PG8_MMA(0, 1, At, B1); PG8_BAR; PG8_SCHED;
            PG8_LDA(At, 1, 1); PG8_STAGE(PG8_SB(1, 0), b3, voffB); PG8_STAGE(PG8_SB(1, 1), b3 + hstep, voffB); PG8_STAGE(PG8_SA(1, 0), a3, voffA);
            PG8_WAIT_V(8); PG8_WAIT_L(0); PG8_BAR; PG8_MMA(1, 0, At, B0); PG8_MMA(1, 1, At, B1); PG8_BAR; PG8_SCHED;
            } else {
            PG8_LDB(B0, 0, 0); PG8_SCHED; PG8_LDA(At, 0, 0); PG8_STAGE(PG8_SA(1, 1), a1 + hstep, voffA);
            PG8_WAIT_L(8); PG8_BAR; PG8_WAIT_L(0); PG8_MMA(0, 0, At, B0); PG8_BAR; PG8_SCHED;
            PG8_LDB(B1, 0, 1); PG8_STAGE(PG8_SB(0, 0), b2, voffB);
            PG8_BAR; PG8_WAIT_L(0); PG8_MMA(0, 1, At, B1); PG8_BAR;
            PG8_LDA(At, 0, 1); PG8_STAGE(PG8_SA(0, 0), a2, voffA);
            PG8_BAR; PG8_WAIT_L(0); PG8_MMA(1, 0, At, B0); PG8_BAR; PG8_SCHED;
            PG8_STAGE(PG8_SB(0, 1), b2 + hstep, voffB);
            PG8_WAIT_V(6); PG8_BAR; PG8_MMA(1, 1, At, B1); PG8_BAR;
            PG8_LDB(B0, 1, 0); PG8_SCHED; PG8_LDA(At, 1, 0); PG8_STAGE(PG8_SA(0, 1), a2 + hstep, voffA);
            PG8_WAIT_L(8); PG8_BAR; PG8_WAIT_L(0); PG8_MMA(0, 0, At, B0); PG8_BAR; PG8_SCHED;
            PG8_LDB(B1, 1, 1); PG8_STAGE(PG8_SB(1, 0), b3, voffB);
            PG8_BAR; PG8_WAIT_L(0); PG8_MMA(0, 1, At, B1); PG8_BAR;
            PG8_LDA(At, 1, 1); PG8_STAGE(PG8_SA(1, 0), a3, voffA);
            PG8_BAR; PG8_WAIT_L(0); PG8_MMA(1, 0, At, B0); PG8_BAR; PG8_SCHED;
            PG8_STAGE(PG8_SB(1, 1), b3 + hstep, voffB);
            PG8_WAIT_V(6); PG8_BAR; PG8_MMA(1, 1, At, B1); PG8_BAR;
            }
        }
        if constexpr (ALIGN_EPI) { if (wr == 0) PG8_BAR; }
        if constexpr (!Epi::AFTER_DRAIN) { E(acc, cur, wr, wc, fr, fq); S.done(cur); }
        if (!has_next) break;
#pragma unroll
        for (int a = 0; a < 2; ++a)
#pragma unroll
            for (int b = 0; b < 2; ++b)
#pragma unroll
                for (int m = 0; m < 4; ++m)
#pragma unroll
                    for (int n = 0; n < 2; ++n) acc[a][b][m][n] = (f32x4){0.f, 0.f, 0.f, 0.f};
        cur = nxt; cA = nA; cB = nB; ++ui;
        if constexpr (ALIGN_EPI) { if (wr == 1) PG8_BAR; }
    }
    PG8_WAIT_V(0);
    if constexpr (!ALIGN_EPI) { if (wr == 0) PG8_BAR; }
    PG8_BAR;
    if constexpr (Epi::AFTER_DRAIN) { E.fused(acc, cur, wr, wc, fr, fq, lds, wid, lane); S.done(cur); }
#undef PG8_SA
#undef PG8_SB
#undef PG8_STAGE
#undef PG8_LDA
#undef PG8_LDB
#undef PG8_MMA
#undef PG8_WAIT_V
#undef PG8_WAIT_L
#undef PG8_BAR
#undef PG8_SCHED
}
}


constexpr int D = 2048, NL = 4, FFN = 5632, NPROJ = 15872, INCOLS = 15888;
constexpr int MR = 9280, MP = 9472, NCH = 145, NCHP = 129;
constexpr int ROW_P0 = 64, ROW_S0 = 8256, NNULL = 48;
constexpr int STATE_N = 327680, ST_SSD = 0, ST_HG = 131072, ST_RET = 262144;
constexpr int GAM_N = 1040;
constexpr float EPS = 1e-6f;
constexpr size_t O_YP = 0, O_YS = 16777216, O_CONVP = O_YS + 2097152, O_SSMP = O_CONVP + 18432, O_HGP = O_SSMP + 524288, O_RETP = O_HGP + 524288,
                 O_CONVS = O_RETP + 262144, O_SSMS = O_CONVS + 294912, O_HGS = O_SSMS + 8388608, O_RETS = O_HGS + 8388608, O_END = O_RETS + 4194304;

constexpr size_t MiB = 1u << 20;
constexpr size_t al(size_t x) { return (x + MiB - 1) / MiB * MiB; }
constexpr size_t WS_CTL = 0, CTL_ZERO_BYTES = 1 * MiB;
constexpr size_t SZ_WIN = (size_t)NPROJ * D * 2, SZ_WBR = (size_t)3 * D * 1024 * 2, SZ_WOUT = (size_t)D * D * 2, SZ_WGU = (size_t)2 * FFN * D * 2, SZ_WDN = (size_t)D * FFN * 2, SZ_WDT = (size_t)16 * D * 2;
constexpr size_t LW_IN = 0, LW_BR = LW_IN + al(SZ_WIN), LW_OUT = LW_BR + al(SZ_WBR), LW_GU = LW_OUT + al(SZ_WOUT), LW_DN = LW_GU + al(SZ_WGU), LW_DT = LW_DN + al(SZ_WDN), LW_SIZE = LW_DT + al(SZ_WDT);
constexpr size_t WS_W = 1 * MiB;
constexpr size_t WS_X = WS_W + 4 * LW_SIZE;
constexpr size_t WS_H = WS_X + al((size_t)MP * D * 4);
constexpr size_t WS_ZS = WS_H + al((size_t)MP * D * 2);
constexpr size_t WS_XBC = WS_ZS + al((size_t)MP * 1024 * 2);
constexpr size_t WS_HQ = WS_XBC + al((size_t)MP * 1536 * 2);
constexpr size_t WS_LG = WS_HQ + al((size_t)MP * 1024 * 2);
constexpr size_t WS_KK = WS_LG + al((size_t)MP * 1024 * 4);
constexpr size_t WS_HV = WS_KK + al((size_t)MP * 1024 * 2);
constexpr size_t WS_HG = WS_HV + al((size_t)MP * 1024 * 2);
constexpr size_t WS_RQ = WS_HG + al((size_t)MP * 1024 * 2);
constexpr size_t WS_RK = WS_RQ + al((size_t)MP * 512 * 2);
constexpr size_t WS_RV = WS_RK + al((size_t)MP * 512 * 2);
constexpr size_t WS_RG = WS_RV + al((size_t)MP * 1024 * 2);
constexpr size_t WS_GT = WS_RG + al((size_t)MP * 1024 * 2);
constexpr size_t WS_DT = WS_GT + al((size_t)MP * 6144 * 2);
constexpr size_t WS_CUM = WS_DT + al((size_t)MP * 16 * 4);
constexpr size_t WS_U = WS_CUM + al((size_t)MP * 16 * 4);
constexpr size_t WS_SB = WS_U + al((size_t)NCH * STATE_N * 4);
constexpr size_t WS_GAM = WS_SB + al((size_t)NCH * STATE_N * 2);
constexpr size_t WS_BR = WS_GAM + al((size_t)NCH * GAM_N * 4);
constexpr size_t WS_TMP = WS_BR + al((size_t)3 * MP * 1024 * 2);
constexpr size_t WS_MIX = WS_TMP + al((size_t)MP * D * 4);
constexpr size_t WS_HID = WS_MIX + al((size_t)MP * D * 2);
constexpr size_t WS_ROPE = WS_HID + al((size_t)MP * FFN * 2);
constexpr size_t WS_LBS = WS_ROPE + al((size_t)MP * 32 * 8);
constexpr size_t WS_AV = WS_LBS + 1 * MiB;
constexpr size_t WS_XTG = WS_AV + al((size_t)MP * 16 * 4);
constexpr size_t WS_BCG = WS_XTG + al((size_t)NCH * 1024 * 64 * 2);
constexpr size_t WS_SLAB = WS_BCG + al((size_t)MP * 512 * 2);
constexpr size_t WS_END = WS_SLAB + (size_t)2 * 256 * 65536 * 4;
constexpr int CW_BAR = 4096, CW_QUEUE = 16384, CW_SK = 32768, CW_TMO = 8;
constexpr int CW_END = CW_SK + 8 * 256 * 64; static_assert((size_t)CW_END * 4 <= 1u << 20, "control words inside the memset region");
constexpr int CW_G2 = 163840;
static_assert((size_t)(CW_G2 + 64 * 64 * 8) * 4 <= 1u << 20, "control words inside the memset region");

constexpr int RING_BYTES = 131072;
constexpr int LDSCTL_OFF = 147456 - 512, LDS_BYTES = 147456;
constexpr int NWAVES = 8, NTHR = 512;

#define GAS __attribute__((address_space(1)))
#define LAS __attribute__((address_space(3)))
typedef unsigned short bf16;
typedef unsigned v4u __attribute__((ext_vector_type(4)));
typedef unsigned v2u __attribute__((ext_vector_type(2)));
typedef float f32x4 __attribute__((ext_vector_type(4)));
typedef float f32x2 __attribute__((ext_vector_type(2)));
typedef short bf16x8 __attribute__((ext_vector_type(8)));
typedef GAS unsigned gu32;
#define RLX_AGENT __ATOMIC_RELAXED, __HIP_MEMORY_SCOPE_AGENT

__device__ __forceinline__ unsigned f2bf(float f) { unsigned u = __builtin_bit_cast(unsigned, f); return (u + 0x7fffu + ((u >> 16) & 1u)) >> 16; }
typedef __bf16 bf16v2 __attribute__((ext_vector_type(2)));
__device__ __forceinline__ unsigned pk2(float lo, float hi) { const f32x2 v = {lo, hi}; return __builtin_bit_cast(unsigned, __builtin_convertvector(v, bf16v2)); }
__device__ __forceinline__ float bf2f(unsigned short b) { return __builtin_bit_cast(float, ((unsigned)b) << 16); }
__device__ __forceinline__ float bflo(unsigned w) { return __builtin_bit_cast(float, w << 16); }
__device__ __forceinline__ float bfhi(unsigned w) { return __builtin_bit_cast(float, w & 0xffff0000u); }
__device__ __forceinline__ float fsigmoid(float v) { return __builtin_amdgcn_rcpf(1.0f + __expf(-v)); }
__device__ __forceinline__ float fsilu(float v) { return v * fsigmoid(v); }
__device__ __forceinline__ f32x4 mfma16(bf16x8 a, bf16x8 b, f32x4 c) { return __builtin_amdgcn_mfma_f32_16x16x32_bf16(a, b, c, 0, 0, 0); }
__device__ __forceinline__ float wave_sum(float v) {
#pragma unroll
    for (int o = 1; o < 64; o <<= 1) v += __shfl_xor(v, o);
    return v;
}
#ifndef MK_G2_NOSPLIT
#define MK_G2_NOSPLIT 0
#endif
#ifndef MK_PREFETCH
#define MK_PREFETCH 0
#endif
#define LDS_WAIT() asm volatile("s_waitcnt lgkmcnt(0)" ::: "memory")
#define LBAR() do { asm volatile("s_waitcnt lgkmcnt(0)" ::: "memory"); __builtin_amdgcn_s_barrier(); asm volatile("" ::: "memory"); } while (0)
#define XB_TMO      128
#define XB_XCNT(j)  (256  + 64 * (j))
#define XB_XSUB(j)  (1280 + 64 * (j))
#define XB_XGEN(j)  (2304 + 64 * (j))
#define XB_TOP      3328
#define XB_TOPGEN   3392
#define XCD_BAR_WORDS 3456
#define XB_SPIN_CAP (1u << 18)

__device__ __forceinline__ unsigned xb_ld(unsigned* p)              { return __hip_atomic_load(p, __ATOMIC_RELAXED, __HIP_MEMORY_SCOPE_AGENT); }
__device__ __forceinline__ unsigned xb_add(unsigned* p, unsigned v) { return __hip_atomic_fetch_add(p, v, __ATOMIC_RELAXED, __HIP_MEMORY_SCOPE_AGENT); }
__device__ __forceinline__ unsigned xb_xcc_id() { return (unsigned)__builtin_amdgcn_s_getreg((3 << 11) | 20) & 0xFu; }
#define XB_SPIN(cond, bar) do { unsigned _sp = 0; while (cond) { __builtin_amdgcn_s_sleep(1); \
    if ((++_sp & 255u) == 0u) { if (xb_ld(&(bar)[XB_TMO])) break; if (_sp > XB_SPIN_CAP) { atomicAdd(&(bar)[XB_TMO], 1u); break; } } } } while (0)

struct XcdBarrier {
    unsigned* bar; unsigned x;
    volatile LAS unsigned* st;
};

__device__ __forceinline__ XcdBarrier xcd_barrier_post(unsigned* bar, volatile LAS unsigned* st) {
    XcdBarrier b; b.bar = bar; b.x = xb_xcc_id(); b.st = st;
    if (threadIdx.x == 0) (void)xb_add(&bar[XB_XCNT(b.x)], 1u);
    return b;
}
__device__ __forceinline__ void xcd_barrier_complete(unsigned* bar, unsigned x, unsigned& nloc, unsigned& nx) {
    const unsigned G = gridDim.x * gridDim.y * gridDim.z;
    unsigned sum, cnt, mine, sp = 0u;
    for (;;) {
        sum = 0u; cnt = 0u; mine = 0u;
#pragma unroll
        for (unsigned j = 0; j < 16; ++j) { const unsigned c = xb_ld(&bar[XB_XCNT(j)]); sum += c; cnt += (c > 0u) ? 1u : 0u; mine = (j == x) ? c : mine; }
        if (sum == G) break;
        __builtin_amdgcn_s_sleep(1);
        if ((++sp & 255u) == 0u) { if (xb_ld(&bar[XB_TMO])) break; if (sp > XB_SPIN_CAP) { atomicAdd(&bar[XB_TMO], 1u); break; } }
    }
    nloc = mine > 0u ? mine : 1u; nx = cnt > 0u ? cnt : 1u;
}

__device__ __forceinline__ void xcd_barrier(const XcdBarrier& b) {
    asm volatile("s_waitcnt vmcnt(0)" ::: "memory");
    __syncthreads();
    if (threadIdx.x == 0) {
        unsigned* bar = b.bar;
        __builtin_amdgcn_s_waitcnt(0);
        unsigned nloc = b.st[0], nx = b.st[1];
        if (nloc == 0u) { xcd_barrier_complete(bar, b.x, nloc, nx); b.st[0] = nloc; b.st[1] = nx; }
        const unsigned old = xb_add(&bar[XB_XSUB(b.x)], 1u);
        const unsigned gen = old / nloc;
        if (old + 1u == (gen + 1u) * nloc) {
            __builtin_amdgcn_fence(__ATOMIC_RELEASE, "agent");
            asm volatile("s_waitcnt vmcnt(0)" ::: "memory");
            const unsigned og = xb_add(&bar[XB_TOP], 1u);
            const unsigned tg = og / nx;
            if (og + 1u == (tg + 1u) * nx) xb_add(&bar[XB_TOPGEN], 1u);
            else XB_SPIN(xb_ld(&bar[XB_TOPGEN]) == tg, bar);
            __builtin_amdgcn_fence(__ATOMIC_ACQUIRE, "agent");
            xb_add(&bar[XB_XGEN(b.x)], 1u);
            asm volatile("s_waitcnt vmcnt(0)" ::: "memory");
        } else {
            XB_SPIN(xb_ld(&bar[XB_XGEN(b.x)]) == gen, bar);
            __builtin_amdgcn_fence(__ATOMIC_ACQUIRE, "agent");
            asm volatile("s_waitcnt vmcnt(0)" ::: "memory");
        }
    }
    __syncthreads();
}


typedef const f32x4 (&AccRef)[2][2][4][2];

struct EpiProj {
    static constexpr bool PERM = true, AFTER_DRAIN = false;
    unsigned char* ws; int layer;
    template <int T> __device__ __forceinline__ void run(AccRef acc, bf16* dst, int pitch, int row0, int col0) const {
        const float* lbs = (const float*)(ws + WS_LBS) + layer * 1024; float* LG = (float*)(ws + WS_LG); const f32x2* rope = (const f32x2*)(ws + WS_ROPE);
        f32x4 lb[2][2];
        if (T == 3) {
#pragma unroll
            for (int bj = 0; bj < 2; ++bj) { lb[bj][0] = *(const f32x4*)(lbs + col0 + bj * 128); lb[bj][1] = *(const f32x4*)(lbs + col0 + bj * 128 + 4); }
        }
#pragma unroll
        for (int ai = 0; ai < 2; ++ai)
#pragma unroll
            for (int m = 0; m < 4; ++m) {
                const int row = row0 + ai * 128 + m * 16;
#pragma unroll
                for (int bj = 0; bj < 2; ++bj) {
                    const int col = col0 + bj * 128;
                    f32x4 v0 = acc[ai][bj][m][0], v1 = acc[ai][bj][m][1];
                    if (T == 1) {
#pragma unroll
                        for (int e = 0; e < 4; ++e) { v0[e] = fsilu(v0[e]); v1[e] = fsilu(v1[e]); }
                    }
                    if (T == 2) {
#pragma unroll
                        for (int e = 0; e < 4; ++e) { v0[e] = fsigmoid(v0[e]); v1[e] = fsigmoid(v1[e]); }
                    }
                    if (T == 3) {
                        f32x4 l0, l1;
#pragma unroll
                        for (int e = 0; e < 4; ++e) {
                            { const float b = lb[bj][0][e], fg = v0[e], s = fsigmoid(fg), sn = fsigmoid(-fg); l0[e] = __logf(fmaxf(b + (1.0f - b) * s, 1e-30f)); v0[e] = (1.0f - b) * sn; }
                            { const float b = lb[bj][1][e], fg = v1[e], s = fsigmoid(fg), sn = fsigmoid(-fg); l1[e] = __logf(fmaxf(b + (1.0f - b) * s, 1e-30f)); v1[e] = (1.0f - b) * sn; }
                        }
                        float* lp = LG + (size_t)row * 1024 + col;
                        *(f32x4*)lp = l0; *(f32x4*)(lp + 4) = l1;
                    }
                    if (T == 4 || T == 5) {
                        const int j = (col & 63) >> 3;
                        const f32x4* rp = (const f32x4*)(rope + (size_t)row * 32 + 4 * j);
                        const f32x4 cs0 = rp[0], cs1 = rp[1];
                        const float c[4] = {cs0[0], cs0[2], cs1[0], cs1[2]}, s[4] = {cs0[1], cs0[3], cs1[1], cs1[3]};
                        const float sc = (T == 5) ? 0.125f : 1.0f;
#pragma unroll
                        for (int e = 0; e < 4; ++e) { const float a = v0[e], b = v1[e]; v0[e] = (a * c[e] - b * s[e]) * sc; v1[e] = (b * c[e] + a * s[e]) * sc; }
                    }
                    v4u w; w.x = pk2(v0[0], v0[1]); w.y = pk2(v0[2], v0[3]); w.z = pk2(v1[0], v1[1]); w.w = pk2(v1[2], v1[3]);
                    *(v4u*)(dst + (size_t)row * pitch + col) = w;
                }
            }
    }
    __device__ __forceinline__ void operator()(AccRef acc, const pg8::Unit& u, int wr, int wc, int fr, int fq) const {
        const int pn = u.pn, row0 = u.pm * 256 + wr * 64 + fr, cl = wc * 32 + 8 * fq;
        if (pn < 4) run<1>(acc, (bf16*)(ws + WS_ZS), 1024, row0, (pn - 0) * 256 + cl);
        else if (pn < 10) run<0>(acc, (bf16*)(ws + WS_XBC), 1536, row0, (pn - 4) * 256 + cl);
        else if (pn < 14) run<1>(acc, (bf16*)(ws + WS_HQ), 1024, row0, (pn - 10) * 256 + cl);
        else if (pn < 18) run<3>(acc, (bf16*)(ws + WS_KK), 1024, row0, (pn - 14) * 256 + cl);
        else if (pn < 22) run<0>(acc, (bf16*)(ws + WS_HV), 1024, row0, (pn - 18) * 256 + cl);
        else if (pn < 26) run<1>(acc, (bf16*)(ws + WS_HG), 1024, row0, (pn - 22) * 256 + cl);
        else if (pn < 28) run<4>(acc, (bf16*)(ws + WS_RQ), 512, row0, (pn - 26) * 256 + cl);
        else if (pn < 30) run<5>(acc, (bf16*)(ws + WS_RK), 512, row0, (pn - 28) * 256 + cl);
        else if (pn < 34) run<0>(acc, (bf16*)(ws + WS_RV), 1024, row0, (pn - 30) * 256 + cl);
        else if (pn < 38) run<1>(acc, (bf16*)(ws + WS_RG), 1024, row0, (pn - 34) * 256 + cl);
        else run<2>(acc, (bf16*)(ws + WS_GT), 6144, row0, (pn - 38) * 256 + cl);
    }
};

struct EpiBranch {
    static constexpr bool PERM = true, AFTER_DRAIN = false;
    bf16* TMP; bf16* MIX; const bf16* GT; float* slabs; unsigned* cnt; unsigned* tmo;
    __device__ __forceinline__ void operator()(AccRef acc, const pg8::Unit& u, int wr, int wc, int fr, int fq) const {
        const int pc = u.pc; int row0 = u.pm * 256 + wr * 64 + fr; const int col0 = u.pn * 256 + wc * 32 + 8 * fq; asm volatile("" : "+v"(row0));
        if (u.kind == 3) {
            const int lane = fr + 16 * fq, wid = wr * 4 + wc; int tid = wid * 64 + lane; asm volatile("" : "+v"(tid));
            const int lt = u.slab;
            f32x4 v[2][2][4][2];
#pragma unroll
            for (int ai = 0; ai < 2; ++ai)
#pragma unroll
                for (int m = 0; m < 4; ++m) { const int row = row0 + ai * 128 + m * 16;
#pragma unroll
                    for (int bj = 0; bj < 2; ++bj) { const v4u g = *(const v4u*)(GT + (size_t)row * 6144 + pc * 2048 + col0 + bj * 128);
                        v[ai][bj][m][0] = acc[ai][bj][m][0] * (f32x4){bflo(g.x), bfhi(g.x), bflo(g.y), bfhi(g.y)}; v[ai][bj][m][1] = acc[ai][bj][m][1] * (f32x4){bflo(g.z), bfhi(g.z), bflo(g.w), bfhi(g.w)}; }
                    __builtin_amdgcn_sched_barrier(0); }
            if (pc < 2) {
                __amdgpu_buffer_rsrc_t rsrc = __builtin_amdgcn_make_buffer_rsrc(slabs + (size_t)(lt * 3 + pc) * 65536, 0, 65536 * 4, 0x00020000);
#pragma unroll
                for (int ai = 0; ai < 2; ++ai)
#pragma unroll
                    for (int bj = 0; bj < 2; ++bj)
#pragma unroll
                        for (int m = 0; m < 4; ++m)
#pragma unroll
                            for (int n = 0; n < 2; ++n) { const int j = ((ai * 2 + bj) * 4 + m) * 2 + n; __builtin_amdgcn_raw_buffer_store_b128(__builtin_bit_cast(pg8::u32x4, v[ai][bj][m][n]), rsrc, (j * 512 + tid) * 16, 0, 16); }
                asm volatile("s_waitcnt vmcnt(0)" ::: "memory");
                if (lane == 0) __hip_atomic_fetch_add(cnt + 64 * lt, 1u, __ATOMIC_RELAXED, __HIP_MEMORY_SCOPE_AGENT);
            } else {
                unsigned sp = 0;
                while ((unsigned)__builtin_amdgcn_readfirstlane(__hip_atomic_load(cnt + 64 * lt, __ATOMIC_RELAXED, __HIP_MEMORY_SCOPE_AGENT)) < 16u) {
                    __builtin_amdgcn_s_sleep(2);
                    if ((++sp & 1023u) == 0u) { if (__hip_atomic_load(tmo, __ATOMIC_RELAXED, __HIP_MEMORY_SCOPE_AGENT) != 0u) break; if (sp > (1u << 22)) { if (lane == 0) __hip_atomic_store(tmo, 1u, __ATOMIC_RELAXED, __HIP_MEMORY_SCOPE_AGENT); break; } }
                }
                __builtin_amdgcn_fence(__ATOMIC_ACQUIRE, "agent");
                const f32x4* s1 = (const f32x4*)(slabs + (size_t)(lt * 3 + 0) * 65536) + tid; const f32x4* s2 = (const f32x4*)(slabs + (size_t)(lt * 3 + 1) * 65536) + tid;
#pragma unroll
                for (int ai = 0; ai < 2; ++ai)
#pragma unroll
                    for (int m = 0; m < 4; ++m) { const int row = row0 + ai * 128 + m * 16;
#pragma unroll
                        for (int bj = 0; bj < 2; ++bj) { const int j0 = ((ai * 2 + bj) * 4 + m) * 2;
                            const f32x4 a = v[ai][bj][m][0] + s1[j0 * 512] + s2[j0 * 512], b = v[ai][bj][m][1] + s1[(j0 + 1) * 512] + s2[(j0 + 1) * 512];
                            v4u w; w.x = pk2(a[0], a[1]); w.y = pk2(a[2], a[3]); w.z = pk2(b[0], b[1]); w.w = pk2(b[2], b[3]); *(v4u*)(MIX + (size_t)row * D + col0 + bj * 128) = w; }
                        __builtin_amdgcn_sched_barrier(0); }
            }
            return;
        }
#pragma unroll
        for (int ai = 0; ai < 2; ++ai)
#pragma unroll
            for (int m = 0; m < 4; ++m) {
                const int row = row0 + ai * 128 + m * 16;
#pragma unroll
                for (int bj = 0; bj < 2; ++bj) {
                    const int col = col0 + bj * 128;
                    const v4u g = *(const v4u*)(GT + (size_t)row * 6144 + pc * 2048 + col);
                    f32x4 v0 = acc[ai][bj][m][0], v1 = acc[ai][bj][m][1];
                    v0[0] *= bflo(g.x); v0[1] *= bfhi(g.x); v0[2] *= bflo(g.y); v0[3] *= bfhi(g.y);
                    v1[0] *= bflo(g.z); v1[1] *= bfhi(g.z); v1[2] *= bflo(g.w); v1[3] *= bfhi(g.w);
                    bf16* tp = TMP + (size_t)row * D + col;
                    if (pc > 0) { const v4u t = *(const v4u*)tp; v0[0] += bflo(t.x); v0[1] += bfhi(t.x); v0[2] += bflo(t.y); v0[3] += bfhi(t.y); v1[0] += bflo(t.z); v1[1] += bfhi(t.z); v1[2] += bflo(t.w); v1[3] += bfhi(t.w); }
                    if (pc < 2) { v4u w; w.x = pk2(v0[0], v0[1]); w.y = pk2(v0[2], v0[3]); w.z = pk2(v1[0], v1[1]); w.w = pk2(v1[2], v1[3]); *(v4u*)tp = w; }
                    else { v4u w; w.x = pk2(v0[0], v0[1]); w.y = pk2(v0[2], v0[3]); w.z = pk2(v1[0], v1[1]); w.w = pk2(v1[2], v1[3]); *(v4u*)(MIX + (size_t)row * D + col) = w; }
                }
            }
    }
};

struct EpiResid {
    static constexpr bool PERM = false, AFTER_DRAIN = false;
    float* X; float* slabs; unsigned* cnt; unsigned* tmo;
    __device__ __forceinline__ void operator()(AccRef acc, const pg8::Unit& u, int wr, int wc, int fr, int fq) const {
        const int lane = fr + 16 * fq, wid = wr * 4 + wc; int tid = wid * 64 + lane; asm volatile("" : "+v"(tid));
        if (u.kind == 1) {
            __amdgpu_buffer_rsrc_t rsrc = __builtin_amdgcn_make_buffer_rsrc(slabs + (size_t)u.slab * 65536, 0, 65536 * 4, 0x00020000);
#pragma unroll
            for (int ai = 0; ai < 2; ++ai)
#pragma unroll
                for (int bj = 0; bj < 2; ++bj)
#pragma unroll
                    for (int m = 0; m < 4; ++m)
#pragma unroll
                        for (int n = 0; n < 2; ++n) { const int j = ((ai * 2 + bj) * 4 + m) * 2 + n; __builtin_amdgcn_raw_buffer_store_b128(__builtin_bit_cast(pg8::u32x4, acc[ai][bj][m][n]), rsrc, (j * 512 + tid) * 16, 0, 16); }
            asm volatile("s_waitcnt vmcnt(0)" ::: "memory");
            if (lane == 0) __hip_atomic_fetch_add(cnt + 64 * u.slab, 1u, __ATOMIC_RELAXED, __HIP_MEMORY_SCOPE_AGENT);
            return;
        }
        const f32x4* sl = (const f32x4*)(slabs + (size_t)u.slab * 65536);
        if (u.kind == 2) {
            unsigned sp = 0;
            while ((unsigned)__builtin_amdgcn_readfirstlane(__hip_atomic_load(cnt + 64 * u.slab, __ATOMIC_RELAXED, __HIP_MEMORY_SCOPE_AGENT)) < 8u) {
                __builtin_amdgcn_s_sleep(2);
                if ((++sp & 1023u) == 0u) { if (__hip_atomic_load(tmo, __ATOMIC_RELAXED, __HIP_MEMORY_SCOPE_AGENT) != 0u) break; if (sp > (1u << 22)) { if (lane == 0) __hip_atomic_store(tmo, 1u, __ATOMIC_RELAXED, __HIP_MEMORY_SCOPE_AGENT); break; } }
            }
            __builtin_amdgcn_fence(__ATOMIC_ACQUIRE, "agent");
        }
        int row0 = u.pm * 256 + wr * 64 + fr; const int col0 = u.pn * 256 + wc * 32 + 4 * fq; asm volatile("" : "+v"(row0));
#pragma unroll
        for (int ai = 0; ai < 2; ++ai)
#pragma unroll
            for (int m = 0; m < 4; ++m) {
                float* rowp = X + (size_t)(row0 + ai * 128 + m * 16) * D + col0;
#pragma unroll
                for (int bj = 0; bj < 2; ++bj)
#pragma unroll
                    for (int n = 0; n < 2; ++n) { f32x4* p = (f32x4*)(rowp + bj * 128 + n * 16); f32x4 v = *p + acc[ai][bj][m][n]; if (u.kind == 2) v += sl[(((ai * 2 + bj) * 4 + m) * 2 + n) * 512 + tid]; *p = v; }
            }
    }
};

struct EpiSwiglu {
    static constexpr bool PERM = true, AFTER_DRAIN = false;
    bf16* HID;
    __device__ __forceinline__ void operator()(AccRef acc, const pg8::Unit& u, int wr, int wc, int fr, int fq) const {
        const int row0 = u.pm * 256 + wr * 64 + fr, col0 = u.pn * 128 + wc * 32 + 8 * fq;
#pragma unroll
        for (int ai = 0; ai < 2; ++ai)
#pragma unroll
            for (int m = 0; m < 4; ++m) {
                const int row = row0 + ai * 128 + m * 16;
                f32x4 g0 = acc[ai][0][m][0], g1 = acc[ai][0][m][1]; const f32x4 u0 = acc[ai][1][m][0], u1 = acc[ai][1][m][1];
#pragma unroll
                for (int e = 0; e < 4; ++e) { g0[e] = fsilu(g0[e]) * u0[e]; g1[e] = fsilu(g1[e]) * u1[e]; }
                v4u w; w.x = pk2(g0[0], g0[1]); w.y = pk2(g0[2], g0[3]); w.z = pk2(g1[0], g1[1]); w.w = pk2(g1[2], g1[3]);
                *(v4u*)(HID + (size_t)row * FFN + col0) = w;
            }
    }
};

struct BranchOrder {
    pg8::StaticOrder S; int R, rem;
    __device__ __forceinline__ void init(int M, int N, int G, int c, int K) { S.init(M, N, G, c, K); R = S.nwg / G; rem = S.nwg - R * G; if (3 * rem > G || MK_G2_NOSPLIT) { R = (S.nwg + G - 1) / G; rem = 0; } }
    __device__ __forceinline__ bool next(int i, pg8::Unit& u) const {
        const int t = i / 3, pc = i - 3 * t;
        if (t < R) { if (!S.next(t, u)) return false; u.pc = pc; return true; }
        if (i == 3 * R && S.c < 3 * rem) { const int lt = S.c / 3; S.tile(R * S.G + lt, u); u.pc = S.c - 3 * lt; u.k0 = 0; u.nt = S.ntk; u.kind = 3; u.slab = lt; return true; }
        return false;
    }
    __device__ __forceinline__ void a_ready(const pg8::Unit&) const {}
    __device__ __forceinline__ void done(const pg8::Unit&) const {}
};

struct EpiNull {
    static constexpr bool PERM = true, AFTER_DRAIN = false;
    float* sink;
    __device__ __forceinline__ void operator()(AccRef acc, const pg8::Unit& u, int wr, int wc, int fr, int fq) const {
        float s = 0.f;
#pragma unroll
        for (int ai = 0; ai < 2; ++ai)
#pragma unroll
            for (int bj = 0; bj < 2; ++bj)
#pragma unroll
                for (int m = 0; m < 4; ++m)
#pragma unroll
                    for (int n = 0; n < 2; ++n) s += acc[ai][bj][m][n][0] + acc[ai][bj][m][n][3];
        if (s == 12345.678f) sink[u.pm + wr + wc + fr + fq] = s;
    }
};

struct Args { const float* in[24]; float* out; unsigned char* ws; int l_lo, l_hi, ph_lo, ph_hi, do_pro, do_fin, use_bar, pad; };
enum { I_XP = 0, I_XS, I_SCONV, I_SSSM, I_SHG, I_SRET, I_META, I_NMIX, I_WIN, I_CONVW, I_CONVB, I_DTB, I_ALOG, I_DSKIP, I_SSDN, I_HGLOW, I_HGN, I_WBR, I_WOUT, I_NFFN, I_WG, I_WU, I_WD, I_NFIN };

typedef const __attribute__((address_space(4))) Args* ArgsP;
#define AREF const __attribute__((address_space(4))) Args&
struct Ctx {
    LAS unsigned char* lds; int tid, lane, wave, vcu, G;
    ArgsP a; unsigned char* ws;
};

template <class F> __device__ __forceinline__ void tr_item(const float* W, int ldw, bf16* WT, int K, int k0, int n0, LAS float* scr, int lane, F srccol) {
    const int sc = srccol(n0 + (lane & 31));
#pragma unroll 8
    for (int i = 0; i < 32; ++i) { const int kk = 2 * i + (lane >> 5); scr[kk * 33 + (lane & 31)] = W[(size_t)(k0 + kk) * ldw + sc]; }
    LDS_WAIT(); asm volatile("" ::: "memory");
    const int c = lane & 7;
#pragma unroll
    for (int j = 0; j < 4; ++j) { const int n = (lane >> 3) + 8 * j; const LAS float* s = scr + (8 * c) * 33 + n;
        v4u o; o.x = pk2(s[0 * 33], s[1 * 33]); o.y = pk2(s[2 * 33], s[3 * 33]); o.z = pk2(s[4 * 33], s[5 * 33]); o.w = pk2(s[6 * 33], s[7 * 33]);
        *(v4u*)(WT + (size_t)(n0 + n) * K + k0 + 8 * c) = o; }
    LDS_WAIT(); asm volatile("" ::: "memory");
}
__device__ __forceinline__ int win_src(int n) {
    if (n >= 6656 && n < 7680) { const int p = n & 63, j = p >> 3, nn = (p >> 2) & 1, e = p & 3; n = (n & ~63) + 32 * nn + 4 * j + e; }
    return n < 2560 ? n : n + 16;
}
__device__ __forceinline__ int ret_dim(int p) { return 32 * ((p >> 2) & 1) + 4 * (p >> 3) + (p & 3); }

__device__ __forceinline__ void p0_prologue(const Ctx& C) {
    AREF A = *C.a; unsigned char* ws = C.ws;
    LAS float* scr = (LAS float*)(C.lds + C.wave * 16384);
    const int gw = C.vcu * NWAVES + C.wave, NGW = C.G * NWAVES;
    constexpr int I_IN = 32 * 496, I_BR = 3 * 16 * 64, I_OUT = 32 * 64, I_GU = 32 * 352, I_DN = 88 * 64, I_L = I_IN + I_BR + I_OUT + I_GU + I_DN;
    for (int it = gw; it < NL * I_L; it += NGW) {
        const int l = it / I_L; int r = it - l * I_L; unsigned char* lw = ws + WS_W + (size_t)l * LW_SIZE;
        if (r < I_IN) { const int kb = r / 496, nb = r - kb * 496; tr_item(A.in[I_WIN] + (size_t)l * D * INCOLS, INCOLS, (bf16*)(lw + LW_IN), D, 64 * kb, 32 * nb, scr, C.lane, [](int n) { return win_src(n); }); continue; } r -= I_IN;
        if (r < I_BR) { const int c = r / 1024, rr = r - c * 1024, kb = rr / 64, nb = rr - kb * 64;
            tr_item(A.in[I_WBR] + ((size_t)l * 3 + c) * 1024 * D, D, (bf16*)(lw + LW_BR) + (size_t)c * D * 1024, 1024, 64 * kb, 32 * nb, scr, C.lane, [](int n) { return n; }); continue; } r -= I_BR;
        if (r < I_OUT) { const int kb = r / 64, nb = r - kb * 64; tr_item(A.in[I_WOUT] + (size_t)l * D * D, D, (bf16*)(lw + LW_OUT), D, 64 * kb, 32 * nb, scr, C.lane, [](int n) { return n; }); continue; } r -= I_OUT;
        if (r < I_GU) { const int kb = r / 352, nb = r - kb * 352, n0 = 32 * nb, t = n0 >> 8, w = n0 & 255; const float* src = (w < 128 ? A.in[I_WG] : A.in[I_WU]) + (size_t)l * D * FFN; const int sbase = 128 * t + (w & 127) - n0;
            tr_item(src, FFN, (bf16*)(lw + LW_GU), D, 64 * kb, n0, scr, C.lane, [sbase](int n) { return n + sbase; }); continue; } r -= I_GU;
        { const int kb = r / 64, nb = r - kb * 64; tr_item(A.in[I_WD] + (size_t)l * FFN * D, D, (bf16*)(lw + LW_DN), FFN, 64 * kb, 32 * nb, scr, C.lane, [](int n) { return n; }); }
    }
    const int gt = C.vcu * NTHR + C.tid, NGT = C.G * NTHR;
    for (int m = gw; m < MP; m += NGW) {
        const float* src = nullptr;
        if (m >= NNULL && m < ROW_P0) src = A.in[I_META] + (size_t)(m - NNULL) * D;
        else if (m >= ROW_P0 && m < ROW_S0) src = A.in[I_XP] + (size_t)(m - ROW_P0) * D;
        else if (m >= ROW_S0 && m < MR) src = A.in[I_XS] + (size_t)(m - ROW_S0) * D;
        f32x4* dst = (f32x4*)(ws + WS_X + (size_t)m * D * 4) + C.lane;
#pragma unroll
        for (int j = 0; j < 8; ++j) dst[64 * j] = src ? ((const f32x4*)src)[C.lane + 64 * j] : (f32x4){0.f, 0.f, 0.f, 0.f};
    }
    for (int i = gt; i < MP * 32; i += NGT) {
        const int row = i >> 5, fi = i & 31;
        const int pos = row < ROW_S0 ? row - ROW_P0 : (row < MR ? 1024 + ((row - ROW_S0) & 63) : 0);
        const double inv = exp(-(double)fi * (9.210340371976184 / 32.0));
        const double ang = (double)pos * inv, n = rint(ang * 0.15915494309189535), r = fma(-n, 6.283185307179586, ang) - n * 2.4492935982947064e-16;
        const double r2 = r * r; double s = 0.0, c = 0.0;
#pragma unroll
        for (int k = 14; k >= 1; --k) { s = (s + 1.0) * (-r2 / (double)((2 * k) * (2 * k + 1))); c = (c + 1.0) * (-r2 / (double)((2 * k - 1) * (2 * k))); }
        ((f32x2*)(ws + WS_ROPE))[i] = (f32x2){(float)(c + 1.0), (float)((s + 1.0) * r)};
    }
    for (int i = gt; i < 1024; i += NGT) {
        const float* hl = A.in[I_HGLOW]; const float v0 = hl[i], v1 = hl[1024 + i], v2 = hl[2048 + i], v3 = hl[3072 + i], mx = fmaxf(fmaxf(v0, v1), fmaxf(v2, v3));
        const float e0 = expf(v0 - mx), e1 = expf(v1 - mx), e2 = expf(v2 - mx), e3 = expf(v3 - mx), inv = 1.0f / (e0 + e1 + e2 + e3);
        float* lb = (float*)(ws + WS_LBS); lb[i] = 0.f; lb[1024 + i] = e1 * inv; lb[2048 + i] = (e1 + e2) * inv; lb[3072 + i] = (e1 + e2 + e3) * inv;
    }
    for (int i = gt; i < 3 * (MP - MR) * 1024 / 8; i += NGT) { const int c = i / ((MP - MR) * 128), r = i - c * (MP - MR) * 128;
        ((v4u*)(ws + WS_BR + ((size_t)c * MP + MR) * 1024 * 2))[r] = (v4u){0u, 0u, 0u, 0u}; }
}

__device__ __forceinline__ float softplusf(float v) { return v > 20.0f ? v : log1pf(expf(v)); }
template <bool WITH_DT> __device__ __forceinline__ void norm_phase(const Ctx& C, const float* X, const float* gain, bf16* H, int l) {
    const int gw = C.vcu * NWAVES + C.wave, NGW = C.G * NWAVES;
    LAS unsigned char* W16 = C.lds;
    float dtb = 0.f, aexp = 0.f;
    if (WITH_DT) {
        AREF A = *C.a; const float* wsrc = A.in[I_WIN] + (size_t)l * D * INCOLS + 2560;
#pragma unroll 4
        for (int i = C.tid; i < D * 4; i += NTHR) { const int k = i >> 2, q = i & 3; const f32x4 v = *(const f32x4*)(wsrc + (size_t)k * INCOLS + 4 * q);
#pragma unroll
            for (int e = 0; e < 4; ++e) *(LAS bf16*)(W16 + ((4 * q + e) * D + k) * 2) = (bf16)f2bf(v[e]); }
        { const int hd = ((C.lane >> 5) & 1) * 8 + ((C.lane >> 4) & 1) * 4 + ((C.lane >> 3) & 1) * 2 + ((C.lane >> 2) & 1); dtb = A.in[I_DTB][l * 16 + hd]; aexp = expf(A.in[I_ALOG][l * 16 + hd]); }
        LBAR();
    }
    f32x4 gn[8];
#pragma unroll
    for (int j = 0; j < 8; ++j) gn[j] = ((const f32x4*)gain)[C.lane + 64 * j];
    for (int m0 = gw; m0 < MP; m0 += 2 * NGW) {
        const int m1 = m0 + NGW; const bool has1 = m1 < MP;
        f32x4 v[2][8];
#pragma unroll
        for (int r = 0; r < 2; ++r) {
            const int m = r ? (has1 ? m1 : m0) : m0;
            const f32x4* xr = (const f32x4*)(X + (size_t)m * D) + C.lane; float s = 0.f;
#pragma unroll
            for (int j = 0; j < 8; ++j) { v[r][j] = xr[64 * j]; s += (v[r][j][0] * v[r][j][0] + v[r][j][1] * v[r][j][1]) + (v[r][j][2] * v[r][j][2] + v[r][j][3] * v[r][j][3]); }
            const float rs = rsqrtf(wave_sum(s) * (1.0f / D) + EPS);
            v2u* o = (v2u*)(H + (size_t)m * D) + C.lane;
#pragma unroll
            for (int j = 0; j < 8; ++j) { v[r][j] = v[r][j] * rs * gn[j]; v2u w; w.x = pk2(v[r][j][0], v[r][j][1]); w.y = pk2(v[r][j][2], v[r][j][3]); if (r == 0 || has1) o[64 * j] = w; }
        }
        if (WITH_DT) {
            float d[2][16];
#pragma unroll
            for (int hg = 0; hg < 4; ++hg) {
#pragma unroll
                for (int hh = 0; hh < 4; ++hh) { const int hd = 4 * hg + hh; float d0 = 0.f, d1 = 0.f;
#pragma unroll
                    for (int j = 0; j < 8; ++j) { const v2u ww = *(const LAS v2u*)(W16 + (hd * D + 4 * (C.lane + 64 * j)) * 2); const float w0 = bflo(ww.x), w1 = bfhi(ww.x), w2 = bflo(ww.y), w3 = bfhi(ww.y);
                        d0 += (v[0][j][0] * w0 + v[0][j][1] * w1) + (v[0][j][2] * w2 + v[0][j][3] * w3); d1 += (v[1][j][0] * w0 + v[1][j][1] * w1) + (v[1][j][2] * w2 + v[1][j][3] * w3); }
                    d[0][hd] = d0; d[1][hd] = d1; }
                __builtin_amdgcn_sched_barrier(0);
            }
            float tot[2];
#pragma unroll
            for (int r = 0; r < 2; ++r) {
#pragma unroll
                for (int n = 8, o = 32; n >= 1; n >>= 1, o >>= 1) {
                    const bool up = (C.lane & o) != 0;
#pragma unroll
                    for (int i2 = 0; i2 < n; ++i2) { const float keep = up ? d[r][i2 + n] : d[r][i2], send = up ? d[r][i2] : d[r][i2 + n]; d[r][i2] = keep + __shfl_xor(send, o); }
                }
                float t = d[r][0]; t += __shfl_xor(t, 2); t += __shfl_xor(t, 1); tot[r] = t;
            }
            const int hd = ((C.lane >> 5) & 1) * 8 + ((C.lane >> 4) & 1) * 4 + ((C.lane >> 3) & 1) * 2 + ((C.lane >> 2) & 1);
            if ((C.lane & 3) == 0) {
                { float dt = softplusf(tot[0] + dtb); if (m0 < NNULL) dt = 0.f; ((float*)(C.ws + WS_DT))[(size_t)m0 * 16 + hd] = dt; ((float*)(C.ws + WS_AV))[(size_t)m0 * 16 + hd] = -dt * aexp; }
                if (has1) { float dt = softplusf(tot[1] + dtb); if (m1 < NNULL) dt = 0.f; ((float*)(C.ws + WS_DT))[(size_t)m1 * 16 + hd] = dt; ((float*)(C.ws + WS_AV))[(size_t)m1 * 16 + hd] = -dt * aexp; }
            }
        }
    }
}
__device__ __forceinline__ void final_phase(const Ctx& C, const float* X, const float* gain, float* out) {
    const int gw = C.vcu * NWAVES + C.wave, NGW = C.G * NWAVES;
    f32x4 gn[8];
#pragma unroll
    for (int j = 0; j < 8; ++j) gn[j] = ((const f32x4*)gain)[C.lane + 64 * j];
    for (int m = ROW_P0 + gw; m < MR; m += NGW) {
        const f32x4* xr = (const f32x4*)(X + (size_t)m * D) + C.lane;
        f32x4 v[8]; float s = 0.f;
#pragma unroll
        for (int j = 0; j < 8; ++j) { v[j] = xr[64 * j]; s += (v[j][0] * v[j][0] + v[j][1] * v[j][1]) + (v[j][2] * v[j][2] + v[j][3] * v[j][3]); }
        const float rs = rsqrtf(wave_sum(s) * (1.0f / D) + EPS);
        f32x4* o = (f32x4*)(out + (m < ROW_S0 ? O_YP + (size_t)(m - ROW_P0) * D : O_YS + (size_t)(m - ROW_S0) * D)) + C.lane;
#pragma unroll
        for (int j = 0; j < 8; ++j) o[64 * j] = v[j] * rs * gn[j];
    }
}

__device__ __forceinline__ bf16x8 ldsfrag(const LAS unsigned char* base, int row, int pitchB, int kel) { return *(const LAS bf16x8*)(base + row * pitchB + kel * 2); }
__device__ __forceinline__ float ret_lgam(int h) { return log1pf(-exp2f(-5.0f - (float)h)); }
struct ConvSrc {
    const bf16* XBC; const float* sconv; int c, r0;
    __device__ __forceinline__ float at(int t, int ch) const {
        if (t >= 0) return bf2f(XBC[(size_t)(r0 + t) * 1536 + ch]);
        if (c == 0) return 0.f;
        if (c < NCHP) return bf2f(XBC[(size_t)(r0 + t) * 1536 + ch]);
        return sconv[((size_t)(c - NCHP) * 3 + (3 + t)) * 1536 + ch];
    }
};

__device__ __forceinline__ v2u pk4(const f32x4 v) { v2u w; w.x = pk2(v[0], v[1]); w.y = pk2(v[2], v[3]); return w; }
__device__ __forceinline__ f32x4 unpk4(const v2u w) { return (f32x4){bflo(w.x), bfhi(w.x), bflo(w.y), bfhi(w.y)}; }
__device__ __forceinline__ void m1_ssd(const Ctx& C, int l, int c, int g) {
    AREF A = *C.a; unsigned char* ws = C.ws; const int tid = C.tid, lane = C.lane, w = C.wave, r0 = 64 * c;
    LAS unsigned char* XT = C.lds; LAS unsigned char* BT = C.lds + 73728;
    LAS float* SDT = (LAS float*)(C.lds + 92160); LAS float* SCUM = (LAS float*)(C.lds + 94208);
    const int l15 = lane & 15, l4 = lane >> 4;
    const ConvSrc cs{(const bf16*)(ws + WS_XBC), A.in[I_SCONV] + (size_t)l * 16 * 3 * 1536, c, r0};
    const float* cw = A.in[I_CONVW] + (size_t)l * 4 * 1536; const float* cb = A.in[I_CONVB] + (size_t)l * 1536;
    const int chx = 512 * g + tid;
    float raw[67];
#pragma unroll
    for (int t = 0; t < 67; ++t) raw[t] = cs.at(t - 3, chx);
    const float xw0 = cw[chx], xw1 = cw[1536 + chx], xw2 = cw[2 * 1536 + chx], xw3 = cw[3 * 1536 + chx], xbias = cb[chx];
    {
        const int hd = 8 * g + w; const float dt = ((const float*)(ws + WS_DT))[(r0 + lane) * 16 + hd]; float v = ((const float*)(ws + WS_AV))[(r0 + lane) * 16 + hd];
#pragma unroll
        for (int o = 1; o < 64; o <<= 1) { const float t = __shfl_up(v, o); if (lane >= o) v += t; }
        SDT[lane * 8 + w] = dt; SCUM[lane * 8 + w] = v; ((float*)(ws + WS_CUM))[(r0 + lane) * 16 + hd] = v;
        if (lane == 63) ((float*)(ws + WS_GAM))[(size_t)c * GAM_N + hd] = expf(v);
    }
    LBAR();
    {
        const int hh = tid >> 6; const float clast = SCUM[63 * 8 + hh];
        bf16* xg = (bf16*)(ws + WS_XTG) + ((size_t)c * 1024 + chx) * 64;
#pragma unroll
        for (int t0 = 0; t0 < 64; t0 += 8) {
            float val[8], vw[8];
#pragma unroll
            for (int tt = 0; tt < 8; ++tt) { const int t = t0 + tt; val[tt] = fsilu(xbias + xw0 * raw[t] + xw1 * raw[t + 1] + xw2 * raw[t + 2] + xw3 * raw[t + 3]);
                vw[tt] = val[tt] * (__expf(clast - SCUM[t * 8 + hh]) * SDT[t * 8 + hh]); }
            v4u o; o.x = pk2(val[0], val[1]); o.y = pk2(val[2], val[3]); o.z = pk2(val[4], val[5]); o.w = pk2(val[6], val[7]); *(v4u*)(xg + t0) = o;
            o.x = pk2(vw[0], vw[1]); o.y = pk2(vw[2], vw[3]); o.z = pk2(vw[4], vw[5]); o.w = pk2(vw[6], vw[7]); *(LAS v4u*)(XT + tid * 144 + t0 * 2) = o;
        }
    }
    {
        const int col = tid & 255, seg = tid >> 8, t0 = 32 * seg, ch = col < 128 ? 1024 + 128 * g + col : 1280 + 128 * g + (col - 128);
        const float w0 = cw[ch], w1 = cw[1536 + ch], w2 = cw[2 * 1536 + ch], w3 = cw[3 * 1536 + ch], bias = cb[ch];
        float rb[35];
#pragma unroll
        for (int t = 0; t < 35; ++t) rb[t] = cs.at(t0 - 3 + t, ch);
        bf16* bg = (bf16*)(ws + WS_BCG) + (size_t)(r0 + t0) * 512 + 256 * g + col;
#pragma unroll
        for (int t8 = 0; t8 < 32; t8 += 8) { float val[8];
#pragma unroll
            for (int tt = 0; tt < 8; ++tt) { const int t = t8 + tt; val[tt] = fsilu(bias + w0 * rb[t] + w1 * rb[t + 1] + w2 * rb[t + 2] + w3 * rb[t + 3]); bg[(unsigned)(t * 512)] = (bf16)f2bf(val[tt]); }
            if (col < 128) { v4u o; o.x = pk2(val[0], val[1]); o.y = pk2(val[2], val[3]); o.z = pk2(val[4], val[5]); o.w = pk2(val[6], val[7]); *(LAS v4u*)(BT + col * 144 + (t0 + t8) * 2) = o; } }
    }
    LBAR();
    {
        const int hd = 8 * g + w; bf16* U = (bf16*)(ws + WS_U) + (size_t)c * STATE_N + ST_SSD + (size_t)hd * 8192;
#pragma unroll 1
        for (int pi = 0; pi < 4; ++pi) {
            const bf16x8 a0 = ldsfrag(XT, 64 * w + 16 * pi + l15, 144, 8 * l4), a1 = ldsfrag(XT, 64 * w + 16 * pi + l15, 144, 32 + 8 * l4);
#pragma unroll
            for (int nj = 0; nj < 8; ++nj) {
                f32x4 acc = (f32x4){0.f, 0.f, 0.f, 0.f};
                acc = mfma16(ldsfrag(BT, 16 * nj + l15, 144, 8 * l4), a0, acc); acc = mfma16(ldsfrag(BT, 16 * nj + l15, 144, 32 + 8 * l4), a1, acc);
                *(v2u*)(U + (16 * pi + l15) * 128 + 16 * nj + 4 * l4) = pk4(acc);
            }
        }
    }
}

__device__ __forceinline__ void m1_hg(const Ctx& C, int l, int c, int h) {
    unsigned char* ws = C.ws; const int tid = C.tid, lane = C.lane, w = C.wave, r0 = 64 * c, l15 = lane & 15, l4 = lane >> 4;
    LAS unsigned char* KT = C.lds; LAS unsigned char* VT = C.lds + 18432; LAS float* SEG = (LAS float*)(C.lds + 36864);
    const int col = tid & 127, seg = tid >> 7; const size_t base = (size_t)(r0 + 16 * seg) * 1024 + 128 * h + col;
    const float* LG = (const float*)(ws + WS_LG) + base; const bf16* KK = (const bf16*)(ws + WS_KK) + base; const bf16* HV = (const bf16*)(ws + WS_HV) + base;
    float cum[16], kk[16], vv[16];
#pragma unroll
    for (int i = 0; i < 16; ++i) { cum[i] = LG[(size_t)i * 1024]; kk[i] = bf2f(KK[(size_t)i * 1024]); vv[i] = bf2f(HV[(size_t)i * 1024]); }
#pragma unroll
    for (int i = 1; i < 16; ++i) cum[i] += cum[i - 1];
    SEG[seg * 128 + col] = cum[15];
    LBAR();
    float off = 0.f, tot = 0.f;
#pragma unroll
    for (int s = 0; s < 4; ++s) { const float t = SEG[s * 128 + col]; tot += t; if (s < seg) off += t; }
#pragma unroll
    for (int i = 0; i < 16; ++i) kk[i] *= __expf(tot - (cum[i] + off));
    { v4u o; o.x = pk2(kk[0], kk[1]); o.y = pk2(kk[2], kk[3]); o.z = pk2(kk[4], kk[5]); o.w = pk2(kk[6], kk[7]); *(LAS v4u*)(KT + col * 144 + seg * 32) = o;
      o.x = pk2(kk[8], kk[9]); o.y = pk2(kk[10], kk[11]); o.z = pk2(kk[12], kk[13]); o.w = pk2(kk[14], kk[15]); *(LAS v4u*)(KT + col * 144 + seg * 32 + 16) = o;
      o.x = pk2(vv[0], vv[1]); o.y = pk2(vv[2], vv[3]); o.z = pk2(vv[4], vv[5]); o.w = pk2(vv[6], vv[7]); *(LAS v4u*)(VT + col * 144 + seg * 32) = o;
      o.x = pk2(vv[8], vv[9]); o.y = pk2(vv[10], vv[11]); o.z = pk2(vv[12], vv[13]); o.w = pk2(vv[14], vv[15]); *(LAS v4u*)(VT + col * 144 + seg * 32 + 16) = o; }
    if (seg == 0) ((float*)(ws + WS_GAM))[(size_t)c * GAM_N + 16 + 128 * h + col] = expf(tot);
    LBAR();
    {
        bf16* U = (bf16*)(ws + WS_U) + (size_t)c * STATE_N + ST_HG + (size_t)h * 16384;
        const bf16x8 a0 = ldsfrag(VT, 16 * w + l15, 144, 8 * l4), a1 = ldsfrag(VT, 16 * w + l15, 144, 32 + 8 * l4);
        const bool nat = c >= NCHP;
#pragma unroll
        for (int kj = 0; kj < 8; ++kj) {
            f32x4 acc = (f32x4){0.f, 0.f, 0.f, 0.f}; const bf16x8 k0 = ldsfrag(KT, 16 * kj + l15, 144, 8 * l4), k1 = ldsfrag(KT, 16 * kj + l15, 144, 32 + 8 * l4);
            if (!nat) { acc = mfma16(k0, a0, acc); acc = mfma16(k1, a1, acc); *(v2u*)(U + (16 * w + l15) * 128 + 16 * kj + 4 * l4) = pk4(acc); }
            else { acc = mfma16(a0, k0, acc); acc = mfma16(a1, k1, acc); *(v2u*)(U + (16 * kj + l15) * 128 + 16 * w + 4 * l4) = pk4(acc); }
        }
    }
}

__device__ __forceinline__ void m1_ret(const Ctx& C, int l, int c, int h) {
    unsigned char* ws = C.ws; const int tid = C.tid, lane = C.lane, w = C.wave, r0 = 64 * c, l15 = lane & 15, l4 = lane >> 4;
    LAS unsigned char* KT = C.lds; LAS unsigned char* VT = C.lds + 9216;
    const float lg = ret_lgam(h);
    {   const int kp = tid & 63, s8 = tid >> 6; const bf16* RK = (const bf16*)(ws + WS_RK) + (size_t)(r0 + 8 * s8) * 512 + 64 * h + kp; float v[8];
#pragma unroll
        for (int i = 0; i < 8; ++i) v[i] = bf2f(RK[(size_t)i * 512]) * __expf((float)(63 - (8 * s8 + i)) * lg);
        v4u o; o.x = pk2(v[0], v[1]); o.y = pk2(v[2], v[3]); o.z = pk2(v[4], v[5]); o.w = pk2(v[6], v[7]); *(LAS v4u*)(KT + kp * 144 + s8 * 16) = o; }
    {   const int col = tid & 127, seg = tid >> 7; const bf16* RV = (const bf16*)(ws + WS_RV) + (size_t)(r0 + 16 * seg) * 1024 + 128 * h + col; float vv[16];
#pragma unroll
        for (int i = 0; i < 16; ++i) vv[i] = bf2f(RV[(size_t)i * 1024]);
        v4u o; o.x = pk2(vv[0], vv[1]); o.y = pk2(vv[2], vv[3]); o.z = pk2(vv[4], vv[5]); o.w = pk2(vv[6], vv[7]); *(LAS v4u*)(VT + col * 144 + seg * 32) = o;
        o.x = pk2(vv[8], vv[9]); o.y = pk2(vv[10], vv[11]); o.z = pk2(vv[12], vv[13]); o.w = pk2(vv[14], vv[15]); *(LAS v4u*)(VT + col * 144 + seg * 32 + 16) = o; }
    LBAR();
    {   bf16* U = (bf16*)(ws + WS_U) + (size_t)c * STATE_N + ST_RET + (size_t)h * 8192;
        const bf16x8 a0 = ldsfrag(VT, 16 * w + l15, 144, 8 * l4), a1 = ldsfrag(VT, 16 * w + l15, 144, 32 + 8 * l4);
        const bool nat = c >= NCHP;
#pragma unroll
        for (int kj = 0; kj < 4; ++kj) {
            f32x4 acc = (f32x4){0.f, 0.f, 0.f, 0.f}; const bf16x8 k0 = ldsfrag(KT, 16 * kj + l15, 144, 8 * l4), k1 = ldsfrag(KT, 16 * kj + l15, 144, 32 + 8 * l4);
            if (!nat) { acc = mfma16(k0, a0, acc); acc = mfma16(k1, a1, acc); *(v2u*)(U + (16 * w + l15) * 64 + 16 * kj + 4 * l4) = pk4(acc); }
            else { acc = mfma16(a0, k0, acc); acc = mfma16(a1, k1, acc); *(v2u*)(U + (16 * kj + l15) * 128 + 16 * w + 4 * l4) = pk4(acc); }
        }
    }
}

#ifndef REPI_M1_SSD
#define REPI_M1_SSD 1
#endif
#ifndef REPI_M1_HG
#define REPI_M1_HG 1
#endif
#ifndef REPI_M1_RET
#define REPI_M1_RET 1
#endif
__device__ __forceinline__ unsigned m1_prefetch(const Ctx& C, int l, int it) {
    constexpr int N_SSD = NCH * 2, N_HG = NCH * 8; unsigned char* ws = C.ws; const int tid = C.tid; unsigned pf = 0;
    if (it < N_SSD) { const int c = it >> 1, g = it & 1, r0 = 64 * c; const bf16* XBC = (const bf16*)(ws + WS_XBC);
#pragma unroll
        for (int q = 0; q < 2; ++q) { const int s = tid + 512 * q; if (s < 768) { const int row = s / 12, p = s - 12 * row; const int col = p < 8 ? 512 * g + 64 * p : (p < 10 ? 1024 + 128 * g + 64 * (p - 8) : 1280 + 128 * g + 64 * (p - 10));
            pf ^= *(const unsigned*)(XBC + (size_t)(r0 + row) * 1536 + col); } } }
    else if (it < N_SSD + N_HG) { const int j = it - N_SSD, c = j >> 3, h = j & 7, row = tid >> 3, p = tid & 7; const size_t b = (size_t)(64 * c + row) * 1024 + 128 * h;
        if (p < 4) pf ^= *(const unsigned*)((const float*)(ws + WS_LG) + b + 32 * p); else if (p < 6) pf ^= *(const unsigned*)((const bf16*)(ws + WS_KK) + b + 64 * (p - 4)); else pf ^= *(const unsigned*)((const bf16*)(ws + WS_HV) + b + 64 * (p - 6)); }
    else { const int j = it - N_SSD - N_HG, c = j >> 3, h = j & 7; if (tid < 192) { const int row = tid / 3, p = tid - 3 * row;
            if (p == 0) pf ^= *(const unsigned*)((const bf16*)(ws + WS_RK) + (size_t)(64 * c + row) * 512 + 64 * h); else pf ^= *(const unsigned*)((const bf16*)(ws + WS_RV) + (size_t)(64 * c + row) * 1024 + 128 * h + 64 * (p - 1)); } }
    return pf;
}
__device__ __forceinline__ void m1_phase(const Ctx& C0, int l, int mask = 7) {
    constexpr int N_SSD = NCH * 2, N_HG = NCH * 8, N_IT = NCH * 18;
    unsigned* cnt = (unsigned*)(C0.ws + WS_CTL) + CW_QUEUE + 64 * (l * 8 + 0 * 4 + (mask == 7 ? 0 : 1));
    volatile LAS int* slot = (volatile LAS int*)(C0.lds + LDSCTL_OFF + 64);
    int n2 = 0;
    if (C0.tid == 0) { slot[0] = (int)__hip_atomic_fetch_add(cnt, 1u, __ATOMIC_RELAXED, __HIP_MEMORY_SCOPE_AGENT); slot[1] = (int)__hip_atomic_fetch_add(cnt, 1u, __ATOMIC_RELAXED, __HIP_MEMORY_SCOPE_AGENT); }
    LBAR();
    int it = slot[0], nx = slot[1];
    LBAR();
    while (it < N_IT) {
        if (C0.tid == 0) n2 = (int)__hip_atomic_fetch_add(cnt, 1u, __ATOMIC_RELAXED, __HIP_MEMORY_SCOPE_AGENT);
        Ctx C = C0; { int t_ = C0.tid; asm volatile("" : "+v"(t_)); C.tid = t_; C.lane = t_ & 63; C.wave = __builtin_amdgcn_readfirstlane(t_ >> 6); }
        unsigned pf = 0; if (MK_PREFETCH && nx < N_IT && mask == 7) pf = m1_prefetch(C, l, nx);
        if (it < N_SSD) { if (mask & 1) m1_ssd(C, l, it >> 1, it & 1); }
        else if (it < N_SSD + N_HG) { if (mask & 2) { const int j = it - N_SSD; m1_hg(C, l, j >> 3, j & 7); } }
        else { if (mask & 4) { const int j = it - N_SSD - N_HG; m1_ret(C, l, j >> 3, j & 7); } }
        if (pf == 0x7fc1abcdu) ((unsigned*)(C0.ws + WS_CTL))[16] = pf;
        LBAR();
        if (C0.tid == 0) slot[0] = n2;
        LBAR();
        it = nx; nx = slot[0];
    }
}

struct StIdx { int kind, h; size_t outoff; int ostride; };
__device__ __forceinline__ void m2_elem(int idx, int& kind, int& h, int& o0, int& ostr) {
    if (idx < ST_HG) { kind = 0; h = idx >> 13; o0 = idx; ostr = 1; }
    else if (idx < ST_RET) { const int r = idx - ST_HG; kind = 1; h = r >> 14; const int v = (r >> 7) & 127, k = r & 127; o0 = h * 16384 + k * 128 + v; ostr = 128; }
    else { const int r = idx - ST_RET; kind = 2; h = r >> 13; const int v = (r >> 6) & 127, kp = r & 63; o0 = h * 8192 + ret_dim(kp) * 128 + v; ostr = 128; }
}
__device__ __forceinline__ void m2_sample_item(AREF A, unsigned char* ws, int l, int j) {
    float* out = A.out; const bf16* U = (const bf16*)(ws + WS_U); const float* GAM = (const float*)(ws + WS_GAM);
    const int b = j / (STATE_N / 4), idx = 4 * (j - b * (STATE_N / 4)), c = NCHP + b;
    const f32x4 u = unpk4(*(const v2u*)(U + (size_t)c * STATE_N + idx));
    if (idx < ST_HG) { const int h = idx >> 13; const size_t o = ((size_t)l * 16 + b) * 131072 + idx; const float t = GAM[(size_t)c * GAM_N + h];
        *(f32x4*)(out + O_SSMS + o) = *(const f32x4*)(A.in[I_SSSM] + o) * t + u; }
    else if (idx < ST_RET) { const int r = idx - ST_HG, h = r >> 14, k = (r >> 7) & 127; const size_t o = ((size_t)l * 16 + b) * 131072 + r; const float t = GAM[(size_t)c * GAM_N + 16 + 128 * h + k];
        *(f32x4*)(out + O_HGS + o) = *(const f32x4*)(A.in[I_SHG] + o) * t + u; }
    else { const int r = idx - ST_RET, h = r >> 13, kp = (r >> 7) & 63, v = r & 127; const size_t o = ((size_t)l * 16 + b) * 65536 + h * 8192 + ret_dim(kp) * 128 + v; const float t = expf(64.0f * ret_lgam(h));
        *(f32x4*)(out + O_RETS + o) = *(const f32x4*)(A.in[I_SRET] + o) * t + u; }
}
__device__ __forceinline__ void m2_phase(const Ctx& C, int l) {
    AREF A = *C.a; unsigned char* ws = C.ws; float* out = A.out;
    const bf16* U = (const bf16*)(ws + WS_U); const float* GAM = (const float*)(ws + WS_GAM); bf16* SB = (bf16*)(ws + WS_SB);
    constexpr int NCB = STATE_N / 4 / NTHR;
    const int nb_other = C.G - NCB;
    constexpr int NSI = 16 * (STATE_N / 4);
    const bool chain_wg = C.vcu < NCB || nb_other <= 0;
    if (chain_wg) {
      for (int e4 = C.vcu * NTHR + C.tid; e4 < STATE_N / 4; e4 += (nb_other > 0 ? NCB : C.G) * NTHR) {
        const int idx = 4 * e4; int kind, h, o0, ostr; m2_elem(idx, kind, h, o0, ostr);
        const float gret = expf(64.0f * ret_lgam(h));
        const int goff = kind == 0 ? h : 16 + 128 * h + (idx & 127);
        f32x4 S = (f32x4){0.f, 0.f, 0.f, 0.f};
        const bf16* up = U + idx; const float* gp = GAM + goff; bf16* sp = SB + idx;
#pragma unroll 1
        for (int c0 = 0; c0 < 128; c0 += 16) {
            v2u u[16]; f32x4 gm[16];
#pragma unroll
            for (int q = 0; q < 16; ++q) { u[q] = *(const v2u*)(up + (size_t)(c0 + q) * STATE_N);
                if (kind == 0) { const float t = gp[(size_t)(c0 + q) * GAM_N]; gm[q] = (f32x4){t, t, t, t}; }
                else if (kind == 1) gm[q] = *(const f32x4*)(gp + (size_t)(c0 + q) * GAM_N);
                else gm[q] = (f32x4){gret, gret, gret, gret}; }
#pragma unroll
            for (int q = 0; q < 16; ++q) { *(v2u*)(sp + (size_t)(c0 + q) * STATE_N) = pk4(S); S = S * gm[q] + unpk4(u[q]); }
        }
        {   const int c = 128; const f32x4 u = unpk4(*(const v2u*)(up + (size_t)c * STATE_N)); f32x4 gm;
            if (kind == 0) { const float t = gp[(size_t)c * GAM_N]; gm = (f32x4){t, t, t, t}; } else if (kind == 1) gm = *(const f32x4*)(gp + (size_t)c * GAM_N); else gm = (f32x4){gret, gret, gret, gret};
            *(v2u*)(sp + (size_t)c * STATE_N) = pk4(S); S = S * gm + u; }
        float* o = out + (kind == 0 ? O_SSMP + (size_t)l * 131072 : kind == 1 ? O_HGP + (size_t)l * 131072 : O_RETP + (size_t)l * 65536);
        if (kind == 0) *(f32x4*)(o + o0) = S; else { o[o0] = S[0]; o[o0 + ostr] = S[1]; o[o0 + 2 * ostr] = S[2]; o[o0 + 3 * ostr] = S[3]; }
      }
    }
    if (!chain_wg || nb_other <= 0) {
      const int ob = nb_other > 0 ? C.vcu - NCB : C.vcu, nob = nb_other > 0 ? nb_other : C.G;
      for (int j = ob * NTHR + C.tid; j < NSI; j += nob * NTHR) m2_sample_item(A, ws, l, j);
      const bf16* XBC = (const bf16*)(ws + WS_XBC);
      for (int i = ob * NTHR + C.tid; i < 17 * 4608; i += nob * NTHR) {
        const int s = i / 4608, r = i - s * 4608, jrow = r / 1536, ch = r - jrow * 1536;
        if (s == 0) out[O_CONVP + (size_t)l * 4608 + r] = bf2f(XBC[(size_t)(ROW_S0 - 3 + jrow) * 1536 + ch]);
        else out[O_CONVS + ((size_t)l * 16 + (s - 1)) * 4608 + r] = bf2f(XBC[(size_t)(ROW_S0 + 64 * (s - 1) + 61 + jrow) * 1536 + ch]);
      }
    }
}


__device__ __forceinline__ void m3_ssd(const Ctx& C, int l, int c, int g) {
    AREF A = *C.a; unsigned char* ws = C.ws; const int tid = C.tid, lane = C.lane, w = C.wave, r0 = 64 * c, l15 = lane & 15, l4 = lane >> 4;
    LAS float* CBS = (LAS float*)C.lds; LAS float* SDT = (LAS float*)(C.lds + 17408); LAS float* SCUM = (LAS float*)(C.lds + 19456); LAS float* SSQ = (LAS float*)(C.lds + 21504);
    LAS unsigned char* CM = C.lds + 23552;
    LAS unsigned char* ZT = C.lds + 40960;
    const bf16* BCG = (const bf16*)(ws + WS_BCG) + (size_t)r0 * 512 + 256 * g;
    const int hd = 8 * g + w;
    const bf16* SB = (const bf16*)(ws + WS_SB) + (size_t)c * STATE_N + ST_SSD + (size_t)hd * 8192;
    const float* S0 = A.in[I_SSSM] + ((size_t)l * 16 + (c >= NCHP ? c - NCHP : 0)) * 131072 + (size_t)hd * 8192;
    const bf16* XTG = (const bf16*)(ws + WS_XTG) + ((size_t)c * 1024 + 512 * g + 64 * w) * 64;
#define M3S_LOAD(SF, XF, PB) do { _Pragma("unroll") for (int ks_ = 0; ks_ < 4; ++ks_) { \
            if (c < NCHP) SF[ks_] = *(const bf16x8*)(SB + (unsigned)((16 * (PB) + l15) * 128 + 32 * ks_ + 8 * l4)); \
            else { const float* sp_ = S0 + (unsigned)((16 * (PB) + l15) * 128 + 32 * ks_ + 8 * l4); const f32x4 s0_ = *(const f32x4*)sp_, s1_ = *(const f32x4*)(sp_ + 4); \
                v4u o_; o_.x = pk2(s0_[0], s0_[1]); o_.y = pk2(s0_[2], s0_[3]); o_.z = pk2(s1_[0], s1_[1]); o_.w = pk2(s1_[2], s1_[3]); SF[ks_] = __builtin_bit_cast(bf16x8, o_); } } \
        XF[0] = *(const bf16x8*)(XTG + (unsigned)((16 * (PB) + l15) * 64 + 8 * l4)); XF[1] = *(const bf16x8*)(XTG + (unsigned)((16 * (PB) + l15) * 64 + 32 + 8 * l4)); } while (0)
    bf16x8 sfA[4], xfA[2], sfB[4], xfB[2];
    M3S_LOAD(sfA, xfA, 0);
    { const int row = tid >> 3, hh = tid & 7; SDT[tid] = ((const float*)(ws + WS_DT))[(r0 + row) * 16 + 8 * g + hh]; SCUM[tid] = ((const float*)(ws + WS_CUM))[(r0 + row) * 16 + 8 * g + hh]; }
    {
        const bf16* ZS = (const bf16*)(ws + WS_ZS) + (size_t)r0 * 1024 + 512 * g;
#pragma unroll
        for (int q = 0; q < 2; ++q) { const int ch = tid + 512 * q, row = ch >> 4, c8 = ch & 15; *(LAS v4u*)(CM + row * 272 + c8 * 16) = *(const v4u*)(BCG + (unsigned)(row * 512 + 128 + c8 * 8)); }
#pragma unroll
        for (int q = 0; q < 8; ++q) { const int ch = tid + 512 * q, row = ch >> 6, c8 = ch & 63; *(LAS v4u*)(ZT + row * 1040 + c8 * 16) = *(const v4u*)(ZS + (unsigned)(row * 1024 + c8 * 8)); }
    }
    {
        const int i = w >> 1;
#pragma unroll
        for (int jj = 0; jj < 2; ++jj) { const int j = 2 * (w & 1) + jj;
            if (j <= i) { f32x4 acc = (f32x4){0.f, 0.f, 0.f, 0.f};
#pragma unroll
                for (int ks = 0; ks < 4; ++ks) acc = mfma16(*(const bf16x8*)(BCG + (unsigned)((16 * j + l15) * 512 + 32 * ks + 8 * l4)), *(const bf16x8*)(BCG + (unsigned)((16 * i + l15) * 512 + 128 + 32 * ks + 8 * l4)), acc);
                *(LAS f32x4*)(CBS + (16 * i + l15) * 68 + 16 * j + 4 * l4) = acc; } }
    }
    LBAR();
    const float dskip = A.in[I_DSKIP][l * 16 + hd];
    v2u Y[4][4]; float ssq[4], ec[4];
    bf16x8 att[4][2];
#pragma unroll
    for (int i = 0; i < 4; ++i) {
        const int t = 16 * i + l15; const float ct = SCUM[t * 8 + w]; ec[i] = __expf(ct); ssq[i] = 0.f;
#pragma unroll
        for (int ks = 0; ks < 2; ++ks) {
            if (ks == 1 && i < 2) { att[i][ks] = (bf16x8){0, 0, 0, 0, 0, 0, 0, 0}; continue; }
            float v[8];
#pragma unroll
            for (int jj = 0; jj < 8; ++jj) { const int s = 32 * ks + 8 * l4 + jj; const float x = CBS[t * 68 + s] * (__expf(ct - SCUM[s * 8 + w]) * SDT[s * 8 + w]); v[jj] = s < t ? x : (s == t ? x + dskip : 0.f); }
            v4u o; o.x = pk2(v[0], v[1]); o.y = pk2(v[2], v[3]); o.z = pk2(v[4], v[5]); o.w = pk2(v[6], v[7]); att[i][ks] = __builtin_bit_cast(bf16x8, o);
        }
    }
#define M3S_BLOCK(SF, XF, PB) do { _Pragma("unroll") for (int i = 0; i < 4; ++i) { const int t = 16 * i + l15; \
            f32x4 yi = (f32x4){0.f, 0.f, 0.f, 0.f}, yn = (f32x4){0.f, 0.f, 0.f, 0.f}; \
            yi = mfma16(XF[0], att[i][0], yi); if (i >= 2) yi = mfma16(XF[1], att[i][1], yi); \
            _Pragma("unroll") for (int ks = 0; ks < 4; ++ks) yn = mfma16(SF[ks], ldsfrag(CM, t, 272, 32 * ks + 8 * l4), yn); \
            const f32x4 z = unpk4(*(const LAS v2u*)(ZT + t * 1040 + (64 * w + 16 * (PB) + 4 * l4) * 2)); \
            const f32x4 y = (yi + yn * ec[i]) * z; ssq[i] += (y[0] * y[0] + y[1] * y[1]) + (y[2] * y[2] + y[3] * y[3]); Y[i][PB] = pk4(y); } } while (0)
    M3S_LOAD(sfB, xfB, 1); M3S_BLOCK(sfA, xfA, 0); __builtin_amdgcn_sched_barrier(0);
    M3S_LOAD(sfA, xfA, 2); M3S_BLOCK(sfB, xfB, 1); __builtin_amdgcn_sched_barrier(0);
    M3S_LOAD(sfB, xfB, 3); M3S_BLOCK(sfA, xfA, 2); __builtin_amdgcn_sched_barrier(0);
    M3S_BLOCK(sfB, xfB, 3);
#undef M3S_LOAD
#undef M3S_BLOCK
#pragma unroll
    for (int i = 0; i < 4; ++i) { float s = ssq[i]; s += __shfl_xor(s, 16); s += __shfl_xor(s, 32); if (l4 == 0) SSQ[w * 64 + 16 * i + l15] = s; }
    LBAR();
    {   const float* gn = A.in[I_SSDN] + (size_t)l * 1024 + 512 * g + 64 * w; bf16* BR = (bf16*)(ws + WS_BR) + (size_t)r0 * 1024 + 512 * g + 64 * w;
#pragma unroll
        for (int i = 0; i < 4; ++i) { const int t = 16 * i + l15; float tot = 0.f;
#pragma unroll
            for (int ww = 0; ww < 8; ++ww) tot += SSQ[ww * 64 + t];
            const float rs = rsqrtf(tot * (1.0f / 512.0f) + EPS);
#pragma unroll
            for (int pb = 0; pb < 4; ++pb) { const int p0 = 16 * pb + 4 * l4; const f32x4 gv = *(const f32x4*)(gn + p0); *(v2u*)(BR + (unsigned)(t * 1024 + p0)) = pk4(unpk4(Y[i][pb]) * rs * gv); } }
    }
}

__device__ __forceinline__ void m3_hg(const Ctx& C, int l, int c, int h) {
    AREF A = *C.a; unsigned char* ws = C.ws; const int tid = C.tid, lane = C.lane, w = C.wave, r0 = 64 * c, l15 = lane & 15, l4 = lane >> 4;
    LAS unsigned char* QT = C.lds; LAS unsigned char* KT = C.lds + 17408; LAS unsigned char* QH = C.lds + 34816; LAS unsigned char* VT = C.lds + 52224; LAS unsigned char* ATT = C.lds + 70656;
    LAS float* SEG = (LAS float*)(C.lds + 79872); LAS float* SSQ = (LAS float*)(C.lds + 83968);
    LAS unsigned char* ST = C.lds + 84480;
    const int i = w >> 1, t = 16 * i + l15;
    const float* gn = A.in[I_HGN] + (size_t)l * 1024 + 128 * h; const bf16* HG = (const bf16*)(ws + WS_HG) + (size_t)r0 * 1024 + 128 * h;
    if (c < NCHP) { const bf16* SB = (const bf16*)(ws + WS_SB) + (size_t)c * STATE_N + ST_HG + (size_t)h * 16384;
#pragma unroll
        for (int q = 0; q < 4; ++q) { const int ch = tid + 512 * q, v = ch >> 4, k8 = ch & 15; *(LAS v4u*)(ST + v * 272 + k8 * 16) = *(const v4u*)(SB + v * 128 + k8 * 8); } }
    else { const float* S0 = A.in[I_SHG] + ((size_t)l * 16 + (c - NCHP)) * 131072 + (size_t)h * 16384;
#pragma unroll
        for (int q = 0; q < 8; ++q) { const int ch = tid + 512 * q, k = ch >> 5, v4 = (ch & 31) * 4; const f32x4 s = *(const f32x4*)(S0 + k * 128 + v4);
#pragma unroll
            for (int e = 0; e < 4; ++e) *(LAS bf16*)(ST + (v4 + e) * 272 + k * 2) = (bf16)f2bf(s[e]); } }
    v2u ggs[4]; f32x4 gvs[4];
#pragma unroll
    for (int b4 = 0; b4 < 4; ++b4) { const int vb = 4 * (w & 1) + b4; ggs[b4] = *(const v2u*)(HG + (unsigned)(t * 1024 + 16 * vb + 4 * l4)); gvs[b4] = *(const f32x4*)(gn + 16 * vb + 4 * l4); }
    {
        const int cp = tid & 63, seg = tid >> 6; const size_t base = (size_t)(r0 + 8 * seg) * 1024 + 128 * h + 2 * cp;
        const float* LG = (const float*)(ws + WS_LG) + base; const bf16* KK = (const bf16*)(ws + WS_KK) + base; const bf16* HV = (const bf16*)(ws + WS_HV) + base; const bf16* HQ = (const bf16*)(ws + WS_HQ) + base;
        f32x2 cum[8]; unsigned kk[8], vv[8], qq[8];
#pragma unroll
        for (int r = 0; r < 8; ++r) { cum[r] = *(const f32x2*)(LG + r * 1024); kk[r] = *(const unsigned*)(KK + r * 1024); vv[r] = *(const unsigned*)(HV + r * 1024); qq[r] = *(const unsigned*)(HQ + r * 1024); }
#pragma unroll
        for (int r = 1; r < 8; ++r) cum[r] = cum[r] + cum[r - 1];
        *(LAS f32x2*)(SEG + seg * 128 + 2 * cp) = cum[7];
        LBAR();
        f32x2 off = (f32x2){0.f, 0.f}, R = (f32x2){0.f, 0.f};
#pragma unroll
        for (int s = 0; s < 8; ++s) { const f32x2 sv = *(const LAS f32x2*)(SEG + s * 128 + 2 * cp); if (s < seg) off = off + sv; if (s < 4) R = R + sv; }
#pragma unroll
        for (int r = 0; r < 8; ++r) { const f32x2 cu = cum[r] + off; const int row = 8 * seg + r; const float q0 = bflo(qq[r]), q1 = bfhi(qq[r]), k0 = bflo(kk[r]), k1 = bfhi(kk[r]);
            *(LAS unsigned*)(QT + row * 272 + cp * 4) = pk2(q0 * __expf(fminf(cu[0] - R[0], 80.f)), q1 * __expf(fminf(cu[1] - R[1], 80.f)));
            *(LAS unsigned*)(KT + row * 272 + cp * 4) = pk2(k0 * __expf(fminf(R[0] - cu[0], 80.f)), k1 * __expf(fminf(R[1] - cu[1], 80.f)));
            *(LAS unsigned*)(QH + row * 272 + cp * 4) = pk2(q0 * __expf(cu[0]), q1 * __expf(cu[1])); }
        v4u o0, o1;
        o0.x = (vv[0] & 0xffffu) | (vv[1] << 16); o0.y = (vv[2] & 0xffffu) | (vv[3] << 16); o0.z = (vv[4] & 0xffffu) | (vv[5] << 16); o0.w = (vv[6] & 0xffffu) | (vv[7] << 16);
        o1.x = (vv[0] >> 16) | (vv[1] & 0xffff0000u); o1.y = (vv[2] >> 16) | (vv[3] & 0xffff0000u); o1.z = (vv[4] >> 16) | (vv[5] & 0xffff0000u); o1.w = (vv[6] >> 16) | (vv[7] & 0xffff0000u);
        *(LAS v4u*)(VT + (2 * cp) * 144 + seg * 16) = o0; *(LAS v4u*)(VT + (2 * cp + 1) * 144 + seg * 16) = o1;
    }
    LBAR();
#pragma unroll
    for (int jj = 0; jj < 2; ++jj) { const int j = 2 * (w & 1) + jj; f32x4 acc = (f32x4){0.f, 0.f, 0.f, 0.f};
        if (j <= i) {
#pragma unroll
            for (int ks = 0; ks < 4; ++ks) acc = mfma16(ldsfrag(KT, 16 * j + l15, 272, 32 * ks + 8 * l4), ldsfrag(QT, t, 272, 32 * ks + 8 * l4), acc); }
#pragma unroll
        for (int e = 0; e < 4; ++e) { const int s = 16 * j + 4 * l4 + e; acc[e] = (j <= i && s <= t) ? acc[e] : 0.f; }
        *(LAS v2u*)(ATT + t * 144 + (16 * j + 4 * l4) * 2) = pk4(acc); }
    LBAR();
    f32x4 O[4]; float ssq = 0.f;
#pragma unroll
    for (int b4 = 0; b4 < 4; ++b4) { const int vb = 4 * (w & 1) + b4; f32x4 acc = (f32x4){0.f, 0.f, 0.f, 0.f};
        acc = mfma16(ldsfrag(VT, 16 * vb + l15, 144, 8 * l4), ldsfrag(ATT, t, 144, 8 * l4), acc);
        if (i >= 2) acc = mfma16(ldsfrag(VT, 16 * vb + l15, 144, 32 + 8 * l4), ldsfrag(ATT, t, 144, 32 + 8 * l4), acc);
#pragma unroll
        for (int ks = 0; ks < 4; ++ks) acc = mfma16(ldsfrag(ST, 16 * vb + l15, 272, 32 * ks + 8 * l4), ldsfrag(QH, t, 272, 32 * ks + 8 * l4), acc);
        O[b4] = acc; ssq += (acc[0] * acc[0] + acc[1] * acc[1]) + (acc[2] * acc[2] + acc[3] * acc[3]); }
    ssq += __shfl_xor(ssq, 16); ssq += __shfl_xor(ssq, 32); if (l4 == 0) SSQ[(w & 1) * 64 + t] = ssq;
    LBAR();
    {   bf16* BR = (bf16*)(ws + WS_BR) + ((size_t)MP + r0) * 1024 + 128 * h;
        const float rs = rsqrtf((SSQ[t] + SSQ[64 + t]) * (1.0f / 128.0f) + EPS);
#pragma unroll
        for (int b4 = 0; b4 < 4; ++b4) { const int v0 = 16 * (4 * (w & 1) + b4) + 4 * l4; const v2u gg = ggs[b4];
            const f32x4 gt = (f32x4){bflo(gg.x), bfhi(gg.x), bflo(gg.y), bfhi(gg.y)};
            *(v2u*)(BR + (unsigned)(t * 1024 + v0)) = pk4(O[b4] * rs * gvs[b4] * gt); }
    }
}

__device__ __forceinline__ void m3_ret(const Ctx& C, int l, int c, int h) {
    AREF A = *C.a; unsigned char* ws = C.ws; const int tid = C.tid, lane = C.lane, w = C.wave, r0 = 64 * c, l15 = lane & 15, l4 = lane >> 4;
    LAS unsigned char* VT = C.lds; LAS unsigned char* ATT = C.lds + 18432; LAS float* SSQ = (LAS float*)(C.lds + 27648);
    const float lg = ret_lgam(h);
    const int i = w >> 1, t = 16 * i + l15;
    const bf16* RG = (const bf16*)(ws + WS_RG) + (size_t)r0 * 1024 + 128 * h;
    LAS unsigned char* ST = C.lds + 28160;
    if (c < NCHP) { const bf16* SB = (const bf16*)(ws + WS_SB) + (size_t)c * STATE_N + ST_RET + (size_t)h * 8192;
#pragma unroll
        for (int q = 0; q < 2; ++q) { const int ch = tid + 512 * q, v = ch >> 3, k8 = ch & 7; *(LAS v4u*)(ST + v * 144 + k8 * 16) = *(const v4u*)(SB + v * 64 + k8 * 8); } }
    else { const float* S0 = A.in[I_SRET] + ((size_t)l * 16 + (c - NCHP)) * 65536 + (size_t)h * 8192;
#pragma unroll
        for (int q = 0; q < 4; ++q) { const int ch = tid + 512 * q, d = ch >> 5, v4 = (ch & 31) * 4, kp = 8 * ((d & 31) >> 2) + 4 * (d >> 5) + (d & 3); const f32x4 s = *(const f32x4*)(S0 + d * 128 + v4);
#pragma unroll
            for (int e = 0; e < 4; ++e) *(LAS bf16*)(ST + (v4 + e) * 144 + kp * 2) = (bf16)f2bf(s[e]); } }
    v2u ggs[4];
#pragma unroll
    for (int b4 = 0; b4 < 4; ++b4) { const int vb = 4 * (w & 1) + b4; ggs[b4] = *(const v2u*)(RG + (unsigned)(t * 1024 + 16 * vb + 4 * l4)); }
    {   const int col = tid & 127, seg = tid >> 7; const bf16* RV = (const bf16*)(ws + WS_RV) + (size_t)(r0 + 16 * seg) * 1024 + 128 * h + col; float vv[16];
#pragma unroll
        for (int i = 0; i < 16; ++i) vv[i] = bf2f(RV[i * 1024]);
        v4u o; o.x = pk2(vv[0], vv[1]); o.y = pk2(vv[2], vv[3]); o.z = pk2(vv[4], vv[5]); o.w = pk2(vv[6], vv[7]); *(LAS v4u*)(VT + col * 144 + seg * 32) = o;
        o.x = pk2(vv[8], vv[9]); o.y = pk2(vv[10], vv[11]); o.z = pk2(vv[12], vv[13]); o.w = pk2(vv[14], vv[15]); *(LAS v4u*)(VT + col * 144 + seg * 32 + 16) = o; }
    const bf16* RQ = (const bf16*)(ws + WS_RQ) + (size_t)r0 * 512 + 64 * h; const bf16* RK = (const bf16*)(ws + WS_RK) + (size_t)r0 * 512 + 64 * h;
    const bf16x8 q0 = *(const bf16x8*)(RQ + (unsigned)(t * 512 + 8 * l4)), q1 = *(const bf16x8*)(RQ + (unsigned)(t * 512 + 32 + 8 * l4));
#pragma unroll
    for (int jj = 0; jj < 2; ++jj) { const int j = 2 * (w & 1) + jj; f32x4 acc = (f32x4){0.f, 0.f, 0.f, 0.f};
        if (j <= i) { acc = mfma16(*(const bf16x8*)(RK + (unsigned)((16 * j + l15) * 512 + 8 * l4)), q0, acc); acc = mfma16(*(const bf16x8*)(RK + (unsigned)((16 * j + l15) * 512 + 32 + 8 * l4)), q1, acc); }
#pragma unroll
        for (int e = 0; e < 4; ++e) { const int s = 16 * j + 4 * l4 + e; acc[e] = (j <= i && s <= t) ? acc[e] * __expf((float)(t - s) * lg) : 0.f; }
        *(LAS v2u*)(ATT + t * 144 + (16 * j + 4 * l4) * 2) = pk4(acc); }
    LBAR();
    const float inner = __expf((float)(t + 1) * lg);
    f32x4 O[4]; float ssq = 0.f;
#pragma unroll
    for (int b4 = 0; b4 < 4; ++b4) { const int vb = 4 * (w & 1) + b4; f32x4 acc = (f32x4){0.f, 0.f, 0.f, 0.f}, acs = (f32x4){0.f, 0.f, 0.f, 0.f};
        acc = mfma16(ldsfrag(VT, 16 * vb + l15, 144, 8 * l4), ldsfrag(ATT, t, 144, 8 * l4), acc);
        if (i >= 2) acc = mfma16(ldsfrag(VT, 16 * vb + l15, 144, 32 + 8 * l4), ldsfrag(ATT, t, 144, 32 + 8 * l4), acc);
        acs = mfma16(ldsfrag(ST, 16 * vb + l15, 144, 8 * l4), q0, acs); acs = mfma16(ldsfrag(ST, 16 * vb + l15, 144, 32 + 8 * l4), q1, acs);
        acc = acc + acs * inner;
        O[b4] = acc; ssq += (acc[0] * acc[0] + acc[1] * acc[1]) + (acc[2] * acc[2] + acc[3] * acc[3]); }
    ssq += __shfl_xor(ssq, 16); ssq += __shfl_xor(ssq, 32); if (l4 == 0) SSQ[(w & 1) * 64 + t] = ssq;
    LBAR();
    {   bf16* BR = (bf16*)(ws + WS_BR) + ((size_t)2 * MP + r0) * 1024 + 128 * h;
        const float rs = rsqrtf((SSQ[t] + SSQ[64 + t]) * (1.0f / 128.0f) + EPS);
#pragma unroll
        for (int b4 = 0; b4 < 4; ++b4) { const int v0 = 16 * (4 * (w & 1) + b4) + 4 * l4; const v2u gg = ggs[b4];
            const f32x4 gt = (f32x4){bflo(gg.x), bfhi(gg.x), bflo(gg.y), bfhi(gg.y)};
            *(v2u*)(BR + (unsigned)(t * 1024 + v0)) = pk4(O[b4] * rs * gt); }
    }
}

#ifndef REPI_M3_SSD
#define REPI_M3_SSD 1
#endif
#ifndef REPI_M3_HG
#define REPI_M3_HG 1
#endif
#ifndef REPI_M3_RET
#define REPI_M3_RET 1
#endif
__device__ __forceinline__ unsigned m3_prefetch(const Ctx& C, int l, int it) {
    constexpr int N_SSD = NCH * 2, N_HG = NCH * 8; unsigned char* ws = C.ws; const int tid = C.tid; unsigned pf = 0;
    if (it < N_SSD) { const int c = it >> 1, g = it & 1, r0 = 64 * c;
        if (c < NCHP) { const bf16* SB = (const bf16*)(ws + WS_SB) + (size_t)c * STATE_N + ST_SSD + (size_t)g * 65536;
#pragma unroll
            for (int q = 0; q < 2; ++q) pf ^= *(const unsigned*)(SB + (tid + 512 * q) * 64); }
        pf ^= *(const unsigned*)((const bf16*)(ws + WS_XTG) + ((size_t)c * 1024 + 512 * g + tid) * 64);
        pf ^= *(const unsigned*)((const bf16*)(ws + WS_ZS) + (size_t)(r0 + (tid >> 3)) * 1024 + 512 * g + 64 * (tid & 7));
        if (tid < 256) pf ^= *(const unsigned*)((const bf16*)(ws + WS_BCG) + (size_t)(r0 + (tid >> 2)) * 512 + 256 * g + 64 * (tid & 3)); }
    else if (it < N_SSD + N_HG) { const int j = it - N_SSD, c = j >> 3, h = j & 7, row = tid >> 3, p = tid & 7; const size_t b = (size_t)(64 * c + row) * 1024 + 128 * h;
        if (p < 4) pf ^= *(const unsigned*)((const float*)(ws + WS_LG) + b + 32 * p); else if (p < 6) pf ^= *(const unsigned*)((const bf16*)(ws + WS_KK) + b + 64 * (p - 4)); else pf ^= *(const unsigned*)((const bf16*)(ws + WS_HV) + b + 64 * (p - 6));
        if (p < 2) pf ^= *(const unsigned*)((const bf16*)(ws + WS_HQ) + b + 64 * p); else if (p < 4) pf ^= *(const unsigned*)((const bf16*)(ws + WS_HG) + b + 64 * (p - 2));
        else if (c < NCHP && tid >= 256) pf ^= *(const unsigned*)((const bf16*)(ws + WS_SB) + (size_t)c * STATE_N + ST_HG + (size_t)h * 16384 + (tid - 256) * 64); }
    else { const int j = it - N_SSD - N_HG, c = j >> 3, h = j & 7, row = tid >> 3, p = tid & 7; const size_t b = (size_t)(64 * c + row) * 1024 + 128 * h;
        if (p < 2) pf ^= *(const unsigned*)((const bf16*)(ws + WS_RV) + b + 64 * p); else if (p < 4) pf ^= *(const unsigned*)((const bf16*)(ws + WS_RG) + b + 64 * (p - 2));
        else if (p == 4) pf ^= *(const unsigned*)((const bf16*)(ws + WS_RQ) + (size_t)(64 * c + row) * 512 + 64 * h); else if (p == 5) pf ^= *(const unsigned*)((const bf16*)(ws + WS_RK) + (size_t)(64 * c + row) * 512 + 64 * h);
        else if (c < NCHP && tid < 128 * 8) { const int k = (row * 2 + (p - 6)); if (k < 128) pf ^= *(const unsigned*)((const bf16*)(ws + WS_SB) + (size_t)c * STATE_N + ST_RET + (size_t)h * 8192 + k * 64); } }
    return pf;
}
__device__ __forceinline__ void m3_phase(const Ctx& C0, int l, int mask = 7) {
    constexpr int N_SSD = NCH * 2, N_HG = NCH * 8, N_IT = NCH * 18;
    unsigned* cnt = (unsigned*)(C0.ws + WS_CTL) + CW_QUEUE + 64 * (l * 8 + 1 * 4 + (mask == 7 ? 0 : 1));
    volatile LAS int* slot = (volatile LAS int*)(C0.lds + LDSCTL_OFF + 64);
    int n2 = 0;
    if (C0.tid == 0) { slot[0] = (int)__hip_atomic_fetch_add(cnt, 1u, __ATOMIC_RELAXED, __HIP_MEMORY_SCOPE_AGENT); slot[1] = (int)__hip_atomic_fetch_add(cnt, 1u, __ATOMIC_RELAXED, __HIP_MEMORY_SCOPE_AGENT); }
    LBAR();
    int it = slot[0], nx = slot[1];
    LBAR();
    while (it < N_IT) {
        if (C0.tid == 0) n2 = (int)__hip_atomic_fetch_add(cnt, 1u, __ATOMIC_RELAXED, __HIP_MEMORY_SCOPE_AGENT);
        Ctx C = C0; { int t_ = C0.tid; asm volatile("" : "+v"(t_)); C.tid = t_; C.lane = t_ & 63; C.wave = __builtin_amdgcn_readfirstlane(t_ >> 6); }
        unsigned pf = 0; if (MK_PREFETCH && nx < N_IT && mask == 7) pf = m3_prefetch(C, l, nx);
        if (it < N_SSD) { if (mask & 1) m3_ssd(C, l, it >> 1, it & 1); }
        else if (it < N_SSD + N_HG) { if (mask & 2) { const int j = it - N_SSD; m3_hg(C, l, j >> 3, j & 7); } }
        else { if (mask & 4) { const int j = it - N_SSD - N_HG; m3_ret(C, l, j >> 3, j & 7); } }
        if (pf == 0x7fc1abcdu) ((unsigned*)(C0.ws + WS_CTL))[16] = pf;
        LBAR();
        if (C0.tid == 0) slot[0] = n2;
        LBAR();
        it = nx; nx = slot[0];
    }
}


enum { PH_NORM1 = 0, PH_GEMM1, PH_M1, PH_M2, PH_M3, PH_GEMM2, PH_GEMM3, PH_NORM2, PH_GU, PH_DOWN, PH_N };

#ifndef REP_P0
#define REP_P0 1
#endif
#ifndef REP_NORM
#define REP_NORM 1
#endif
#ifndef REP_G1
#define REP_G1 1
#endif
#ifndef REP_M1
#define REP_M1 1
#endif
#ifndef REP_M2
#define REP_M2 1
#endif
#ifndef REP_M3
#define REP_M3 1
#endif
#ifndef REP_G2
#define REP_G2 1
#endif
#ifndef REP_G3
#define REP_G3 1
#endif
#ifndef REP_GU
#define REP_GU 1
#endif
#ifndef REP_DN
#define REP_DN 1
#endif
#ifndef PROBE_MASK
#define PROBE_MASK 7
#endif
#ifndef G1_ALIGN
#define G1_ALIGN true
#endif
#ifndef REP_BAR
#define REP_BAR 1
#endif
__global__ void __launch_bounds__(NTHR, 2) trunk_fwd(Args args) {
    extern __shared__ __attribute__((aligned(16))) unsigned char lds_raw[];
    Ctx C; C.lds = (LAS unsigned char*)lds_raw; C.tid = threadIdx.x; C.lane = C.tid & 63; C.wave = __builtin_amdgcn_readfirstlane(C.tid >> 6);
    const int wave0 = C.wave;
    C.G = gridDim.x; { const int bx = blockIdx.x; C.vcu = (C.G % 8 == 0) ? (bx % 8) * (C.G / 8) + bx / 8 : bx; }
    ArgsP ap = (ArgsP)__builtin_amdgcn_kernarg_segment_ptr();
    C.a = ap; C.ws = ap->ws;
    unsigned char* ws = ap->ws; const int use_bar = ap->use_bar;
    for (int u = C.tid; u < (LDS_BYTES - LDSCTL_OFF) / 4; u += NTHR) ((LAS unsigned*)(C.lds + LDSCTL_OFF))[u] = 0u;
    __syncthreads();
    XcdBarrier bar; bar.bar = (unsigned*)(ws + WS_CTL) + CW_BAR; bar.x = 0; bar.st = nullptr;
    if (use_bar) bar = xcd_barrier_post((unsigned*)(ws + WS_CTL) + CW_BAR, (volatile LAS unsigned*)(C.lds + LDSCTL_OFF));
#define GRID_BAR() do { if (use_bar) for (int rb_ = 0; rb_ < REP_BAR; ++rb_) { bar.bar = (unsigned*)(ws + WS_CTL) + CW_BAR; xcd_barrier(bar); } } while (0)
#define FRESH() do { int w0_ = wave0; asm volatile("" : "+s"(w0_)); unsigned z_ = 0u; asm volatile("" : "+v"(z_)); int t_ = w0_ * 64 + (int)__builtin_amdgcn_mbcnt_hi(~0u, __builtin_amdgcn_mbcnt_lo(~0u, z_)); asm volatile("" : "+v"(t_)); C.tid = t_; C.lane = t_ & 63; C.wave = __builtin_amdgcn_readfirstlane(t_ >> 6); \
        int g_ = gridDim.x; asm volatile("" : "+s"(g_)); C.G = g_; int b_ = blockIdx.x; asm volatile("" : "+s"(b_)); bx = b_; C.vcu = (C.G % 8 == 0) ? (b_ % 8) * (C.G / 8) + b_ / 8 : b_; \
        ArgsP a_ = (ArgsP)__builtin_amdgcn_kernarg_segment_ptr(); asm volatile("" : "+s"(a_)); ap = a_; C.a = a_; unsigned char* w_ = a_->ws; ws = w_; C.ws = w_; X = (float*)(ws + WS_X); H = (bf16*)(ws + WS_H); lw = ws + WS_W + (size_t)l * LW_SIZE; } while (0)
#define IN(k) (ap->ph_lo <= (k) && (k) < ap->ph_hi)

    if (ap->do_pro) { for (int r_ = 0; r_ < REP_P0; ++r_) p0_prologue(C); GRID_BAR(); }

    float* X = (float*)(ws + WS_X); bf16* H = (bf16*)(ws + WS_H); int bx = blockIdx.x; unsigned char* lw = ws;
    const int l_hi = ap->l_hi;
    for (int l = ap->l_lo; l < l_hi; ++l) {
        if (IN(PH_NORM1)) for (int r_ = 0; r_ < REP_NORM; ++r_) { asm volatile("; MARK_PH_NORM1"); FRESH(); norm_phase<true>(C, X, ap->in[I_NMIX] + (size_t)l * D, H, l); GRID_BAR(); }
        if (IN(PH_GEMM1)) for (int r_ = 0; r_ < REP_G1; ++r_) { asm volatile("; MARK_PH_GEMM1"); FRESH();
            pg8::Gemm g{H, (const bf16*)(lw + LW_IN), MP, NPROJ, D, 0, 0}; pg8::StaticOrder S; S.init(MP, NPROJ, C.G, bx, D);
            if (r_ == 0) { EpiProj E{ws, l};
            pg8::gemm_phase<EpiProj, pg8::StaticOrder, G1_ALIGN, true>(C.lds, g, S, E, C.tid); }
            else { EpiNull E{(float*)(ws + WS_TMP)}; pg8::gemm_phase<EpiNull, pg8::StaticOrder, G1_ALIGN, true>(C.lds, g, S, E, C.tid); }
            GRID_BAR();
        }
        if (IN(PH_M1)) for (int r_ = 0; r_ < REP_M1; ++r_) { asm volatile("; MARK_PH_M1"); FRESH(); m1_phase(C, l, r_ == 0 ? 7 : PROBE_MASK); GRID_BAR(); }
        if (IN(PH_M2)) for (int r_ = 0; r_ < REP_M2; ++r_) { asm volatile("; MARK_PH_M2"); FRESH(); m2_phase(C, l); GRID_BAR(); }
        if (IN(PH_M3)) for (int r_ = 0; r_ < REP_M3; ++r_) { asm volatile("; MARK_PH_M3"); FRESH(); m3_phase(C, l, r_ == 0 ? 7 : PROBE_MASK); GRID_BAR(); }
        if (IN(PH_GEMM2)) for (int r_ = 0; r_ < REP_G2; ++r_) { asm volatile("; MARK_PH_GEMM2"); FRESH();
            pg8::Gemm g{(const bf16*)(ws + WS_BR), (const bf16*)(lw + LW_BR), MP, D, 1024, (size_t)MP * 1024 * 2, (size_t)D * 1024 * 2}; BranchOrder S; S.init(MP, D, C.G, bx, 1024);
            EpiBranch E{(bf16*)(ws + WS_TMP), (bf16*)(ws + WS_MIX), (const bf16*)(ws + WS_GT), (float*)(ws + WS_SLAB), (unsigned*)(ws + WS_CTL) + CW_G2 + 64 * (64 * (l * REP_G2 + r_)), (unsigned*)(ws + WS_CTL) + CW_TMO};
            pg8::gemm_phase<EpiBranch, BranchOrder, true, true>(C.lds, g, S, E, C.tid);
            GRID_BAR();
        }
        if (IN(PH_GEMM3)) for (int r_ = 0; r_ < REP_G3; ++r_) { asm volatile("; MARK_PH_GEMM3"); FRESH();
            pg8::Gemm g{(const bf16*)(ws + WS_MIX), (const bf16*)(lw + LW_OUT), MP, D, D, 0, 0}; pg8::StaticOrder S; S.init(MP, D, C.G, bx, D);
            const int ep = 2 * l + 0;
            EpiResid E{r_ == 0 ? X : (float*)(ws + WS_TMP), (float*)(ws + WS_SLAB) + (size_t)(ep & 1) * 256 * 65536, (unsigned*)(ws + WS_CTL) + CW_SK + (ep & 7) * 256 * 64, (unsigned*)(ws + WS_CTL) + CW_TMO};
            pg8::gemm_phase<EpiResid, pg8::StaticOrder, true, true>(C.lds, g, S, E, C.tid);
            GRID_BAR();
        }
        if (IN(PH_NORM2)) for (int r_ = 0; r_ < REP_NORM; ++r_) { asm volatile("; MARK_PH_NORM2"); FRESH(); norm_phase<false>(C, X, ap->in[I_NFFN] + (size_t)l * D, H, l); GRID_BAR(); }
        if (IN(PH_GU)) for (int r_ = 0; r_ < REP_GU; ++r_) { asm volatile("; MARK_PH_GU"); FRESH();
            pg8::Gemm g{H, (const bf16*)(lw + LW_GU), MP, 2 * FFN, D, 0, 0}; pg8::StaticOrder S; S.init(MP, 2 * FFN, C.G, bx, D);
            EpiSwiglu E{(bf16*)(ws + WS_HID)};
            pg8::gemm_phase<EpiSwiglu, pg8::StaticOrder, true, true>(C.lds, g, S, E, C.tid);
            GRID_BAR();
        }
        if (IN(PH_DOWN)) for (int r_ = 0; r_ < REP_DN; ++r_) { asm volatile("; MARK_PH_DOWN"); FRESH();
            pg8::Gemm g{(const bf16*)(ws + WS_HID), (const bf16*)(lw + LW_DN), MP, D, FFN, 0, 0}; pg8::StreamOrder S; S.init(MP, D, C.G, C.vcu, FFN);
            const int ep = 2 * l + 1;
            EpiResid E{r_ == 0 ? X : (float*)(ws + WS_TMP), (float*)(ws + WS_SLAB) + (size_t)(ep & 1) * 256 * 65536, (unsigned*)(ws + WS_CTL) + CW_SK + (ep & 7) * 256 * 64, (unsigned*)(ws + WS_CTL) + CW_TMO};
            pg8::gemm_phase<EpiResid, pg8::StreamOrder, true, true>(C.lds, g, S, E, C.tid);
            GRID_BAR();
        }
    }
    if (ap->do_fin) { const int l = 0; FRESH(); final_phase(C, X, ap->in[I_NFIN], ap->out); }
#undef IN
#undef GRID_BAR
#undef FRESH
}


__global__ void probe_dump(const unsigned short* src, size_t n_src, float* out, size_t n_out) {
    for (size_t i = (size_t)blockIdx.x * blockDim.x + threadIdx.x; i < n_out; i += (size_t)gridDim.x * blockDim.x) {
        const size_t j = (i * 4 + (i & 3)) % n_src; out[i] = __builtin_bit_cast(float, ((unsigned)src[j]) << 16) * 1e-3f + 1.0f; }
}
#ifndef MK_REPS
#define MK_REPS 1
#endif
#ifndef MK_ONE_LAUNCH
#define MK_ONE_LAUNCH 1
#endif
extern "C" void kernel_launch(void* const* d_in, const int* in_sizes, int n_in, void* d_out, int out_size, void* d_ws, size_t ws_size, hipStream_t stream) {
    static int grid = 0;
    if (grid == 0) {
        if (n_in != 24 || (size_t)out_size != O_END || ws_size < WS_END) { fprintf(stderr, "kernel_launch: unexpected shapes (n_in %d, out %d, ws %zu, need %zu)\n", n_in, out_size, ws_size, (size_t)WS_END); grid = -1; return; }
        int dev = 0, cus = 0, per_cu = 0;
        if (hipGetDevice(&dev) != hipSuccess || hipDeviceGetAttribute(&cus, hipDeviceAttributeMultiprocessorCount, dev) != hipSuccess) { grid = -1; return; }
        if (hipFuncSetAttribute((const void*)trunk_fwd, hipFuncAttributeMaxDynamicSharedMemorySize, LDS_BYTES) != hipSuccess) { fprintf(stderr, "kernel_launch: hipFuncSetAttribute failed\n"); grid = -1; return; }
        if (hipOccupancyMaxActiveBlocksPerMultiprocessor(&per_cu, (const void*)trunk_fwd, NTHR, LDS_BYTES) != hipSuccess || per_cu < 1) fprintf(stderr, "kernel_launch: occupancy query reports %d\n", per_cu);
        (void)hipGetLastError();
        grid = cus;
    }
    if (grid < 0) return;
    (void)hipMemsetAsync((char*)d_ws + WS_CTL, 0, CTL_ZERO_BYTES, stream);
    Args a{};
    for (int i = 0; i < 24; ++i) a.in[i] = (const float*)d_in[i];
    a.out = (float*)d_out; a.ws = (unsigned char*)d_ws;
#if MK_ONE_LAUNCH
    a.l_lo = 0; a.l_hi = NL; a.ph_lo = 0; a.ph_hi = PH_N; a.do_pro = 1; a.do_fin = 1; a.use_bar = 1; a.pad = 0;
    hipLaunchKernelGGL(trunk_fwd, dim3(grid), dim3(NTHR), LDS_BYTES, stream, a);
#else
    for (int rep = 0; rep < MK_REPS; ++rep) {
    a.use_bar = 0; a.pad = 0;
    a.l_lo = 0; a.l_hi = 0; a.ph_lo = 0; a.ph_hi = 0; a.do_pro = 1; a.do_fin = 0;
    hipLaunchKernelGGL(trunk_fwd, dim3(grid), dim3(NTHR), LDS_BYTES, stream, a);
    a.do_pro = 0;
#ifdef PROBE_NPH
    { int cnt = 0; for (int l = 0; l < NL && cnt < PROBE_NPH; ++l) for (int ph = 0; ph < PH_N && cnt < PROBE_NPH; ++ph, ++cnt) { a.l_lo = l; a.l_hi = l + 1; a.ph_lo = ph; a.ph_hi = ph + 1; hipLaunchKernelGGL(trunk_fwd, dim3(grid), dim3(NTHR), LDS_BYTES, stream, a); } }
    probe_dump<<<2048, 256, 0, stream>>>((const unsigned short*)((char*)d_ws + PROBE_LO), (size_t)(PROBE_HI - PROBE_LO) / 2, (float*)d_out, (size_t)O_END);
    return;
#endif
    for (int l = 0; l < NL; ++l) for (int ph = 0; ph < PH_N; ++ph) { a.l_lo = l; a.l_hi = l + 1; a.ph_lo = ph; a.ph_hi = ph + 1; hipLaunchKernelGGL(trunk_fwd, dim3(grid), dim3(NTHR), LDS_BYTES, stream, a); }
    a.l_lo = 0; a.l_hi = 0; a.ph_lo = 0; a.ph_hi = 0; a.do_fin = 1;
    hipLaunchKernelGGL(trunk_fwd, dim3(grid), dim3(NTHR), LDS_BYTES, stream, a);
    }
#endif
    const hipError_t le = hipPeekAtLastError();
    if (le != hipSuccess) fprintf(stderr, "kernel_launch: launch failed: %s\n", hipGetErrorName(le));
}
```

```cpp
#include <hip/hip_runtime.h>
#include <cstdio>
#include <cstdint>
#ifndef PG8_WGM
#define PG8_WGM 8
#endif
namespace pg8 {
#define PG8_LAS __attribute__((address_space(3)))
typedef unsigned short bf16_t;
typedef short bf16x8 __attribute__((ext_vector_type(8)));
typedef float f32x4 __attribute__((ext_vector_type(4)));
typedef unsigned u32x4 __attribute__((ext_vector_type(4)));
constexpr int BM = 256, BK = 64, HALF = 128, HTB = HALF * BK * 2  , STAGE_BYTES = 8 * HTB, NXCD = 8, WGM = PG8_WGM;

__host__ __device__ __forceinline__ int lds_byte(int r, int c) { const int st = (r >> 4) * 2 + (c >> 5), rr = r & 15, cc = c & 31, ob = rr * 64 + cc * 2; return st * 1024 + (ob ^ (((ob >> 9) & 1) << 5)); }
__host__ __device__ __forceinline__ void stage_rc(int b, int& R, int& C) { const int st = b / 1024, sb = b % 1024, swz = sb ^ (((sb >> 9) & 1) << 5); R = (st >> 1) * 16 + swz / 64; C = (st & 1) * 32 + (swz % 64) / 2; }
__host__ __device__ __forceinline__ int perm32(int rho) { const int n = rho >> 4, i = rho & 15; return 8 * (i >> 2) + 4 * n + (i & 3); }

struct Unit { int pm, pn, pc, k0, nt, kind, slab; };
struct Gemm { const bf16_t* A; const bf16_t* Bt; int M, N, K; size_t csA, csB; };

struct StaticOrder {
    int nM, nN, nwg, G, c, ntk, sametile = 0;
    __host__ __device__ __forceinline__ void init(int M, int N, int G_, int c_, int K) { nM = M / BM; nN = N / BM; nwg = nM * nN; G = G_; c = c_; ntk = K / BK; }
    __host__ __device__ __forceinline__ void tile(int L, Unit& u) const {
        int wgid = L; { const int q = nwg / NXCD, r = nwg % NXCD, xcd = wgid % NXCD, off = wgid / NXCD; wgid = (xcd < r ? xcd * (q + 1) : r * (q + 1) + (xcd - r) * q) + off; }
        const int nig = WGM * nN, gid = wgid / nig, fm = gid * WGM, gsz = (nM - fm) < WGM ? (nM - fm) : WGM;
        u.pm = fm + ((wgid % nig) % gsz); u.pn = (wgid % nig) / gsz; u.pc = 0;
    }
    __host__ __device__ __forceinline__ void tile_seq(int wgid, Unit& u) const {
        const int nig = WGM * nN, gid = wgid / nig, fm = gid * WGM, gsz = (nM - fm) < WGM ? (nM - fm) : WGM;
        u.pm = fm + ((wgid % nig) % gsz); u.pn = (wgid % nig) / gsz; u.pc = 0;
    }
    __host__ __device__ __forceinline__ bool next(int i, Unit& u) const {
        const long L = (long)i * G + c; if (L >= nwg) return false;
        tile((int)L, u); u.k0 = 0; u.nt = ntk; u.kind = 0; u.slab = 0;
#ifdef PROBE_SAMETILE
        if (sametile) { u.pm = 0; u.pn = 0; }
#endif
        return true;
    }
    __device__ __forceinline__ void a_ready(const Unit&) const {}
    __device__ __forceinline__ void done(const Unit&) const {}
};
struct StreamOrder {
    StaticOrder S; int P, lo, hi, r;
    __host__ __device__ __forceinline__ void init(int M, int N, int G, int rank, int K) { S.init(M, N, G, 0, K); P = K / (2 * BK); r = rank; const long W = (long)S.nwg * P; lo = (int)((W * rank) / G); hi = (int)((W * (rank + 1)) / G); }
    __host__ __device__ __forceinline__ bool next(int i, Unit& u) const {
        const int tail = (lo % P) ? P - lo % P : 0, head = hi % P, t0 = (lo + tail) / P, nfull = (hi - head) / P - t0;
        int k = i;
        if (head) { if (k == 0) { S.tile_seq(hi / P, u); u.k0 = 0; u.nt = 2 * head; u.kind = 1; u.slab = r; return true; } --k; }
        if (k < nfull) { S.tile_seq(t0 + k, u); u.k0 = 0; u.nt = 2 * P; u.kind = 0; u.slab = 0; return true; }
        k -= nfull;
        if (tail && k == 0) { S.tile_seq(lo / P, u); u.k0 = 2 * (P - tail); u.nt = 2 * tail; u.kind = 2; u.slab = r - 1; return true; }
        return false;
    }
    __device__ __forceinline__ void a_ready(const Unit&) const {}
    __device__ __forceinline__ void done(const Unit&) const {}
};

__device__ __forceinline__ unsigned cvt_pk_bf16(float lo, float hi) { unsigned r; asm volatile("v_cvt_pk_bf16_f32 %0, %1, %2" : "=v"(r) : "v"(lo), "v"(hi)); return r; }

template <class Epi, class Sched, bool ALIGN_EPI = false, bool SP2 = false>
__device__ __forceinline__ void gemm_phase(PG8_LAS unsigned char* lds, const Gemm g, const Sched& S, const Epi& E, const int tid) {
    const int wid = __builtin_amdgcn_readfirstlane(tid >> 6), lane = tid & 63, wr = wid >> 2, wc = wid & 3, fr = lane & 15, fq = lane >> 4;
    const int K = g.K;
    unsigned voffA[2], voffB[2];
#pragma unroll
    for (int i = 0; i < 2; ++i) { int R, C; stage_rc(tid * 16 + i * 8192, R, C); const int Rb = Epi::PERM ? ((R & ~31) + perm32(R & 31)) : R;
        voffA[i] = (unsigned)(R * K + C) * 2u; voffB[i] = (unsigned)(Rb * K + C) * 2u; }
    const size_t kstep = (size_t)(BK * 2);
    const size_t hstep = (size_t)HALF * K * 2;
    const size_t tstep = 2 * hstep;
    const unsigned ldsw = (unsigned)wid * 1024u;
    const int aoff = lds_byte(wr * 64 + fr, fq * 8), boff = lds_byte(wc * 32 + fr, fq * 8);
#define PG8_SA(b, h) (((b) * 2 + (h)) * HTB)
#define PG8_SB(b, h) ((4 + (b) * 2 + (h)) * HTB)
#define PG8_STAGE(bufoff, gbase, voff) do { _Pragma("unroll") for (int _i = 0; _i < 2; ++_i) \
        __builtin_amdgcn_global_load_lds((const unsigned*)((const char*)(gbase) + (voff)[_i]), (PG8_LAS unsigned*)(lds + (bufoff) + ldsw + _i * 8192), 16, 0, 0); } while (0)
#define PG8_LDA(dst, b, h) do { _Pragma("unroll") for (int m = 0; m < 4; ++m) _Pragma("unroll") for (int k = 0; k < 2; ++k) dst[m][k] = *(const PG8_LAS bf16x8*)(lds + PG8_SA(b, h) + aoff + m * 2048 + k * 1024); } while (0)
#define PG8_LDB(dst, b, h) do { _Pragma("unroll") for (int n = 0; n < 2; ++n) _Pragma("unroll") for (int k = 0; k < 2; ++k) dst[n][k] = *(const PG8_LAS bf16x8*)(lds + PG8_SB(b, h) + boff + n * 2048 + k * 1024); } while (0)
#define PG8_MMA(ai, bj, At, Bt) do { __builtin_amdgcn_s_setprio(1); _Pragma("unroll") for (int m = 0; m < 4; ++m) _Pragma("unroll") for (int n = 0; n < 2; ++n) _Pragma("unroll") for (int k = 0; k < 2; ++k) \
        acc[ai][bj][m][n] = __builtin_amdgcn_mfma_f32_16x16x32_bf16(Bt[n][k], At[m][k], acc[ai][bj][m][n], 0, 0, 0); __builtin_amdgcn_s_setprio(0); } while (0)
#define PG8_WAIT_V(n) asm volatile("s_waitcnt vmcnt(" #n ")" ::: "memory")
#define PG8_WAIT_L(n) asm volatile("s_waitcnt lgkmcnt(" #n ")" ::: "memory")
#define PG8_BAR __builtin_amdgcn_s_barrier()
#define PG8_SCHED __builtin_amdgcn_sched_barrier(0)
    Unit cur, nxt; int ui = 0;
    if (!S.next(0, cur)) return;
    f32x4 acc[2][2][4][2];
#pragma unroll
    for (int a = 0; a < 2; ++a)
#pragma unroll
        for (int b = 0; b < 2; ++b)
#pragma unroll
            for (int m = 0; m < 4; ++m)
#pragma unroll
                for (int n = 0; n < 2; ++n) acc[a][b][m][n] = (f32x4){0.f, 0.f, 0.f, 0.f};
    bf16x8 At[4][2], B0[2][2], B1[2][2];
    const char* cA = (const char*)g.A + (size_t)cur.pm * tstep + (size_t)cur.pc * g.csA + (size_t)cur.k0 * kstep; const char* cB = (const char*)g.Bt + (size_t)cur.pn * tstep + (size_t)cur.pc * g.csB + (size_t)cur.k0 * kstep;
    S.a_ready(cur);
    if constexpr (SP2) {
        PG8_STAGE(PG8_SB(0, 0), cB, voffB); PG8_STAGE(PG8_SB(0, 1), cB + hstep, voffB); PG8_STAGE(PG8_SA(0, 0), cA, voffA); PG8_STAGE(PG8_SA(0, 1), cA + hstep, voffA);
        if (wr == 1) PG8_BAR;
        PG8_WAIT_V(2); PG8_BAR;
        PG8_STAGE(PG8_SB(1, 0), cB + kstep, voffB); PG8_STAGE(PG8_SA(1, 0), cA + kstep, voffA); PG8_STAGE(PG8_SB(1, 1), cB + hstep + kstep, voffB);
        PG8_WAIT_V(6); PG8_BAR;
    } else {
        PG8_STAGE(PG8_SB(0, 0), cB, voffB); PG8_STAGE(PG8_SA(0, 0), cA, voffA); PG8_STAGE(PG8_SB(0, 1), cB + hstep, voffB); PG8_STAGE(PG8_SA(0, 1), cA + hstep, voffA);
        if (wr == 1) PG8_BAR;
        PG8_WAIT_V(4); PG8_BAR;
        PG8_STAGE(PG8_SB(1, 0), cB + kstep, voffB); PG8_STAGE(PG8_SA(1, 0), cA + kstep, voffA); PG8_STAGE(PG8_SB(1, 1), cB + hstep + kstep, voffB);
        PG8_WAIT_V(6); PG8_BAR;
    }
    for (;;) {
        const bool has_next = S.next(ui + 1, nxt);
        const char* nA = has_next ? (const char*)g.A + (size_t)nxt.pm * tstep + (size_t)nxt.pc * g.csA + (size_t)nxt.k0 * kstep : cA; const char* nB = has_next ? (const char*)g.Bt + (size_t)nxt.pn * tstep + (size_t)nxt.pc * g.csB + (size_t)nxt.k0 * kstep : cB;
        const int nt = cur.nt;
        for (int t = 0; t < nt; t += 2) {
            const bool last = (t == nt - 2);
            const char* a1 = cA + (size_t)(t + 1) * kstep;
            const char* a2 = last ? nA : cA + (size_t)(t + 2) * kstep; const char* b2 = last ? nB : cB + (size_t)(t + 2) * kstep;
            const char* a3 = a2 + kstep; const char* b3 = b2 + kstep;
            if (last && has_next) S.a_ready(nxt);
            if constexpr (SP2) {
            PG8_LDB(B0, 0, 0); PG8_LDB(B1, 0, 1); PG8_SCHED; PG8_LDA(At, 0, 0); PG8_STAGE(PG8_SA(1, 1), a1 + hstep, voffA);
            PG8_WAIT_V(8); PG8_WAIT_L(0); PG8_BAR; PG8_MMA(0, 0, At, B0); PG8_MMA(0, 1, At, B1); PG8_BAR; PG8_SCHED;
            PG8_LDA(At, 0, 1); PG8_STAGE(PG8_SB(0, 0), b2, voffB); PG8_STAGE(PG8_SB(0, 1), b2 + hstep, voffB); PG8_STAGE(PG8_SA(0, 0), a2, voffA);
            PG8_WAIT_V(8); PG8_WAIT_L(0); PG8_BAR; PG8_MMA(1, 0, At, B0); PG8_MMA(1, 1, At, B1); PG8_BAR; PG8_SCHED;
            PG8_LDB(B0, 1, 0); PG8_LDB(B1, 1, 1); PG8_SCHED; PG8_LDA(At, 1, 0); PG8_STAGE(PG8_SA(0, 1), a2 + hstep, voffA);
            PG8_WAIT_V(8); PG8_WAIT_L(0); PG8_BAR; PG8_MMA(0, 0, At, B0); PG8_MMA(0, 1, At, B1); PG8_BAR; PG8_SCHED;
            PG8_LDA(At, 1, 1); PG8_STAGE(PG8_SB(1, 0), b3, voffB); PG8_STAGE(PG8_SB(1, 1), b3 + hstep, voffB); PG8_STAGE(PG8_SA(1, 0), a3, voffA);
            PG8_WAIT_V(8); PG8_WAIT_L(0); PG8_BAR; PG8_MMA(1, 0, At, B0); PG8_MMA(1, 1, At, B1); PG8_BAR; PG8_SCHED;
            } else {
            PG8_LDB(B0, 0, 0); PG8_SCHED; PG8_LDA(At, 0, 0); PG8_STAGE(PG8_SA(1, 1), a1 + hstep, voffA);
            PG8_WAIT_L(8); PG8_BAR; PG8_WAIT_L(0); PG8_MMA(0, 0, At, B0); PG8_BAR; PG8_SCHED;
            PG8_LDB(B1, 0, 1); PG8_STAGE(PG8_SB(0, 0), b2, voffB);
            PG8_BAR; PG8_WAIT_L(0); PG8_MMA(0, 1, At, B1); PG8_BAR;
            PG8_LDA(At, 0, 1); PG8_STAGE(PG8_SA(0, 0), a2, voffA);
            PG8_BAR; PG8_WAIT_L(0); PG8_MMA(1, 0, At, B0); PG8_BAR; PG8_SCHED;
            PG8_STAGE(PG8_SB(0, 1), b2 + hstep, voffB);
            PG8_WAIT_V(6); PG8_BAR; PG8_MMA(1, 1, At, B1); PG8_BAR;
            PG8_LDB(B0, 1, 0); PG8_SCHED; PG8_LDA(At, 1, 0); PG8_STAGE(PG8_SA(0, 1), a2 + hstep, voffA);
            PG8_WAIT_L(8); PG8_BAR; PG8_WAIT_L(0); PG8_MMA(0, 0, At, B0); PG8_BAR; PG8_SCHED;
            PG8_LDB(B1, 1, 1); PG8_STAGE(PG8_SB(1, 0), b3, voffB);
            PG8_BAR; PG8_WAIT_L(0); PG8_MMA(0, 1, At, B1); PG8_BAR;
            PG8_LDA(At, 1, 1); PG8_STAGE(PG8_SA(1, 0), a3, voffA);
            PG8_BAR; PG8_WAIT_L(0); PG8_MMA(1, 0, At, B0); PG8_BAR; PG8_SCHED;
            PG8_STAGE(PG8_SB(1, 1), b3 + hstep, voffB);
            PG8_WAIT_V(6); PG8_BAR; PG8_MMA(1, 1, At, B1); PG8_BAR;
            }
        }
        if constexpr (ALIGN_EPI) { if (wr == 0) PG8_BAR; }
        if constexpr (!Epi::AFTER_DRAIN) { E(acc, cur, wr, wc, fr, fq); S.done(cur); }
        if (!has_next) break;
#pragma unroll
        for (int a = 0; a < 2; ++a)
#pragma unroll
            for (int b = 0; b < 2; ++b)
#pragma unroll
                for (int m = 0; m < 4; ++m)
#pragma unroll
                    for (int n = 0; n < 2; ++n) acc[a][b][m][n] = (f32x4){0.f, 0.f, 0.f, 0.f};
        cur = nxt; cA = nA; cB = nB; ++ui;
        if constexpr (ALIGN_EPI) { if (wr == 1) PG8_BAR; }
    }
    PG8_WAIT_V(0);
    if constexpr (!ALIGN_EPI) { if (wr == 0) PG8_BAR; }
    PG8_BAR;
    if constexpr (Epi::AFTER_DRAIN) { E.fused(acc, cur, wr, wc, fr, fq, lds, wid, lane); S.done(cur); }
#undef PG8_SA
#undef PG8_SB
#undef PG8_STAGE
#undef PG8_LDA
#undef PG8_LDB
#undef PG8_MMA
#undef PG8_WAIT_V
#undef PG8_WAIT_L
#undef PG8_BAR
#undef PG8_SCHED
}
}


constexpr int D = 2048, NL = 4, FFN = 5632, NPROJ = 15872, INCOLS = 15888;
constexpr int MR = 9280, MP = 9472, NCH = 145, NCHP = 129;
constexpr int ROW_P0 = 64, ROW_S0 = 8256, NNULL = 48;
constexpr int STATE_N = 327680, ST_SSD = 0, ST_HG = 131072, ST_RET = 262144;
constexpr int GAM_N = 1040;
constexpr float EPS = 1e-6f;
constexpr size_t O_YP = 0, O_YS = 16777216, O_CONVP = O_YS + 2097152, O_SSMP = O_CONVP + 18432, O_HGP = O_SSMP + 524288, O_RETP = O_HGP + 524288,
                 O_CONVS = O_RETP + 262144, O_SSMS = O_CONVS + 294912, O_HGS = O_SSMS + 8388608, O_RETS = O_HGS + 8388608, O_END = O_RETS + 4194304;

constexpr size_t MiB = 1u << 20;
constexpr size_t al(size_t x) { return (x + MiB - 1) / MiB * MiB; }
constexpr size_t WS_CTL = 0, CTL_ZERO_BYTES = 2 * MiB;
constexpr size_t SZ_WIN = (size_t)NPROJ * D * 2, SZ_WBR = (size_t)3 * D * 1024 * 2, SZ_WOUT = (size_t)D * D * 2, SZ_WGU = (size_t)2 * FFN * D * 2, SZ_WDN = (size_t)D * FFN * 2, SZ_WDT = (size_t)16 * D * 2;
constexpr size_t LW_IN = 0, LW_BR = LW_IN + al(SZ_WIN), LW_OUT = LW_BR + al(SZ_WBR), LW_GU = LW_OUT + al(SZ_WOUT), LW_DN = LW_GU + al(SZ_WGU), LW_DT = LW_DN + al(SZ_WDN), LW_SIZE = LW_DT + al(SZ_WDT);
constexpr size_t WS_W = 2 * MiB;
constexpr size_t WS_X = WS_W + 4 * LW_SIZE;
constexpr size_t WS_H = WS_X + al((size_t)MP * D * 4);
constexpr size_t WS_ZS = WS_H + al((size_t)MP * D * 2);
constexpr size_t WS_XBC = WS_ZS + al((size_t)MP * 1024 * 2);
constexpr size_t WS_HQ = WS_XBC + al((size_t)MP * 1536 * 2);
constexpr size_t WS_LG = WS_HQ + al((size_t)MP * 1024 * 2);
constexpr size_t WS_KK = WS_LG + al((size_t)MP * 1024 * 4);
constexpr size_t WS_HV = WS_KK + al((size_t)MP * 1024 * 2);
constexpr size_t WS_HG = WS_HV + al((size_t)MP * 1024 * 2);
constexpr size_t WS_RQ = WS_HG + al((size_t)MP * 1024 * 2);
constexpr size_t WS_RK = WS_RQ + al((size_t)MP * 512 * 2);
constexpr size_t WS_RV = WS_RK + al((size_t)MP * 512 * 2);
constexpr size_t WS_RG = WS_RV + al((size_t)MP * 1024 * 2);
constexpr size_t WS_GT = WS_RG + al((size_t)MP * 1024 * 2);
constexpr size_t WS_DT = WS_GT + al((size_t)MP * 6144 * 2);
constexpr size_t WS_CUM = WS_DT + al((size_t)MP * 16 * 4);
constexpr size_t WS_U = WS_CUM + al((size_t)MP * 16 * 4);
constexpr size_t WS_SB = WS_U + al((size_t)NCH * STATE_N * 4);
constexpr size_t WS_GAM = WS_SB + al((size_t)NCH * STATE_N * 2);
constexpr size_t WS_BR = WS_GAM + al((size_t)NCH * GAM_N * 4);
constexpr size_t WS_TMP = WS_BR + al((size_t)3 * MP * 1024 * 2);
constexpr size_t WS_MIX = WS_TMP + al((size_t)MP * D * 4);
constexpr size_t WS_HID = WS_MIX + al((size_t)MP * D * 2);
constexpr size_t WS_ROPE = WS_HID + al((size_t)MP * FFN * 2);
constexpr size_t WS_LBS = WS_ROPE + al((size_t)MP * 32 * 8);
constexpr size_t WS_AV = WS_LBS + 1 * MiB;
constexpr size_t WS_XTG = WS_AV + al((size_t)MP * 16 * 4);
constexpr size_t WS_BCG = WS_XTG + al((size_t)NCH * 1024 * 64 * 2);
constexpr size_t WS_SLAB = WS_BCG + al((size_t)MP * 512 * 2);
constexpr size_t WS_END = WS_SLAB + (size_t)2 * 256 * 65536 * 4;
constexpr int CW_BAR = 4096, CW_QUEUE = 16384, CW_SK = 32768, CW_TMO = 8;
constexpr int CW_END = CW_SK + 8 * 256 * 64;
constexpr int CW_G2 = 163840;
constexpr int CW_RS = CW_G2 + 64 * 64 * 8;
constexpr int CW_RDY = 360448;
static_assert((size_t)CW_RS * 4 + (size_t)8 * MP * 8 <= (size_t)CW_RDY * 4 && (size_t)(CW_RDY + 8 * 64 * 32) * 4 <= ((size_t)2 << 20), "hand-off counters inside the memset region");
static_assert((size_t)CW_RS * 4 + (size_t)8 * MP * 8 <= (size_t)2 << 20, "control words inside the memset region");
typedef unsigned long long u64;
__device__ __forceinline__ float rs_to_rstd(u64 s) { return rsqrtf((float)s * (1.0f / 1048576.0f) * (1.0f / D) + EPS); }
__device__ __forceinline__ u64 ss_to_fix(float s) { return (u64)(s * 1048576.0f); }

constexpr int RING_BYTES = 131072;
constexpr int LDSCTL_OFF = 147456 - 512, LDS_BYTES = 147456;
constexpr int NWAVES = 8, NTHR = 512;

#define GAS __attribute__((address_space(1)))
#define LAS __attribute__((address_space(3)))
typedef unsigned short bf16;
typedef unsigned v4u __attribute__((ext_vector_type(4)));
typedef unsigned v2u __attribute__((ext_vector_type(2)));
typedef float f32x4 __attribute__((ext_vector_type(4)));
typedef float f32x2 __attribute__((ext_vector_type(2)));
typedef short bf16x8 __attribute__((ext_vector_type(8)));
typedef GAS unsigned gu32;
#define RLX_AGENT __ATOMIC_RELAXED, __HIP_MEMORY_SCOPE_AGENT

__device__ __forceinline__ unsigned f2bf(float f) { unsigned u = __builtin_bit_cast(unsigned, f); return (u + 0x7fffu + ((u >> 16) & 1u)) >> 16; }
typedef __bf16 bf16v2 __attribute__((ext_vector_type(2)));
__device__ __forceinline__ unsigned pk2(float lo, float hi) { const f32x2 v = {lo, hi}; return __builtin_bit_cast(unsigned, __builtin_convertvector(v, bf16v2)); }
__device__ __forceinline__ float bf2f(unsigned short b) { return __builtin_bit_cast(float, ((unsigned)b) << 16); }
__device__ __forceinline__ float bflo(unsigned w) { return __builtin_bit_cast(float, w << 16); }
__device__ __forceinline__ float bfhi(unsigned w) { return __builtin_bit_cast(float, w & 0xffff0000u); }
__device__ __forceinline__ float fsigmoid(float v) { return __builtin_amdgcn_rcpf(1.0f + __expf(-v)); }
__device__ __forceinline__ float fsilu(float v) { return v * fsigmoid(v); }
__device__ __forceinline__ f32x4 mfma16(bf16x8 a, bf16x8 b, f32x4 c) { return __builtin_amdgcn_mfma_f32_16x16x32_bf16(a, b, c, 0, 0, 0); }
__device__ __forceinline__ float wave_sum(float v) {
#pragma unroll
    for (int o = 1; o < 64; o <<= 1) v += __shfl_xor(v, o);
    return v;
}
#ifndef MK_G2_NOSPLIT
#define MK_G2_NOSPLIT 0
#endif
#ifndef MK_PREFETCH
#define MK_PREFETCH 0
#endif
__device__ __forceinline__ v2u pk4(const f32x4 v) { v2u w; w.x = pk2(v[0], v[1]); w.y = pk2(v[2], v[3]); return w; }
__device__ __forceinline__ f32x4 unpk4(const v2u w) { return (f32x4){bflo(w.x), bfhi(w.x), bflo(w.y), bfhi(w.y)}; }
#define LDS_WAIT() asm volatile("s_waitcnt lgkmcnt(0)" ::: "memory")
#define LBAR() do { asm volatile("s_waitcnt lgkmcnt(0)" ::: "memory"); __builtin_amdgcn_s_barrier(); asm volatile("" ::: "memory"); } while (0)
#define XB_TMO      128
#define XB_XCNT(j)  (256  + 64 * (j))
#define XB_XSUB(j)  (1280 + 64 * (j))
#define XB_XGEN(j)  (2304 + 64 * (j))
#define XB_TOP      3328
#define XB_TOPGEN   3392
#define XCD_BAR_WORDS 3456
#define XB_SPIN_CAP (1u << 18)

__device__ __forceinline__ unsigned xb_ld(unsigned* p)              { return __hip_atomic_load(p, __ATOMIC_RELAXED, __HIP_MEMORY_SCOPE_AGENT); }
__device__ __forceinline__ unsigned xb_add(unsigned* p, unsigned v) { return __hip_atomic_fetch_add(p, v, __ATOMIC_RELAXED, __HIP_MEMORY_SCOPE_AGENT); }
__device__ __forceinline__ unsigned xb_xcc_id() { return (unsigned)__builtin_amdgcn_s_getreg((3 << 11) | 20) & 0xFu; }
#define XB_SPIN(cond, bar) do { unsigned _sp = 0; while (cond) { __builtin_amdgcn_s_sleep(1); \
    if ((++_sp & 255u) == 0u) { if (xb_ld(&(bar)[XB_TMO])) break; if (_sp > XB_SPIN_CAP) { atomicAdd(&(bar)[XB_TMO], 1u); break; } } } } while (0)

struct XcdBarrier {
    unsigned* bar; unsigned x;
    volatile LAS unsigned* st;
};

__device__ __forceinline__ XcdBarrier xcd_barrier_post(unsigned* bar, volatile LAS unsigned* st) {
    XcdBarrier b; b.bar = bar; b.x = xb_xcc_id(); b.st = st;
    if (threadIdx.x == 0) (void)xb_add(&bar[XB_XCNT(b.x)], 1u);
    return b;
}
__device__ __forceinline__ void xcd_barrier_complete(unsigned* bar, unsigned x, unsigned& nloc, unsigned& nx) {
    const unsigned G = gridDim.x * gridDim.y * gridDim.z;
    unsigned sum, cnt, mine, sp = 0u;
    for (;;) {
        sum = 0u; cnt = 0u; mine = 0u;
#pragma unroll
        for (unsigned j = 0; j < 16; ++j) { const unsigned c = xb_ld(&bar[XB_XCNT(j)]); sum += c; cnt += (c > 0u) ? 1u : 0u; mine = (j == x) ? c : mine; }
        if (sum == G) break;
        __builtin_amdgcn_s_sleep(1);
        if ((++sp & 255u) == 0u) { if (xb_ld(&bar[XB_TMO])) break; if (sp > XB_SPIN_CAP) { atomicAdd(&bar[XB_TMO], 1u); break; } }
    }
    nloc = mine > 0u ? mine : 1u; nx = cnt > 0u ? cnt : 1u;
}

__device__ __forceinline__ void xcd_barrier(const XcdBarrier& b) {
    asm volatile("s_waitcnt vmcnt(0)" ::: "memory");
    __syncthreads();
    if (threadIdx.x == 0) {
        unsigned* bar = b.bar;
        __builtin_amdgcn_s_waitcnt(0);
        unsigned nloc = b.st[0], nx = b.st[1];
        if (nloc == 0u) { xcd_barrier_complete(bar, b.x, nloc, nx); b.st[0] = nloc; b.st[1] = nx; }
        const unsigned old = xb_add(&bar[XB_XSUB(b.x)], 1u);
        const unsigned gen = old / nloc;
        if (old + 1u == (gen + 1u) * nloc) {
            __builtin_amdgcn_fence(__ATOMIC_RELEASE, "agent");
            asm volatile("s_waitcnt vmcnt(0)" ::: "memory");
            const unsigned og = xb_add(&bar[XB_TOP], 1u);
            const unsigned tg = og / nx;
            if (og + 1u == (tg + 1u) * nx) xb_add(&bar[XB_TOPGEN], 1u);
            else XB_SPIN(xb_ld(&bar[XB_TOPGEN]) == tg, bar);
            __builtin_amdgcn_fence(__ATOMIC_ACQUIRE, "agent");
            xb_add(&bar[XB_XGEN(b.x)], 1u);
            asm volatile("s_waitcnt vmcnt(0)" ::: "memory");
        } else {
            XB_SPIN(xb_ld(&bar[XB_XGEN(b.x)]) == gen, bar);
            __builtin_amdgcn_fence(__ATOMIC_ACQUIRE, "agent");
            asm volatile("s_waitcnt vmcnt(0)" ::: "memory");
        }
    }
    __syncthreads();
}


typedef const f32x4 (&AccRef)[2][2][4][2];

struct EpiProj {
    static constexpr bool PERM = true, AFTER_DRAIN = false;
    unsigned char* ws; int layer;
    template <int T> __device__ __forceinline__ void run(AccRef acc, bf16* dst, int pitch, int row0, int col0, int ltid = 0) const {
        const float* lbs = (const float*)(ws + WS_LBS) + layer * 1024; bf16* LG = (bf16*)(ws + WS_LG); const f32x2* rope = (const f32x2*)(ws + WS_ROPE); const u64* RS = (const u64*)((const unsigned*)(ws + WS_CTL) + CW_RS) + (size_t)(2 * layer) * MP;
        f32x4 lb[2][2];
        if (T == 3) {
#pragma unroll
            for (int bj = 0; bj < 2; ++bj) { lb[bj][0] = *(const f32x4*)(lbs + col0 + bj * 128); lb[bj][1] = *(const f32x4*)(lbs + col0 + bj * 128 + 4); }
        }
#pragma unroll
        for (int ai = 0; ai < 2; ++ai)
#pragma unroll
            for (int m = 0; m < 4; ++m) {
                const int row = row0 + ai * 128 + m * 16; const float rsr = rs_to_rstd(RS[row]);
#pragma unroll
                for (int bj = 0; bj < 2; ++bj) {
                    const int col = col0 + bj * 128;
                    f32x4 v0 = acc[ai][bj][m][0] * rsr, v1 = acc[ai][bj][m][1] * rsr;
                    if (T == 1) {
#pragma unroll
                        for (int e = 0; e < 4; ++e) { v0[e] = fsilu(v0[e]); v1[e] = fsilu(v1[e]); }
                    }
                    if (T == 2) {
#pragma unroll
                        for (int e = 0; e < 4; ++e) { v0[e] = fsigmoid(v0[e]); v1[e] = fsigmoid(v1[e]); }
                    }
                    if (T == 3) {
                        f32x4 l0, l1;
#pragma unroll
                        for (int e = 0; e < 4; ++e) {
                            { const float b = lb[bj][0][e], fg = v0[e], s = fsigmoid(fg), sn = fsigmoid(-fg); l0[e] = __logf(fmaxf(b + (1.0f - b) * s, 1e-30f)); v0[e] = (1.0f - b) * sn; }
                            { const float b = lb[bj][1][e], fg = v1[e], s = fsigmoid(fg), sn = fsigmoid(-fg); l1[e] = __logf(fmaxf(b + (1.0f - b) * s, 1e-30f)); v1[e] = (1.0f - b) * sn; }
                        }
                        { v4u wl; wl.x = pk2(l0[0], l0[1]); wl.y = pk2(l0[2], l0[3]); wl.z = pk2(l1[0], l1[1]); wl.w = pk2(l1[2], l1[3]); *(v4u*)(LG + (size_t)row * 1024 + col) = wl; }
                    }
                    if (T == 4 || T == 5) {
                        const int j = (col & 63) >> 3;
                        const f32x4* rp = (const f32x4*)(rope + (size_t)row * 32 + 4 * j);
                        const f32x4 cs0 = rp[0], cs1 = rp[1];
                        const float c[4] = {cs0[0], cs0[2], cs1[0], cs1[2]}, s[4] = {cs0[1], cs0[3], cs1[1], cs1[3]};
                        const float sc = (T == 5) ? 0.125f : 1.0f;
#pragma unroll
                        for (int e = 0; e < 4; ++e) { const float a = v0[e], b = v1[e]; v0[e] = (a * c[e] - b * s[e]) * sc; v1[e] = (b * c[e] + a * s[e]) * sc; }
                    }
                    v4u w; w.x = pk2(v0[0], v0[1]); w.y = pk2(v0[2], v0[3]); w.z = pk2(v1[0], v1[1]); w.w = pk2(v1[2], v1[3]);
                    if (T == 2) *(v4u*)(dst + ((size_t)((ai * 4 + m) * 2 + bj) * 512 + ltid) * 8) = w;
                    else *(v4u*)(dst + (size_t)row * pitch + col) = w;
                }
            }
    }
    __device__ __forceinline__ void operator()(AccRef acc, const pg8::Unit& u, int wr, int wc, int fr, int fq) const {
        const int pn = u.pn, row0 = u.pm * 256 + wr * 64 + fr, cl = wc * 32 + 8 * fq;
        if (pn < 4) run<1>(acc, (bf16*)(ws + WS_ZS), 1024, row0, (pn - 0) * 256 + cl);
        else if (pn < 10) run<0>(acc, (bf16*)(ws + WS_XBC), 1536, row0, (pn - 4) * 256 + cl);
        else if (pn < 14) run<1>(acc, (bf16*)(ws + WS_HQ), 1024, row0, (pn - 10) * 256 + cl);
        else if (pn < 18) run<3>(acc, (bf16*)(ws + WS_KK), 1024, row0, (pn - 14) * 256 + cl);
        else if (pn < 22) run<0>(acc, (bf16*)(ws + WS_HV), 1024, row0, (pn - 18) * 256 + cl);
        else if (pn < 26) run<1>(acc, (bf16*)(ws + WS_HG), 1024, row0, (pn - 22) * 256 + cl);
        else if (pn < 28) run<4>(acc, (bf16*)(ws + WS_RQ), 512, row0, (pn - 26) * 256 + cl);
        else if (pn < 30) run<5>(acc, (bf16*)(ws + WS_RK), 512, row0, (pn - 28) * 256 + cl);
        else if (pn < 34) run<0>(acc, (bf16*)(ws + WS_RV), 1024, row0, (pn - 30) * 256 + cl);
        else if (pn < 38) run<1>(acc, (bf16*)(ws + WS_RG), 1024, row0, (pn - 34) * 256 + cl);
        else run<2>(acc, (bf16*)(ws + WS_GT) + (size_t)(u.pm * 24 + (pn - 38)) * 65536, 6144, row0, (pn - 38) * 256 + cl, (wr * 4 + wc) * 64 + fr + 16 * fq);
    }
};

template <int MODE = 0  > struct EpiBranchT {
    static constexpr bool PERM = true, AFTER_DRAIN = false;
    bf16* TMP; bf16* MIX; const bf16* GT; float* slabs; unsigned* cnt; unsigned* tmo; unsigned* rdy = nullptr;
    __device__ __forceinline__ void operator()(AccRef acc, const pg8::Unit& u, int wr, int wc, int fr, int fq) const {
        const int pc = u.pc; int row0 = u.pm * 256 + wr * 64 + fr; const int col0 = u.pn * 256 + wc * 32 + 8 * fq; asm volatile("" : "+v"(row0));
        int ltid = (wr * 4 + wc) * 64 + fr + 16 * fq; asm volatile("" : "+v"(ltid));
        if (u.kind == 3) {
            const int lane = fr + 16 * fq, wid = wr * 4 + wc; int tid = wid * 64 + lane; asm volatile("" : "+v"(tid));
            const int lt = u.slab;
            v4u vp[2][4][2];
#pragma unroll
            for (int ai = 0; ai < 2; ++ai) {
                v4u gq[4][2];
#pragma unroll
                for (int m = 0; m < 4; ++m)
#pragma unroll
                    for (int bj = 0; bj < 2; ++bj) gq[m][bj] = *(const v4u*)(GT + ((size_t)(u.pm * 24 + pc * 8 + u.pn) * 16 + (ai * 4 + m) * 2 + bj) * 4096 + (size_t)ltid * 8);
                __builtin_amdgcn_sched_barrier(0);
#pragma unroll
                for (int m = 0; m < 4; ++m)
#pragma unroll
                    for (int bj = 0; bj < 2; ++bj) { const v4u g = gq[m][bj]; const f32x4 a = acc[ai][bj][m][0] * (f32x4){bflo(g.x), bfhi(g.x), bflo(g.y), bfhi(g.y)}, b = acc[ai][bj][m][1] * (f32x4){bflo(g.z), bfhi(g.z), bflo(g.w), bfhi(g.w)};
                        v4u w; w.x = pk2(a[0], a[1]); w.y = pk2(a[2], a[3]); w.z = pk2(b[0], b[1]); w.w = pk2(b[2], b[3]); vp[ai][m][bj] = w; }
                __builtin_amdgcn_sched_barrier(0);
            }
            if (pc < 2) {
                __amdgpu_buffer_rsrc_t rsrc = __builtin_amdgcn_make_buffer_rsrc(slabs + (size_t)(lt * 3 + pc) * 65536, 0, 65536 * 4, 0x00020000);
#pragma unroll
                for (int ai = 0; ai < 2; ++ai)
#pragma unroll
                    for (int m = 0; m < 4; ++m)
#pragma unroll
                        for (int bj = 0; bj < 2; ++bj) { const int j = (ai * 4 + m) * 2 + bj; __builtin_amdgcn_raw_buffer_store_b128(vp[ai][m][bj], rsrc, (j * 512 + tid) * 16, 0, 16); }
                asm volatile("s_waitcnt vmcnt(0)" ::: "memory");
                if (lane == 0) __hip_atomic_fetch_add(cnt + 64 * lt, 1u, __ATOMIC_RELAXED, __HIP_MEMORY_SCOPE_AGENT);
            } else {
                unsigned sp = 0;
                while ((unsigned)__builtin_amdgcn_readfirstlane(__hip_atomic_load(cnt + 64 * lt, __ATOMIC_RELAXED, __HIP_MEMORY_SCOPE_AGENT)) < 16u) {
                    __builtin_amdgcn_s_sleep(2);
                    if ((++sp & 1023u) == 0u) { if (__hip_atomic_load(tmo, __ATOMIC_RELAXED, __HIP_MEMORY_SCOPE_AGENT) != 0u) break; if (sp > (1u << 22)) { if (lane == 0) __hip_atomic_store(tmo, 1u, __ATOMIC_RELAXED, __HIP_MEMORY_SCOPE_AGENT); break; } }
                }
                __builtin_amdgcn_fence(__ATOMIC_ACQUIRE, "agent");
                const v4u* s1 = (const v4u*)(slabs + (size_t)(lt * 3 + 0) * 65536) + tid; const v4u* s2 = (const v4u*)(slabs + (size_t)(lt * 3 + 1) * 65536) + tid;
#pragma unroll
                for (int ai = 0; ai < 2; ++ai) {
                    v4u q1[4][2], q2[4][2];
#pragma unroll
                    for (int m = 0; m < 4; ++m)
#pragma unroll
                        for (int bj = 0; bj < 2; ++bj) { const int j = (ai * 4 + m) * 2 + bj; q1[m][bj] = s1[j * 512]; q2[m][bj] = s2[j * 512]; }
                    __builtin_amdgcn_sched_barrier(0);
#pragma unroll
                    for (int m = 0; m < 4; ++m)
#pragma unroll
                        for (int bj = 0; bj < 2; ++bj) { const v4u a = vp[ai][m][bj], b = q1[m][bj], c = q2[m][bj]; v4u w;
                            w.x = pk2(bflo(a.x) + bflo(b.x) + bflo(c.x), bfhi(a.x) + bfhi(b.x) + bfhi(c.x)); w.y = pk2(bflo(a.y) + bflo(b.y) + bflo(c.y), bfhi(a.y) + bfhi(b.y) + bfhi(c.y));
                            w.z = pk2(bflo(a.z) + bflo(b.z) + bflo(c.z), bfhi(a.z) + bfhi(b.z) + bfhi(c.z)); w.w = pk2(bflo(a.w) + bflo(b.w) + bflo(c.w), bfhi(a.w) + bfhi(b.w) + bfhi(c.w));
                            if (rdy) __builtin_amdgcn_raw_buffer_store_b128(__builtin_bit_cast(pg8::u32x4, w), __builtin_amdgcn_make_buffer_rsrc(MIX, 0, MP * D * 2, 0x00020000), ((row0 + ai * 128 + m * 16) * D + col0 + bj * 128) * 2, 0, 16);
                            else *(v4u*)(MIX + (size_t)(row0 + ai * 128 + m * 16) * D + col0 + bj * 128) = w; }
                    __builtin_amdgcn_sched_barrier(0);
                }
                if (rdy) { asm volatile("s_waitcnt vmcnt(0)" ::: "memory"); if (lane == 0) __hip_atomic_fetch_add(rdy + 32 * u.pm, 1u, __ATOMIC_RELAXED, __HIP_MEMORY_SCOPE_AGENT); }
            }
            return;
        }
#pragma unroll
        for (int ai = 0; ai < 2; ++ai) {
            v4u gq[4][2];
#pragma unroll
            for (int m = 0; m < 4; ++m)
#pragma unroll
                for (int bj = 0; bj < 2; ++bj) gq[m][bj] = MODE == 2 ? (v4u){0x3f803f80u, 0x3f803f80u, 0x3f803f80u, 0x3f803f80u} : *(const v4u*)(GT + ((size_t)(u.pm * 24 + pc * 8 + u.pn) * 16 + (ai * 4 + m) * 2 + bj) * 4096 + (size_t)ltid * 8);
            v4u tq[4][2];
            if (pc > 0 && MODE != 1) {
#pragma unroll
                for (int m = 0; m < 4; ++m)
#pragma unroll
                    for (int bj = 0; bj < 2; ++bj) tq[m][bj] = *(const v4u*)(TMP + ((size_t)(u.pm * 8 + u.pn) * 16 + (ai * 4 + m) * 2 + bj) * 4096 + (size_t)ltid * 8);
            }
            __builtin_amdgcn_sched_barrier(0);
#pragma unroll
            for (int m = 0; m < 4; ++m) {
                const int row = row0 + ai * 128 + m * 16;
#pragma unroll
                for (int bj = 0; bj < 2; ++bj) {
                    const int col = col0 + bj * 128;
                    const v4u g = gq[m][bj];
                    f32x4 v0 = acc[ai][bj][m][0], v1 = acc[ai][bj][m][1];
                    v0[0] *= bflo(g.x); v0[1] *= bfhi(g.x); v0[2] *= bflo(g.y); v0[3] *= bfhi(g.y);
                    v1[0] *= bflo(g.z); v1[1] *= bfhi(g.z); v1[2] *= bflo(g.w); v1[3] *= bfhi(g.w);
                    bf16* tp = TMP + ((size_t)(u.pm * 8 + u.pn) * 16 + (ai * 4 + m) * 2 + bj) * 4096 + (size_t)ltid * 8;
                    if (pc > 0 && MODE != 1) { const v4u t = tq[m][bj]; v0[0] += bflo(t.x); v0[1] += bfhi(t.x); v0[2] += bflo(t.y); v0[3] += bfhi(t.y); v1[0] += bflo(t.z); v1[1] += bfhi(t.z); v1[2] += bflo(t.w); v1[3] += bfhi(t.w); }
                    if (pc < 2 && MODE != 1) { v4u w; w.x = pk2(v0[0], v0[1]); w.y = pk2(v0[2], v0[3]); w.z = pk2(v1[0], v1[1]); w.w = pk2(v1[2], v1[3]); *(v4u*)tp = w; }
                    else { v4u w; w.x = pk2(v0[0], v0[1]); w.y = pk2(v0[2], v0[3]); w.z = pk2(v1[0], v1[1]); w.w = pk2(v1[2], v1[3]);
                        if (rdy) __builtin_amdgcn_raw_buffer_store_b128(__builtin_bit_cast(pg8::u32x4, w), __builtin_amdgcn_make_buffer_rsrc(MIX, 0, MP * D * 2, 0x00020000), (row * D + col) * 2, 0, 16); else *(v4u*)(MIX + (size_t)row * D + col) = w; }
                }
            }
            __builtin_amdgcn_sched_barrier(0);
        }
        if (rdy && pc == 2) { asm volatile("s_waitcnt vmcnt(0)" ::: "memory"); if (fr + 16 * fq == 0) __hip_atomic_fetch_add(rdy + 32 * u.pm, 1u, __ATOMIC_RELAXED, __HIP_MEMORY_SCOPE_AGENT); }
    }
};
typedef EpiBranchT<0> EpiBranch;

struct EpiResid {
    static constexpr bool PERM = true, AFTER_DRAIN = false;
    bf16* X; float* slabs; unsigned* cnt; unsigned* tmo; u64* RSN; unsigned* rdy = nullptr;
    __device__ __forceinline__ void operator()(AccRef acc, const pg8::Unit& u, int wr, int wc, int fr, int fq) const {
        const int lane = fr + 16 * fq, wid = wr * 4 + wc; int tid = wid * 64 + lane; asm volatile("" : "+v"(tid));
        if (u.kind == 1) {
            __amdgpu_buffer_rsrc_t rsrc = __builtin_amdgcn_make_buffer_rsrc(slabs + (size_t)u.slab * 65536, 0, 65536 * 4, 0x00020000);
#pragma unroll
            for (int ai = 0; ai < 2; ++ai)
#pragma unroll
                for (int bj = 0; bj < 2; ++bj)
#pragma unroll
                    for (int m = 0; m < 4; ++m)
#pragma unroll
                        for (int n = 0; n < 2; ++n) { const int j = ((ai * 2 + bj) * 4 + m) * 2 + n; __builtin_amdgcn_raw_buffer_store_b128(__builtin_bit_cast(pg8::u32x4, acc[ai][bj][m][n]), rsrc, (j * 512 + tid) * 16, 0, 16); }
            asm volatile("s_waitcnt vmcnt(0)" ::: "memory");
            if (lane == 0) __hip_atomic_fetch_add(cnt + 64 * u.slab, 1u, __ATOMIC_RELAXED, __HIP_MEMORY_SCOPE_AGENT);
            return;
        }
        const f32x4* sl = (const f32x4*)(slabs + (size_t)u.slab * 65536);
        if (u.kind == 2) {
            unsigned sp = 0;
            while ((unsigned)__builtin_amdgcn_readfirstlane(__hip_atomic_load(cnt + 64 * u.slab, __ATOMIC_RELAXED, __HIP_MEMORY_SCOPE_AGENT)) < 8u) {
                __builtin_amdgcn_s_sleep(2);
                if ((++sp & 1023u) == 0u) { if (__hip_atomic_load(tmo, __ATOMIC_RELAXED, __HIP_MEMORY_SCOPE_AGENT) != 0u) break; if (sp > (1u << 22)) { if (lane == 0) __hip_atomic_store(tmo, 1u, __ATOMIC_RELAXED, __HIP_MEMORY_SCOPE_AGENT); break; } }
            }
            __builtin_amdgcn_fence(__ATOMIC_ACQUIRE, "agent");
        }
        int row0 = u.pm * 256 + wr * 64 + fr; const int col0 = u.pn * 256 + wc * 32 + 8 * fq; asm volatile("" : "+v"(row0));
        __amdgpu_buffer_rsrc_t xr = __builtin_amdgcn_make_buffer_rsrc(X, 0, MP * D * 2, 0x00020000);
#pragma unroll
        for (int ai = 0; ai < 2; ++ai) {
            v4u xq[4][2];
            float ssq[4] = {0.f, 0.f, 0.f, 0.f};
#pragma unroll
            for (int m = 0; m < 4; ++m)
#pragma unroll
                for (int bj = 0; bj < 2; ++bj) xq[m][bj] = *(const v4u*)(X + (size_t)(row0 + ai * 128 + m * 16) * D + col0 + bj * 128);
            __builtin_amdgcn_sched_barrier(0);
#pragma unroll
            for (int m = 0; m < 4; ++m)
#pragma unroll
                for (int bj = 0; bj < 2; ++bj) { const v4u x = xq[m][bj]; f32x4 a = acc[ai][bj][m][0] + (f32x4){bflo(x.x), bfhi(x.x), bflo(x.y), bfhi(x.y)}, b = acc[ai][bj][m][1] + (f32x4){bflo(x.z), bfhi(x.z), bflo(x.w), bfhi(x.w)};
                    if (u.kind == 2) { const int j0 = ((ai * 2 + bj) * 4 + m) * 2; a += sl[j0 * 512 + tid]; b += sl[(j0 + 1) * 512 + tid]; }
                    v4u w; w.x = pk2(a[0], a[1]); w.y = pk2(a[2], a[3]); w.z = pk2(b[0], b[1]); w.w = pk2(b[2], b[3]); if (rdy) __builtin_amdgcn_raw_buffer_store_b128(__builtin_bit_cast(pg8::u32x4, w), xr, ((row0 + ai * 128 + m * 16) * D + col0 + bj * 128) * 2, 0, 16); else *(v4u*)(X + (size_t)(row0 + ai * 128 + m * 16) * D + col0 + bj * 128) = w;
                    ssq[m] += ((a[0] * a[0] + a[1] * a[1]) + (a[2] * a[2] + a[3] * a[3])) + ((b[0] * b[0] + b[1] * b[1]) + (b[2] * b[2] + b[3] * b[3])); }
            if (RSN) {
#pragma unroll
                for (int m = 0; m < 4; ++m) { float s = ssq[m]; s += __shfl_xor(s, 16); s += __shfl_xor(s, 32); if (fq == 0) __hip_atomic_fetch_add(RSN + row0 + ai * 128 + m * 16, ss_to_fix(s), __ATOMIC_RELAXED, __HIP_MEMORY_SCOPE_AGENT); } }
            __builtin_amdgcn_sched_barrier(0);
        }
        if (rdy) { asm volatile("s_waitcnt vmcnt(0)" ::: "memory");
            if (lane == 0) __hip_atomic_fetch_add(rdy + 32 * u.pm, 1u, __ATOMIC_RELAXED, __HIP_MEMORY_SCOPE_AGENT); }
    }
};

struct EpiSwiglu {
    static constexpr bool PERM = true, AFTER_DRAIN = false;
    bf16* HID; float* slabs; unsigned* cnt; unsigned* tmo; const u64* RS;
    __device__ __forceinline__ void operator()(AccRef acc, const pg8::Unit& u, int wr, int wc, int fr, int fq) const {
        const int lane = fr + 16 * fq, wid = wr * 4 + wc; int tid = wid * 64 + lane; asm volatile("" : "+v"(tid));
        if (u.kind == 1) {
            __amdgpu_buffer_rsrc_t rsrc = __builtin_amdgcn_make_buffer_rsrc(slabs + (size_t)u.slab * 65536, 0, 65536 * 4, 0x00020000);
#pragma unroll
            for (int ai = 0; ai < 2; ++ai)
#pragma unroll
                for (int bj = 0; bj < 2; ++bj)
#pragma unroll
                    for (int m = 0; m < 4; ++m)
#pragma unroll
                        for (int n = 0; n < 2; ++n) { const int j = ((ai * 2 + bj) * 4 + m) * 2 + n; __builtin_amdgcn_raw_buffer_store_b128(__builtin_bit_cast(pg8::u32x4, acc[ai][bj][m][n]), rsrc, (j * 512 + tid) * 16, 0, 16); }
            asm volatile("s_waitcnt vmcnt(0)" ::: "memory");
            if (lane == 0) __hip_atomic_fetch_add(cnt + 64 * u.slab, 1u, __ATOMIC_RELAXED, __HIP_MEMORY_SCOPE_AGENT);
            return;
        }
        const f32x4* sl = (const f32x4*)(slabs + (size_t)u.slab * 65536);
        if (u.kind == 2) {
            unsigned sp = 0;
            while ((unsigned)__builtin_amdgcn_readfirstlane(__hip_atomic_load(cnt + 64 * u.slab, __ATOMIC_RELAXED, __HIP_MEMORY_SCOPE_AGENT)) < 8u) {
                __builtin_amdgcn_s_sleep(2);
                if ((++sp & 1023u) == 0u) { if (__hip_atomic_load(tmo, __ATOMIC_RELAXED, __HIP_MEMORY_SCOPE_AGENT) != 0u) break; if (sp > (1u << 22)) { if (lane == 0) __hip_atomic_store(tmo, 1u, __ATOMIC_RELAXED, __HIP_MEMORY_SCOPE_AGENT); break; } }
            }
            __builtin_amdgcn_fence(__ATOMIC_ACQUIRE, "agent");
        }
        int row0 = u.pm * 256 + wr * 64 + fr; const int col0 = u.pn * 128 + wc * 32 + 8 * fq; asm volatile("" : "+v"(row0));
#pragma unroll
        for (int ai = 0; ai < 2; ++ai)
#pragma unroll
            for (int m = 0; m < 4; ++m) {
                const int row = row0 + ai * 128 + m * 16;
                f32x4 g0 = acc[ai][0][m][0], g1 = acc[ai][0][m][1], u0 = acc[ai][1][m][0], u1 = acc[ai][1][m][1];
                if (u.kind == 2) { const int jg = ((ai * 2 + 0) * 4 + m) * 2, ju = ((ai * 2 + 1) * 4 + m) * 2; g0 += sl[jg * 512 + tid]; g1 += sl[(jg + 1) * 512 + tid]; u0 += sl[ju * 512 + tid]; u1 += sl[(ju + 1) * 512 + tid]; }
                { const float rsr = rs_to_rstd(RS[row]); g0 *= rsr; g1 *= rsr; u0 *= rsr; u1 *= rsr; }
#pragma unroll
                for (int e = 0; e < 4; ++e) { g0[e] = fsilu(g0[e]) * u0[e]; g1[e] = fsilu(g1[e]) * u1[e]; }
                v4u w; w.x = pk2(g0[0], g0[1]); w.y = pk2(g0[2], g0[3]); w.z = pk2(g1[0], g1[1]); w.w = pk2(g1[2], g1[3]);
                *(v4u*)(HID + (size_t)row * FFN + col0) = w;
            }
    }
};

struct BranchOrder {
    pg8::StaticOrder S; int R, rem, dep;
    __device__ __forceinline__ void init(int M, int N, int G, int c, int K) { S.init(M, N, G, c, K); R = S.nwg / G; rem = S.nwg - R * G; if (3 * rem > G || MK_G2_NOSPLIT) { R = (S.nwg + G - 1) / G; rem = 0; }
        dep = (G == 256 && S.nM == 37 && S.nN == 8 && pg8::WGM == 8 && R == 1 && rem == 40) ? 1 : 0; }
    __device__ __forceinline__ bool next(int i, pg8::Unit& u) const {
        const int t = i / 3, pc = i - 3 * t;
        if (dep) {
            const int x = S.c & 7, j = S.c >> 3, q = x == 6 ? 96 + j : 32 * (x - 3) + j;
            const bool full = t < 1, part = (i == 3) && ((x >= 3 && x <= 5) || (x == 6 && j < 24));
            if (!full && !part) return false;
            const int lt = q / 3;
            pg8::Unit v; S.tile_seq(full ? 32 * x + j : 256 + lt, v); v.pc = full ? pc : q - 3 * lt; v.k0 = 0; v.nt = S.ntk; v.kind = full ? 0 : 3; v.slab = full ? 0 : lt;
            u = v; return true;
        }
        if (t < R) { if (!S.next(t, u)) return false; u.pc = pc; return true; }
        if (i == 3 * R && S.c < 3 * rem) { const int lt = S.c / 3; S.tile(R * S.G + lt, u); u.pc = S.c - 3 * lt; u.k0 = 0; u.nt = S.ntk; u.kind = 3; u.slab = lt; return true; }
        return false;
    }
    __device__ __forceinline__ void a_ready(const pg8::Unit&) const {}
    __device__ __forceinline__ void done(const pg8::Unit&) const {}
};

struct EpiNull {
    static constexpr bool PERM = true, AFTER_DRAIN = false;
    float* sink;
    __device__ __forceinline__ void operator()(AccRef acc, const pg8::Unit& u, int wr, int wc, int fr, int fq) const {
        float s = 0.f;
#pragma unroll
        for (int ai = 0; ai < 2; ++ai)
#pragma unroll
            for (int bj = 0; bj < 2; ++bj)
#pragma unroll
                for (int m = 0; m < 4; ++m)
#pragma unroll
                    for (int n = 0; n < 2; ++n) s += acc[ai][bj][m][n][0] + acc[ai][bj][m][n][3];
        if (s == 12345.678f) sink[u.pm + wr + wc + fr + fq] = s;
    }
};

__device__ __forceinline__ void panel_wait(const unsigned* rdy, unsigned* tmo, unsigned long long& seen, int pm) {
    const unsigned long long bit = 1ull << pm;
    if (seen & bit) return;
    const unsigned* p = rdy + 32 * pm; unsigned sp = 0; bool waited = false;
    while ((unsigned)__builtin_amdgcn_readfirstlane(__hip_atomic_load(p, __ATOMIC_RELAXED, __HIP_MEMORY_SCOPE_AGENT)) < 64u) {
        waited = true; __builtin_amdgcn_s_sleep(2);
        if ((++sp & 1023u) == 0u) { if (__hip_atomic_load(tmo, __ATOMIC_RELAXED, __HIP_MEMORY_SCOPE_AGENT) != 0u) break; if (sp > (1u << 22)) { __hip_atomic_store(tmo, 1u, __ATOMIC_RELAXED, __HIP_MEMORY_SCOPE_AGENT); break; } }
    }
    if (seen == 0ull || waited) __builtin_amdgcn_fence(__ATOMIC_ACQUIRE, "agent");
    seen |= bit;
}
struct G3Order {
    pg8::StaticOrder S; int dep; const unsigned* rdy; unsigned* tmo; mutable unsigned long long seen;
    __device__ __forceinline__ void init(int M, int N, int G, int c, int K, const unsigned* rdy_, unsigned* tmo_) { S.init(M, N, G, c, K); dep = (G == 256 && S.nM == 37 && S.nN == 8 && pg8::WGM == 8) ? 1 : 0; rdy = rdy_; tmo = tmo_; seen = 0ull; }
    __device__ __forceinline__ bool next(int i, pg8::Unit& u) const {
        if (!dep) return S.next(i, u);
        const int x = S.c & 7, j = S.c >> 3;
        if (!(i == 0 || (i == 1 && (x == 7 || (x == 6 && j >= 24))))) return false;
        pg8::Unit t; S.tile_seq(i == 0 ? 32 * x + j : 256 + (x == 7 ? j : 8 + j), t); t.k0 = 0; t.nt = S.ntk; t.kind = 0; t.slab = 0;
        u = t; return true;
    }
    __device__ __forceinline__ void a_ready(const pg8::Unit& u) const { if (dep && rdy) panel_wait(rdy, tmo, seen, u.pm); }
    __device__ __forceinline__ void done(const pg8::Unit&) const {}
};
struct GuOrder {
    pg8::StaticOrder S; int dep; const unsigned* rdy; unsigned* tmo; mutable unsigned long long seen;
    __device__ __forceinline__ void init(int M, int N, int G, int c, int K, const unsigned* rdy_, unsigned* tmo_) { S.init(M, N, G, c, K); dep = (G == 256 && S.nM == 37 && S.nN == 44 && pg8::WGM == 8) ? 1 : 0; rdy = rdy_; tmo = tmo_; seen = 0ull; }
    __device__ __forceinline__ bool next(int i, pg8::Unit& u) const {
        if (!dep) return S.next(i, u);
        const int x = S.c & 7, j = S.c >> 3, lp = 32 * i + j, st = x < 3 ? 224 * x : 668 + 192 * (x - 3), nx = x < 2 ? 224 : (x == 2 ? 220 : 192);
        if (lp >= nx) return false;
        pg8::Unit t; S.tile_seq(st + lp, t); t.k0 = 0; t.nt = S.ntk; t.kind = 0; t.slab = 0;
        u = t; return true;
    }
    __device__ __forceinline__ void a_ready(const pg8::Unit& u) const { if (dep) panel_wait(rdy, tmo, seen, u.pm); }
    __device__ __forceinline__ void done(const pg8::Unit&) const {}
};

struct Args { const float* in[24]; float* out; unsigned char* ws; int l_lo, l_hi, ph_lo, ph_hi, do_pro, do_fin, use_bar, pad; };
enum { I_XP = 0, I_XS, I_SCONV, I_SSSM, I_SHG, I_SRET, I_META, I_NMIX, I_WIN, I_CONVW, I_CONVB, I_DTB, I_ALOG, I_DSKIP, I_SSDN, I_HGLOW, I_HGN, I_WBR, I_WOUT, I_NFFN, I_WG, I_WU, I_WD, I_NFIN };

typedef const __attribute__((address_space(4))) Args* ArgsP;
#define AREF const __attribute__((address_space(4))) Args&
struct Ctx {
    LAS unsigned char* lds; int tid, lane, wave, vcu, G;
    ArgsP a; unsigned char* ws;
};

template <class F> __device__ __forceinline__ void tr_item(const float* W, int ldw, bf16* WT, int K, int k0, int n0, LAS float* scr, int lane, F srccol, const float* kscale = nullptr) {
    const int sc = srccol(n0 + (lane & 31));
#pragma unroll
    for (int i = 0; i < 32; ++i) { const int kk = 2 * i + (lane >> 5); scr[kk * 33 + (lane & 31)] = __builtin_nontemporal_load(W + (size_t)(k0 + kk) * ldw + sc); }
    LDS_WAIT(); asm volatile("" ::: "memory");
    const int c = lane & 7;
    f32x4 g0 = (f32x4){1.f, 1.f, 1.f, 1.f}, g1 = g0;
    if (kscale) { g0 = *(const f32x4*)(kscale + k0 + 8 * c); g1 = *(const f32x4*)(kscale + k0 + 8 * c + 4); }
#pragma unroll
    for (int j = 0; j < 4; ++j) { const int n = (lane >> 3) + 8 * j; const LAS float* s = scr + (8 * c) * 33 + n;
        v4u o; o.x = pk2(s[0 * 33] * g0[0], s[1 * 33] * g0[1]); o.y = pk2(s[2 * 33] * g0[2], s[3 * 33] * g0[3]); o.z = pk2(s[4 * 33] * g1[0], s[5 * 33] * g1[1]); o.w = pk2(s[6 * 33] * g1[2], s[7 * 33] * g1[3]);
        *(v4u*)(WT + (size_t)(n0 + n) * K + k0 + 8 * c) = o; }
    LDS_WAIT(); asm volatile("" ::: "memory");
}
__device__ __forceinline__ int win_src(int n) {
    if (n >= 6656 && n < 7680) { const int p = n & 63, j = p >> 3, nn = (p >> 2) & 1, e = p & 3; n = (n & ~63) + 32 * nn + 4 * j + e; }
    return n < 2560 ? n : n + 16;
}
__device__ __forceinline__ int ret_dim(int p) { return 32 * ((p >> 2) & 1) + 4 * (p >> 3) + (p & 3); }

__device__ __forceinline__ void p0_prologue(const Ctx& C) {
    AREF A = *C.a; unsigned char* ws = C.ws;
    LAS float* scr = (LAS float*)(C.lds + C.wave * 16384);
    const int gw = C.vcu * NWAVES + C.wave, NGW = C.G * NWAVES;
    constexpr int I_IN = 32 * 496, I_BR = 3 * 16 * 64, I_OUT = 32 * 64, I_GU = 32 * 352, I_DN = 88 * 64, I_L = I_IN + I_BR + I_OUT + I_GU + I_DN;
    for (int it = gw; it < NL * I_L; it += NGW) {
        const int l = it / I_L; int r = it - l * I_L; unsigned char* lw = ws + WS_W + (size_t)l * LW_SIZE;
        if (r < I_IN) { const int kb = r / 496, nb = r - kb * 496; tr_item(A.in[I_WIN] + (size_t)l * D * INCOLS, INCOLS, (bf16*)(lw + LW_IN), D, 64 * kb, 32 * nb, scr, C.lane, [](int n) { return win_src(n); }, A.in[I_NMIX] + (size_t)l * D); continue; } r -= I_IN;
        if (r < I_BR) { const int c = r / 1024, rr = r - c * 1024, kb = rr / 64, nb = rr - kb * 64;
            tr_item(A.in[I_WBR] + ((size_t)l * 3 + c) * 1024 * D, D, (bf16*)(lw + LW_BR) + (size_t)c * D * 1024, 1024, 64 * kb, 32 * nb, scr, C.lane, [](int n) { return n; }); continue; } r -= I_BR;
        if (r < I_OUT) { const int kb = r / 64, nb = r - kb * 64; tr_item(A.in[I_WOUT] + (size_t)l * D * D, D, (bf16*)(lw + LW_OUT), D, 64 * kb, 32 * nb, scr, C.lane, [](int n) { return n; }); continue; } r -= I_OUT;
        if (r < I_GU) { const int kb = r / 352, nb = r - kb * 352, n0 = 32 * nb, t = n0 >> 8, w = n0 & 255; const float* src = (w < 128 ? A.in[I_WG] : A.in[I_WU]) + (size_t)l * D * FFN; const int sbase = 128 * t + (w & 127) - n0;
            tr_item(src, FFN, (bf16*)(lw + LW_GU), D, 64 * kb, n0, scr, C.lane, [sbase](int n) { return n + sbase; }, A.in[I_NFFN] + (size_t)l * D); continue; } r -= I_GU;
        { const int kb = r / 64, nb = r - kb * 64; tr_item(A.in[I_WD] + (size_t)l * FFN * D, D, (bf16*)(lw + LW_DN), FFN, 64 * kb, 32 * nb, scr, C.lane, [](int n) { return n; }); }
    }
    const int gt = C.vcu * NTHR + C.tid, NGT = C.G * NTHR;
    for (int i = gt; i < NL * 16 * D; i += NGT) { const int l = i / (16 * D), r = i - l * 16 * D, h = r / D, k = r - h * D;
        ((bf16*)(ws + WS_W + (size_t)l * LW_SIZE + LW_DT))[r] = (bf16)f2bf(A.in[I_NMIX][l * D + k] * A.in[I_WIN][((size_t)l * D + k) * INCOLS + 2560 + h]); }
    for (int m = gw; m < MP; m += NGW) {
        const float* src = nullptr;
        if (m >= NNULL && m < ROW_P0) src = A.in[I_META] + (size_t)(m - NNULL) * D;
        else if (m >= ROW_P0 && m < ROW_S0) src = A.in[I_XP] + (size_t)(m - ROW_P0) * D;
        else if (m >= ROW_S0 && m < MR) src = A.in[I_XS] + (size_t)(m - ROW_S0) * D;
        v2u* dst = (v2u*)(ws + WS_X + (size_t)m * D * 2) + C.lane; float s = 0.f;
#pragma unroll
        for (int j = 0; j < 8; ++j) { const f32x4 v = src ? ((const f32x4*)src)[C.lane + 64 * j] : (f32x4){0.f, 0.f, 0.f, 0.f}; dst[64 * j] = pk4(v); s += (v[0] * v[0] + v[1] * v[1]) + (v[2] * v[2] + v[3] * v[3]); }
        s = wave_sum(s); if (C.lane == 0) ((u64*)((unsigned*)(ws + WS_CTL) + CW_RS))[m] = ss_to_fix(s);
    }
    for (int i = gt; i < MP * 32; i += NGT) {
        const int row = i >> 5, fi = i & 31;
        const int pos = row < ROW_S0 ? row - ROW_P0 : (row < MR ? 1024 + ((row - ROW_S0) & 63) : 0);
        const double inv = exp(-(double)fi * (9.210340371976184 / 32.0));
        const double ang = (double)pos * inv, n = rint(ang * 0.15915494309189535), r = fma(-n, 6.283185307179586, ang) - n * 2.4492935982947064e-16;
        const double r2 = r * r; double s = 0.0, c = 0.0;
#pragma unroll
        for (int k = 14; k >= 1; --k) { s = (s + 1.0) * (-r2 / (double)((2 * k) * (2 * k + 1))); c = (c + 1.0) * (-r2 / (double)((2 * k - 1) * (2 * k))); }
        ((f32x2*)(ws + WS_ROPE))[i] = (f32x2){(float)(c + 1.0), (float)((s + 1.0) * r)};
    }
    for (int i = gt; i < 1024; i += NGT) {
        const float* hl = A.in[I_HGLOW]; const float v0 = hl[i], v1 = hl[1024 + i], v2 = hl[2048 + i], v3 = hl[3072 + i], mx = fmaxf(fmaxf(v0, v1), fmaxf(v2, v3));
        const float e0 = expf(v0 - mx), e1 = expf(v1 - mx), e2 = expf(v2 - mx), e3 = expf(v3 - mx), inv = 1.0f / (e0 + e1 + e2 + e3);
        float* lb = (float*)(ws + WS_LBS); lb[i] = 0.f; lb[1024 + i] = e1 * inv; lb[2048 + i] = (e1 + e2) * inv; lb[3072 + i] = (e1 + e2 + e3) * inv;
    }
    for (int i = gt; i < 3 * (MP - MR) * 1024 / 8; i += NGT) { const int c = i / ((MP - MR) * 128), r = i - c * (MP - MR) * 128;
        ((v4u*)(ws + WS_BR + ((size_t)c * MP + MR) * 1024 * 2))[r] = (v4u){0u, 0u, 0u, 0u}; }
}

__device__ __forceinline__ float softplusf(float v) { return v > 20.0f ? v : log1pf(expf(v)); }
__device__ __forceinline__ void dt_rows(const Ctx& C, int l) {
    AREF A = *C.a; unsigned char* ws = C.ws; const int tid = C.tid, lane = C.lane, w = C.wave, l15 = lane & 15, l4 = lane >> 4;
    LAS float* DTP = (LAS float*)C.lds;
    const int rbase = 37 * C.vcu; const bf16* X = (const bf16*)(ws + WS_X); const bf16* WDT = (const bf16*)(ws + WS_W + (size_t)l * LW_SIZE + LW_DT);
    f32x4 acc[3];
#pragma unroll
    for (int rb = 0; rb < 3; ++rb) acc[rb] = (f32x4){0.f, 0.f, 0.f, 0.f};
#pragma unroll 2
    for (int ks = 0; ks < 8; ++ks) {
        const int ko = 256 * w + 32 * ks + 8 * l4;
        const bf16x8 bf = *(const bf16x8*)(WDT + (size_t)l15 * D + ko);
#pragma unroll
        for (int rb = 0; rb < 3; ++rb) { int row = rbase + 16 * rb + l15; row = row < MP ? row : MP - 1; acc[rb] = mfma16(*(const bf16x8*)(X + (size_t)row * D + ko), bf, acc[rb]); }
    }
#pragma unroll
    for (int rb = 0; rb < 3; ++rb)
#pragma unroll
        for (int e = 0; e < 4; ++e) DTP[(w * 48 + 16 * rb + 4 * l4 + e) * 16 + l15] = acc[rb][e];
    LBAR();
    const u64* RS = (const u64*)((const unsigned*)(ws + WS_CTL) + CW_RS) + (size_t)(2 * l) * MP;
    for (int i = tid; i < 37 * 16; i += NTHR) { const int r = i >> 4, hd = i & 15, m = rbase + r;
        if (m < MR) { float raw = 0.f;
#pragma unroll
            for (int ww = 0; ww < 8; ++ww) raw += DTP[(ww * 48 + r) * 16 + hd];
            float dt = softplusf(raw * rs_to_rstd(RS[m]) + A.in[I_DTB][l * 16 + hd]); if (m < NNULL) dt = 0.f;
            ((float*)(ws + WS_DT))[(size_t)m * 16 + hd] = dt; ((float*)(ws + WS_AV))[(size_t)m * 16 + hd] = -dt * expf(A.in[I_ALOG][l * 16 + hd]); } }
}
__device__ __forceinline__ void final_phase(const Ctx& C, const bf16* X, const float* gain, float* out) {
    const int gw = C.vcu * NWAVES + C.wave, NGW = C.G * NWAVES;
    f32x4 gn[8];
#pragma unroll
    for (int j = 0; j < 8; ++j) gn[j] = ((const f32x4*)gain)[C.lane + 64 * j];
    for (int m = ROW_P0 + gw; m < MR; m += NGW) {
        const v2u* xr = (const v2u*)(X + (size_t)m * D) + C.lane;
        f32x4 v[8]; float s = 0.f;
#pragma unroll
        for (int j = 0; j < 8; ++j) { v[j] = unpk4(xr[64 * j]); s += (v[j][0] * v[j][0] + v[j][1] * v[j][1]) + (v[j][2] * v[j][2] + v[j][3] * v[j][3]); }
        const float rs = rsqrtf(wave_sum(s) * (1.0f / D) + EPS);
        f32x4* o = (f32x4*)(out + (m < ROW_S0 ? O_YP + (size_t)(m - ROW_P0) * D : O_YS + (size_t)(m - ROW_S0) * D)) + C.lane;
#pragma unroll
        for (int j = 0; j < 8; ++j) o[64 * j] = v[j] * rs * gn[j];
    }
}

__device__ __forceinline__ bf16x8 ldsfrag(const LAS unsigned char* base, int row, int pitchB, int kel) { return *(const LAS bf16x8*)(base + row * pitchB + kel * 2); }
__device__ __forceinline__ float ret_lgam(int h) { return log1pf(-exp2f(-5.0f - (float)h)); }
struct ConvSrc {
    const bf16* XBC; const float* sconv; int c, r0;
    __device__ __forceinline__ float at(int t, int ch) const {
        if (t >= 0) return bf2f(XBC[(size_t)(r0 + t) * 1536 + ch]);
        if (c == 0) return 0.f;
        if (c < NCHP) return bf2f(XBC[(size_t)(r0 + t) * 1536 + ch]);
        return sconv[((size_t)(c - NCHP) * 3 + (3 + t)) * 1536 + ch];
    }
};

__device__ __forceinline__ void m1_ssd(const Ctx& C, int l, int c, int g, int skip = 0) {
    AREF A = *C.a; unsigned char* ws = C.ws; const int tid = C.tid, lane = C.lane, w = C.wave, r0 = 64 * c;
    LAS unsigned char* XT = C.lds; LAS unsigned char* BT = C.lds + 73728;
    LAS float* SDT = (LAS float*)(C.lds + 92160); LAS float* SCUM = (LAS float*)(C.lds + 94208);
    const int l15 = lane & 15, l4 = lane >> 4;
    const ConvSrc cs{(const bf16*)(ws + WS_XBC), A.in[I_SCONV] + (size_t)l * 16 * 3 * 1536, c, r0};
    const float* cw = A.in[I_CONVW] + (size_t)l * 4 * 1536; const float* cb = A.in[I_CONVB] + (size_t)l * 1536;
    LAS unsigned char* RX = C.lds; LAS unsigned char* RBC = C.lds + 96256;
    const int chx = 512 * g + tid;
    {   const bf16* XBC = (const bf16*)(ws + WS_XBC); const float* sc = A.in[I_SCONV] + (size_t)l * 16 * 3 * 1536 + (size_t)(c >= NCHP ? c - NCHP : 0) * 3 * 1536;
#pragma unroll
        for (int q = 0; q < 9; ++q) { const int chn = tid + 512 * q; if (chn < 67 * 64) { const int row = chn >> 6, c16 = chn & 63, t = row - 3, col = 512 * g + 8 * c16; v4u v = (v4u){0u, 0u, 0u, 0u};
                if (t >= 0 || (c > 0 && c < NCHP)) v = *(const v4u*)(XBC + (size_t)(r0 + t) * 1536 + col);
                else if (c >= NCHP) { const f32x4 a = *(const f32x4*)(sc + (3 + t) * 1536 + col), b = *(const f32x4*)(sc + (3 + t) * 1536 + col + 4); v.x = pk2(a[0], a[1]); v.y = pk2(a[2], a[3]); v.z = pk2(b[0], b[1]); v.w = pk2(b[2], b[3]); }
                *(LAS v4u*)(RX + row * 1040 + c16 * 16) = v; } }
#pragma unroll
        for (int q = 0; q < 5; ++q) { const int chn = tid + 512 * q; if (chn < 67 * 32) { const int row = chn >> 5, c16 = chn & 31, t = row - 3, col = (c16 < 16 ? 1024 + 128 * g : 1280 + 128 * g - 128) + 8 * c16; v4u v = (v4u){0u, 0u, 0u, 0u};
                if (t >= 0 || (c > 0 && c < NCHP)) v = *(const v4u*)(XBC + (size_t)(r0 + t) * 1536 + col);
                else if (c >= NCHP) { const f32x4 a = *(const f32x4*)(sc + (3 + t) * 1536 + col), b = *(const f32x4*)(sc + (3 + t) * 1536 + col + 4); v.x = pk2(a[0], a[1]); v.y = pk2(a[2], a[3]); v.z = pk2(b[0], b[1]); v.w = pk2(b[2], b[3]); }
                *(LAS v4u*)(RBC + row * 528 + c16 * 16) = v; } }
    }
    const float xw0 = cw[chx], xw1 = cw[1536 + chx], xw2 = cw[2 * 1536 + chx], xw3 = cw[3 * 1536 + chx], xbias = cb[chx];
    {
        const int hd = 8 * g + w; const float dt = ((const float*)(ws + WS_DT))[(r0 + lane) * 16 + hd]; float v = ((const float*)(ws + WS_AV))[(r0 + lane) * 16 + hd];
#pragma unroll
        for (int o = 1; o < 64; o <<= 1) { const float t = __shfl_up(v, o); if (lane >= o) v += t; }
        SDT[lane * 8 + w] = dt; SCUM[lane * 8 + w] = v; ((float*)(ws + WS_CUM))[(r0 + lane) * 16 + hd] = v;
        if (lane == 63) ((float*)(ws + WS_GAM))[(size_t)c * GAM_N + hd] = expf(v);
    }
    LBAR();
    float raw[67];
#pragma unroll
    for (int t = 0; t < 67; ++t) raw[t] = bf2f(*(const LAS bf16*)(RX + t * 1040 + tid * 2));
    LBAR();
    if (!(skip & 1)) {
        const int hh = tid >> 6; const float clast = SCUM[63 * 8 + hh];
        bf16* xg = (bf16*)(ws + WS_XTG) + ((size_t)c * 1024 + chx) * 64;
#pragma unroll
        for (int t0 = 0; t0 < 64; t0 += 8) {
            float val[8], vw[8];
#pragma unroll
            for (int tt = 0; tt < 8; ++tt) { const int t = t0 + tt; val[tt] = fsilu(xbias + xw0 * raw[t] + xw1 * raw[t + 1] + xw2 * raw[t + 2] + xw3 * raw[t + 3]);
                vw[tt] = val[tt] * (__expf(clast - SCUM[t * 8 + hh]) * SDT[t * 8 + hh]); }
            v4u o; o.x = pk2(val[0], val[1]); o.y = pk2(val[2], val[3]); o.z = pk2(val[4], val[5]); o.w = pk2(val[6], val[7]); *(v4u*)(xg + t0) = o;
            o.x = pk2(vw[0], vw[1]); o.y = pk2(vw[2], vw[3]); o.z = pk2(vw[4], vw[5]); o.w = pk2(vw[6], vw[7]); *(LAS v4u*)(XT + tid * 144 + t0 * 2) = o;
        }
    }
    if (!(skip & 2)) {
        const int col = tid & 255, seg = tid >> 8, t0 = 32 * seg, ch = col < 128 ? 1024 + 128 * g + col : 1280 + 128 * g + (col - 128);
        const float w0 = cw[ch], w1 = cw[1536 + ch], w2 = cw[2 * 1536 + ch], w3 = cw[3 * 1536 + ch], bias = cb[ch];
        float rb[35];
#pragma unroll
        for (int t = 0; t < 35; ++t) rb[t] = bf2f(*(const LAS bf16*)(RBC + (t0 + t) * 528 + col * 2));
        bf16* bg = (bf16*)(ws + WS_BCG) + (size_t)(r0 + t0) * 512 + 256 * g + col;
#pragma unroll
        for (int t8 = 0; t8 < 32; t8 += 8) { float val[8];
#pragma unroll
            for (int tt = 0; tt < 8; ++tt) { const int t = t8 + tt; val[tt] = fsilu(bias + w0 * rb[t] + w1 * rb[t + 1] + w2 * rb[t + 2] + w3 * rb[t + 3]); bg[(unsigned)(t * 512)] = (bf16)f2bf(val[tt]); }
            if (col < 128) { v4u o; o.x = pk2(val[0], val[1]); o.y = pk2(val[2], val[3]); o.z = pk2(val[4], val[5]); o.w = pk2(val[6], val[7]); *(LAS v4u*)(BT + col * 144 + (t0 + t8) * 2) = o; } }
    }
    LBAR();
    if (!(skip & 4)) {
        const int hd = 8 * g + w; bf16* U = (bf16*)(ws + WS_U) + (size_t)c * STATE_N + ST_SSD + (size_t)hd * 8192;
#pragma unroll 1
        for (int pi = 0; pi < 4; ++pi) {
            const bf16x8 a0 = ldsfrag(XT, 64 * w + 16 * pi + l15, 144, 8 * l4), a1 = ldsfrag(XT, 64 * w + 16 * pi + l15, 144, 32 + 8 * l4);
#pragma unroll
            for (int nj = 0; nj < 8; ++nj) {
                f32x4 acc = (f32x4){0.f, 0.f, 0.f, 0.f};
                acc = mfma16(ldsfrag(BT, 16 * nj + l15, 144, 8 * l4), a0, acc); acc = mfma16(ldsfrag(BT, 16 * nj + l15, 144, 32 + 8 * l4), a1, acc);
                *(v2u*)(U + (16 * pi + l15) * 128 + 16 * nj + 4 * l4) = pk4(acc);
            }
        }
    }
}

__device__ __forceinline__ void m1_hg(const Ctx& C, int l, int c, int h) {
    unsigned char* ws = C.ws; const int tid = C.tid, lane = C.lane, w = C.wave, r0 = 64 * c, l15 = lane & 15, l4 = lane >> 4;
    LAS unsigned char* KT = C.lds; LAS unsigned char* VT = C.lds + 18432; LAS float* SEG = (LAS float*)(C.lds + 36864);
    const int col = tid & 127, seg = tid >> 7;
    {
        LAS unsigned char* RAW = C.lds + 40960;
        const bf16* src0 = (const bf16*)(ws + WS_LG); const bf16* src1 = (const bf16*)(ws + WS_KK); const bf16* src2 = (const bf16*)(ws + WS_HV);
#pragma unroll
        for (int q = 0; q < 6; ++q) { const int chn = tid + 512 * q, arr = chn >> 10, rem = chn & 1023, row = rem >> 4, c16 = rem & 15;
            const bf16* s = (arr == 0 ? src0 : (arr == 1 ? src1 : src2)) + (size_t)(r0 + row) * 1024 + 128 * h + 8 * c16;
            *(LAS v4u*)(RAW + arr * 17408 + row * 272 + c16 * 16) = *(const v4u*)s; }
        LBAR();
    }
    float cum[16], kk[16], vv[16];
#pragma unroll
    for (int i = 0; i < 16; ++i) { const LAS unsigned char* p = C.lds + 40960 + (16 * seg + i) * 272 + col * 2; cum[i] = bf2f(*(const LAS bf16*)p); kk[i] = bf2f(*(const LAS bf16*)(p + 17408)); vv[i] = bf2f(*(const LAS bf16*)(p + 34816)); }
#pragma unroll
    for (int i = 1; i < 16; ++i) cum[i] += cum[i - 1];
    SEG[seg * 128 + col] = cum[15];
    LBAR();
    float off = 0.f, tot = 0.f;
#pragma unroll
    for (int s = 0; s < 4; ++s) { const float t = SEG[s * 128 + col]; tot += t; if (s < seg) off += t; }
#pragma unroll
    for (int i = 0; i < 16; ++i) kk[i] *= __expf(tot - (cum[i] + off));
    { v4u o; o.x = pk2(kk[0], kk[1]); o.y = pk2(kk[2], kk[3]); o.z = pk2(kk[4], kk[5]); o.w = pk2(kk[6], kk[7]); *(LAS v4u*)(KT + col * 144 + seg * 32) = o;
      o.x = pk2(kk[8], kk[9]); o.y = pk2(kk[10], kk[11]); o.z = pk2(kk[12], kk[13]); o.w = pk2(kk[14], kk[15]); *(LAS v4u*)(KT + col * 144 + seg * 32 + 16) = o;
      o.x = pk2(vv[0], vv[1]); o.y = pk2(vv[2], vv[3]); o.z = pk2(vv[4], vv[5]); o.w = pk2(vv[6], vv[7]); *(LAS v4u*)(VT + col * 144 + seg * 32) = o;
      o.x = pk2(vv[8], vv[9]); o.y = pk2(vv[10], vv[11]); o.z = pk2(vv[12], vv[13]); o.w = pk2(vv[14], vv[15]); *(LAS v4u*)(VT + col * 144 + seg * 32 + 16) = o; }
    if (seg == 0) ((float*)(ws + WS_GAM))[(size_t)c * GAM_N + 16 + 128 * h + col] = expf(tot);
    LBAR();
    {
        bf16* U = (bf16*)(ws + WS_U) + (size_t)c * STATE_N + ST_HG + (size_t)h * 16384;
        const bf16x8 a0 = ldsfrag(VT, 16 * w + l15, 144, 8 * l4), a1 = ldsfrag(VT, 16 * w + l15, 144, 32 + 8 * l4);
        const bool nat = c >= NCHP;
#pragma unroll
        for (int kj = 0; kj < 8; ++kj) {
            f32x4 acc = (f32x4){0.f, 0.f, 0.f, 0.f}; const bf16x8 k0 = ldsfrag(KT, 16 * kj + l15, 144, 8 * l4), k1 = ldsfrag(KT, 16 * kj + l15, 144, 32 + 8 * l4);
            if (!nat) { acc = mfma16(k0, a0, acc); acc = mfma16(k1, a1, acc); *(v2u*)(U + (16 * w + l15) * 128 + 16 * kj + 4 * l4) = pk4(acc); }
            else { acc = mfma16(a0, k0, acc); acc = mfma16(a1, k1, acc); *(v2u*)(U + (16 * kj + l15) * 128 + 16 * w + 4 * l4) = pk4(acc); }
        }
    }
}

__device__ __forceinline__ void m1_ret(const Ctx& C, int l, int c, int h) {
    unsigned char* ws = C.ws; const int tid = C.tid, lane = C.lane, w = C.wave, r0 = 64 * c, l15 = lane & 15, l4 = lane >> 4;
    LAS unsigned char* KT = C.lds; LAS unsigned char* VT = C.lds + 9216;
    const float lg = ret_lgam(h);
    {   const int kp = tid & 63, s8 = tid >> 6; const bf16* RK = (const bf16*)(ws + WS_RK) + (size_t)(r0 + 8 * s8) * 512 + 64 * h + kp; float v[8];
#pragma unroll
        for (int i = 0; i < 8; ++i) v[i] = bf2f(RK[(size_t)i * 512]) * __expf((float)(63 - (8 * s8 + i)) * lg);
        v4u o; o.x = pk2(v[0], v[1]); o.y = pk2(v[2], v[3]); o.z = pk2(v[4], v[5]); o.w = pk2(v[6], v[7]); *(LAS v4u*)(KT + kp * 144 + s8 * 16) = o; }
    {   const int col = tid & 127, seg = tid >> 7; const bf16* RV = (const bf16*)(ws + WS_RV) + (size_t)(r0 + 16 * seg) * 1024 + 128 * h + col; float vv[16];
#pragma unroll
        for (int i = 0; i < 16; ++i) vv[i] = bf2f(RV[(size_t)i * 1024]);
        v4u o; o.x = pk2(vv[0], vv[1]); o.y = pk2(vv[2], vv[3]); o.z = pk2(vv[4], vv[5]); o.w = pk2(vv[6], vv[7]); *(LAS v4u*)(VT + col * 144 + seg * 32) = o;
        o.x = pk2(vv[8], vv[9]); o.y = pk2(vv[10], vv[11]); o.z = pk2(vv[12], vv[13]); o.w = pk2(vv[14], vv[15]); *(LAS v4u*)(VT + col * 144 + seg * 32 + 16) = o; }
    LBAR();
    {   bf16* U = (bf16*)(ws + WS_U) + (size_t)c * STATE_N + ST_RET + (size_t)h * 8192;
        const bf16x8 a0 = ldsfrag(VT, 16 * w + l15, 144, 8 * l4), a1 = ldsfrag(VT, 16 * w + l15, 144, 32 + 8 * l4);
        const bool nat = c >= NCHP;
#pragma unroll
        for (int kj = 0; kj < 4; ++kj) {
            f32x4 acc = (f32x4){0.f, 0.f, 0.f, 0.f}; const bf16x8 k0 = ldsfrag(KT, 16 * kj + l15, 144, 8 * l4), k1 = ldsfrag(KT, 16 * kj + l15, 144, 32 + 8 * l4);
            if (!nat) { acc = mfma16(k0, a0, acc); acc = mfma16(k1, a1, acc); *(v2u*)(U + (16 * w + l15) * 64 + 16 * kj + 4 * l4) = pk4(acc); }
            else { acc = mfma16(a0, k0, acc); acc = mfma16(a1, k1, acc); *(v2u*)(U + (16 * kj + l15) * 128 + 16 * w + 4 * l4) = pk4(acc); }
        }
    }
}

#ifndef PROBE_SKIP
#define PROBE_SKIP 0
#endif
#ifndef REPI_M1_SSD
#define REPI_M1_SSD 1
#endif
#ifndef REPI_M1_HG
#define REPI_M1_HG 1
#endif
#ifndef REPI_M1_RET
#define REPI_M1_RET 1
#endif
__device__ __forceinline__ unsigned m1_prefetch(const Ctx& C, int l, int it) {
    constexpr int N_SSD = NCH * 2, N_HG = NCH * 8; unsigned char* ws = C.ws; const int tid = C.tid; unsigned pf = 0;
    if (it < N_SSD) { const int c = it >> 1, g = it & 1, r0 = 64 * c; const bf16* XBC = (const bf16*)(ws + WS_XBC);
#pragma unroll
        for (int q = 0; q < 2; ++q) { const int s = tid + 512 * q; if (s < 768) { const int row = s / 12, p = s - 12 * row; const int col = p < 8 ? 512 * g + 64 * p : (p < 10 ? 1024 + 128 * g + 64 * (p - 8) : 1280 + 128 * g + 64 * (p - 10));
            pf ^= *(const unsigned*)(XBC + (size_t)(r0 + row) * 1536 + col); } } }
    else if (it < N_SSD + N_HG) { const int j = it - N_SSD, c = j >> 3, h = j & 7, row = tid >> 3, p = tid & 7; const size_t b = (size_t)(64 * c + row) * 1024 + 128 * h;
        if (p < 4) pf ^= *(const unsigned*)((const bf16*)(ws + WS_LG) + b + 32 * p); else if (p < 6) pf ^= *(const unsigned*)((const bf16*)(ws + WS_KK) + b + 64 * (p - 4)); else pf ^= *(const unsigned*)((const bf16*)(ws + WS_HV) + b + 64 * (p - 6)); }
    else { const int j = it - N_SSD - N_HG, c = j >> 3, h = j & 7; if (tid < 192) { const int row = tid / 3, p = tid - 3 * row;
            if (p == 0) pf ^= *(const unsigned*)((const bf16*)(ws + WS_RK) + (size_t)(64 * c + row) * 512 + 64 * h); else pf ^= *(const unsigned*)((const bf16*)(ws + WS_RV) + (size_t)(64 * c + row) * 1024 + 128 * h + 64 * (p - 1)); } }
    return pf;
}
__device__ __forceinline__ void m1_phase(const Ctx& C0, int l, int mask = 7) {
    constexpr int N_SSD = NCH * 2, N_HG = NCH * 8, N_IT = NCH * 18;
    unsigned* cnt = (unsigned*)(C0.ws + WS_CTL) + CW_QUEUE + 64 * (l * 8 + 0 * 4 + (mask == 7 ? 0 : 1));
    volatile LAS int* slot = (volatile LAS int*)(C0.lds + LDSCTL_OFF + 64);
    int n2 = 0;
    if (C0.tid == 0) { slot[0] = (int)__hip_atomic_fetch_add(cnt, 1u, __ATOMIC_RELAXED, __HIP_MEMORY_SCOPE_AGENT); slot[1] = (int)__hip_atomic_fetch_add(cnt, 1u, __ATOMIC_RELAXED, __HIP_MEMORY_SCOPE_AGENT); }
    LBAR();
    int it = slot[0], nx = slot[1];
    LBAR();
    while (it < N_IT) {
        if (C0.tid == 0) n2 = (int)__hip_atomic_fetch_add(cnt, 1u, __ATOMIC_RELAXED, __HIP_MEMORY_SCOPE_AGENT);
        Ctx C = C0; { int t_ = C0.tid; asm volatile("" : "+v"(t_)); C.tid = t_; C.lane = t_ & 63; C.wave = __builtin_amdgcn_readfirstlane(t_ >> 6); }
        unsigned pf = 0; if (MK_PREFETCH && nx < N_IT && mask == 7) pf = m1_prefetch(C, l, nx);
        if (it < N_SSD) { if (mask & 1) m1_ssd(C, l, it >> 1, it & 1, mask == 7 ? 0 : PROBE_SKIP); }
        else if (it < N_SSD + N_HG) { if (mask & 2) { const int j = it - N_SSD; m1_hg(C, l, j >> 3, j & 7); } }
        else { if (mask & 4) { const int j = it - N_SSD - N_HG; m1_ret(C, l, j >> 3, j & 7); } }
        if (pf == 0x7fc1abcdu) ((unsigned*)(C0.ws + WS_CTL))[16] = pf;
        LBAR();
        if (C0.tid == 0) slot[0] = n2;
        LBAR();
        it = nx; nx = slot[0];
    }
}

struct StIdx { int kind, h; size_t outoff; int ostride; };
__device__ __forceinline__ void m2_elem(int idx, int& kind, int& h, int& o0, int& ostr) {
    if (idx < ST_HG) { kind = 0; h = idx >> 13; o0 = idx; ostr = 1; }
    else if (idx < ST_RET) { const int r = idx - ST_HG; kind = 1; h = r >> 14; const int v = (r >> 7) & 127, k = r & 127; o0 = h * 16384 + k * 128 + v; ostr = 128; }
    else { const int r = idx - ST_RET; kind = 2; h = r >> 13; const int v = (r >> 6) & 127, kp = r & 63; o0 = h * 8192 + ret_dim(kp) * 128 + v; ostr = 128; }
}
__device__ __forceinline__ void m2_sample_item(AREF A, unsigned char* ws, int l, int j) {
    float* out = A.out; const bf16* U = (const bf16*)(ws + WS_U); const float* GAM = (const float*)(ws + WS_GAM);
    const int b = j / (STATE_N / 4), idx = 4 * (j - b * (STATE_N / 4)), c = NCHP + b;
    const f32x4 u = unpk4(*(const v2u*)(U + (size_t)c * STATE_N + idx));
    if (idx < ST_HG) { const int h = idx >> 13; const size_t o = ((size_t)l * 16 + b) * 131072 + idx; const float t = GAM[(size_t)c * GAM_N + h];
        *(f32x4*)(out + O_SSMS + o) = *(const f32x4*)(A.in[I_SSSM] + o) * t + u; }
    else if (idx < ST_RET) { const int r = idx - ST_HG, h = r >> 14, k = (r >> 7) & 127; const size_t o = ((size_t)l * 16 + b) * 131072 + r; const float t = GAM[(size_t)c * GAM_N + 16 + 128 * h + k];
        *(f32x4*)(out + O_HGS + o) = *(const f32x4*)(A.in[I_SHG] + o) * t + u; }
    else { const int r = idx - ST_RET, h = r >> 13, kp = (r >> 7) & 63, v = r & 127; const size_t o = ((size_t)l * 16 + b) * 65536 + h * 8192 + ret_dim(kp) * 128 + v; const float t = expf(64.0f * ret_lgam(h));
        *(f32x4*)(out + O_RETS + o) = *(const f32x4*)(A.in[I_SRET] + o) * t + u; }
}
__device__ __forceinline__ void m2_phase(const Ctx& C, int l) {
    AREF A = *C.a; unsigned char* ws = C.ws; float* out = A.out;
    const bf16* U = (const bf16*)(ws + WS_U); const float* GAM = (const float*)(ws + WS_GAM); bf16* SB = (bf16*)(ws + WS_SB);
    constexpr int CT = 320, ST = NTHR - CT, NSI = 16 * (STATE_N / 4);
    if (C.tid < CT) {
      for (int e4 = C.vcu * CT + C.tid; e4 < STATE_N / 4; e4 += C.G * CT) {
        const int idx = 4 * e4; int kind, h, o0, ostr; m2_elem(idx, kind, h, o0, ostr);
        const float gret = expf(64.0f * ret_lgam(h));
        const int goff = kind == 0 ? h : 16 + 128 * h + (idx & 127);
        f32x4 S = (f32x4){0.f, 0.f, 0.f, 0.f};
        const bf16* up = U + idx; const float* gp = GAM + goff; bf16* sp = SB + idx;
#pragma unroll 1
        for (int c0 = 0; c0 < 128; c0 += 16) {
            v2u u[16]; f32x4 gm[16];
#pragma unroll
            for (int q = 0; q < 16; ++q) { u[q] = *(const v2u*)(up + (size_t)(c0 + q) * STATE_N);
                if (kind == 0) { const float t = gp[(size_t)(c0 + q) * GAM_N]; gm[q] = (f32x4){t, t, t, t}; }
                else if (kind == 1) gm[q] = *(const f32x4*)(gp + (size_t)(c0 + q) * GAM_N);
                else gm[q] = (f32x4){gret, gret, gret, gret}; }
#pragma unroll
            for (int q = 0; q < 16; ++q) { *(v2u*)(sp + (size_t)(c0 + q) * STATE_N) = pk4(S); S = S * gm[q] + unpk4(u[q]); }
        }
        {   const int c = 128; const f32x4 u = unpk4(*(const v2u*)(up + (size_t)c * STATE_N)); f32x4 gm;
            if (kind == 0) { const float t = gp[(size_t)c * GAM_N]; gm = (f32x4){t, t, t, t}; } else if (kind == 1) gm = *(const f32x4*)(gp + (size_t)c * GAM_N); else gm = (f32x4){gret, gret, gret, gret};
            *(v2u*)(sp + (size_t)c * STATE_N) = pk4(S); S = S * gm + u; }
        float* o = out + (kind == 0 ? O_SSMP + (size_t)l * 131072 : kind == 1 ? O_HGP + (size_t)l * 131072 : O_RETP + (size_t)l * 65536);
        if (kind == 0) *(f32x4*)(o + o0) = S; else { o[o0] = S[0]; o[o0 + ostr] = S[1]; o[o0 + 2 * ostr] = S[2]; o[o0 + 3 * ostr] = S[3]; }
      }
    } else {
      const int st = C.vcu * ST + (C.tid - CT), nst = C.G * ST;
      for (int j = st; j < NSI; j += nst) m2_sample_item(A, ws, l, j);
      const bf16* XBC = (const bf16*)(ws + WS_XBC);
      for (int i = st; i < 17 * 4608; i += nst) {
        const int s = i / 4608, r = i - s * 4608, jrow = r / 1536, ch = r - jrow * 1536;
        if (s == 0) out[O_CONVP + (size_t)l * 4608 + r] = bf2f(XBC[(size_t)(ROW_S0 - 3 + jrow) * 1536 + ch]);
        else out[O_CONVS + ((size_t)l * 16 + (s - 1)) * 4608 + r] = bf2f(XBC[(size_t)(ROW_S0 + 64 * (s - 1) + 61 + jrow) * 1536 + ch]);
      }
    }
}


__device__ __forceinline__ void m3_ssd(const Ctx& C, int l, int c, int g) {
    AREF A = *C.a; unsigned char* ws = C.ws; const int tid = C.tid, lane = C.lane, w = C.wave, r0 = 64 * c, l15 = lane & 15, l4 = lane >> 4;
    LAS float* CBS = (LAS float*)C.lds; LAS float* SDT = (LAS float*)(C.lds + 17408); LAS float* SCUM = (LAS float*)(C.lds + 19456); LAS float* SSQ = (LAS float*)(C.lds + 21504);
    LAS unsigned char* CM = C.lds + 23552;
    LAS unsigned char* ZT = C.lds + 40960;
    const bf16* BCG = (const bf16*)(ws + WS_BCG) + (size_t)r0 * 512 + 256 * g;
    const int hd = 8 * g + w;
    const bf16* SB = (const bf16*)(ws + WS_SB) + (size_t)c * STATE_N + ST_SSD + (size_t)hd * 8192;
    const float* S0 = A.in[I_SSSM] + ((size_t)l * 16 + (c >= NCHP ? c - NCHP : 0)) * 131072 + (size_t)hd * 8192;
    const bf16* XTG = (const bf16*)(ws + WS_XTG) + ((size_t)c * 1024 + 512 * g + 64 * w) * 64;
#define M3S_LOAD(SF, XF, PB) do { _Pragma("unroll") for (int ks_ = 0; ks_ < 4; ++ks_) { \
            if (c < NCHP) SF[ks_] = *(const bf16x8*)(SB + (unsigned)((16 * (PB) + l15) * 128 + 32 * ks_ + 8 * l4)); \
            else { const float* sp_ = S0 + (unsigned)((16 * (PB) + l15) * 128 + 32 * ks_ + 8 * l4); const f32x4 s0_ = *(const f32x4*)sp_, s1_ = *(const f32x4*)(sp_ + 4); \
                v4u o_; o_.x = pk2(s0_[0], s0_[1]); o_.y = pk2(s0_[2], s0_[3]); o_.z = pk2(s1_[0], s1_[1]); o_.w = pk2(s1_[2], s1_[3]); SF[ks_] = __builtin_bit_cast(bf16x8, o_); } } \
        XF[0] = *(const bf16x8*)(XTG + (unsigned)((16 * (PB) + l15) * 64 + 8 * l4)); XF[1] = *(const bf16x8*)(XTG + (unsigned)((16 * (PB) + l15) * 64 + 32 + 8 * l4)); } while (0)
    bf16x8 sfA[4], xfA[2], sfB[4], xfB[2];
    M3S_LOAD(sfA, xfA, 0);
    { const int row = tid >> 3, hh = tid & 7; SDT[tid] = ((const float*)(ws + WS_DT))[(r0 + row) * 16 + 8 * g + hh]; SCUM[tid] = ((const float*)(ws + WS_CUM))[(r0 + row) * 16 + 8 * g + hh]; }
    {
        const bf16* ZS = (const bf16*)(ws + WS_ZS) + (size_t)r0 * 1024 + 512 * g;
#pragma unroll
        for (int q = 0; q < 2; ++q) { const int ch = tid + 512 * q, row = ch >> 4, c8 = ch & 15; *(LAS v4u*)(CM + row * 272 + c8 * 16) = *(const v4u*)(BCG + (unsigned)(row * 512 + 128 + c8 * 8)); }
#pragma unroll
        for (int q = 0; q < 8; ++q) { const int ch = tid + 512 * q, row = ch >> 6, c8 = ch & 63; *(LAS v4u*)(ZT + row * 1040 + c8 * 16) = *(const v4u*)(ZS + (unsigned)(row * 1024 + c8 * 8)); }
    }
    {
        const int i = w >> 1;
#pragma unroll
        for (int jj = 0; jj < 2; ++jj) { const int j = 2 * (w & 1) + jj;
            if (j <= i) { f32x4 acc = (f32x4){0.f, 0.f, 0.f, 0.f};
#pragma unroll
                for (int ks = 0; ks < 4; ++ks) acc = mfma16(*(const bf16x8*)(BCG + (unsigned)((16 * j + l15) * 512 + 32 * ks + 8 * l4)), *(const bf16x8*)(BCG + (unsigned)((16 * i + l15) * 512 + 128 + 32 * ks + 8 * l4)), acc);
                *(LAS f32x4*)(CBS + (16 * i + l15) * 68 + 16 * j + 4 * l4) = acc; } }
    }
    LBAR();
    const float dskip = A.in[I_DSKIP][l * 16 + hd];
    v2u Y[4][4]; float ssq[4], ec[4];
    bf16x8 att[4][2];
#pragma unroll
    for (int i = 0; i < 4; ++i) {
        const int t = 16 * i + l15; const float ct = SCUM[t * 8 + w]; ec[i] = __expf(ct); ssq[i] = 0.f;
#pragma unroll
        for (int ks = 0; ks < 2; ++ks) {
            if (ks == 1 && i < 2) { att[i][ks] = (bf16x8){0, 0, 0, 0, 0, 0, 0, 0}; continue; }
            float v[8];
#pragma unroll
            for (int jj = 0; jj < 8; ++jj) { const int s = 32 * ks + 8 * l4 + jj; const float x = CBS[t * 68 + s] * (__expf(ct - SCUM[s * 8 + w]) * SDT[s * 8 + w]); v[jj] = s < t ? x : (s == t ? x + dskip : 0.f); }
            v4u o; o.x = pk2(v[0], v[1]); o.y = pk2(v[2], v[3]); o.z = pk2(v[4], v[5]); o.w = pk2(v[6], v[7]); att[i][ks] = __builtin_bit_cast(bf16x8, o);
        }
    }
#define M3S_BLOCK(SF, XF, PB) do { _Pragma("unroll") for (int i = 0; i < 4; ++i) { const int t = 16 * i + l15; \
            f32x4 yi = (f32x4){0.f, 0.f, 0.f, 0.f}, yn = (f32x4){0.f, 0.f, 0.f, 0.f}; \
            yi = mfma16(XF[0], att[i][0], yi); if (i >= 2) yi = mfma16(XF[1], att[i][1], yi); \
            _Pragma("unroll") for (int ks = 0; ks < 4; ++ks) yn = mfma16(SF[ks], ldsfrag(CM, t, 272, 32 * ks + 8 * l4), yn); \
            const f32x4 z = unpk4(*(const LAS v2u*)(ZT + t * 1040 + (64 * w + 16 * (PB) + 4 * l4) * 2)); \
            const f32x4 y = (yi + yn * ec[i]) * z; ssq[i] += (y[0] * y[0] + y[1] * y[1]) + (y[2] * y[2] + y[3] * y[3]); Y[i][PB] = pk4(y); } } while (0)
    M3S_LOAD(sfB, xfB, 1); M3S_BLOCK(sfA, xfA, 0); __builtin_amdgcn_sched_barrier(0);
    M3S_LOAD(sfA, xfA, 2); M3S_BLOCK(sfB, xfB, 1); __builtin_amdgcn_sched_barrier(0);
    M3S_LOAD(sfB, xfB, 3); M3S_BLOCK(sfA, xfA, 2); __builtin_amdgcn_sched_barrier(0);
    M3S_BLOCK(sfB, xfB, 3);
#undef M3S_LOAD
#undef M3S_BLOCK
#pragma unroll
    for (int i = 0; i < 4; ++i) { float s = ssq[i]; s += __shfl_xor(s, 16); s += __shfl_xor(s, 32); if (l4 == 0) SSQ[w * 64 + 16 * i + l15] = s; }
    LBAR();
    {   const float* gn = A.in[I_SSDN] + (size_t)l * 1024 + 512 * g + 64 * w; bf16* BR = (bf16*)(ws + WS_BR) + (size_t)r0 * 1024 + 512 * g + 64 * w;
#pragma unroll
        for (int i = 0; i < 4; ++i) { const int t = 16 * i + l15; float tot = 0.f;
#pragma unroll
            for (int ww = 0; ww < 8; ++ww) tot += SSQ[ww * 64 + t];
            const float rs = rsqrtf(tot * (1.0f / 512.0f) + EPS);
#pragma unroll
            for (int pb = 0; pb < 4; ++pb) { const int p0 = 16 * pb + 4 * l4; const f32x4 gv = *(const f32x4*)(gn + p0); *(v2u*)(BR + (unsigned)(t * 1024 + p0)) = pk4(unpk4(Y[i][pb]) * rs * gv); } }
    }
}

__device__ __forceinline__ void m3_hg(const Ctx& C, int l, int c, int h) {
    AREF A = *C.a; unsigned char* ws = C.ws; const int tid = C.tid, lane = C.lane, w = C.wave, r0 = 64 * c, l15 = lane & 15, l4 = lane >> 4;
    LAS unsigned char* QT = C.lds; LAS unsigned char* KT = C.lds + 17408; LAS unsigned char* QH = C.lds + 34816; LAS unsigned char* VT = C.lds + 52224; LAS unsigned char* ATT = C.lds + 70656;
    LAS float* SEG = (LAS float*)(C.lds + 79872); LAS float* SSQ = (LAS float*)(C.lds + 83968);
    LAS unsigned char* ST = C.lds + 84480;
    const int i = w >> 1, t = 16 * i + l15;
    const float* gn = A.in[I_HGN] + (size_t)l * 1024 + 128 * h; const bf16* HG = (const bf16*)(ws + WS_HG) + (size_t)r0 * 1024 + 128 * h;
    if (c < NCHP) { const bf16* SB = (const bf16*)(ws + WS_SB) + (size_t)c * STATE_N + ST_HG + (size_t)h * 16384;
#pragma unroll
        for (int q = 0; q < 4; ++q) { const int ch = tid + 512 * q, v = ch >> 4, k8 = ch & 15; *(LAS v4u*)(ST + v * 272 + k8 * 16) = *(const v4u*)(SB + v * 128 + k8 * 8); } }
    else { const float* S0 = A.in[I_SHG] + ((size_t)l * 16 + (c - NCHP)) * 131072 + (size_t)h * 16384;
#pragma unroll
        for (int q = 0; q < 8; ++q) { const int ch = tid + 512 * q, k = ch >> 5, v4 = (ch & 31) * 4; const f32x4 s = *(const f32x4*)(S0 + k * 128 + v4);
#pragma unroll
            for (int e = 0; e < 4; ++e) *(LAS bf16*)(ST + (v4 + e) * 272 + k * 2) = (bf16)f2bf(s[e]); } }
    v2u ggs[4]; f32x4 gvs[4];
#pragma unroll
    for (int b4 = 0; b4 < 4; ++b4) { const int vb = 4 * (w & 1) + b4; ggs[b4] = *(const v2u*)(HG + (unsigned)(t * 1024 + 16 * vb + 4 * l4)); gvs[b4] = *(const f32x4*)(gn + 16 * vb + 4 * l4); }
    {
        const int cp = tid & 63, seg = tid >> 6; const size_t base = (size_t)(r0 + 8 * seg) * 1024 + 128 * h + 2 * cp;
        const bf16* LG = (const bf16*)(ws + WS_LG) + base; const bf16* KK = (const bf16*)(ws + WS_KK) + base; const bf16* HV = (const bf16*)(ws + WS_HV) + base; const bf16* HQ = (const bf16*)(ws + WS_HQ) + base;
        f32x2 cum[8]; unsigned kk[8], vv[8], qq[8];
#pragma unroll
        for (int r = 0; r < 8; ++r) { { const unsigned lw_ = *(const unsigned*)(LG + r * 1024); cum[r] = (f32x2){bflo(lw_), bfhi(lw_)}; } kk[r] = *(const unsigned*)(KK + r * 1024); vv[r] = *(const unsigned*)(HV + r * 1024); qq[r] = *(const unsigned*)(HQ + r * 1024); }
#pragma unroll
        for (int r = 1; r < 8; ++r) cum[r] = cum[r] + cum[r - 1];
        *(LAS f32x2*)(SEG + seg * 128 + 2 * cp) = cum[7];
        LBAR();
        f32x2 off = (f32x2){0.f, 0.f}, R = (f32x2){0.f, 0.f};
#pragma unroll
        for (int s = 0; s < 8; ++s) { const f32x2 sv = *(const LAS f32x2*)(SEG + s * 128 + 2 * cp); if (s < seg) off = off + sv; if (s < 4) R = R + sv; }
#pragma unroll
        for (int r = 0; r < 8; ++r) { const f32x2 cu = cum[r] + off; const int row = 8 * seg + r; const float q0 = bflo(qq[r]), q1 = bfhi(qq[r]), k0 = bflo(kk[r]), k1 = bfhi(kk[r]);
            *(LAS unsigned*)(QT + row * 272 + cp * 4) = pk2(q0 * __expf(fminf(cu[0] - R[0], 80.f)), q1 * __expf(fminf(cu[1] - R[1], 80.f)));
            *(LAS unsigned*)(KT + row * 272 + cp * 4) = pk2(k0 * __expf(fminf(R[0] - cu[0], 80.f)), k1 * __expf(fminf(R[1] - cu[1], 80.f)));
            *(LAS unsigned*)(QH + row * 272 + cp * 4) = pk2(q0 * __expf(cu[0]), q1 * __expf(cu[1])); }
        v4u o0, o1;
        o0.x = (vv[0] & 0xffffu) | (vv[1] << 16); o0.y = (vv[2] & 0xffffu) | (vv[3] << 16); o0.z = (vv[4] & 0xffffu) | (vv[5] << 16); o0.w = (vv[6] & 0xffffu) | (vv[7] << 16);
        o1.x = (vv[0] >> 16) | (vv[1] & 0xffff0000u); o1.y = (vv[2] >> 16) | (vv[3] & 0xffff0000u); o1.z = (vv[4] >> 16) | (vv[5] & 0xffff0000u); o1.w = (vv[6] >> 16) | (vv[7] & 0xffff0000u);
        *(LAS v4u*)(VT + (2 * cp) * 144 + seg * 16) = o0; *(LAS v4u*)(VT + (2 * cp + 1) * 144 + seg * 16) = o1;
    }
    LBAR();
#pragma unroll
    for (int jj = 0; jj < 2; ++jj) { const int j = 2 * (w & 1) + jj; f32x4 acc = (f32x4){0.f, 0.f, 0.f, 0.f};
        if (j <= i) {
#pragma unroll
            for (int ks = 0; ks < 4; ++ks) acc = mfma16(ldsfrag(KT, 16 * j + l15, 272, 32 * ks + 8 * l4), ldsfrag(QT, t, 272, 32 * ks + 8 * l4), acc); }
#pragma unroll
        for (int e = 0; e < 4; ++e) { const int s = 16 * j + 4 * l4 + e; acc[e] = (j <= i && s <= t) ? acc[e] : 0.f; }
        *(LAS v2u*)(ATT + t * 144 + (16 * j + 4 * l4) * 2) = pk4(acc); }
    LBAR();
    f32x4 O[4]; float ssq = 0.f;
#pragma unroll
    for (int b4 = 0; b4 < 4; ++b4) { const int vb = 4 * (w & 1) + b4; f32x4 acc = (f32x4){0.f, 0.f, 0.f, 0.f};
        acc = mfma16(ldsfrag(VT, 16 * vb + l15, 144, 8 * l4), ldsfrag(ATT, t, 144, 8 * l4), acc);
        if (i >= 2) acc = mfma16(ldsfrag(VT, 16 * vb + l15, 144, 32 + 8 * l4), ldsfrag(ATT, t, 144, 32 + 8 * l4), acc);
#pragma unroll
        for (int ks = 0; ks < 4; ++ks) acc = mfma16(ldsfrag(ST, 16 * vb + l15, 272, 32 * ks + 8 * l4), ldsfrag(QH, t, 272, 32 * ks + 8 * l4), acc);
        O[b4] = acc; ssq += (acc[0] * acc[0] + acc[1] * acc[1]) + (acc[2] * acc[2] + acc[3] * acc[3]); }
    ssq += __shfl_xor(ssq, 16); ssq += __shfl_xor(ssq, 32); if (l4 == 0) SSQ[(w & 1) * 64 + t] = ssq;
    LBAR();
    {   bf16* BR = (bf16*)(ws + WS_BR) + ((size_t)MP + r0) * 1024 + 128 * h;
        const float rs = rsqrtf((SSQ[t] + SSQ[64 + t]) * (1.0f / 128.0f) + EPS);
#pragma unroll
        for (int b4 = 0; b4 < 4; ++b4) { const int v0 = 16 * (4 * (w & 1) + b4) + 4 * l4; const v2u gg = ggs[b4];
            const f32x4 gt = (f32x4){bflo(gg.x), bfhi(gg.x), bflo(gg.y), bfhi(gg.y)};
            *(v2u*)(BR + (unsigned)(t * 1024 + v0)) = pk4(O[b4] * rs * gvs[b4] * gt); }
    }
}

__device__ __forceinline__ void m3_ret(const Ctx& C, int l, int c, int h) {
    AREF A = *C.a; unsigned char* ws = C.ws; const int tid = C.tid, lane = C.lane, w = C.wave, r0 = 64 * c, l15 = lane & 15, l4 = lane >> 4;
    LAS unsigned char* VT = C.lds; LAS unsigned char* ATT = C.lds + 18432; LAS float* SSQ = (LAS float*)(C.lds + 27648);
    const float lg = ret_lgam(h);
    const int i = w >> 1, t = 16 * i + l15;
    const bf16* RG = (const bf16*)(ws + WS_RG) + (size_t)r0 * 1024 + 128 * h;
    LAS unsigned char* ST = C.lds + 28160;
    if (c < NCHP) { const bf16* SB = (const bf16*)(ws + WS_SB) + (size_t)c * STATE_N + ST_RET + (size_t)h * 8192;
#pragma unroll
        for (int q = 0; q < 2; ++q) { const int ch = tid + 512 * q, v = ch >> 3, k8 = ch & 7; *(LAS v4u*)(ST + v * 144 + k8 * 16) = *(const v4u*)(SB + v * 64 + k8 * 8); } }
    else { const float* S0 = A.in[I_SRET] + ((size_t)l * 16 + (c - NCHP)) * 65536 + (size_t)h * 8192;
#pragma unroll
        for (int q = 0; q < 4; ++q) { const int ch = tid + 512 * q, d = ch >> 5, v4 = (ch & 31) * 4, kp = 8 * ((d & 31) >> 2) + 4 * (d >> 5) + (d & 3); const f32x4 s = *(const f32x4*)(S0 + d * 128 + v4);
#pragma unroll
            for (int e = 0; e < 4; ++e) *(LAS bf16*)(ST + (v4 + e) * 144 + kp * 2) = (bf16)f2bf(s[e]); } }
    v2u ggs[4];
#pragma unroll
    for (int b4 = 0; b4 < 4; ++b4) { const int vb = 4 * (w & 1) + b4; ggs[b4] = *(const v2u*)(RG + (unsigned)(t * 1024 + 16 * vb + 4 * l4)); }
    {   const int col = tid & 127, seg = tid >> 7; const bf16* RV = (const bf16*)(ws + WS_RV) + (size_t)(r0 + 16 * seg) * 1024 + 128 * h + col; float vv[16];
#pragma unroll
        for (int i = 0; i < 16; ++i) vv[i] = bf2f(RV[i * 1024]);
        v4u o; o.x = pk2(vv[0], vv[1]); o.y = pk2(vv[2], vv[3]); o.z = pk2(vv[4], vv[5]); o.w = pk2(vv[6], vv[7]); *(LAS v4u*)(VT + col * 144 + seg * 32) = o;
        o.x = pk2(vv[8], vv[9]); o.y = pk2(vv[10], vv[11]); o.z = pk2(vv[12], vv[13]); o.w = pk2(vv[14], vv[15]); *(LAS v4u*)(VT + col * 144 + seg * 32 + 16) = o; }
    const bf16* RQ = (const bf16*)(ws + WS_RQ) + (size_t)r0 * 512 + 64 * h; const bf16* RK = (const bf16*)(ws + WS_RK) + (size_t)r0 * 512 + 64 * h;
    const bf16x8 q0 = *(const bf16x8*)(RQ + (unsigned)(t * 512 + 8 * l4)), q1 = *(const bf16x8*)(RQ + (unsigned)(t * 512 + 32 + 8 * l4));
#pragma unroll
    for (int jj = 0; jj < 2; ++jj) { const int j = 2 * (w & 1) + jj; f32x4 acc = (f32x4){0.f, 0.f, 0.f, 0.f};
        if (j <= i) { acc = mfma16(*(const bf16x8*)(RK + (unsigned)((16 * j + l15) * 512 + 8 * l4)), q0, acc); acc = mfma16(*(const bf16x8*)(RK + (unsigned)((16 * j + l15) * 512 + 32 + 8 * l4)), q1, acc); }
#pragma unroll
        for (int e = 0; e < 4; ++e) { const int s = 16 * j + 4 * l4 + e; acc[e] = (j <= i && s <= t) ? acc[e] * __expf((float)(t - s) * lg) : 0.f; }
        *(LAS v2u*)(ATT + t * 144 + (16 * j + 4 * l4) * 2) = pk4(acc); }
    LBAR();
    const float inner = __expf((float)(t + 1) * lg);
    f32x4 O[4]; float ssq = 0.f;
#pragma unroll
    for (int b4 = 0; b4 < 4; ++b4) { const int vb = 4 * (w & 1) + b4; f32x4 acc = (f32x4){0.f, 0.f, 0.f, 0.f}, acs = (f32x4){0.f, 0.f, 0.f, 0.f};
        acc = mfma16(ldsfrag(VT, 16 * vb + l15, 144, 8 * l4), ldsfrag(ATT, t, 144, 8 * l4), acc);
        if (i >= 2) acc = mfma16(ldsfrag(VT, 16 * vb + l15, 144, 32 + 8 * l4), ldsfrag(ATT, t, 144, 32 + 8 * l4), acc);
        acs = mfma16(ldsfrag(ST, 16 * vb + l15, 144, 8 * l4), q0, acs); acs = mfma16(ldsfrag(ST, 16 * vb + l15, 144, 32 + 8 * l4), q1, acs);
        acc = acc + acs * inner;
        O[b4] = acc; ssq += (acc[0] * acc[0] + acc[1] * acc[1]) + (acc[2] * acc[2] + acc[3] * acc[3]); }
    ssq += __shfl_xor(ssq, 16); ssq += __shfl_xor(ssq, 32); if (l4 == 0) SSQ[(w & 1) * 64 + t] = ssq;
    LBAR();
    {   bf16* BR = (bf16*)(ws + WS_BR) + ((size_t)2 * MP + r0) * 1024 + 128 * h;
        const float rs = rsqrtf((SSQ[t] + SSQ[64 + t]) * (1.0f / 128.0f) + EPS);
#pragma unroll
        for (int b4 = 0; b4 < 4; ++b4) { const int v0 = 16 * (4 * (w & 1) + b4) + 4 * l4; const v2u gg = ggs[b4];
            const f32x4 gt = (f32x4){bflo(gg.x), bfhi(gg.x), bflo(gg.y), bfhi(gg.y)};
            *(v2u*)(BR + (unsigned)(t * 1024 + v0)) = pk4(O[b4] * rs * gt); }
    }
}

#ifndef REPI_M3_SSD
#define REPI_M3_SSD 1
#endif
#ifndef REPI_M3_HG
#define REPI_M3_HG 1
#endif
#ifndef REPI_M3_RET
#define REPI_M3_RET 1
#endif
__device__ __forceinline__ unsigned m3_prefetch(const Ctx& C, int l, int it) {
    constexpr int N_SSD = NCH * 2, N_HG = NCH * 8; unsigned char* ws = C.ws; const int tid = C.tid; unsigned pf = 0;
    if (it < N_SSD) { const int c = it >> 1, g = it & 1, r0 = 64 * c;
        if (c < NCHP) { const bf16* SB = (const bf16*)(ws + WS_SB) + (size_t)c * STATE_N + ST_SSD + (size_t)g * 65536;
#pragma unroll
            for (int q = 0; q < 2; ++q) pf ^= *(const unsigned*)(SB + (tid + 512 * q) * 64); }
        pf ^= *(const unsigned*)((const bf16*)(ws + WS_XTG) + ((size_t)c * 1024 + 512 * g + tid) * 64);
        pf ^= *(const unsigned*)((const bf16*)(ws + WS_ZS) + (size_t)(r0 + (tid >> 3)) * 1024 + 512 * g + 64 * (tid & 7));
        if (tid < 256) pf ^= *(const unsigned*)((const bf16*)(ws + WS_BCG) + (size_t)(r0 + (tid >> 2)) * 512 + 256 * g + 64 * (tid & 3)); }
    else if (it < N_SSD + N_HG) { const int j = it - N_SSD, c = j >> 3, h = j & 7, row = tid >> 3, p = tid & 7; const size_t b = (size_t)(64 * c + row) * 1024 + 128 * h;
        if (p < 4) pf ^= *(const unsigned*)((const bf16*)(ws + WS_LG) + b + 32 * p); else if (p < 6) pf ^= *(const unsigned*)((const bf16*)(ws + WS_KK) + b + 64 * (p - 4)); else pf ^= *(const unsigned*)((const bf16*)(ws + WS_HV) + b + 64 * (p - 6));
        if (p < 2) pf ^= *(const unsigned*)((const bf16*)(ws + WS_HQ) + b + 64 * p); else if (p < 4) pf ^= *(const unsigned*)((const bf16*)(ws + WS_HG) + b + 64 * (p - 2));
        else if (c < NCHP && tid >= 256) pf ^= *(const unsigned*)((const bf16*)(ws + WS_SB) + (size_t)c * STATE_N + ST_HG + (size_t)h * 16384 + (tid - 256) * 64); }
    else { const int j = it - N_SSD - N_HG, c = j >> 3, h = j & 7, row = tid >> 3, p = tid & 7; const size_t b = (size_t)(64 * c + row) * 1024 + 128 * h;
        if (p < 2) pf ^= *(const unsigned*)((const bf16*)(ws + WS_RV) + b + 64 * p); else if (p < 4) pf ^= *(const unsigned*)((const bf16*)(ws + WS_RG) + b + 64 * (p - 2));
        else if (p == 4) pf ^= *(const unsigned*)((const bf16*)(ws + WS_RQ) + (size_t)(64 * c + row) * 512 + 64 * h); else if (p == 5) pf ^= *(const unsigned*)((const bf16*)(ws + WS_RK) + (size_t)(64 * c + row) * 512 + 64 * h);
        else if (c < NCHP && tid < 128 * 8) { const int k = (row * 2 + (p - 6)); if (k < 128) pf ^= *(const unsigned*)((const bf16*)(ws + WS_SB) + (size_t)c * STATE_N + ST_RET + (size_t)h * 8192 + k * 64); } }
    return pf;
}
__device__ __forceinline__ void m3_phase(const Ctx& C0, int l, int mask = 7) {
    constexpr int N_SSD = NCH * 2, N_HG = NCH * 8, N_IT = NCH * 18;
    unsigned* cnt = (unsigned*)(C0.ws + WS_CTL) + CW_QUEUE + 64 * (l * 8 + 1 * 4 + (mask == 7 ? 0 : 1));
    volatile LAS int* slot = (volatile LAS int*)(C0.lds + LDSCTL_OFF + 64);
    int n2 = 0;
    if (C0.tid == 0) { slot[0] = (int)__hip_atomic_fetch_add(cnt, 1u, __ATOMIC_RELAXED, __HIP_MEMORY_SCOPE_AGENT); slot[1] = (int)__hip_atomic_fetch_add(cnt, 1u, __ATOMIC_RELAXED, __HIP_MEMORY_SCOPE_AGENT); }
    LBAR();
    int it = slot[0], nx = slot[1];
    LBAR();
    while (it < N_IT) {
        if (C0.tid == 0) n2 = (int)__hip_atomic_fetch_add(cnt, 1u, __ATOMIC_RELAXED, __HIP_MEMORY_SCOPE_AGENT);
        Ctx C = C0; { int t_ = C0.tid; asm volatile("" : "+v"(t_)); C.tid = t_; C.lane = t_ & 63; C.wave = __builtin_amdgcn_readfirstlane(t_ >> 6); }
        unsigned pf = 0; if (MK_PREFETCH && nx < N_IT && mask == 7) pf = m3_prefetch(C, l, nx);
        if (it < N_SSD) { if (mask & 1) m3_ssd(C, l, it >> 1, it & 1); }
        else if (it < N_SSD + N_HG) { if (mask & 2) { const int j = it - N_SSD; m3_hg(C, l, j >> 3, j & 7); } }
        else { if (mask & 4) { const int j = it - N_SSD - N_HG; m3_ret(C, l, j >> 3, j & 7); } }
        if (pf == 0x7fc1abcdu) ((unsigned*)(C0.ws + WS_CTL))[16] = pf;
        LBAR();
        if (C0.tid == 0) slot[0] = n2;
        LBAR();
        it = nx; nx = slot[0];
    }
}


enum { PH_GEMM1 = 0, PH_M1, PH_M2, PH_M3, PH_GEMM2, PH_GEMM3, PH_GU, PH_DOWN, PH_N };

__device__ __forceinline__ void stagger(int bx, int ticks) {
    if ((bx & 1) && ticks > 0) { const unsigned long long t0 = wall_clock64(); while (wall_clock64() - t0 < (unsigned long long)ticks) __builtin_amdgcn_s_sleep(32); }
}
#ifndef PROBE_G2_MODE
#define PROBE_G2_MODE 0
#endif
#ifndef PROBE_G2_NOSPLIT
#define PROBE_G2_NOSPLIT 0
#endif
#ifndef PROBE_G2_REAL
#define PROBE_G2_REAL 0
#endif
#ifndef STAG_G2
#define STAG_G2 0
#endif
#ifndef STAG_G3
#define STAG_G3 0
#endif
#ifndef STAG_DN
#define STAG_DN 0
#endif
#ifndef STAG_G1
#define STAG_G1 0
#endif
#ifndef STAG_GU
#define STAG_GU 0
#endif
#ifndef REP_P0
#define REP_P0 1
#endif
#ifndef REP_NORM
#define REP_NORM 1
#endif
#ifndef REP_G1
#define REP_G1 1
#endif
#ifndef REP_M1
#define REP_M1 1
#endif
#ifndef REP_M2
#define REP_M2 1
#endif
#ifndef REP_M3
#define REP_M3 1
#endif
#ifndef REP_G2
#define REP_G2 1
#endif
#ifndef REP_G3
#define REP_G3 1
#endif
#ifndef REP_GU
#define REP_GU 1
#endif
#ifndef REP_DN
#define REP_DN 1
#endif
#ifndef PROBE_MASK
#define PROBE_MASK 7
#endif
#ifndef G1_ALIGN
#define G1_ALIGN true
#endif
#ifndef REP_DT
#define REP_DT 1
#endif
#ifndef MK_G2_HANDOFF
#define MK_G2_HANDOFF 1
#endif
#ifndef REP_BAR
#define REP_BAR 1
#endif
__global__ void __launch_bounds__(NTHR, 2) trunk_fwd(Args args) {
    extern __shared__ __attribute__((aligned(16))) unsigned char lds_raw[];
    Ctx C; C.lds = (LAS unsigned char*)lds_raw; C.tid = threadIdx.x; C.lane = C.tid & 63; C.wave = __builtin_amdgcn_readfirstlane(C.tid >> 6);
    const int wave0 = C.wave;
    C.G = gridDim.x; { const int bx = blockIdx.x; C.vcu = (C.G % 8 == 0) ? (bx % 8) * (C.G / 8) + bx / 8 : bx; }
    ArgsP ap = (ArgsP)__builtin_amdgcn_kernarg_segment_ptr();
    C.a = ap; C.ws = ap->ws;
    unsigned char* ws = ap->ws; const int use_bar = ap->use_bar;
    for (int u = C.tid; u < (LDS_BYTES - LDSCTL_OFF) / 4; u += NTHR) ((LAS unsigned*)(C.lds + LDSCTL_OFF))[u] = 0u;
    __syncthreads();
    XcdBarrier bar; bar.bar = (unsigned*)(ws + WS_CTL) + CW_BAR; bar.x = 0; bar.st = nullptr;
    if (use_bar) bar = xcd_barrier_post((unsigned*)(ws + WS_CTL) + CW_BAR, (volatile LAS unsigned*)(C.lds + LDSCTL_OFF));
#define GRID_BAR() do { if (use_bar) for (int rb_ = 0; rb_ < REP_BAR; ++rb_) { bar.bar = (unsigned*)(ws + WS_CTL) + CW_BAR; xcd_barrier(bar); } } while (0)
#define FRESH() do { int w0_ = wave0; asm volatile("" : "+s"(w0_)); unsigned z_ = 0u; asm volatile("" : "+v"(z_)); int t_ = w0_ * 64 + (int)__builtin_amdgcn_mbcnt_hi(~0u, __builtin_amdgcn_mbcnt_lo(~0u, z_)); asm volatile("" : "+v"(t_)); C.tid = t_; C.lane = t_ & 63; C.wave = __builtin_amdgcn_readfirstlane(t_ >> 6); \
        int g_ = gridDim.x; asm volatile("" : "+s"(g_)); C.G = g_; int b_ = blockIdx.x; asm volatile("" : "+s"(b_)); bx = b_; C.vcu = (C.G % 8 == 0) ? (b_ % 8) * (C.G / 8) + b_ / 8 : b_; \
        ArgsP a_ = (ArgsP)__builtin_amdgcn_kernarg_segment_ptr(); asm volatile("" : "+s"(a_)); ap = a_; C.a = a_; unsigned char* w_ = a_->ws; ws = w_; C.ws = w_; X = (bf16*)(ws + WS_X); H = (bf16*)(ws + WS_H); lw = ws + WS_W + (size_t)l * LW_SIZE; } while (0)
#define IN(k) (ap->ph_lo <= (k) && (k) < ap->ph_hi)

    if (ap->do_pro) { for (int r_ = 0; r_ < REP_P0; ++r_) p0_prologue(C); GRID_BAR(); }

    bf16* X = (bf16*)(ws + WS_X); bf16* H = (bf16*)(ws + WS_H); int bx = blockIdx.x; unsigned char* lw = ws;
    const int l_hi = ap->l_hi;
    for (int l = ap->l_lo; l < l_hi; ++l) {
        if (IN(PH_GEMM1)) for (int r_ = 0; r_ < REP_G1; ++r_) { asm volatile("; MARK_PH_GEMM1"); FRESH(); stagger(bx, STAG_G1);
            pg8::Gemm g{X, (const bf16*)(lw + LW_IN), MP, NPROJ, D, 0, 0}; pg8::StaticOrder S; S.init(MP, NPROJ, C.G, bx, D);
            if (r_ == 0) { EpiProj E{ws, l};
            pg8::gemm_phase<EpiProj, pg8::StaticOrder, G1_ALIGN, true>(C.lds, g, S, E, C.tid); for (int q_ = 0; q_ < REP_DT; ++q_) { dt_rows(C, l); LBAR(); } }
            else { S.sametile = 1; EpiNull E{(float*)(ws + WS_TMP)}; pg8::gemm_phase<EpiNull, pg8::StaticOrder, G1_ALIGN, true>(C.lds, g, S, E, C.tid); }
            GRID_BAR();
        }
        if (IN(PH_M1)) for (int r_ = 0; r_ < REP_M1; ++r_) { asm volatile("; MARK_PH_M1"); FRESH(); m1_phase(C, l, r_ == 0 ? 7 : PROBE_MASK); GRID_BAR(); }
        if (IN(PH_M2)) for (int r_ = 0; r_ < REP_M2; ++r_) { asm volatile("; MARK_PH_M2"); FRESH(); m2_phase(C, l); GRID_BAR(); }
        if (IN(PH_M3)) for (int r_ = 0; r_ < REP_M3; ++r_) { asm volatile("; MARK_PH_M3"); FRESH(); m3_phase(C, l, r_ == 0 ? 7 : PROBE_MASK); GRID_BAR(); }
        if (IN(PH_GEMM2)) for (int r_ = 0; r_ < REP_G2; ++r_) { asm volatile("; MARK_PH_GEMM2"); FRESH(); stagger(bx, STAG_G2);
            pg8::Gemm g{(const bf16*)(ws + WS_BR), (const bf16*)(lw + LW_BR), MP, D, 1024, (size_t)MP * 1024 * 2, (size_t)D * 1024 * 2}; BranchOrder S; S.init(MP, D, C.G, bx, 1024);
            EpiBranch E{(bf16*)(ws + WS_TMP), (bf16*)(ws + WS_MIX), (const bf16*)(ws + WS_GT), (float*)(ws + WS_SLAB), (unsigned*)(ws + WS_CTL) + CW_G2 + 64 * (64 * (l * REP_G2 + r_)), (unsigned*)(ws + WS_CTL) + CW_TMO, (S.dep && REP_G2 == 1 && MK_G2_HANDOFF) ? (unsigned*)(ws + WS_CTL) + CW_RDY + (2 * l) * 64 * 32 : nullptr};
            if (r_ == 0 || PROBE_G2_REAL) pg8::gemm_phase<EpiBranch, BranchOrder, true, true>(C.lds, g, S, E, C.tid);
            else if (PROBE_G2_MODE) { EpiBranchT<PROBE_G2_MODE> E2{(bf16*)(ws + WS_HID), (bf16*)(ws + WS_HID) + (size_t)MP * D, (const bf16*)(ws + WS_GT), (float*)(ws + WS_SLAB) + (size_t)256 * 65536, (unsigned*)(ws + WS_CTL) + CW_G2 + 64 * 64 * 7, (unsigned*)(ws + WS_CTL) + CW_TMO}; S.rem = 0; S.R = (S.S.nwg + S.S.G - 1) / S.S.G; pg8::gemm_phase<EpiBranchT<PROBE_G2_MODE>, BranchOrder, true, true>(C.lds, g, S, E2, C.tid); }
            else { if (PROBE_G2_NOSPLIT) { S.rem = 0; S.R = (S.S.nwg + S.S.G - 1) / S.S.G; } EpiNull EN{(float*)(ws + WS_TMP)}; pg8::gemm_phase<EpiNull, BranchOrder, true, true>(C.lds, g, S, EN, C.tid); }
            if (!(S.dep && REP_G2 == 1 && MK_G2_HANDOFF)) GRID_BAR();
        }
        if (IN(PH_GEMM3)) for (int r_ = 0; r_ < REP_G3; ++r_) { asm volatile("; MARK_PH_GEMM3"); FRESH(); stagger(bx, STAG_G3);
            pg8::Gemm g{(const bf16*)(ws + WS_MIX), (const bf16*)(lw + LW_OUT), MP, D, D, 0, 0}; G3Order S; S.init(MP, D, C.G, bx, D, (REP_G2 == 1 && !MK_G2_NOSPLIT && MK_G2_HANDOFF) ? (const unsigned*)(ws + WS_CTL) + CW_RDY + (2 * l) * 64 * 32 : nullptr, (unsigned*)(ws + WS_CTL) + CW_TMO);
            const int ep = 2 * l + 0;
            EpiResid E{r_ == 0 ? X : (bf16*)(ws + WS_TMP), (float*)(ws + WS_SLAB) + (size_t)(ep & 1) * 256 * 65536, (unsigned*)(ws + WS_CTL) + CW_SK + (ep & 7) * 256 * 64, (unsigned*)(ws + WS_CTL) + CW_TMO,
                       r_ == 0 ? (u64*)((unsigned*)(ws + WS_CTL) + CW_RS) + (size_t)(2 * l + 1) * MP : nullptr, (r_ == 0 && S.dep) ? (unsigned*)(ws + WS_CTL) + CW_RDY + (2 * l + 1) * 64 * 32 : nullptr};
            pg8::gemm_phase<EpiResid, G3Order, true, true>(C.lds, g, S, E, C.tid);
            if (!S.dep) GRID_BAR();
        }
        if (IN(PH_GU)) for (int r_ = 0; r_ < REP_GU; ++r_) { asm volatile("; MARK_PH_GU"); FRESH(); stagger(bx, STAG_GU);
            pg8::Gemm g{X, (const bf16*)(lw + LW_GU), MP, 2 * FFN, D, 0, 0}; GuOrder S; S.init(MP, 2 * FFN, C.G, bx, D, (const unsigned*)(ws + WS_CTL) + CW_RDY + (2 * l + 1) * 64 * 32, (unsigned*)(ws + WS_CTL) + CW_TMO);
            EpiSwiglu E{(bf16*)(ws + WS_HID), (float*)(ws + WS_SLAB), (unsigned*)(ws + WS_CTL) + CW_SK + ((2 * l) & 7) * 256 * 64, (unsigned*)(ws + WS_CTL) + CW_TMO, (const u64*)((const unsigned*)(ws + WS_CTL) + CW_RS) + (size_t)(2 * l + 1) * MP};
            pg8::gemm_phase<EpiSwiglu, GuOrder, true, true>(C.lds, g, S, E, C.tid);
            GRID_BAR();
        }
        if (IN(PH_DOWN)) for (int r_ = 0; r_ < REP_DN; ++r_) { asm volatile("; MARK_PH_DOWN"); FRESH(); stagger(bx, STAG_DN);
            pg8::Gemm g{(const bf16*)(ws + WS_HID), (const bf16*)(lw + LW_DN), MP, D, FFN, 0, 0}; pg8::StreamOrder S; S.init(MP, D, C.G, C.vcu, FFN);
            const int ep = 2 * l + 1;
            EpiResid E{r_ == 0 ? X : (bf16*)(ws + WS_TMP), (float*)(ws + WS_SLAB) + (size_t)(ep & 1) * 256 * 65536, (unsigned*)(ws + WS_CTL) + CW_SK + (ep & 7) * 256 * 64, (unsigned*)(ws + WS_CTL) + CW_TMO,
                       (r_ == 0 && l + 1 < NL) ? (u64*)((unsigned*)(ws + WS_CTL) + CW_RS) + (size_t)(2 * l + 2) * MP : nullptr};
            pg8::gemm_phase<EpiResid, pg8::StreamOrder, true, true>(C.lds, g, S, E, C.tid);
            GRID_BAR();
        }
    }
    if (ap->do_fin) { const int l = 0; FRESH(); final_phase(C, X, ap->in[I_NFIN], ap->out); }
#undef IN
#undef GRID_BAR
#undef FRESH
}


__global__ void probe_dump(const unsigned short* src, size_t n_src, float* out, size_t n_out) {
    for (size_t i = (size_t)blockIdx.x * blockDim.x + threadIdx.x; i < n_out; i += (size_t)gridDim.x * blockDim.x) {
        const size_t j = (i * 4 + (i & 3)) % n_src; out[i] = __builtin_bit_cast(float, ((unsigned)src[j]) << 16) * 1e-3f + 1.0f; }
}
#ifndef MK_REPS
#define MK_REPS 1
#endif
#ifndef MK_ONE_LAUNCH
#define MK_ONE_LAUNCH 1
#endif
extern "C" void kernel_launch(void* const* d_in, const int* in_sizes, int n_in, void* d_out, int out_size, void* d_ws, size_t ws_size, hipStream_t stream) {
    static int grid = 0;
    if (grid == 0) {
        if (n_in != 24 || (size_t)out_size != O_END || ws_size < WS_END) { fprintf(stderr, "kernel_launch: unexpected shapes (n_in %d, out %d, ws %zu, need %zu)\n", n_in, out_size, ws_size, (size_t)WS_END); grid = -1; return; }
        int dev = 0, cus = 0, per_cu = 0;
        if (hipGetDevice(&dev) != hipSuccess || hipDeviceGetAttribute(&cus, hipDeviceAttributeMultiprocessorCount, dev) != hipSuccess) { grid = -1; return; }
        if (hipFuncSetAttribute((const void*)trunk_fwd, hipFuncAttributeMaxDynamicSharedMemorySize, LDS_BYTES) != hipSuccess) { fprintf(stderr, "kernel_launch: hipFuncSetAttribute failed\n"); grid = -1; return; }
        if (hipOccupancyMaxActiveBlocksPerMultiprocessor(&per_cu, (const void*)trunk_fwd, NTHR, LDS_BYTES) != hipSuccess || per_cu < 1) fprintf(stderr, "kernel_launch: occupancy query reports %d\n", per_cu);
        (void)hipGetLastError();
        grid = cus;
    }
    if (grid < 0) return;
    (void)hipMemsetAsync((char*)d_ws + WS_CTL, 0, CTL_ZERO_BYTES, stream);
    Args a{};
    for (int i = 0; i < 24; ++i) a.in[i] = (const float*)d_in[i];
    a.out = (float*)d_out; a.ws = (unsigned char*)d_ws;
#if MK_ONE_LAUNCH
    a.l_lo = 0; a.l_hi = NL; a.ph_lo = 0; a.ph_hi = PH_N; a.do_pro = 1; a.do_fin = 1; a.use_bar = 1; a.pad = 0;
    hipLaunchKernelGGL(trunk_fwd, dim3(grid), dim3(NTHR), LDS_BYTES, stream, a);
#else
    for (int rep = 0; rep < MK_REPS; ++rep) {
    a.use_bar = 0; a.pad = 0;
    a.l_lo = 0; a.l_hi = 0; a.ph_lo = 0; a.ph_hi = 0; a.do_pro = 1; a.do_fin = 0;
    hipLaunchKernelGGL(trunk_fwd, dim3(grid), dim3(NTHR), LDS_BYTES, stream, a);
    a.do_pro = 0;
#ifdef PROBE_NPH
    { int cnt = 0; for (int l = 0; l < NL && cnt < PROBE_NPH; ++l) for (int ph = 0; ph < PH_N && cnt < PROBE_NPH; ++ph, ++cnt) { a.l_lo = l; a.l_hi = l + 1; a.ph_lo = ph; a.ph_hi = ph + 1; hipLaunchKernelGGL(trunk_fwd, dim3(grid), dim3(NTHR), LDS_BYTES, stream, a); } }
    probe_dump<<<2048, 256, 0, stream>>>((const unsigned short*)((char*)d_ws + PROBE_LO), (size_t)(PROBE_HI - PROBE_LO) / 2, (float*)d_out, (size_t)O_END);
    return;
#endif
    for (int l = 0; l < NL; ++l) for (int ph = 0; ph < PH_N; ++ph) { a.l_lo = l; a.l_hi = l + 1; a.ph_lo = ph; a.ph_hi = ph + 1; hipLaunchKernelGGL(trunk_fwd, dim3(grid), dim3(NTHR), LDS_BYTES, stream, a); }
    a.l_lo = 0; a.l_hi = 0; a.ph_lo = 0; a.ph_hi = 0; a.do_fin = 1;
    hipLaunchKernelGGL(trunk_fwd, dim3(grid), dim3(NTHR), LDS_BYTES, stream, a);
    }
#endif
    const hipError_t le = hipPeekAtLastError();
    if (le != hipSuccess) fprintf(stderr, "kernel_launch: launch failed: %s\n", hipGetErrorName(le));
}
```

```cpp
#include <hip/hip_runtime.h>
#include <cstdio>
#include <cstdint>
#ifndef PG8_WGM
#define PG8_WGM 8
#endif
namespace pg8 {
#define PG8_LAS __attribute__((address_space(3)))
typedef unsigned short bf16_t;
typedef short bf16x8 __attribute__((ext_vector_type(8)));
typedef float f32x4 __attribute__((ext_vector_type(4)));
typedef unsigned u32x4 __attribute__((ext_vector_type(4)));
constexpr int BM = 256, BK = 64, HALF = 128, HTB = HALF * BK * 2  , STAGE_BYTES = 8 * HTB, NXCD = 8, WGM = PG8_WGM;

__host__ __device__ __forceinline__ int lds_byte(int r, int c) { const int st = (r >> 4) * 2 + (c >> 5), rr = r & 15, cc = c & 31, ob = rr * 64 + cc * 2; return st * 1024 + (ob ^ (((ob >> 9) & 1) << 5)); }
__host__ __device__ __forceinline__ void stage_rc(int b, int& R, int& C) { const int st = b / 1024, sb = b % 1024, swz = sb ^ (((sb >> 9) & 1) << 5); R = (st >> 1) * 16 + swz / 64; C = (st & 1) * 32 + (swz % 64) / 2; }
__host__ __device__ __forceinline__ int perm32(int rho) { const int n = rho >> 4, i = rho & 15; return 8 * (i >> 2) + 4 * n + (i & 3); }

struct Unit { int pm, pn, pc, k0, nt, kind, slab; };
struct Gemm { const bf16_t* A; const bf16_t* Bt; int M, N, K; size_t csA, csB; };

struct StaticOrder {
    int nM, nN, nwg, G, c, ntk, sametile = 0;
    __host__ __device__ __forceinline__ void init(int M, int N, int G_, int c_, int K) { nM = M / BM; nN = N / BM; nwg = nM * nN; G = G_; c = c_; ntk = K / BK; }
    __host__ __device__ __forceinline__ void tile(int L, Unit& u) const {
        int wgid = L; { const int q = nwg / NXCD, r = nwg % NXCD, xcd = wgid % NXCD, off = wgid / NXCD; wgid = (xcd < r ? xcd * (q + 1) : r * (q + 1) + (xcd - r) * q) + off; }
        const int nig = WGM * nN, gid = wgid / nig, fm = gid * WGM, gsz = (nM - fm) < WGM ? (nM - fm) : WGM;
        u.pm = fm + ((wgid % nig) % gsz); u.pn = (wgid % nig) / gsz; u.pc = 0;
    }
    __host__ __device__ __forceinline__ void tile_seq(int wgid, Unit& u) const {
        const int nig = WGM * nN, gid = wgid / nig, fm = gid * WGM, gsz = (nM - fm) < WGM ? (nM - fm) : WGM;
        u.pm = fm + ((wgid % nig) % gsz); u.pn = (wgid % nig) / gsz; u.pc = 0;
    }
    __host__ __device__ __forceinline__ bool next(int i, Unit& u) const {
        const long L = (long)i * G + c; if (L >= nwg) return false;
        tile((int)L, u); u.k0 = 0; u.nt = ntk; u.kind = 0; u.slab = 0;
#ifdef PROBE_SAMETILE
        if (sametile) { u.pm = 0; u.pn = 0; }
#endif
        return true;
    }
    __device__ __forceinline__ void a_ready(const Unit&) const {}
    __device__ __forceinline__ void done(const Unit&) const {}
};
struct StreamOrder {
    StaticOrder S; int P, lo, hi, r;
    __host__ __device__ __forceinline__ void init(int M, int N, int G, int rank, int K) { S.init(M, N, G, 0, K); P = K / (2 * BK); r = rank; const long W = (long)S.nwg * P; lo = (int)((W * rank) / G); hi = (int)((W * (rank + 1)) / G); }
    __host__ __device__ __forceinline__ bool next(int i, Unit& u) const {
        const int tail = (lo % P) ? P - lo % P : 0, head = hi % P, t0 = (lo + tail) / P, nfull = (hi - head) / P - t0;
        int k = i;
        if (head) { if (k == 0) { S.tile_seq(hi / P, u); u.k0 = 0; u.nt = 2 * head; u.kind = 1; u.slab = r; return true; } --k; }
        if (k < nfull) { S.tile_seq(t0 + k, u); u.k0 = 0; u.nt = 2 * P; u.kind = 0; u.slab = 0; return true; }
        k -= nfull;
        if (tail && k == 0) { S.tile_seq(lo / P, u); u.k0 = 2 * (P - tail); u.nt = 2 * tail; u.kind = 2; u.slab = r - 1; return true; }
        return false;
    }
    __device__ __forceinline__ void a_ready(const Unit&) const {}
    __device__ __forceinline__ void done(const Unit&) const {}
};

__device__ __forceinline__ unsigned cvt_pk_bf16(float lo, float hi) { unsigned r; asm volatile("v_cvt_pk_bf16_f32 %0, %1, %2" : "=v"(r) : "v"(lo), "v"(hi)); return r; }

template <class Epi, class Sched, bool ALIGN_EPI = false, bool SP2 = false>
__device__ __forceinline__ void gemm_phase(PG8_LAS unsigned char* lds, const Gemm g, const Sched& S, const Epi& E, const int tid) {
    const int wid = __builtin_amdgcn_readfirstlane(tid >> 6), lane = tid & 63, wr = wid >> 2, wc = wid & 3, fr = lane & 15, fq = lane >> 4;
    const int K = g.K;
    unsigned voffA[2], voffB[2];
#pragma unroll
    for (int i = 0; i < 2; ++i) { int R, C; stage_rc(tid * 16 + i * 8192, R, C); const int Rb = Epi::PERM ? ((R & ~31) + perm32(R & 31)) : R;
        voffA[i] = (unsigned)(R * K + C) * 2u; voffB[i] = (unsigned)(Rb * K + C) * 2u; }
    const size_t kstep = (size_t)(BK * 2);
    const size_t hstep = (size_t)HALF * K * 2;
    const size_t tstep = 2 * hstep;
    const unsigned ldsw = (unsigned)wid * 1024u;
    const int aoff = lds_byte(wr * 64 + fr, fq * 8), boff = lds_byte(wc * 32 + fr, fq * 8);
#define PG8_SA(b, h) (((b) * 2 + (h)) * HTB)
#define PG8_SB(b, h) ((4 + (b) * 2 + (h)) * HTB)
#define PG8_STAGE(bufoff, gbase, voff) do { _Pragma("unroll") for (int _i = 0; _i < 2; ++_i) \
        __builtin_amdgcn_global_load_lds((const unsigned*)((const char*)(gbase) + (voff)[_i]), (PG8_LAS unsigned*)(lds + (bufoff) + ldsw + _i * 8192), 16, 0, 0); } while (0)
#define PG8_LDA(dst, b, h) do { _Pragma("unroll") for (int m = 0; m < 4; ++m) _Pragma("unroll") for (int k = 0; k < 2; ++k) dst[m][k] = *(const PG8_LAS bf16x8*)(lds + PG8_SA(b, h) + aoff + m * 2048 + k * 1024); } while (0)
#define PG8_LDB(dst, b, h) do { _Pragma("unroll") for (int n = 0; n < 2; ++n) _Pragma("unroll") for (int k = 0; k < 2; ++k) dst[n][k] = *(const PG8_LAS bf16x8*)(lds + PG8_SB(b, h) + boff + n * 2048 + k * 1024); } while (0)
#define PG8_MMA(ai, bj, At, Bt) do { __builtin_amdgcn_s_setprio(1); _Pragma("unroll") for (int m = 0; m < 4; ++m) _Pragma("unroll") for (int n = 0; n < 2; ++n) _Pragma("unroll") for (int k = 0; k < 2; ++k) \
        acc[ai][bj][m][n] = __builtin_amdgcn_mfma_f32_16x16x32_bf16(Bt[n][k], At[m][k], acc[ai][bj][m][n], 0, 0, 0); __builtin_amdgcn_s_setprio(0); } while (0)
#define PG8_WAIT_V(n) asm volatile("s_waitcnt vmcnt(" #n ")" ::: "memory")
#define PG8_WAIT_L(n) asm volatile("s_waitcnt lgkmcnt(" #n ")" ::: "memory")
#define PG8_BAR __builtin_amdgcn_s_barrier()
#define PG8_SCHED __builtin_amdgcn_sched_barrier(0)
    Unit cur, nxt; int ui = 0;
    if (!S.next(0, cur)) return;
    f32x4 acc[2][2][4][2];
#pragma unroll
    for (int a = 0; a < 2; ++a)
#pragma unroll
        for (int b = 0; b < 2; ++b)
#pragma unroll
            for (int m = 0; m < 4; ++m)
#pragma unroll
                for (int n = 0; n < 2; ++n) acc[a][b][m][n] = (f32x4){0.f, 0.f, 0.f, 0.f};
    bf16x8 At[4][2], B0[2][2], B1[2][2];
    const char* cA = (const char*)g.A + (size_t)cur.pm * tstep + (size_t)cur.pc * g.csA + (size_t)cur.k0 * kstep; const char* cB = (const char*)g.Bt + (size_t)cur.pn * tstep + (size_t)cur.pc * g.csB + (size_t)cur.k0 * kstep;
    S.a_ready(cur);
    if constexpr (SP2) {
        PG8_STAGE(PG8_SB(0, 0), cB, voffB); PG8_STAGE(PG8_SB(0, 1), cB + hstep, voffB); PG8_STAGE(PG8_SA(0, 0), cA, voffA); PG8_STAGE(PG8_SA(0, 1), cA + hstep, voffA);
        if (wr == 1) PG8_BAR;
        PG8_WAIT_V(2); PG8_BAR;
        PG8_STAGE(PG8_SB(1, 0), cB + kstep, voffB); PG8_STAGE(PG8_SA(1, 0), cA + kstep, voffA); PG8_STAGE(PG8_SB(1, 1), cB + hstep + kstep, voffB);
        PG8_WAIT_V(6); PG8_BAR;
    } else {
        PG8_STAGE(PG8_SB(0, 0), cB, voffB); PG8_STAGE(PG8_SA(0, 0), cA, voffA); PG8_STAGE(PG8_SB(0, 1), cB + hstep, voffB); PG8_STAGE(PG8_SA(0, 1), cA + hstep, voffA);
        if (wr == 1) PG8_BAR;
        PG8_WAIT_V(4); PG8_BAR;
        PG8_STAGE(PG8_SB(1, 0), cB + kstep, voffB); PG8_STAGE(PG8_SA(1, 0), cA + kstep, voffA); PG8_STAGE(PG8_SB(1, 1), cB + hstep + kstep, voffB);
        PG8_WAIT_V(6); PG8_BAR;
    }
    for (;;) {
        const bool has_next = S.next(ui + 1, nxt);
        const char* nA = has_next ? (const char*)g.A + (size_t)nxt.pm * tstep + (size_t)nxt.pc * g.csA + (size_t)nxt.k0 * kstep : cA; const char* nB = has_next ? (const char*)g.Bt + (size_t)nxt.pn * tstep + (size_t)nxt.pc * g.csB + (size_t)nxt.k0 * kstep : cB;
        const int nt = cur.nt;
        for (int t = 0; t < nt; t += 2) {
            const bool last = (t == nt - 2);
            const char* a1 = cA + (size_t)(t + 1) * kstep;
            const char* a2 = last ? nA : cA + (size_t)(t + 2) * kstep; const char* b2 = last ? nB : cB + (size_t)(t + 2) * kstep;
            const char* a3 = a2 + kstep; const char* b3 = b2 + kstep;
            if (last && has_next) S.a_ready(nxt);
            if constexpr (SP2) {
            PG8_LDB(B0, 0, 0); PG8_LDB(B1, 0, 1); PG8_SCHED; PG8_LDA(At, 0, 0); PG8_STAGE(PG8_SA(1, 1), a1 + hstep, voffA);
            PG8_WAIT_V(8); PG8_WAIT_L(0); PG8_BAR; PG8_MMA(0, 0, At, B0); PG8_MMA(0, 1, At, B1); PG8_BAR; PG8_SCHED;
            PG8_LDA(At, 0, 1); PG8_STAGE(PG8_SB(0, 0), b2, voffB); PG8_STAGE(PG8_SB(0, 1), b2 + hstep, voffB); PG8_STAGE(PG8_SA(0, 0), a2, voffA);
            PG8_WAIT_V(8); PG8_WAIT_L(0); PG8_BAR; PG8_MMA(1, 0, At, B0); PG8_MMA(1, 1, At, B1); PG8_BAR; PG8_SCHED;
            PG8_LDB(B0, 1, 0); PG8_LDB(B1, 1, 1); PG8_SCHED; PG8_LDA(At, 1, 0); PG8_STAGE(PG8_SA(0, 1), a2 + hstep, voffA);
            PG8_WAIT_V(8); PG8_WAIT_L(0); PG8_BAR; PG8_MMA(0, 0, At, B0); PG8_MMA(0, 1, At, B1); PG8_BAR; PG8_SCHED;
            PG8_LDA(At, 1, 1); PG8_STAGE(PG8_SB(1, 0), b3, voffB); PG8_STAGE(PG8_SB(1, 1), b3 + hstep, voffB); PG8_STAGE(PG8_SA(1, 0), a3, voffA);
            PG8_WAIT_V(8); PG8_WAIT_L(0); PG8_BAR; PG8_MMA(1, 0, At, B0); PG8_MMA(1, 1, At, B1); PG8_BAR; PG8_SCHED;
            } else {
            PG8_LDB(B0, 0, 0); PG8_SCHED; PG8_LDA(At, 0, 0); PG8_STAGE(PG8_SA(1, 1), a1 + hstep, voffA);
            PG8_WAIT_L(8); PG8_BAR; PG8_WAIT_L(0); PG8_MMA(0, 0, At, B0); PG8_BAR; PG8_SCHED;
            PG8_LDB(B1, 0, 1); PG8_STAGE(PG8_SB(0, 0), b2, voffB);
            PG8_BAR; PG8_WAIT_L(0); PG8_MMA(0, 1, At, B1); PG8_BAR;
            PG8_LDA(At, 0, 1); PG8_STAGE(PG8_SA(0, 0), a2, voffA);
            PG8_BAR; PG8_WAIT_L(0); PG8_MMA(1, 0, At, B0); PG8_BAR; PG8_SCHED;
            PG8_STAGE(PG8_SB(0, 1), b2 + hstep, voffB);
            PG8_WAIT_V(6); PG8_BAR; PG8_MMA(1, 1, At, B1); PG8_BAR;
            PG8_LDB(B0, 1, 0); PG8_SCHED; PG8_LDA(At, 1, 0); PG8_STAGE(PG8_SA(0, 1), a2 + hstep, voffA);
            PG8_WAIT_L(8); PG8_BAR; PG8_WAIT_L(0); PG8_MMA(0, 0, At, B0); PG8_BAR; PG8_SCHED;
            PG8_LDB(B1, 1, 1); PG8_STAGE(PG8_SB(1, 0), b3, voffB);
            PG8_BAR; PG8_WAIT_L(0); PG8_MMA(0, 1, At, B1); PG8_BAR;
            PG8_LDA(At, 1, 1); PG8_STAGE(PG8_SA(1, 0), a3, voffA);
            PG8_BAR; PG8_WAIT_L(0); PG8_MMA(1, 0, At, B0); PG8_BAR; PG8_SCHED;
            PG8_STAGE(PG8_SB(1, 1), b3 + hstep, voffB);
            PG8_WAIT_V(6); PG8_BAR; PG8_MMA(1, 1, At, B1); PG8_BAR;
            }
        }
        if constexpr (ALIGN_EPI) { if (wr == 0) PG8_BAR; }
        if constexpr (!Epi::AFTER_DRAIN) { E(acc, cur, wr, wc, fr, fq); S.done(cur); }
        if (!has_next) break;
#pragma unroll
        for (int a = 0; a < 2; ++a)
#pragma unroll
            for (int b = 0; b < 2; ++b)
#pragma unroll
                for (int m = 0; m < 4; ++m)
#pragma unroll
                    for (int n = 0; n < 2; ++n) acc[a][b][m][n] = (f32x4){0.f, 0.f, 0.f, 0.f};
        cur = nxt; cA = nA; cB = nB; ++ui;
        if constexpr (ALIGN_EPI) { if (wr == 1) PG8_BAR; }
    }
    PG8_WAIT_V(0);
    if constexpr (!ALIGN_EPI) { if (wr == 0) PG8_BAR; }
    PG8_BAR;
    if constexpr (Epi::AFTER_DRAIN) { E.fused(acc, cur, wr, wc, fr, fq, lds, wid, lane); S.done(cur); }
#undef PG8_SA
#undef PG8_SB
#undef PG8_STAGE
#undef PG8_LDA
#undef PG8_LDB
#undef PG8_MMA
#undef PG8_WAIT_V
#undef PG8_WAIT_L
#undef PG8_BAR
#undef PG8_SCHED
}
}


constexpr int D = 2048, NL = 4, FFN = 5632, NPROJ = 15872, INCOLS = 15888;
constexpr int MR = 9280, MP = 9472, NCH = 145, NCHP = 129;
constexpr int ROW_P0 = 64, ROW_S0 = 8256, NNULL = 48;
constexpr int STATE_N = 327680, ST_SSD = 0, ST_HG = 131072, ST_RET = 262144;
constexpr int GAM_N = 1040;
constexpr float EPS = 1e-6f;
constexpr size_t O_YP = 0, O_YS = 16777216, O_CONVP = O_YS + 2097152, O_SSMP = O_CONVP + 18432, O_HGP = O_SSMP + 524288, O_RETP = O_HGP + 524288,
                 O_CONVS = O_RETP + 262144, O_SSMS = O_CONVS + 294912, O_HGS = O_SSMS + 8388608, O_RETS = O_HGS + 8388608, O_END = O_RETS + 4194304;

constexpr size_t MiB = 1u << 20;
constexpr size_t al(size_t x) { return (x + MiB - 1) / MiB * MiB; }
constexpr size_t WS_CTL = 0, CTL_ZERO_BYTES = 2 * MiB;
constexpr size_t SZ_WIN = (size_t)NPROJ * D * 2, SZ_WBR = (size_t)3 * D * 1024 * 2, SZ_WOUT = (size_t)D * D * 2, SZ_WGU = (size_t)2 * FFN * D * 2, SZ_WDN = (size_t)D * FFN * 2, SZ_WDT = (size_t)16 * D * 2;
constexpr size_t LW_IN = 0, LW_BR = LW_IN + al(SZ_WIN), LW_OUT = LW_BR + al(SZ_WBR), LW_GU = LW_OUT + al(SZ_WOUT), LW_DN = LW_GU + al(SZ_WGU), LW_DT = LW_DN + al(SZ_WDN), LW_SIZE = LW_DT + al(SZ_WDT);
constexpr size_t WS_W = 2 * MiB;
constexpr size_t WS_X = WS_W + 4 * LW_SIZE;
constexpr size_t WS_H = WS_X + al((size_t)MP * D * 4);
constexpr size_t WS_ZS = WS_H + al((size_t)MP * D * 2);
constexpr size_t WS_XBC = WS_ZS + al((size_t)MP * 1024 * 2);
constexpr size_t WS_HQ = WS_XBC + al((size_t)MP * 1536 * 2);
constexpr size_t WS_LG = WS_HQ + al((size_t)MP * 1024 * 2);
constexpr size_t WS_KK = WS_LG + al((size_t)MP * 1024 * 4);
constexpr size_t WS_HV = WS_KK + al((size_t)MP * 1024 * 2);
constexpr size_t WS_HG = WS_HV + al((size_t)MP * 1024 * 2);
constexpr size_t WS_RQ = WS_HG + al((size_t)MP * 1024 * 2);
constexpr size_t WS_RK = WS_RQ + al((size_t)MP * 512 * 2);
constexpr size_t WS_RV = WS_RK + al((size_t)MP * 512 * 2);
constexpr size_t WS_RG = WS_RV + al((size_t)MP * 1024 * 2);
constexpr size_t WS_GT = WS_RG + al((size_t)MP * 1024 * 2);
constexpr size_t WS_DT = WS_GT + al((size_t)MP * 6144 * 2);
constexpr size_t WS_CUM = WS_DT + al((size_t)MP * 16 * 4);
constexpr size_t WS_U = WS_CUM + al((size_t)MP * 16 * 4);
constexpr size_t WS_SB = WS_U + al((size_t)NCH * STATE_N * 4);
constexpr size_t WS_GAM = WS_SB + al((size_t)NCH * STATE_N * 2);
constexpr size_t WS_BR = WS_GAM + al((size_t)NCH * GAM_N * 4);
constexpr size_t WS_TMP = WS_BR + al((size_t)3 * MP * 1024 * 2);
constexpr size_t WS_MIX = WS_TMP + al((size_t)MP * D * 4);
constexpr size_t WS_HID = WS_MIX + al((size_t)MP * D * 2);
constexpr size_t WS_ROPE = WS_HID + al((size_t)MP * FFN * 2);
constexpr size_t WS_LBS = WS_ROPE + al((size_t)MP * 32 * 8);
constexpr size_t WS_AV = WS_LBS + 1 * MiB;
constexpr size_t WS_XTG = WS_AV + al((size_t)MP * 16 * 4);
constexpr size_t WS_BCG = WS_XTG + al((size_t)NCH * 1024 * 64 * 2);
constexpr size_t WS_SLAB = WS_BCG + al((size_t)MP * 512 * 2);
constexpr size_t WS_END = WS_SLAB + (size_t)2 * 256 * 65536 * 4;
constexpr int CW_BAR = 4096, CW_QUEUE = 16384, CW_SK = 32768, CW_TMO = 8;
constexpr int CW_END = CW_SK + 8 * 256 * 64;
constexpr int CW_G2 = 163840;
constexpr int CW_RS = CW_G2 + 64 * 64 * 8;
constexpr int CW_RDY = 360448;
static_assert((size_t)CW_RS * 4 + (size_t)8 * MP * 8 <= (size_t)CW_RDY * 4 && (size_t)(CW_RDY + 8 * 64 * 32) * 4 <= ((size_t)2 << 20), "hand-off counters inside the memset region");
static_assert((size_t)CW_RS * 4 + (size_t)8 * MP * 8 <= (size_t)2 << 20, "control words inside the memset region");
typedef unsigned long long u64;
__device__ __forceinline__ float rs_to_rstd(u64 s) { return rsqrtf((float)s * (1.0f / 1048576.0f) * (1.0f / D) + EPS); }
__device__ __forceinline__ u64 ss_to_fix(float s) { return (u64)(s * 1048576.0f); }

constexpr int RING_BYTES = 131072;
constexpr int LDSCTL_OFF = 147456 - 512, LDS_BYTES = 147456;
constexpr int NWAVES = 8, NTHR = 512;

#define GAS __attribute__((address_space(1)))
#define LAS __attribute__((address_space(3)))
typedef unsigned short bf16;
typedef unsigned v4u __attribute__((ext_vector_type(4)));
typedef unsigned v2u __attribute__((ext_vector_type(2)));
typedef float f32x4 __attribute__((ext_vector_type(4)));
typedef float f32x2 __attribute__((ext_vector_type(2)));
typedef short bf16x8 __attribute__((ext_vector_type(8)));
typedef GAS unsigned gu32;
#define RLX_AGENT __ATOMIC_RELAXED, __HIP_MEMORY_SCOPE_AGENT

__device__ __forceinline__ unsigned f2bf(float f) { unsigned u = __builtin_bit_cast(unsigned, f); return (u + 0x7fffu + ((u >> 16) & 1u)) >> 16; }
typedef __bf16 bf16v2 __attribute__((ext_vector_type(2)));
__device__ __forceinline__ unsigned pk2(float lo, float hi) { const f32x2 v = {lo, hi}; return __builtin_bit_cast(unsigned, __builtin_convertvector(v, bf16v2)); }
__device__ __forceinline__ float bf2f(unsigned short b) { return __builtin_bit_cast(float, ((unsigned)b) << 16); }
__device__ __forceinline__ float bflo(unsigned w) { return __builtin_bit_cast(float, w << 16); }
__device__ __forceinline__ float bfhi(unsigned w) { return __builtin_bit_cast(float, w & 0xffff0000u); }
__device__ __forceinline__ float fsigmoid(float v) { return __builtin_amdgcn_rcpf(1.0f + __expf(-v)); }
__device__ __forceinline__ float fsilu(float v) { return v * fsigmoid(v); }
__device__ __forceinline__ f32x4 mfma16(bf16x8 a, bf16x8 b, f32x4 c) { return __builtin_amdgcn_mfma_f32_16x16x32_bf16(a, b, c, 0, 0, 0); }
__device__ __forceinline__ float wave_sum(float v) {
#pragma unroll
    for (int o = 1; o < 64; o <<= 1) v += __shfl_xor(v, o);
    return v;
}
#ifndef MK_G2_NOSPLIT
#define MK_G2_NOSPLIT 0
#endif
#ifndef MK_PREFETCH
#define MK_PREFETCH 0
#endif
__device__ __forceinline__ v2u pk4(const f32x4 v) { v2u w; w.x = pk2(v[0], v[1]); w.y = pk2(v[2], v[3]); return w; }
__device__ __forceinline__ f32x4 unpk4(const v2u w) { return (f32x4){bflo(w.x), bfhi(w.x), bflo(w.y), bfhi(w.y)}; }
#define LDS_WAIT() asm volatile("s_waitcnt lgkmcnt(0)" ::: "memory")
#define LBAR() do { asm volatile("s_waitcnt lgkmcnt(0)" ::: "memory"); __builtin_amdgcn_s_barrier(); asm volatile("" ::: "memory"); } while (0)
#define XB_TMO      128
#define XB_XCNT(j)  (256  + 64 * (j))
#define XB_XSUB(j)  (1280 + 64 * (j))
#define XB_XGEN(j)  (2304 + 64 * (j))
#define XB_TOP      3328
#define XB_TOPGEN   3392
#define XCD_BAR_WORDS 3456
#define XB_SPIN_CAP (1u << 18)

__device__ __forceinline__ unsigned xb_ld(unsigned* p)              { return __hip_atomic_load(p, __ATOMIC_RELAXED, __HIP_MEMORY_SCOPE_AGENT); }
__device__ __forceinline__ unsigned xb_add(unsigned* p, unsigned v) { return __hip_atomic_fetch_add(p, v, __ATOMIC_RELAXED, __HIP_MEMORY_SCOPE_AGENT); }
__device__ __forceinline__ unsigned xb_xcc_id() { return (unsigned)__builtin_amdgcn_s_getreg((3 << 11) | 20) & 0xFu; }
#define XB_SPIN(cond, bar) do { unsigned _sp = 0; while (cond) { __builtin_amdgcn_s_sleep(1); \
    if ((++_sp & 255u) == 0u) { if (xb_ld(&(bar)[XB_TMO])) break; if (_sp > XB_SPIN_CAP) { atomicAdd(&(bar)[XB_TMO], 1u); break; } } } } while (0)

struct XcdBarrier {
    unsigned* bar; unsigned x;
    volatile LAS unsigned* st;
};

__device__ __forceinline__ XcdBarrier xcd_barrier_post(unsigned* bar, volatile LAS unsigned* st) {
    XcdBarrier b; b.bar = bar; b.x = xb_xcc_id(); b.st = st;
    if (threadIdx.x == 0) (void)xb_add(&bar[XB_XCNT(b.x)], 1u);
    return b;
}
__device__ __forceinline__ void xcd_barrier_complete(unsigned* bar, unsigned x, unsigned& nloc, unsigned& nx) {
    const unsigned G = gridDim.x * gridDim.y * gridDim.z;
    unsigned sum, cnt, mine, sp = 0u;
    for (;;) {
        sum = 0u; cnt = 0u; mine = 0u;
#pragma unroll
        for (unsigned j = 0; j < 16; ++j) { const unsigned c = xb_ld(&bar[XB_XCNT(j)]); sum += c; cnt += (c > 0u) ? 1u : 0u; mine = (j == x) ? c : mine; }
        if (sum == G) break;
        __builtin_amdgcn_s_sleep(1);
        if ((++sp & 255u) == 0u) { if (xb_ld(&bar[XB_TMO])) break; if (sp > XB_SPIN_CAP) { atomicAdd(&bar[XB_TMO], 1u); break; } }
    }
    nloc = mine > 0u ? mine : 1u; nx = cnt > 0u ? cnt : 1u;
}

__device__ __forceinline__ void xcd_barrier(const XcdBarrier& b) {
    asm volatile("s_waitcnt vmcnt(0)" ::: "memory");
    __syncthreads();
    if (threadIdx.x == 0) {
        unsigned* bar = b.bar;
        __builtin_amdgcn_s_waitcnt(0);
        unsigned nloc = b.st[0], nx = b.st[1];
        if (nloc == 0u) { xcd_barrier_complete(bar, b.x, nloc, nx); b.st[0] = nloc; b.st[1] = nx; }
        const unsigned old = xb_add(&bar[XB_XSUB(b.x)], 1u);
        const unsigned gen = old / nloc;
        if (old + 1u == (gen + 1u) * nloc) {
            __builtin_amdgcn_fence(__ATOMIC_RELEASE, "agent");
            asm volatile("s_waitcnt vmcnt(0)" ::: "memory");
            const unsigned og = xb_add(&bar[XB_TOP], 1u);
            const unsigned tg = og / nx;
            if (og + 1u == (tg + 1u) * nx) xb_add(&bar[XB_TOPGEN], 1u);
            else XB_SPIN(xb_ld(&bar[XB_TOPGEN]) == tg, bar);
            __builtin_amdgcn_fence(__ATOMIC_ACQUIRE, "agent");
            xb_add(&bar[XB_XGEN(b.x)], 1u);
            asm volatile("s_waitcnt vmcnt(0)" ::: "memory");
        } else {
            XB_SPIN(xb_ld(&bar[XB_XGEN(b.x)]) == gen, bar);
            __builtin_amdgcn_fence(__ATOMIC_ACQUIRE, "agent");
            asm volatile("s_waitcnt vmcnt(0)" ::: "memory");
        }
    }
    __syncthreads();
}


typedef const f32x4 (&AccRef)[2][2][4][2];

struct EpiProj {
    static constexpr bool PERM = true, AFTER_DRAIN = false;
    unsigned char* ws; int layer;
    template <int T> __device__ __forceinline__ void run(AccRef acc, bf16* dst, int pitch, int row0, int col0, int ltid = 0) const {
        const float* lbs = (const float*)(ws + WS_LBS) + layer * 1024; bf16* LG = (bf16*)(ws + WS_LG); const f32x2* rope = (const f32x2*)(ws + WS_ROPE); const u64* RS = (const u64*)((const unsigned*)(ws + WS_CTL) + CW_RS) + (size_t)(2 * layer) * MP;
        f32x4 lb[2][2];
        if (T == 3) {
#pragma unroll
            for (int bj = 0; bj < 2; ++bj) { lb[bj][0] = *(const f32x4*)(lbs + col0 + bj * 128); lb[bj][1] = *(const f32x4*)(lbs + col0 + bj * 128 + 4); }
        }
#pragma unroll
        for (int ai = 0; ai < 2; ++ai)
#pragma unroll
            for (int m = 0; m < 4; ++m) {
                const int row = row0 + ai * 128 + m * 16; const float rsr = rs_to_rstd(RS[row]);
#pragma unroll
                for (int bj = 0; bj < 2; ++bj) {
                    const int col = col0 + bj * 128;
                    f32x4 v0 = acc[ai][bj][m][0] * rsr, v1 = acc[ai][bj][m][1] * rsr;
                    if (T == 1) {
#pragma unroll
                        for (int e = 0; e < 4; ++e) { v0[e] = fsilu(v0[e]); v1[e] = fsilu(v1[e]); }
                    }
                    if (T == 2) {
#pragma unroll
                        for (int e = 0; e < 4; ++e) { v0[e] = fsigmoid(v0[e]); v1[e] = fsigmoid(v1[e]); }
                    }
                    if (T == 3) {
                        f32x4 l0, l1;
#pragma unroll
                        for (int e = 0; e < 4; ++e) {
                            { const float b = lb[bj][0][e], fg = v0[e], s = fsigmoid(fg), sn = fsigmoid(-fg); l0[e] = __logf(fmaxf(b + (1.0f - b) * s, 1e-30f)); v0[e] = (1.0f - b) * sn; }
                            { const float b = lb[bj][1][e], fg = v1[e], s = fsigmoid(fg), sn = fsigmoid(-fg); l1[e] = __logf(fmaxf(b + (1.0f - b) * s, 1e-30f)); v1[e] = (1.0f - b) * sn; }
                        }
                        { v4u wl; wl.x = pk2(l0[0], l0[1]); wl.y = pk2(l0[2], l0[3]); wl.z = pk2(l1[0], l1[1]); wl.w = pk2(l1[2], l1[3]); *(v4u*)(LG + (size_t)row * 1024 + col) = wl; }
                    }
                    if (T == 4 || T == 5) {
                        const int j = (col & 63) >> 3;
                        const f32x4* rp = (const f32x4*)(rope + (size_t)row * 32 + 4 * j);
                        const f32x4 cs0 = rp[0], cs1 = rp[1];
                        const float c[4] = {cs0[0], cs0[2], cs1[0], cs1[2]}, s[4] = {cs0[1], cs0[3], cs1[1], cs1[3]};
                        const float sc = (T == 5) ? 0.125f : 1.0f;
#pragma unroll
                        for (int e = 0; e < 4; ++e) { const float a = v0[e], b = v1[e]; v0[e] = (a * c[e] - b * s[e]) * sc; v1[e] = (b * c[e] + a * s[e]) * sc; }
                    }
                    v4u w; w.x = pk2(v0[0], v0[1]); w.y = pk2(v0[2], v0[3]); w.z = pk2(v1[0], v1[1]); w.w = pk2(v1[2], v1[3]);
                    if (T == 2) *(v4u*)(dst + ((size_t)((ai * 4 + m) * 2 + bj) * 512 + ltid) * 8) = w;
                    else *(v4u*)(dst + (size_t)row * pitch + col) = w;
                }
            }
    }
    __device__ __forceinline__ void operator()(AccRef acc, const pg8::Unit& u, int wr, int wc, int fr, int fq) const {
        const int pn = u.pn, row0 = u.pm * 256 + wr * 64 + fr, cl = wc * 32 + 8 * fq;
        if (pn < 4) run<1>(acc, (bf16*)(ws + WS_ZS), 1024, row0, (pn - 0) * 256 + cl);
        else if (pn < 10) run<0>(acc, (bf16*)(ws + WS_XBC), 1536, row0, (pn - 4) * 256 + cl);
        else if (pn < 14) run<1>(acc, (bf16*)(ws + WS_HQ), 1024, row0, (pn - 10) * 256 + cl);
        else if (pn < 18) run<3>(acc, (bf16*)(ws + WS_KK), 1024, row0, (pn - 14) * 256 + cl);
        else if (pn < 22) run<0>(acc, (bf16*)(ws + WS_HV), 1024, row0, (pn - 18) * 256 + cl);
        else if (pn < 26) run<1>(acc, (bf16*)(ws + WS_HG), 1024, row0, (pn - 22) * 256 + cl);
        else if (pn < 28) run<4>(acc, (bf16*)(ws + WS_RQ), 512, row0, (pn - 26) * 256 + cl);
        else if (pn < 30) run<5>(acc, (bf16*)(ws + WS_RK), 512, row0, (pn - 28) * 256 + cl);
        else if (pn < 34) run<0>(acc, (bf16*)(ws + WS_RV), 1024, row0, (pn - 30) * 256 + cl);
        else if (pn < 38) run<1>(acc, (bf16*)(ws + WS_RG), 1024, row0, (pn - 34) * 256 + cl);
        else run<2>(acc, (bf16*)(ws + WS_GT) + (size_t)(u.pm * 24 + (pn - 38)) * 65536, 6144, row0, (pn - 38) * 256 + cl, (wr * 4 + wc) * 64 + fr + 16 * fq);
    }
};

template <int MODE = 0  > struct EpiBranchT {
    static constexpr bool PERM = true, AFTER_DRAIN = false;
    bf16* TMP; bf16* MIX; const bf16* GT; float* slabs; unsigned* cnt; unsigned* tmo; unsigned* rdy = nullptr;
    __device__ __forceinline__ void operator()(AccRef acc, const pg8::Unit& u, int wr, int wc, int fr, int fq) const {
        const int pc = u.pc; int row0 = u.pm * 256 + wr * 64 + fr; const int col0 = u.pn * 256 + wc * 32 + 8 * fq; asm volatile("" : "+v"(row0));
        int ltid = (wr * 4 + wc) * 64 + fr + 16 * fq; asm volatile("" : "+v"(ltid));
        if (u.kind == 3) {
            const int lane = fr + 16 * fq, wid = wr * 4 + wc; int tid = wid * 64 + lane; asm volatile("" : "+v"(tid));
            const int lt = u.slab;
            v4u vp[2][4][2];
#pragma unroll
            for (int ai = 0; ai < 2; ++ai) {
                v4u gq[4][2];
#pragma unroll
                for (int m = 0; m < 4; ++m)
#pragma unroll
                    for (int bj = 0; bj < 2; ++bj) gq[m][bj] = *(const v4u*)(GT + ((size_t)(u.pm * 24 + pc * 8 + u.pn) * 16 + (ai * 4 + m) * 2 + bj) * 4096 + (size_t)ltid * 8);
                __builtin_amdgcn_sched_barrier(0);
#pragma unroll
                for (int m = 0; m < 4; ++m)
#pragma unroll
                    for (int bj = 0; bj < 2; ++bj) { const v4u g = gq[m][bj]; const f32x4 a = acc[ai][bj][m][0] * (f32x4){bflo(g.x), bfhi(g.x), bflo(g.y), bfhi(g.y)}, b = acc[ai][bj][m][1] * (f32x4){bflo(g.z), bfhi(g.z), bflo(g.w), bfhi(g.w)};
                        v4u w; w.x = pk2(a[0], a[1]); w.y = pk2(a[2], a[3]); w.z = pk2(b[0], b[1]); w.w = pk2(b[2], b[3]); vp[ai][m][bj] = w; }
                __builtin_amdgcn_sched_barrier(0);
            }
            if (pc < 2) {
                __amdgpu_buffer_rsrc_t rsrc = __builtin_amdgcn_make_buffer_rsrc(slabs + (size_t)(lt * 3 + pc) * 65536, 0, 65536 * 4, 0x00020000);
#pragma unroll
                for (int ai = 0; ai < 2; ++ai)
#pragma unroll
                    for (int m = 0; m < 4; ++m)
#pragma unroll
                        for (int bj = 0; bj < 2; ++bj) { const int j = (ai * 4 + m) * 2 + bj; __builtin_amdgcn_raw_buffer_store_b128(vp[ai][m][bj], rsrc, (j * 512 + tid) * 16, 0, 16); }
                asm volatile("s_waitcnt vmcnt(0)" ::: "memory");
                if (lane == 0) __hip_atomic_fetch_add(cnt + 64 * lt, 1u, __ATOMIC_RELAXED, __HIP_MEMORY_SCOPE_AGENT);
            } else {
                unsigned sp = 0;
                while ((unsigned)__builtin_amdgcn_readfirstlane(__hip_atomic_load(cnt + 64 * lt, __ATOMIC_RELAXED, __HIP_MEMORY_SCOPE_AGENT)) < 16u) {
                    __builtin_amdgcn_s_sleep(2);
                    if ((++sp & 1023u) == 0u) { if (__hip_atomic_load(tmo, __ATOMIC_RELAXED, __HIP_MEMORY_SCOPE_AGENT) != 0u) break; if (sp > (1u << 22)) { if (lane == 0) __hip_atomic_store(tmo, 1u, __ATOMIC_RELAXED, __HIP_MEMORY_SCOPE_AGENT); break; } }
                }
                __builtin_amdgcn_fence(__ATOMIC_ACQUIRE, "agent");
                const v4u* s1 = (const v4u*)(slabs + (size_t)(lt * 3 + 0) * 65536) + tid; const v4u* s2 = (const v4u*)(slabs + (size_t)(lt * 3 + 1) * 65536) + tid;
#pragma unroll
                for (int ai = 0; ai < 2; ++ai) {
                    v4u q1[4][2], q2[4][2];
#pragma unroll
                    for (int m = 0; m < 4; ++m)
#pragma unroll
                        for (int bj = 0; bj < 2; ++bj) { const int j = (ai * 4 + m) * 2 + bj; q1[m][bj] = s1[j * 512]; q2[m][bj] = s2[j * 512]; }
                    __builtin_amdgcn_sched_barrier(0);
#pragma unroll
                    for (int m = 0; m < 4; ++m)
#pragma unroll
                        for (int bj = 0; bj < 2; ++bj) { const v4u a = vp[ai][m][bj], b = q1[m][bj], c = q2[m][bj]; v4u w;
                            w.x = pk2(bflo(a.x) + bflo(b.x) + bflo(c.x), bfhi(a.x) + bfhi(b.x) + bfhi(c.x)); w.y = pk2(bflo(a.y) + bflo(b.y) + bflo(c.y), bfhi(a.y) + bfhi(b.y) + bfhi(c.y));
                            w.z = pk2(bflo(a.z) + bflo(b.z) + bflo(c.z), bfhi(a.z) + bfhi(b.z) + bfhi(c.z)); w.w = pk2(bflo(a.w) + bflo(b.w) + bflo(c.w), bfhi(a.w) + bfhi(b.w) + bfhi(c.w));
                            if (rdy) __builtin_amdgcn_raw_buffer_store_b128(__builtin_bit_cast(pg8::u32x4, w), __builtin_amdgcn_make_buffer_rsrc(MIX, 0, MP * D * 2, 0x00020000), ((row0 + ai * 128 + m * 16) * D + col0 + bj * 128) * 2, 0, 16);
                            else *(v4u*)(MIX + (size_t)(row0 + ai * 128 + m * 16) * D + col0 + bj * 128) = w; }
                    __builtin_amdgcn_sched_barrier(0);
                }
                if (rdy) { asm volatile("s_waitcnt vmcnt(0)" ::: "memory"); if (lane == 0) __hip_atomic_fetch_add(rdy + 32 * u.pm, 1u, __ATOMIC_RELAXED, __HIP_MEMORY_SCOPE_AGENT); }
            }
            return;
        }
#pragma unroll
        for (int ai = 0; ai < 2; ++ai) {
            v4u gq[4][2];
#pragma unroll
            for (int m = 0; m < 4; ++m)
#pragma unroll
                for (int bj = 0; bj < 2; ++bj) gq[m][bj] = MODE == 2 ? (v4u){0x3f803f80u, 0x3f803f80u, 0x3f803f80u, 0x3f803f80u} : *(const v4u*)(GT + ((size_t)(u.pm * 24 + pc * 8 + u.pn) * 16 + (ai * 4 + m) * 2 + bj) * 4096 + (size_t)ltid * 8);
            v4u tq[4][2];
            if (pc > 0 && MODE != 1) {
#pragma unroll
                for (int m = 0; m < 4; ++m)
#pragma unroll
                    for (int bj = 0; bj < 2; ++bj) tq[m][bj] = *(const v4u*)(TMP + ((size_t)(u.pm * 8 + u.pn) * 16 + (ai * 4 + m) * 2 + bj) * 4096 + (size_t)ltid * 8);
            }
            __builtin_amdgcn_sched_barrier(0);
#pragma unroll
            for (int m = 0; m < 4; ++m) {
                const int row = row0 + ai * 128 + m * 16;
#pragma unroll
                for (int bj = 0; bj < 2; ++bj) {
                    const int col = col0 + bj * 128;
                    const v4u g = gq[m][bj];
                    f32x4 v0 = acc[ai][bj][m][0], v1 = acc[ai][bj][m][1];
                    v0[0] *= bflo(g.x); v0[1] *= bfhi(g.x); v0[2] *= bflo(g.y); v0[3] *= bfhi(g.y);
                    v1[0] *= bflo(g.z); v1[1] *= bfhi(g.z); v1[2] *= bflo(g.w); v1[3] *= bfhi(g.w);
                    bf16* tp = TMP + ((size_t)(u.pm * 8 + u.pn) * 16 + (ai * 4 + m) * 2 + bj) * 4096 + (size_t)ltid * 8;
                    if (pc > 0 && MODE != 1) { const v4u t = tq[m][bj]; v0[0] += bflo(t.x); v0[1] += bfhi(t.x); v0[2] += bflo(t.y); v0[3] += bfhi(t.y); v1[0] += bflo(t.z); v1[1] += bfhi(t.z); v1[2] += bflo(t.w); v1[3] += bfhi(t.w); }
                    if (pc < 2 && MODE != 1) { v4u w; w.x = pk2(v0[0], v0[1]); w.y = pk2(v0[2], v0[3]); w.z = pk2(v1[0], v1[1]); w.w = pk2(v1[2], v1[3]); *(v4u*)tp = w; }
                    else { v4u w; w.x = pk2(v0[0], v0[1]); w.y = pk2(v0[2], v0[3]); w.z = pk2(v1[0], v1[1]); w.w = pk2(v1[2], v1[3]);
                        if (rdy) __builtin_amdgcn_raw_buffer_store_b128(__builtin_bit_cast(pg8::u32x4, w), __builtin_amdgcn_make_buffer_rsrc(MIX, 0, MP * D * 2, 0x00020000), (row * D + col) * 2, 0, 16); else *(v4u*)(MIX + (size_t)row * D + col) = w; }
                }
            }
            __builtin_amdgcn_sched_barrier(0);
        }
        if (rdy && pc == 2) { asm volatile("s_waitcnt vmcnt(0)" ::: "memory"); if (fr + 16 * fq == 0) __hip_atomic_fetch_add(rdy + 32 * u.pm, 1u, __ATOMIC_RELAXED, __HIP_MEMORY_SCOPE_AGENT); }
    }
};
typedef EpiBranchT<0> EpiBranch;

struct EpiResid {
    static constexpr bool PERM = true, AFTER_DRAIN = false;
    bf16* X; float* slabs; unsigned* cnt; unsigned* tmo; u64* RSN; unsigned* rdy = nullptr;
    __device__ __forceinline__ void operator()(AccRef acc, const pg8::Unit& u, int wr, int wc, int fr, int fq) const {
        const int lane = fr + 16 * fq, wid = wr * 4 + wc; int tid = wid * 64 + lane; asm volatile("" : "+v"(tid));
        if (u.kind == 1) {
            __amdgpu_buffer_rsrc_t rsrc = __builtin_amdgcn_make_buffer_rsrc(slabs + (size_t)u.slab * 65536, 0, 65536 * 4, 0x00020000);
#pragma unroll
            for (int ai = 0; ai < 2; ++ai)
#pragma unroll
                for (int bj = 0; bj < 2; ++bj)
#pragma unroll
                    for (int m = 0; m < 4; ++m)
#pragma unroll
                        for (int n = 0; n < 2; ++n) { const int j = ((ai * 2 + bj) * 4 + m) * 2 + n; __builtin_amdgcn_raw_buffer_store_b128(__builtin_bit_cast(pg8::u32x4, acc[ai][bj][m][n]), rsrc, (j * 512 + tid) * 16, 0, 16); }
            asm volatile("s_waitcnt vmcnt(0)" ::: "memory");
            if (lane == 0) __hip_atomic_fetch_add(cnt + 64 * u.slab, 1u, __ATOMIC_RELAXED, __HIP_MEMORY_SCOPE_AGENT);
            return;
        }
        const f32x4* sl = (const f32x4*)(slabs + (size_t)u.slab * 65536);
        if (u.kind == 2) {
            unsigned sp = 0;
            while ((unsigned)__builtin_amdgcn_readfirstlane(__hip_atomic_load(cnt + 64 * u.slab, __ATOMIC_RELAXED, __HIP_MEMORY_SCOPE_AGENT)) < 8u) {
                __builtin_amdgcn_s_sleep(2);
                if ((++sp & 1023u) == 0u) { if (__hip_atomic_load(tmo, __ATOMIC_RELAXED, __HIP_MEMORY_SCOPE_AGENT) != 0u) break; if (sp > (1u << 22)) { if (lane == 0) __hip_atomic_store(tmo, 1u, __ATOMIC_RELAXED, __HIP_MEMORY_SCOPE_AGENT); break; } }
            }
            __builtin_amdgcn_fence(__ATOMIC_ACQUIRE, "agent");
        }
        int row0 = u.pm * 256 + wr * 64 + fr; const int col0 = u.pn * 256 + wc * 32 + 8 * fq; asm volatile("" : "+v"(row0));
        __amdgpu_buffer_rsrc_t xr = __builtin_amdgcn_make_buffer_rsrc(X, 0, MP * D * 2, 0x00020000);
#pragma unroll
        for (int ai = 0; ai < 2; ++ai) {
            v4u xq[4][2];
            float ssq[4] = {0.f, 0.f, 0.f, 0.f};
#pragma unroll
            for (int m = 0; m < 4; ++m)
#pragma unroll
                for (int bj = 0; bj < 2; ++bj) xq[m][bj] = *(const v4u*)(X + (size_t)(row0 + ai * 128 + m * 16) * D + col0 + bj * 128);
            __builtin_amdgcn_sched_barrier(0);
#pragma unroll
            for (int m = 0; m < 4; ++m)
#pragma unroll
                for (int bj = 0; bj < 2; ++bj) { const v4u x = xq[m][bj]; f32x4 a = acc[ai][bj][m][0] + (f32x4){bflo(x.x), bfhi(x.x), bflo(x.y), bfhi(x.y)}, b = acc[ai][bj][m][1] + (f32x4){bflo(x.z), bfhi(x.z), bflo(x.w), bfhi(x.w)};
                    if (u.kind == 2) { const int j0 = ((ai * 2 + bj) * 4 + m) * 2; a += sl[j0 * 512 + tid]; b += sl[(j0 + 1) * 512 + tid]; }
                    v4u w; w.x = pk2(a[0], a[1]); w.y = pk2(a[2], a[3]); w.z = pk2(b[0], b[1]); w.w = pk2(b[2], b[3]); if (rdy) __builtin_amdgcn_raw_buffer_store_b128(__builtin_bit_cast(pg8::u32x4, w), xr, ((row0 + ai * 128 + m * 16) * D + col0 + bj * 128) * 2, 0, 16); else *(v4u*)(X + (size_t)(row0 + ai * 128 + m * 16) * D + col0 + bj * 128) = w;
                    ssq[m] += ((a[0] * a[0] + a[1] * a[1]) + (a[2] * a[2] + a[3] * a[3])) + ((b[0] * b[0] + b[1] * b[1]) + (b[2] * b[2] + b[3] * b[3])); }
            if (RSN) {
#pragma unroll
                for (int m = 0; m < 4; ++m) { float s = ssq[m]; s += __shfl_xor(s, 16); s += __shfl_xor(s, 32); if (fq == 0) __hip_atomic_fetch_add(RSN + row0 + ai * 128 + m * 16, ss_to_fix(s), __ATOMIC_RELAXED, __HIP_MEMORY_SCOPE_AGENT); } }
            __builtin_amdgcn_sched_barrier(0);
        }
        if (rdy) { asm volatile("s_waitcnt vmcnt(0)" ::: "memory");
            if (lane == 0) __hip_atomic_fetch_add(rdy + 32 * u.pm, 1u, __ATOMIC_RELAXED, __HIP_MEMORY_SCOPE_AGENT); }
    }
};

struct EpiSwiglu {
    static constexpr bool PERM = true, AFTER_DRAIN = false;
    bf16* HID; float* slabs; unsigned* cnt; unsigned* tmo; const u64* RS;
    __device__ __forceinline__ void operator()(AccRef acc, const pg8::Unit& u, int wr, int wc, int fr, int fq) const {
        const int lane = fr + 16 * fq, wid = wr * 4 + wc; int tid = wid * 64 + lane; asm volatile("" : "+v"(tid));
        if (u.kind == 1) {
            __amdgpu_buffer_rsrc_t rsrc = __builtin_amdgcn_make_buffer_rsrc(slabs + (size_t)u.slab * 65536, 0, 65536 * 4, 0x00020000);
#pragma unroll
            for (int ai = 0; ai < 2; ++ai)
#pragma unroll
                for (int bj = 0; bj < 2; ++bj)
#pragma unroll
                    for (int m = 0; m < 4; ++m)
#pragma unroll
                        for (int n = 0; n < 2; ++n) { const int j = ((ai * 2 + bj) * 4 + m) * 2 + n; __builtin_amdgcn_raw_buffer_store_b128(__builtin_bit_cast(pg8::u32x4, acc[ai][bj][m][n]), rsrc, (j * 512 + tid) * 16, 0, 16); }
            asm volatile("s_waitcnt vmcnt(0)" ::: "memory");
            if (lane == 0) __hip_atomic_fetch_add(cnt + 64 * u.slab, 1u, __ATOMIC_RELAXED, __HIP_MEMORY_SCOPE_AGENT);
            return;
        }
        const f32x4* sl = (const f32x4*)(slabs + (size_t)u.slab * 65536);
        if (u.kind == 2) {
            unsigned sp = 0;
            while ((unsigned)__builtin_amdgcn_readfirstlane(__hip_atomic_load(cnt + 64 * u.slab, __ATOMIC_RELAXED, __HIP_MEMORY_SCOPE_AGENT)) < 8u) {
                __builtin_amdgcn_s_sleep(2);
                if ((++sp & 1023u) == 0u) { if (__hip_atomic_load(tmo, __ATOMIC_RELAXED, __HIP_MEMORY_SCOPE_AGENT) != 0u) break; if (sp > (1u << 22)) { if (lane == 0) __hip_atomic_store(tmo, 1u, __ATOMIC_RELAXED, __HIP_MEMORY_SCOPE_AGENT); break; } }
            }
            __builtin_amdgcn_fence(__ATOMIC_ACQUIRE, "agent");
        }
        int row0 = u.pm * 256 + wr * 64 + fr; const int col0 = u.pn * 128 + wc * 32 + 8 * fq; asm volatile("" : "+v"(row0));
#pragma unroll
        for (int ai = 0; ai < 2; ++ai)
#pragma unroll
            for (int m = 0; m < 4; ++m) {
                const int row = row0 + ai * 128 + m * 16;
                f32x4 g0 = acc[ai][0][m][0], g1 = acc[ai][0][m][1], u0 = acc[ai][1][m][0], u1 = acc[ai][1][m][1];
                if (u.kind == 2) { const int jg = ((ai * 2 + 0) * 4 + m) * 2, ju = ((ai * 2 + 1) * 4 + m) * 2; g0 += sl[jg * 512 + tid]; g1 += sl[(jg + 1) * 512 + tid]; u0 += sl[ju * 512 + tid]; u1 += sl[(ju + 1) * 512 + tid]; }
                { const float rsr = rs_to_rstd(RS[row]); g0 *= rsr; g1 *= rsr; u0 *= rsr; u1 *= rsr; }
#pragma unroll
                for (int e = 0; e < 4; ++e) { g0[e] = fsilu(g0[e]) * u0[e]; g1[e] = fsilu(g1[e]) * u1[e]; }
                v4u w; w.x = pk2(g0[0], g0[1]); w.y = pk2(g0[2], g0[3]); w.z = pk2(g1[0], g1[1]); w.w = pk2(g1[2], g1[3]);
                *(v4u*)(HID + (size_t)row * FFN + col0) = w;
            }
    }
};

struct BranchOrder {
    pg8::StaticOrder S; int R, rem, dep;
    __device__ __forceinline__ void init(int M, int N, int G, int c, int K) { S.init(M, N, G, c, K); R = S.nwg / G; rem = S.nwg - R * G; if (3 * rem > G || MK_G2_NOSPLIT) { R = (S.nwg + G - 1) / G; rem = 0; }
        dep = (G == 256 && S.nM == 37 && S.nN == 8 && pg8::WGM == 8 && R == 1 && rem == 40) ? 1 : 0; }
    __device__ __forceinline__ bool next(int i, pg8::Unit& u) const {
        const int t = i / 3, pc = i - 3 * t;
        if (dep) {
            const int x = S.c & 7, j = S.c >> 3, q = x == 6 ? 96 + j : 32 * (x - 3) + j;
            const bool full = t < 1, part = (i == 3) && ((x >= 3 && x <= 5) || (x == 6 && j < 24));
            if (!full && !part) return false;
            const int lt = q / 3;
            pg8::Unit v; S.tile_seq(full ? 32 * x + j : 256 + lt, v); v.pc = full ? pc : q - 3 * lt; v.k0 = 0; v.nt = S.ntk; v.kind = full ? 0 : 3; v.slab = full ? 0 : lt;
            u = v; return true;
        }
        if (t < R) { if (!S.next(t, u)) return false; u.pc = pc; return true; }
        if (i == 3 * R && S.c < 3 * rem) { const int lt = S.c / 3; S.tile(R * S.G + lt, u); u.pc = S.c - 3 * lt; u.k0 = 0; u.nt = S.ntk; u.kind = 3; u.slab = lt; return true; }
        return false;
    }
    __device__ __forceinline__ void a_ready(const pg8::Unit&) const {}
    __device__ __forceinline__ void done(const pg8::Unit&) const {}
};

struct EpiNull {
    static constexpr bool PERM = true, AFTER_DRAIN = false;
    float* sink;
    __device__ __forceinline__ void operator()(AccRef acc, const pg8::Unit& u, int wr, int wc, int fr, int fq) const {
        float s = 0.f;
#pragma unroll
        for (int ai = 0; ai < 2; ++ai)
#pragma unroll
            for (int bj = 0; bj < 2; ++bj)
#pragma unroll
                for (int m = 0; m < 4; ++m)
#pragma unroll
                    for (int n = 0; n < 2; ++n) s += acc[ai][bj][m][n][0] + acc[ai][bj][m][n][3];
        if (s == 12345.678f) sink[u.pm + wr + wc + fr + fq] = s;
    }
};

__device__ __forceinline__ void panel_wait(const unsigned* rdy, unsigned* tmo, unsigned long long& seen, int pm) {
    const unsigned long long bit = 1ull << pm;
    if (seen & bit) return;
    if (__builtin_amdgcn_readfirstlane(threadIdx.x >> 6) == 0) {
        const unsigned* p = rdy + 32 * pm; unsigned sp = 0; bool waited = false;
        while ((unsigned)__builtin_amdgcn_readfirstlane(__hip_atomic_load(p, __ATOMIC_RELAXED, __HIP_MEMORY_SCOPE_AGENT)) < 64u) {
            waited = true; __builtin_amdgcn_s_sleep(2);
            if ((++sp & 1023u) == 0u) { if (__hip_atomic_load(tmo, __ATOMIC_RELAXED, __HIP_MEMORY_SCOPE_AGENT) != 0u) break; if (sp > (1u << 22)) { __hip_atomic_store(tmo, 1u, __ATOMIC_RELAXED, __HIP_MEMORY_SCOPE_AGENT); break; } }
        }
        if (seen == 0ull || waited) __builtin_amdgcn_fence(__ATOMIC_ACQUIRE, "agent");
    }
    __builtin_amdgcn_s_barrier();
    seen |= bit;
}
struct G3Order {
    pg8::StaticOrder S; int dep; const unsigned* rdy; unsigned* tmo; mutable unsigned long long seen;
    __device__ __forceinline__ void init(int M, int N, int G, int c, int K, const unsigned* rdy_, unsigned* tmo_) { S.init(M, N, G, c, K); dep = (G == 256 && S.nM == 37 && S.nN == 8 && pg8::WGM == 8) ? 1 : 0; rdy = rdy_; tmo = tmo_; seen = 0ull; }
    __device__ __forceinline__ bool next(int i, pg8::Unit& u) const {
        if (!dep) return S.next(i, u);
        const int x = S.c & 7, j = S.c >> 3;
        if (!(i == 0 || (i == 1 && (x == 7 || (x == 6 && j >= 24))))) return false;
        pg8::Unit t; S.tile_seq(i == 0 ? 32 * x + j : 256 + (x == 7 ? j : 8 + j), t); t.k0 = 0; t.nt = S.ntk; t.kind = 0; t.slab = 0;
        u = t; return true;
    }
    __device__ __forceinline__ void a_ready(const pg8::Unit& u) const { if (dep && rdy) panel_wait(rdy, tmo, seen, u.pm); }
    __device__ __forceinline__ void done(const pg8::Unit&) const {}
};
struct GuOrder {
    pg8::StaticOrder S; int dep; const unsigned* rdy; unsigned* tmo; mutable unsigned long long seen;
    __device__ __forceinline__ void init(int M, int N, int G, int c, int K, const unsigned* rdy_, unsigned* tmo_) { S.init(M, N, G, c, K); dep = (G == 256 && S.nM == 37 && S.nN == 44 && pg8::WGM == 8) ? 1 : 0; rdy = rdy_; tmo = tmo_; seen = 0ull; }
    __device__ __forceinline__ bool next(int i, pg8::Unit& u) const {
        if (!dep) return S.next(i, u);
        const int x = S.c & 7, j = S.c >> 3, lp = 32 * i + j, st = x < 3 ? 224 * x : 668 + 192 * (x - 3), nx = x < 2 ? 224 : (x == 2 ? 220 : 192);
        if (lp >= nx) return false;
        pg8::Unit t; S.tile_seq(st + lp, t); t.k0 = 0; t.nt = S.ntk; t.kind = 0; t.slab = 0;
        u = t; return true;
    }
    __device__ __forceinline__ void a_ready(const pg8::Unit& u) const { if (dep) panel_wait(rdy, tmo, seen, u.pm); }
    __device__ __forceinline__ void done(const pg8::Unit&) const {}
};

struct Args { const float* in[24]; float* out; unsigned char* ws; int l_lo, l_hi, ph_lo, ph_hi, do_pro, do_fin, use_bar, pad; };
enum { I_XP = 0, I_XS, I_SCONV, I_SSSM, I_SHG, I_SRET, I_META, I_NMIX, I_WIN, I_CONVW, I_CONVB, I_DTB, I_ALOG, I_DSKIP, I_SSDN, I_HGLOW, I_HGN, I_WBR, I_WOUT, I_NFFN, I_WG, I_WU, I_WD, I_NFIN };

typedef const __attribute__((address_space(4))) Args* ArgsP;
#define AREF const __attribute__((address_space(4))) Args&
struct Ctx {
    LAS unsigned char* lds; int tid, lane, wave, vcu, G;
    ArgsP a; unsigned char* ws;
};

template <class F> __device__ __forceinline__ void tr_item(const float* W, int ldw, bf16* WT, int K, int k0, int n0, LAS float* scr, int lane, F srccol, const float* kscale = nullptr) {
    const int sc = srccol(n0 + (lane & 31));
#pragma unroll
    for (int i = 0; i < 32; ++i) { const int kk = 2 * i + (lane >> 5); scr[kk * 33 + (lane & 31)] = __builtin_nontemporal_load(W + (size_t)(k0 + kk) * ldw + sc); }
    LDS_WAIT(); asm volatile("" ::: "memory");
    const int c = lane & 7;
    f32x4 g0 = (f32x4){1.f, 1.f, 1.f, 1.f}, g1 = g0;
    if (kscale) { g0 = *(const f32x4*)(kscale + k0 + 8 * c); g1 = *(const f32x4*)(kscale + k0 + 8 * c + 4); }
#pragma unroll
    for (int j = 0; j < 4; ++j) { const int n = (lane >> 3) + 8 * j; const LAS float* s = scr + (8 * c) * 33 + n;
        v4u o; o.x = pk2(s[0 * 33] * g0[0], s[1 * 33] * g0[1]); o.y = pk2(s[2 * 33] * g0[2], s[3 * 33] * g0[3]); o.z = pk2(s[4 * 33] * g1[0], s[5 * 33] * g1[1]); o.w = pk2(s[6 * 33] * g1[2], s[7 * 33] * g1[3]);
        *(v4u*)(WT + (size_t)(n0 + n) * K + k0 + 8 * c) = o; }
    LDS_WAIT(); asm volatile("" ::: "memory");
}
__device__ __forceinline__ int win_src(int n) {
    if (n >= 6656 && n < 7680) { const int p = n & 63, j = p >> 3, nn = (p >> 2) & 1, e = p & 3; n = (n & ~63) + 32 * nn + 4 * j + e; }
    return n < 2560 ? n : n + 16;
}
__device__ __forceinline__ int ret_dim(int p) { return 32 * ((p >> 2) & 1) + 4 * (p >> 3) + (p & 3); }

__device__ __forceinline__ void p0_prologue(const Ctx& C) {
    AREF A = *C.a; unsigned char* ws = C.ws;
    LAS float* scr = (LAS float*)(C.lds + C.wave * 16384);
    const int gw = C.vcu * NWAVES + C.wave, NGW = C.G * NWAVES;
    constexpr int I_IN = 32 * 496, I_BR = 3 * 16 * 64, I_OUT = 32 * 64, I_GU = 32 * 352, I_DN = 88 * 64, I_L = I_IN + I_BR + I_OUT + I_GU + I_DN;
    for (int it = gw; it < NL * I_L; it += NGW) {
        const int l = it / I_L; int r = it - l * I_L; unsigned char* lw = ws + WS_W + (size_t)l * LW_SIZE;
        if (r < I_IN) { const int kb = r / 496, nb = r - kb * 496; tr_item(A.in[I_WIN] + (size_t)l * D * INCOLS, INCOLS, (bf16*)(lw + LW_IN), D, 64 * kb, 32 * nb, scr, C.lane, [](int n) { return win_src(n); }, A.in[I_NMIX] + (size_t)l * D); continue; } r -= I_IN;
        if (r < I_BR) { const int c = r / 1024, rr = r - c * 1024, kb = rr / 64, nb = rr - kb * 64;
            tr_item(A.in[I_WBR] + ((size_t)l * 3 + c) * 1024 * D, D, (bf16*)(lw + LW_BR) + (size_t)c * D * 1024, 1024, 64 * kb, 32 * nb, scr, C.lane, [](int n) { return n; }); continue; } r -= I_BR;
        if (r < I_OUT) { const int kb = r / 64, nb = r - kb * 64; tr_item(A.in[I_WOUT] + (size_t)l * D * D, D, (bf16*)(lw + LW_OUT), D, 64 * kb, 32 * nb, scr, C.lane, [](int n) { return n; }); continue; } r -= I_OUT;
        if (r < I_GU) { const int kb = r / 352, nb = r - kb * 352, n0 = 32 * nb, t = n0 >> 8, w = n0 & 255; const float* src = (w < 128 ? A.in[I_WG] : A.in[I_WU]) + (size_t)l * D * FFN; const int sbase = 128 * t + (w & 127) - n0;
            tr_item(src, FFN, (bf16*)(lw + LW_GU), D, 64 * kb, n0, scr, C.lane, [sbase](int n) { return n + sbase; }, A.in[I_NFFN] + (size_t)l * D); continue; } r -= I_GU;
        { const int kb = r / 64, nb = r - kb * 64; tr_item(A.in[I_WD] + (size_t)l * FFN * D, D, (bf16*)(lw + LW_DN), FFN, 64 * kb, 32 * nb, scr, C.lane, [](int n) { return n; }); }
    }
    const int gt = C.vcu * NTHR + C.tid, NGT = C.G * NTHR;
    for (int i = gt; i < NL * 16 * D; i += NGT) { const int l = i / (16 * D), r = i - l * 16 * D, h = r / D, k = r - h * D;
        ((bf16*)(ws + WS_W + (size_t)l * LW_SIZE + LW_DT))[r] = (bf16)f2bf(A.in[I_NMIX][l * D + k] * A.in[I_WIN][((size_t)l * D + k) * INCOLS + 2560 + h]); }
    for (int m = gw; m < MP; m += NGW) {
        const float* src = nullptr;
        if (m >= NNULL && m < ROW_P0) src = A.in[I_META] + (size_t)(m - NNULL) * D;
        else if (m >= ROW_P0 && m < ROW_S0) src = A.in[I_XP] + (size_t)(m - ROW_P0) * D;
        else if (m >= ROW_S0 && m < MR) src = A.in[I_XS] + (size_t)(m - ROW_S0) * D;
        v2u* dst = (v2u*)(ws + WS_X + (size_t)m * D * 2) + C.lane; float s = 0.f;
#pragma unroll
        for (int j = 0; j < 8; ++j) { const f32x4 v = src ? ((const f32x4*)src)[C.lane + 64 * j] : (f32x4){0.f, 0.f, 0.f, 0.f}; dst[64 * j] = pk4(v); s += (v[0] * v[0] + v[1] * v[1]) + (v[2] * v[2] + v[3] * v[3]); }
        s = wave_sum(s); if (C.lane == 0) ((u64*)((unsigned*)(ws + WS_CTL) + CW_RS))[m] = ss_to_fix(s);
    }
    for (int i = gt; i < MP * 32; i += NGT) {
        const int row = i >> 5, fi = i & 31;
        const int pos = row < ROW_S0 ? row - ROW_P0 : (row < MR ? 1024 + ((row - ROW_S0) & 63) : 0);
        const double inv = exp(-(double)fi * (9.210340371976184 / 32.0));
        const double ang = (double)pos * inv, n = rint(ang * 0.15915494309189535), r = fma(-n, 6.283185307179586, ang) - n * 2.4492935982947064e-16;
        const double r2 = r * r; double s = 0.0, c = 0.0;
#pragma unroll
        for (int k = 14; k >= 1; --k) { s = (s + 1.0) * (-r2 / (double)((2 * k) * (2 * k + 1))); c = (c + 1.0) * (-r2 / (double)((2 * k - 1) * (2 * k))); }
        ((f32x2*)(ws + WS_ROPE))[i] = (f32x2){(float)(c + 1.0), (float)((s + 1.0) * r)};
    }
    for (int i = gt; i < 1024; i += NGT) {
        const float* hl = A.in[I_HGLOW]; const float v0 = hl[i], v1 = hl[1024 + i], v2 = hl[2048 + i], v3 = hl[3072 + i], mx = fmaxf(fmaxf(v0, v1), fmaxf(v2, v3));
        const float e0 = expf(v0 - mx), e1 = expf(v1 - mx), e2 = expf(v2 - mx), e3 = expf(v3 - mx), inv = 1.0f / (e0 + e1 + e2 + e3);
        float* lb = (float*)(ws + WS_LBS); lb[i] = 0.f; lb[1024 + i] = e1 * inv; lb[2048 + i] = (e1 + e2) * inv; lb[3072 + i] = (e1 + e2 + e3) * inv;
    }
    for (int i = gt; i < 3 * (MP - MR) * 1024 / 8; i += NGT) { const int c = i / ((MP - MR) * 128), r = i - c * (MP - MR) * 128;
        ((v4u*)(ws + WS_BR + ((size_t)c * MP + MR) * 1024 * 2))[r] = (v4u){0u, 0u, 0u, 0u}; }
}

__device__ __forceinline__ float softplusf(float v) { return v > 20.0f ? v : log1pf(expf(v)); }
__device__ __forceinline__ void dt_rows(const Ctx& C, int l) {
    AREF A = *C.a; unsigned char* ws = C.ws; const int tid = C.tid, lane = C.lane, w = C.wave, l15 = lane & 15, l4 = lane >> 4;
    LAS float* DTP = (LAS float*)C.lds;
    const int rbase = 37 * C.vcu; const bf16* X = (const bf16*)(ws + WS_X); const bf16* WDT = (const bf16*)(ws + WS_W + (size_t)l * LW_SIZE + LW_DT);
    f32x4 acc[3];
#pragma unroll
    for (int rb = 0; rb < 3; ++rb) acc[rb] = (f32x4){0.f, 0.f, 0.f, 0.f};
#pragma unroll 2
    for (int ks = 0; ks < 8; ++ks) {
        const int ko = 256 * w + 32 * ks + 8 * l4;
        const bf16x8 bf = *(const bf16x8*)(WDT + (size_t)l15 * D + ko);
#pragma unroll
        for (int rb = 0; rb < 3; ++rb) { int row = rbase + 16 * rb + l15; row = row < MP ? row : MP - 1; acc[rb] = mfma16(*(const bf16x8*)(X + (size_t)row * D + ko), bf, acc[rb]); }
    }
#pragma unroll
    for (int rb = 0; rb < 3; ++rb)
#pragma unroll
        for (int e = 0; e < 4; ++e) DTP[(w * 48 + 16 * rb + 4 * l4 + e) * 16 + l15] = acc[rb][e];
    LBAR();
    const u64* RS = (const u64*)((const unsigned*)(ws + WS_CTL) + CW_RS) + (size_t)(2 * l) * MP;
    for (int i = tid; i < 37 * 16; i += NTHR) { const int r = i >> 4, hd = i & 15, m = rbase + r;
        if (m < MR) { float raw = 0.f;
#pragma unroll
            for (int ww = 0; ww < 8; ++ww) raw += DTP[(ww * 48 + r) * 16 + hd];
            float dt = softplusf(raw * rs_to_rstd(RS[m]) + A.in[I_DTB][l * 16 + hd]); if (m < NNULL) dt = 0.f;
            ((float*)(ws + WS_DT))[(size_t)m * 16 + hd] = dt; ((float*)(ws + WS_AV))[(size_t)m * 16 + hd] = -dt * expf(A.in[I_ALOG][l * 16 + hd]); } }
}
__device__ __forceinline__ void final_phase(const Ctx& C, const bf16* X, const float* gain, float* out) {
    const int gw = C.vcu * NWAVES + C.wave, NGW = C.G * NWAVES;
    f32x4 gn[8];
#pragma unroll
    for (int j = 0; j < 8; ++j) gn[j] = ((const f32x4*)gain)[C.lane + 64 * j];
    for (int m = ROW_P0 + gw; m < MR; m += NGW) {
        const v2u* xr = (const v2u*)(X + (size_t)m * D) + C.lane;
        f32x4 v[8]; float s = 0.f;
#pragma unroll
        for (int j = 0; j < 8; ++j) { v[j] = unpk4(xr[64 * j]); s += (v[j][0] * v[j][0] + v[j][1] * v[j][1]) + (v[j][2] * v[j][2] + v[j][3] * v[j][3]); }
        const float rs = rsqrtf(wave_sum(s) * (1.0f / D) + EPS);
        f32x4* o = (f32x4*)(out + (m < ROW_S0 ? O_YP + (size_t)(m - ROW_P0) * D : O_YS + (size_t)(m - ROW_S0) * D)) + C.lane;
#pragma unroll
        for (int j = 0; j < 8; ++j) o[64 * j] = v[j] * rs * gn[j];
    }
}

__device__ __forceinline__ bf16x8 ldsfrag(const LAS unsigned char* base, int row, int pitchB, int kel) { return *(const LAS bf16x8*)(base + row * pitchB + kel * 2); }
__device__ __forceinline__ float ret_lgam(int h) { return log1pf(-exp2f(-5.0f - (float)h)); }
struct ConvSrc {
    const bf16* XBC; const float* sconv; int c, r0;
    __device__ __forceinline__ float at(int t, int ch) const {
        if (t >= 0) return bf2f(XBC[(size_t)(r0 + t) * 1536 + ch]);
        if (c == 0) return 0.f;
        if (c < NCHP) return bf2f(XBC[(size_t)(r0 + t) * 1536 + ch]);
        return sconv[((size_t)(c - NCHP) * 3 + (3 + t)) * 1536 + ch];
    }
};

__device__ __forceinline__ void m1_ssd(const Ctx& C, int l, int c, int g, int skip = 0) {
    AREF A = *C.a; unsigned char* ws = C.ws; const int tid = C.tid, lane = C.lane, w = C.wave, r0 = 64 * c;
    LAS unsigned char* XT = C.lds; LAS unsigned char* BT = C.lds + 73728;
    LAS float* SDT = (LAS float*)(C.lds + 92160); LAS float* SCUM = (LAS float*)(C.lds + 94208);
    const int l15 = lane & 15, l4 = lane >> 4;
    const ConvSrc cs{(const bf16*)(ws + WS_XBC), A.in[I_SCONV] + (size_t)l * 16 * 3 * 1536, c, r0};
    const float* cw = A.in[I_CONVW] + (size_t)l * 4 * 1536; const float* cb = A.in[I_CONVB] + (size_t)l * 1536;
    LAS unsigned char* RX = C.lds; LAS unsigned char* RBC = C.lds + 96256;
    const int chx = 512 * g + tid;
    {   const bf16* XBC = (const bf16*)(ws + WS_XBC); const float* sc = A.in[I_SCONV] + (size_t)l * 16 * 3 * 1536 + (size_t)(c >= NCHP ? c - NCHP : 0) * 3 * 1536;
#pragma unroll
        for (int q = 0; q < 9; ++q) { const int chn = tid + 512 * q; if (chn < 67 * 64) { const int row = chn >> 6, c16 = chn & 63, t = row - 3, col = 512 * g + 8 * c16; v4u v = (v4u){0u, 0u, 0u, 0u};
                if (t >= 0 || (c > 0 && c < NCHP)) v = *(const v4u*)(XBC + (size_t)(r0 + t) * 1536 + col);
                else if (c >= NCHP) { const f32x4 a = *(const f32x4*)(sc + (3 + t) * 1536 + col), b = *(const f32x4*)(sc + (3 + t) * 1536 + col + 4); v.x = pk2(a[0], a[1]); v.y = pk2(a[2], a[3]); v.z = pk2(b[0], b[1]); v.w = pk2(b[2], b[3]); }
                *(LAS v4u*)(RX + row * 1040 + c16 * 16) = v; } }
#pragma unroll
        for (int q = 0; q < 5; ++q) { const int chn = tid + 512 * q; if (chn < 67 * 32) { const int row = chn >> 5, c16 = chn & 31, t = row - 3, col = (c16 < 16 ? 1024 + 128 * g : 1280 + 128 * g - 128) + 8 * c16; v4u v = (v4u){0u, 0u, 0u, 0u};
                if (t >= 0 || (c > 0 && c < NCHP)) v = *(const v4u*)(XBC + (size_t)(r0 + t) * 1536 + col);
                else if (c >= NCHP) { const f32x4 a = *(const f32x4*)(sc + (3 + t) * 1536 + col), b = *(const f32x4*)(sc + (3 + t) * 1536 + col + 4); v.x = pk2(a[0], a[1]); v.y = pk2(a[2], a[3]); v.z = pk2(b[0], b[1]); v.w = pk2(b[2], b[3]); }
                *(LAS v4u*)(RBC + row * 528 + c16 * 16) = v; } }
    }
    const float xw0 = cw[chx], xw1 = cw[1536 + chx], xw2 = cw[2 * 1536 + chx], xw3 = cw[3 * 1536 + chx], xbias = cb[chx];
    {
        const int hd = 8 * g + w; const float dt = ((const float*)(ws + WS_DT))[(r0 + lane) * 16 + hd]; float v = ((const float*)(ws + WS_AV))[(r0 + lane) * 16 + hd];
#pragma unroll
        for (int o = 1; o < 64; o <<= 1) { const float t = __shfl_up(v, o); if (lane >= o) v += t; }
        SDT[lane * 8 + w] = dt; SCUM[lane * 8 + w] = v; ((float*)(ws + WS_CUM))[(r0 + lane) * 16 + hd] = v;
        if (lane == 63) ((float*)(ws + WS_GAM))[(size_t)c * GAM_N + hd] = expf(v);
    }
    LBAR();
    float raw[67];
#pragma unroll
    for (int t = 0; t < 67; ++t) raw[t] = bf2f(*(const LAS bf16*)(RX + t * 1040 + tid * 2));
    LBAR();
    if (!(skip & 1)) {
        const int hh = tid >> 6; const float clast = SCUM[63 * 8 + hh];
        bf16* xg = (bf16*)(ws + WS_XTG) + ((size_t)c * 1024 + chx) * 64;
#pragma unroll
        for (int t0 = 0; t0 < 64; t0 += 8) {
            float val[8], vw[8];
#pragma unroll
            for (int tt = 0; tt < 8; ++tt) { const int t = t0 + tt; val[tt] = fsilu(xbias + xw0 * raw[t] + xw1 * raw[t + 1] + xw2 * raw[t + 2] + xw3 * raw[t + 3]);
                vw[tt] = val[tt] * (__expf(clast - SCUM[t * 8 + hh]) * SDT[t * 8 + hh]); }
            v4u o; o.x = pk2(val[0], val[1]); o.y = pk2(val[2], val[3]); o.z = pk2(val[4], val[5]); o.w = pk2(val[6], val[7]); *(v4u*)(xg + t0) = o;
            o.x = pk2(vw[0], vw[1]); o.y = pk2(vw[2], vw[3]); o.z = pk2(vw[4], vw[5]); o.w = pk2(vw[6], vw[7]); *(LAS v4u*)(XT + tid * 144 + t0 * 2) = o;
        }
    }
    if (!(skip & 2)) {
        const int col = tid & 255, seg = tid >> 8, t0 = 32 * seg, ch = col < 128 ? 1024 + 128 * g + col : 1280 + 128 * g + (col - 128);
        const float w0 = cw[ch], w1 = cw[1536 + ch], w2 = cw[2 * 1536 + ch], w3 = cw[3 * 1536 + ch], bias = cb[ch];
        float rb[35];
#pragma unroll
        for (int t = 0; t < 35; ++t) rb[t] = bf2f(*(const LAS bf16*)(RBC + (t0 + t) * 528 + col * 2));
        bf16* bg = (bf16*)(ws + WS_BCG) + (size_t)(r0 + t0) * 512 + 256 * g + col;
#pragma unroll
        for (int t8 = 0; t8 < 32; t8 += 8) { float val[8];
#pragma unroll
            for (int tt = 0; tt < 8; ++tt) { const int t = t8 + tt; val[tt] = fsilu(bias + w0 * rb[t] + w1 * rb[t + 1] + w2 * rb[t + 2] + w3 * rb[t + 3]); bg[(unsigned)(t * 512)] = (bf16)f2bf(val[tt]); }
            if (col < 128) { v4u o; o.x = pk2(val[0], val[1]); o.y = pk2(val[2], val[3]); o.z = pk2(val[4], val[5]); o.w = pk2(val[6], val[7]); *(LAS v4u*)(BT + col * 144 + (t0 + t8) * 2) = o; } }
    }
    LBAR();
    if (!(skip & 4)) {
        const int hd = 8 * g + w; bf16* U = (bf16*)(ws + WS_U) + (size_t)c * STATE_N + ST_SSD + (size_t)hd * 8192;
#pragma unroll 1
        for (int pi = 0; pi < 4; ++pi) {
            const bf16x8 a0 = ldsfrag(XT, 64 * w + 16 * pi + l15, 144, 8 * l4), a1 = ldsfrag(XT, 64 * w + 16 * pi + l15, 144, 32 + 8 * l4);
#pragma unroll
            for (int nj = 0; nj < 8; ++nj) {
                f32x4 acc = (f32x4){0.f, 0.f, 0.f, 0.f};
                acc = mfma16(ldsfrag(BT, 16 * nj + l15, 144, 8 * l4), a0, acc); acc = mfma16(ldsfrag(BT, 16 * nj + l15, 144, 32 + 8 * l4), a1, acc);
                *(v2u*)(U + (16 * pi + l15) * 128 + 16 * nj + 4 * l4) = pk4(acc);
            }
        }
    }
}

__device__ __forceinline__ void m1_hg(const Ctx& C, int l, int c, int h) {
    unsigned char* ws = C.ws; const int tid = C.tid, lane = C.lane, w = C.wave, r0 = 64 * c, l15 = lane & 15, l4 = lane >> 4;
    LAS unsigned char* KT = C.lds; LAS unsigned char* VT = C.lds + 18432; LAS float* SEG = (LAS float*)(C.lds + 36864);
    const int col = tid & 127, seg = tid >> 7;
    {
        LAS unsigned char* RAW = C.lds + 40960;
        const bf16* src0 = (const bf16*)(ws + WS_LG); const bf16* src1 = (const bf16*)(ws + WS_KK); const bf16* src2 = (const bf16*)(ws + WS_HV);
#pragma unroll
        for (int q = 0; q < 6; ++q) { const int chn = tid + 512 * q, arr = chn >> 10, rem = chn & 1023, row = rem >> 4, c16 = rem & 15;
            const bf16* s = (arr == 0 ? src0 : (arr == 1 ? src1 : src2)) + (size_t)(r0 + row) * 1024 + 128 * h + 8 * c16;
            *(LAS v4u*)(RAW + arr * 17408 + row * 272 + c16 * 16) = *(const v4u*)s; }
        LBAR();
    }
    float cum[16], kk[16], vv[16];
#pragma unroll
    for (int i = 0; i < 16; ++i) { const LAS unsigned char* p = C.lds + 40960 + (16 * seg + i) * 272 + col * 2; cum[i] = bf2f(*(const LAS bf16*)p); kk[i] = bf2f(*(const LAS bf16*)(p + 17408)); vv[i] = bf2f(*(const LAS bf16*)(p + 34816)); }
#pragma unroll
    for (int i = 1; i < 16; ++i) cum[i] += cum[i - 1];
    SEG[seg * 128 + col] = cum[15];
    LBAR();
    float off = 0.f, tot = 0.f;
#pragma unroll
    for (int s = 0; s < 4; ++s) { const float t = SEG[s * 128 + col]; tot += t; if (s < seg) off += t; }
#pragma unroll
    for (int i = 0; i < 16; ++i) kk[i] *= __expf(tot - (cum[i] + off));
    { v4u o; o.x = pk2(kk[0], kk[1]); o.y = pk2(kk[2], kk[3]); o.z = pk2(kk[4], kk[5]); o.w = pk2(kk[6], kk[7]); *(LAS v4u*)(KT + col * 144 + seg * 32) = o;
      o.x = pk2(kk[8], kk[9]); o.y = pk2(kk[10], kk[11]); o.z = pk2(kk[12], kk[13]); o.w = pk2(kk[14], kk[15]); *(LAS v4u*)(KT + col * 144 + seg * 32 + 16) = o;
      o.x = pk2(vv[0], vv[1]); o.y = pk2(vv[2], vv[3]); o.z = pk2(vv[4], vv[5]); o.w = pk2(vv[6], vv[7]); *(LAS v4u*)(VT + col * 144 + seg * 32) = o;
      o.x = pk2(vv[8], vv[9]); o.y = pk2(vv[10], vv[11]); o.z = pk2(vv[12], vv[13]); o.w = pk2(vv[14], vv[15]); *(LAS v4u*)(VT + col * 144 + seg * 32 + 16) = o; }
    if (seg == 0) ((float*)(ws + WS_GAM))[(size_t)c * GAM_N + 16 + 128 * h + col] = expf(tot);
    LBAR();
    {
        bf16* U = (bf16*)(ws + WS_U) + (size_t)c * STATE_N + ST_HG + (size_t)h * 16384;
        const bf16x8 a0 = ldsfrag(VT, 16 * w + l15, 144, 8 * l4), a1 = ldsfrag(VT, 16 * w + l15, 144, 32 + 8 * l4);
        const bool nat = c >= NCHP;
#pragma unroll
        for (int kj = 0; kj < 8; ++kj) {
            f32x4 acc = (f32x4){0.f, 0.f, 0.f, 0.f}; const bf16x8 k0 = ldsfrag(KT, 16 * kj + l15, 144, 8 * l4), k1 = ldsfrag(KT, 16 * kj + l15, 144, 32 + 8 * l4);
            if (!nat) { acc = mfma16(k0, a0, acc); acc = mfma16(k1, a1, acc); *(v2u*)(U + (16 * w + l15) * 128 + 16 * kj + 4 * l4) = pk4(acc); }
            else { acc = mfma16(a0, k0, acc); acc = mfma16(a1, k1, acc); *(v2u*)(U + (16 * kj + l15) * 128 + 16 * w + 4 * l4) = pk4(acc); }
        }
    }
}

__device__ __forceinline__ void m1_ret(const Ctx& C, int l, int c, int h) {
    unsigned char* ws = C.ws; const int tid = C.tid, lane = C.lane, w = C.wave, r0 = 64 * c, l15 = lane & 15, l4 = lane >> 4;
    LAS unsigned char* KT = C.lds; LAS unsigned char* VT = C.lds + 9216;
    const float lg = ret_lgam(h);
    {   const int kp = tid & 63, s8 = tid >> 6; const bf16* RK = (const bf16*)(ws + WS_RK) + (size_t)(r0 + 8 * s8) * 512 + 64 * h + kp; float v[8];
#pragma unroll
        for (int i = 0; i < 8; ++i) v[i] = bf2f(RK[(size_t)i * 512]) * __expf((float)(63 - (8 * s8 + i)) * lg);
        v4u o; o.x = pk2(v[0], v[1]); o.y = pk2(v[2], v[3]); o.z = pk2(v[4], v[5]); o.w = pk2(v[6], v[7]); *(LAS v4u*)(KT + kp * 144 + s8 * 16) = o; }
    {   const int col = tid & 127, seg = tid >> 7; const bf16* RV = (const bf16*)(ws + WS_RV) + (size_t)(r0 + 16 * seg) * 1024 + 128 * h + col; float vv[16];
#pragma unroll
        for (int i = 0; i < 16; ++i) vv[i] = bf2f(RV[(size_t)i * 1024]);
        v4u o; o.x = pk2(vv[0], vv[1]); o.y = pk2(vv[2], vv[3]); o.z = pk2(vv[4], vv[5]); o.w = pk2(vv[6], vv[7]); *(LAS v4u*)(VT + col * 144 + seg * 32) = o;
        o.x = pk2(vv[8], vv[9]); o.y = pk2(vv[10], vv[11]); o.z = pk2(vv[12], vv[13]); o.w = pk2(vv[14], vv[15]); *(LAS v4u*)(VT + col * 144 + seg * 32 + 16) = o; }
    LBAR();
    {   bf16* U = (bf16*)(ws + WS_U) + (size_t)c * STATE_N + ST_RET + (size_t)h * 8192;
        const bf16x8 a0 = ldsfrag(VT, 16 * w + l15, 144, 8 * l4), a1 = ldsfrag(VT, 16 * w + l15, 144, 32 + 8 * l4);
        const bool nat = c >= NCHP;
#pragma unroll
        for (int kj = 0; kj < 4; ++kj) {
            f32x4 acc = (f32x4){0.f, 0.f, 0.f, 0.f}; const bf16x8 k0 = ldsfrag(KT, 16 * kj + l15, 144, 8 * l4), k1 = ldsfrag(KT, 16 * kj + l15, 144, 32 + 8 * l4);
            if (!nat) { acc = mfma16(k0, a0, acc); acc = mfma16(k1, a1, acc); *(v2u*)(U + (16 * w + l15) * 64 + 16 * kj + 4 * l4) = pk4(acc); }
            else { acc = mfma16(a0, k0, acc); acc = mfma16(a1, k1, acc); *(v2u*)(U + (16 * kj + l15) * 128 + 16 * w + 4 * l4) = pk4(acc); }
        }
    }
}

#ifndef PROBE_SKIP
#define PROBE_SKIP 0
#endif
#ifndef REPI_M1_SSD
#define REPI_M1_SSD 1
#endif
#ifndef REPI_M1_HG
#define REPI_M1_HG 1
#endif
#ifndef REPI_M1_RET
#define REPI_M1_RET 1
#endif
__device__ __forceinline__ unsigned m1_prefetch(const Ctx& C, int l, int it) {
    constexpr int N_SSD = NCH * 2, N_HG = NCH * 8; unsigned char* ws = C.ws; const int tid = C.tid; unsigned pf = 0;
    if (it < N_SSD) { const int c = it >> 1, g = it & 1, r0 = 64 * c; const bf16* XBC = (const bf16*)(ws + WS_XBC);
#pragma unroll
        for (int q = 0; q < 2; ++q) { const int s = tid + 512 * q; if (s < 768) { const int row = s / 12, p = s - 12 * row; const int col = p < 8 ? 512 * g + 64 * p : (p < 10 ? 1024 + 128 * g + 64 * (p - 8) : 1280 + 128 * g + 64 * (p - 10));
            pf ^= *(const unsigned*)(XBC + (size_t)(r0 + row) * 1536 + col); } } }
    else if (it < N_SSD + N_HG) { const int j = it - N_SSD, c = j >> 3, h = j & 7, row = tid >> 3, p = tid & 7; const size_t b = (size_t)(64 * c + row) * 1024 + 128 * h;
        if (p < 4) pf ^= *(const unsigned*)((const bf16*)(ws + WS_LG) + b + 32 * p); else if (p < 6) pf ^= *(const unsigned*)((const bf16*)(ws + WS_KK) + b + 64 * (p - 4)); else pf ^= *(const unsigned*)((const bf16*)(ws + WS_HV) + b + 64 * (p - 6)); }
    else { const int j = it - N_SSD - N_HG, c = j >> 3, h = j & 7; if (tid < 192) { const int row = tid / 3, p = tid - 3 * row;
            if (p == 0) pf ^= *(const unsigned*)((const bf16*)(ws + WS_RK) + (size_t)(64 * c + row) * 512 + 64 * h); else pf ^= *(const unsigned*)((const bf16*)(ws + WS_RV) + (size_t)(64 * c + row) * 1024 + 128 * h + 64 * (p - 1)); } }
    return pf;
}
__device__ __forceinline__ void m1_phase(const Ctx& C0, int l, int mask = 7) {
    constexpr int N_SSD = NCH * 2, N_HG = NCH * 8, N_IT = NCH * 18;
    unsigned* cnt = (unsigned*)(C0.ws + WS_CTL) + CW_QUEUE + 64 * (l * 8 + 0 * 4 + (mask == 7 ? 0 : 1));
    volatile LAS int* slot = (volatile LAS int*)(C0.lds + LDSCTL_OFF + 64);
    int n2 = 0;
    if (C0.tid == 0) { slot[0] = (int)__hip_atomic_fetch_add(cnt, 1u, __ATOMIC_RELAXED, __HIP_MEMORY_SCOPE_AGENT); slot[1] = (int)__hip_atomic_fetch_add(cnt, 1u, __ATOMIC_RELAXED, __HIP_MEMORY_SCOPE_AGENT); }
    LBAR();
    int it = slot[0], nx = slot[1];
    LBAR();
    while (it < N_IT) {
        if (C0.tid == 0) n2 = (int)__hip_atomic_fetch_add(cnt, 1u, __ATOMIC_RELAXED, __HIP_MEMORY_SCOPE_AGENT);
        Ctx C = C0; { int t_ = C0.tid; asm volatile("" : "+v"(t_)); C.tid = t_; C.lane = t_ & 63; C.wave = __builtin_amdgcn_readfirstlane(t_ >> 6); }
        unsigned pf = 0; if (MK_PREFETCH && nx < N_IT && mask == 7) pf = m1_prefetch(C, l, nx);
        if (it < N_SSD) { if (mask & 1) m1_ssd(C, l, it >> 1, it & 1, mask == 7 ? 0 : PROBE_SKIP); }
        else if (it < N_SSD + N_HG) { if (mask & 2) { const int j = it - N_SSD; m1_hg(C, l, j >> 3, j & 7); } }
        else { if (mask & 4) { const int j = it - N_SSD - N_HG; m1_ret(C, l, j >> 3, j & 7); } }
        if (pf == 0x7fc1abcdu) ((unsigned*)(C0.ws + WS_CTL))[16] = pf;
        LBAR();
        if (C0.tid == 0) slot[0] = n2;
        LBAR();
        it = nx; nx = slot[0];
    }
}

struct StIdx { int kind, h; size_t outoff; int ostride; };
__device__ __forceinline__ void m2_elem(int idx, int& kind, int& h, int& o0, int& ostr) {
    if (idx < ST_HG) { kind = 0; h = idx >> 13; o0 = idx; ostr = 1; }
    else if (idx < ST_RET) { const int r = idx - ST_HG; kind = 1; h = r >> 14; const int v = (r >> 7) & 127, k = r & 127; o0 = h * 16384 + k * 128 + v; ostr = 128; }
    else { const int r = idx - ST_RET; kind = 2; h = r >> 13; const int v = (r >> 6) & 127, kp = r & 63; o0 = h * 8192 + ret_dim(kp) * 128 + v; ostr = 128; }
}
__device__ __forceinline__ void m2_sample_item(AREF A, unsigned char* ws, int l, int j) {
    float* out = A.out; const bf16* U = (const bf16*)(ws + WS_U); const float* GAM = (const float*)(ws + WS_GAM);
    const int b = j / (STATE_N / 4), idx = 4 * (j - b * (STATE_N / 4)), c = NCHP + b;
    const f32x4 u = unpk4(*(const v2u*)(U + (size_t)c * STATE_N + idx));
    if (idx < ST_HG) { const int h = idx >> 13; const size_t o = ((size_t)l * 16 + b) * 131072 + idx; const float t = GAM[(size_t)c * GAM_N + h];
        *(f32x4*)(out + O_SSMS + o) = *(const f32x4*)(A.in[I_SSSM] + o) * t + u; }
    else if (idx < ST_RET) { const int r = idx - ST_HG, h = r >> 14, k = (r >> 7) & 127; const size_t o = ((size_t)l * 16 + b) * 131072 + r; const float t = GAM[(size_t)c * GAM_N + 16 + 128 * h + k];
        *(f32x4*)(out + O_HGS + o) = *(const f32x4*)(A.in[I_SHG] + o) * t + u; }
    else { const int r = idx - ST_RET, h = r >> 13, kp = (r >> 7) & 63, v = r & 127; const size_t o = ((size_t)l * 16 + b) * 65536 + h * 8192 + ret_dim(kp) * 128 + v; const float t = expf(64.0f * ret_lgam(h));
        *(f32x4*)(out + O_RETS + o) = *(const f32x4*)(A.in[I_SRET] + o) * t + u; }
}
__device__ __forceinline__ void m2_phase(const Ctx& C, int l) {
    AREF A = *C.a; unsigned char* ws = C.ws; float* out = A.out;
    const bf16* U = (const bf16*)(ws + WS_U); const float* GAM = (const float*)(ws + WS_GAM); bf16* SB = (bf16*)(ws + WS_SB);
    constexpr int CT = 320, ST = NTHR - CT, NSI = 16 * (STATE_N / 4);
    if (C.tid < CT) {
      for (int e4 = C.vcu * CT + C.tid; e4 < STATE_N / 4; e4 += C.G * CT) {
        const int idx = 4 * e4; int kind, h, o0, ostr; m2_elem(idx, kind, h, o0, ostr);
        const float gret = expf(64.0f * ret_lgam(h));
        const int goff = kind == 0 ? h : 16 + 128 * h + (idx & 127);
        f32x4 S = (f32x4){0.f, 0.f, 0.f, 0.f};
        const bf16* up = U + idx; const float* gp = GAM + goff; bf16* sp = SB + idx;
#pragma unroll 1
        for (int c0 = 0; c0 < 128; c0 += 16) {
            v2u u[16]; f32x4 gm[16];
#pragma unroll
            for (int q = 0; q < 16; ++q) { u[q] = *(const v2u*)(up + (size_t)(c0 + q) * STATE_N);
                if (kind == 0) { const float t = gp[(size_t)(c0 + q) * GAM_N]; gm[q] = (f32x4){t, t, t, t}; }
                else if (kind == 1) gm[q] = *(const f32x4*)(gp + (size_t)(c0 + q) * GAM_N);
                else gm[q] = (f32x4){gret, gret, gret, gret}; }
#pragma unroll
            for (int q = 0; q < 16; ++q) { *(v2u*)(sp + (size_t)(c0 + q) * STATE_N) = pk4(S); S = S * gm[q] + unpk4(u[q]); }
        }
        {   const int c = 128; const f32x4 u = unpk4(*(const v2u*)(up + (size_t)c * STATE_N)); f32x4 gm;
            if (kind == 0) { const float t = gp[(size_t)c * GAM_N]; gm = (f32x4){t, t, t, t}; } else if (kind == 1) gm = *(const f32x4*)(gp + (size_t)c * GAM_N); else gm = (f32x4){gret, gret, gret, gret};
            *(v2u*)(sp + (size_t)c * STATE_N) = pk4(S); S = S * gm + u; }
        float* o = out + (kind == 0 ? O_SSMP + (size_t)l * 131072 : kind == 1 ? O_HGP + (size_t)l * 131072 : O_RETP + (size_t)l * 65536);
        if (kind == 0) *(f32x4*)(o + o0) = S; else { o[o0] = S[0]; o[o0 + ostr] = S[1]; o[o0 + 2 * ostr] = S[2]; o[o0 + 3 * ostr] = S[3]; }
      }
    } else {
      const int st = C.vcu * ST + (C.tid - CT), nst = C.G * ST;
      for (int j = st; j < NSI; j += nst) m2_sample_item(A, ws, l, j);
      const bf16* XBC = (const bf16*)(ws + WS_XBC);
      for (int i = st; i < 17 * 4608; i += nst) {
        const int s = i / 4608, r = i - s * 4608, jrow = r / 1536, ch = r - jrow * 1536;
        if (s == 0) out[O_CONVP + (size_t)l * 4608 + r] = bf2f(XBC[(size_t)(ROW_S0 - 3 + jrow) * 1536 + ch]);
        else out[O_CONVS + ((size_t)l * 16 + (s - 1)) * 4608 + r] = bf2f(XBC[(size_t)(ROW_S0 + 64 * (s - 1) + 61 + jrow) * 1536 + ch]);
      }
    }
}


__device__ __forceinline__ void m3_ssd(const Ctx& C, int l, int c, int g) {
    AREF A = *C.a; unsigned char* ws = C.ws; const int tid = C.tid, lane = C.lane, w = C.wave, r0 = 64 * c, l15 = lane & 15, l4 = lane >> 4;
    LAS float* CBS = (LAS float*)C.lds; LAS float* SDT = (LAS float*)(C.lds + 17408); LAS float* SCUM = (LAS float*)(C.lds + 19456); LAS float* SSQ = (LAS float*)(C.lds + 21504);
    LAS unsigned char* CM = C.lds + 23552;
    LAS unsigned char* ZT = C.lds + 40960;
    const bf16* BCG = (const bf16*)(ws + WS_BCG) + (size_t)r0 * 512 + 256 * g;
    const int hd = 8 * g + w;
    const bf16* SB = (const bf16*)(ws + WS_SB) + (size_t)c * STATE_N + ST_SSD + (size_t)hd * 8192;
    const float* S0 = A.in[I_SSSM] + ((size_t)l * 16 + (c >= NCHP ? c - NCHP : 0)) * 131072 + (size_t)hd * 8192;
    const bf16* XTG = (const bf16*)(ws + WS_XTG) + ((size_t)c * 1024 + 512 * g + 64 * w) * 64;
#define M3S_LOAD(SF, XF, PB) do { _Pragma("unroll") for (int ks_ = 0; ks_ < 4; ++ks_) { \
            if (c < NCHP) SF[ks_] = *(const bf16x8*)(SB + (unsigned)((16 * (PB) + l15) * 128 + 32 * ks_ + 8 * l4)); \
            else { const float* sp_ = S0 + (unsigned)((16 * (PB) + l15) * 128 + 32 * ks_ + 8 * l4); const f32x4 s0_ = *(const f32x4*)sp_, s1_ = *(const f32x4*)(sp_ + 4); \
                v4u o_; o_.x = pk2(s0_[0], s0_[1]); o_.y = pk2(s0_[2], s0_[3]); o_.z = pk2(s1_[0], s1_[1]); o_.w = pk2(s1_[2], s1_[3]); SF[ks_] = __builtin_bit_cast(bf16x8, o_); } } \
        XF[0] = *(const bf16x8*)(XTG + (unsigned)((16 * (PB) + l15) * 64 + 8 * l4)); XF[1] = *(const bf16x8*)(XTG + (unsigned)((16 * (PB) + l15) * 64 + 32 + 8 * l4)); } while (0)
    bf16x8 sfA[4], xfA[2], sfB[4], xfB[2];
    M3S_LOAD(sfA, xfA, 0);
    { const int row = tid >> 3, hh = tid & 7; SDT[tid] = ((const float*)(ws + WS_DT))[(r0 + row) * 16 + 8 * g + hh]; SCUM[tid] = ((const float*)(ws + WS_CUM))[(r0 + row) * 16 + 8 * g + hh]; }
    {
        const bf16* ZS = (const bf16*)(ws + WS_ZS) + (size_t)r0 * 1024 + 512 * g;
#pragma unroll
        for (int q = 0; q < 2; ++q) { const int ch = tid + 512 * q, row = ch >> 4, c8 = ch & 15; *(LAS v4u*)(CM + row * 272 + c8 * 16) = *(const v4u*)(BCG + (unsigned)(row * 512 + 128 + c8 * 8)); }
#pragma unroll
        for (int q = 0; q < 8; ++q) { const int ch = tid + 512 * q, row = ch >> 6, c8 = ch & 63; *(LAS v4u*)(ZT + row * 1040 + c8 * 16) = *(const v4u*)(ZS + (unsigned)(row * 1024 + c8 * 8)); }
    }
    {
        const int i = w >> 1;
#pragma unroll
        for (int jj = 0; jj < 2; ++jj) { const int j = 2 * (w & 1) + jj;
            if (j <= i) { f32x4 acc = (f32x4){0.f, 0.f, 0.f, 0.f};
#pragma unroll
                for (int ks = 0; ks < 4; ++ks) acc = mfma16(*(const bf16x8*)(BCG + (unsigned)((16 * j + l15) * 512 + 32 * ks + 8 * l4)), *(const bf16x8*)(BCG + (unsigned)((16 * i + l15) * 512 + 128 + 32 * ks + 8 * l4)), acc);
                *(LAS f32x4*)(CBS + (16 * i + l15) * 68 + 16 * j + 4 * l4) = acc; } }
    }
    LBAR();
    const float dskip = A.in[I_DSKIP][l * 16 + hd];
    v2u Y[4][4]; float ssq[4], ec[4];
    bf16x8 att[4][2];
#pragma unroll
    for (int i = 0; i < 4; ++i) {
        const int t = 16 * i + l15; const float ct = SCUM[t * 8 + w]; ec[i] = __expf(ct); ssq[i] = 0.f;
#pragma unroll
        for (int ks = 0; ks < 2; ++ks) {
            if (ks == 1 && i < 2) { att[i][ks] = (bf16x8){0, 0, 0, 0, 0, 0, 0, 0}; continue; }
            float v[8];
#pragma unroll
            for (int jj = 0; jj < 8; ++jj) { const int s = 32 * ks + 8 * l4 + jj; const float x = CBS[t * 68 + s] * (__expf(ct - SCUM[s * 8 + w]) * SDT[s * 8 + w]); v[jj] = s < t ? x : (s == t ? x + dskip : 0.f); }
            v4u o; o.x = pk2(v[0], v[1]); o.y = pk2(v[2], v[3]); o.z = pk2(v[4], v[5]); o.w = pk2(v[6], v[7]); att[i][ks] = __builtin_bit_cast(bf16x8, o);
        }
    }
#define M3S_BLOCK(SF, XF, PB) do { _Pragma("unroll") for (int i = 0; i < 4; ++i) { const int t = 16 * i + l15; \
            f32x4 yi = (f32x4){0.f, 0.f, 0.f, 0.f}, yn = (f32x4){0.f, 0.f, 0.f, 0.f}; \
            yi = mfma16(XF[0], att[i][0], yi); if (i >= 2) yi = mfma16(XF[1], att[i][1], yi); \
            _Pragma("unroll") for (int ks = 0; ks < 4; ++ks) yn = mfma16(SF[ks], ldsfrag(CM, t, 272, 32 * ks + 8 * l4), yn); \
            const f32x4 z = unpk4(*(const LAS v2u*)(ZT + t * 1040 + (64 * w + 16 * (PB) + 4 * l4) * 2)); \
            const f32x4 y = (yi + yn * ec[i]) * z; ssq[i] += (y[0] * y[0] + y[1] * y[1]) + (y[2] * y[2] + y[3] * y[3]); Y[i][PB] = pk4(y); } } while (0)
    M3S_LOAD(sfB, xfB, 1); M3S_BLOCK(sfA, xfA, 0); __builtin_amdgcn_sched_barrier(0);
    M3S_LOAD(sfA, xfA, 2); M3S_BLOCK(sfB, xfB, 1); __builtin_amdgcn_sched_barrier(0);
    M3S_LOAD(sfB, xfB, 3); M3S_BLOCK(sfA, xfA, 2); __builtin_amdgcn_sched_barrier(0);
    M3S_BLOCK(sfB, xfB, 3);
#undef M3S_LOAD
#undef M3S_BLOCK
#pragma unroll
    for (int i = 0; i < 4; ++i) { float s = ssq[i]; s += __shfl_xor(s, 16); s += __shfl_xor(s, 32); if (l4 == 0) SSQ[w * 64 + 16 * i + l15] = s; }
    LBAR();
    {   const float* gn = A.in[I_SSDN] + (size_t)l * 1024 + 512 * g + 64 * w; bf16* BR = (bf16*)(ws + WS_BR) + (size_t)r0 * 1024 + 512 * g + 64 * w;
#pragma unroll
        for (int i = 0; i < 4; ++i) { const int t = 16 * i + l15; float tot = 0.f;
#pragma unroll
            for (int ww = 0; ww < 8; ++ww) tot += SSQ[ww * 64 + t];
            const float rs = rsqrtf(tot * (1.0f / 512.0f) + EPS);
#pragma unroll
            for (int pb = 0; pb < 4; ++pb) { const int p0 = 16 * pb + 4 * l4; const f32x4 gv = *(const f32x4*)(gn + p0); *(v2u*)(BR + (unsigned)(t * 1024 + p0)) = pk4(unpk4(Y[i][pb]) * rs * gv); } }
    }
}

__device__ __forceinline__ void m3_hg(const Ctx& C, int l, int c, int h) {
    AREF A = *C.a; unsigned char* ws = C.ws; const int tid = C.tid, lane = C.lane, w = C.wave, r0 = 64 * c, l15 = lane & 15, l4 = lane >> 4;
    LAS unsigned char* QT = C.lds; LAS unsigned char* KT = C.lds + 17408; LAS unsigned char* QH = C.lds + 34816; LAS unsigned char* VT = C.lds + 52224; LAS unsigned char* ATT = C.lds + 70656;
    LAS float* SEG = (LAS float*)(C.lds + 79872); LAS float* SSQ = (LAS float*)(C.lds + 83968);
    LAS unsigned char* ST = C.lds + 84480;
    const int i = w >> 1, t = 16 * i + l15;
    const float* gn = A.in[I_HGN] + (size_t)l * 1024 + 128 * h; const bf16* HG = (const bf16*)(ws + WS_HG) + (size_t)r0 * 1024 + 128 * h;
    if (c < NCHP) { const bf16* SB = (const bf16*)(ws + WS_SB) + (size_t)c * STATE_N + ST_HG + (size_t)h * 16384;
#pragma unroll
        for (int q = 0; q < 4; ++q) { const int ch = tid + 512 * q, v = ch >> 4, k8 = ch & 15; *(LAS v4u*)(ST + v * 272 + k8 * 16) = *(const v4u*)(SB + v * 128 + k8 * 8); } }
    else { const float* S0 = A.in[I_SHG] + ((size_t)l * 16 + (c - NCHP)) * 131072 + (size_t)h * 16384;
#pragma unroll
        for (int q = 0; q < 8; ++q) { const int ch = tid + 512 * q, k = ch >> 5, v4 = (ch & 31) * 4; const f32x4 s = *(const f32x4*)(S0 + k * 128 + v4);
#pragma unroll
            for (int e = 0; e < 4; ++e) *(LAS bf16*)(ST + (v4 + e) * 272 + k * 2) = (bf16)f2bf(s[e]); } }
    v2u ggs[4]; f32x4 gvs[4];
#pragma unroll
    for (int b4 = 0; b4 < 4; ++b4) { const int vb = 4 * (w & 1) + b4; ggs[b4] = *(const v2u*)(HG + (unsigned)(t * 1024 + 16 * vb + 4 * l4)); gvs[b4] = *(const f32x4*)(gn + 16 * vb + 4 * l4); }
    {
        const int cp = tid & 63, seg = tid >> 6; const size_t base = (size_t)(r0 + 8 * seg) * 1024 + 128 * h + 2 * cp;
        const bf16* LG = (const bf16*)(ws + WS_LG) + base; const bf16* KK = (const bf16*)(ws + WS_KK) + base; const bf16* HV = (const bf16*)(ws + WS_HV) + base; const bf16* HQ = (const bf16*)(ws + WS_HQ) + base;
        f32x2 cum[8]; unsigned kk[8], vv[8], qq[8];
#pragma unroll
        for (int r = 0; r < 8; ++r) { { const unsigned lw_ = *(const unsigned*)(LG + r * 1024); cum[r] = (f32x2){bflo(lw_), bfhi(lw_)}; } kk[r] = *(const unsigned*)(KK + r * 1024); vv[r] = *(const unsigned*)(HV + r * 1024); qq[r] = *(const unsigned*)(HQ + r * 1024); }
#pragma unroll
        for (int r = 1; r < 8; ++r) cum[r] = cum[r] + cum[r - 1];
        *(LAS f32x2*)(SEG + seg * 128 + 2 * cp) = cum[7];
        LBAR();
        f32x2 off = (f32x2){0.f, 0.f}, R = (f32x2){0.f, 0.f};
#pragma unroll
        for (int s = 0; s < 8; ++s) { const f32x2 sv = *(const LAS f32x2*)(SEG + s * 128 + 2 * cp); if (s < seg) off = off + sv; if (s < 4) R = R + sv; }
#pragma unroll
        for (int r = 0; r < 8; ++r) { const f32x2 cu = cum[r] + off; const int row = 8 * seg + r; const float q0 = bflo(qq[r]), q1 = bfhi(qq[r]), k0 = bflo(kk[r]), k1 = bfhi(kk[r]);
            *(LAS unsigned*)(QT + row * 272 + cp * 4) = pk2(q0 * __expf(fminf(cu[0] - R[0], 80.f)), q1 * __expf(fminf(cu[1] - R[1], 80.f)));
            *(LAS unsigned*)(KT + row * 272 + cp * 4) = pk2(k0 * __expf(fminf(R[0] - cu[0], 80.f)), k1 * __expf(fminf(R[1] - cu[1], 80.f)));
            *(LAS unsigned*)(QH + row * 272 + cp * 4) = pk2(q0 * __expf(cu[0]), q1 * __expf(cu[1])); }
        v4u o0, o1;
        o0.x = (vv[0] & 0xffffu) | (vv[1] << 16); o0.y = (vv[2] & 0xffffu) | (vv[3] << 16); o0.z = (vv[4] & 0xffffu) | (vv[5] << 16); o0.w = (vv[6] & 0xffffu) | (vv[7] << 16);
        o1.x = (vv[0] >> 16) | (vv[1] & 0xffff0000u); o1.y = (vv[2] >> 16) | (vv[3] & 0xffff0000u); o1.z = (vv[4] >> 16) | (vv[5] & 0xffff0000u); o1.w = (vv[6] >> 16) | (vv[7] & 0xffff0000u);
        *(LAS v4u*)(VT + (2 * cp) * 144 + seg * 16) = o0; *(LAS v4u*)(VT + (2 * cp + 1) * 144 + seg * 16) = o1;
    }
    LBAR();
#pragma unroll
    for (int jj = 0; jj < 2; ++jj) { const int j = 2 * (w & 1) + jj; f32x4 acc = (f32x4){0.f, 0.f, 0.f, 0.f};
        if (j <= i) {
#pragma unroll
            for (int ks = 0; ks < 4; ++ks) acc = mfma16(ldsfrag(KT, 16 * j + l15, 272, 32 * ks + 8 * l4), ldsfrag(QT, t, 272, 32 * ks + 8 * l4), acc); }
#pragma unroll
        for (int e = 0; e < 4; ++e) { const int s = 16 * j + 4 * l4 + e; acc[e] = (j <= i && s <= t) ? acc[e] : 0.f; }
        *(LAS v2u*)(ATT + t * 144 + (16 * j + 4 * l4) * 2) = pk4(acc); }
    LBAR();
    f32x4 O[4]; float ssq = 0.f;
#pragma unroll
    for (int b4 = 0; b4 < 4; ++b4) { const int vb = 4 * (w & 1) + b4; f32x4 acc = (f32x4){0.f, 0.f, 0.f, 0.f};
        acc = mfma16(ldsfrag(VT, 16 * vb + l15, 144, 8 * l4), ldsfrag(ATT, t, 144, 8 * l4), acc);
        if (i >= 2) acc = mfma16(ldsfrag(VT, 16 * vb + l15, 144, 32 + 8 * l4), ldsfrag(ATT, t, 144, 32 + 8 * l4), acc);
#pragma unroll
        for (int ks = 0; ks < 4; ++ks) acc = mfma16(ldsfrag(ST, 16 * vb + l15, 272, 32 * ks + 8 * l4), ldsfrag(QH, t, 272, 32 * ks + 8 * l4), acc);
        O[b4] = acc; ssq += (acc[0] * acc[0] + acc[1] * acc[1]) + (acc[2] * acc[2] + acc[3] * acc[3]); }
    ssq += __shfl_xor(ssq, 16); ssq += __shfl_xor(ssq, 32); if (l4 == 0) SSQ[(w & 1) * 64 + t] = ssq;
    LBAR();
    {   bf16* BR = (bf16*)(ws + WS_BR) + ((size_t)MP + r0) * 1024 + 128 * h;
        const float rs = rsqrtf((SSQ[t] + SSQ[64 + t]) * (1.0f / 128.0f) + EPS);
#pragma unroll
        for (int b4 = 0; b4 < 4; ++b4) { const int v0 = 16 * (4 * (w & 1) + b4) + 4 * l4; const v2u gg = ggs[b4];
            const f32x4 gt = (f32x4){bflo(gg.x), bfhi(gg.x), bflo(gg.y), bfhi(gg.y)};
            *(v2u*)(BR + (unsigned)(t * 1024 + v0)) = pk4(O[b4] * rs * gvs[b4] * gt); }
    }
}

__device__ __forceinline__ void m3_ret(const Ctx& C, int l, int c, int h) {
    AREF A = *C.a; unsigned char* ws = C.ws; const int tid = C.tid, lane = C.lane, w = C.wave, r0 = 64 * c, l15 = lane & 15, l4 = lane >> 4;
    LAS unsigned char* VT = C.lds; LAS unsigned char* ATT = C.lds + 18432; LAS float* SSQ = (LAS float*)(C.lds + 27648);
    const float lg = ret_lgam(h);
    const int i = w >> 1, t = 16 * i + l15;
    const bf16* RG = (const bf16*)(ws + WS_RG) + (size_t)r0 * 1024 + 128 * h;
    LAS unsigned char* ST = C.lds + 28160;
    if (c < NCHP) { const bf16* SB = (const bf16*)(ws + WS_SB) + (size_t)c * STATE_N + ST_RET + (size_t)h * 8192;
#pragma unroll
        for (int q = 0; q < 2; ++q) { const int ch = tid + 512 * q, v = ch >> 3, k8 = ch & 7; *(LAS v4u*)(ST + v * 144 + k8 * 16) = *(const v4u*)(SB + v * 64 + k8 * 8); } }
    else { const float* S0 = A.in[I_SRET] + ((size_t)l * 16 + (c - NCHP)) * 65536 + (size_t)h * 8192;
#pragma unroll
        for (int q = 0; q < 4; ++q) { const int ch = tid + 512 * q, d = ch >> 5, v4 = (ch & 31) * 4, kp = 8 * ((d & 31) >> 2) + 4 * (d >> 5) + (d & 3); const f32x4 s = *(const f32x4*)(S0 + d * 128 + v4);
#pragma unroll
            for (int e = 0; e < 4; ++e) *(LAS bf16*)(ST + (v4 + e) * 144 + kp * 2) = (bf16)f2bf(s[e]); } }
    v2u ggs[4];
#pragma unroll
    for (int b4 = 0; b4 < 4; ++b4) { const int vb = 4 * (w & 1) + b4; ggs[b4] = *(const v2u*)(RG + (unsigned)(t * 1024 + 16 * vb + 4 * l4)); }
    {   const int col = tid & 127, seg = tid >> 7; const bf16* RV = (const bf16*)(ws + WS_RV) + (size_t)(r0 + 16 * seg) * 1024 + 128 * h + col; float vv[16];
#pragma unroll
        for (int i = 0; i < 16; ++i) vv[i] = bf2f(RV[i * 1024]);
        v4u o; o.x = pk2(vv[0], vv[1]); o.y = pk2(vv[2], vv[3]); o.z = pk2(vv[4], vv[5]); o.w = pk2(vv[6], vv[7]); *(LAS v4u*)(VT + col * 144 + seg * 32) = o;
        o.x = pk2(vv[8], vv[9]); o.y = pk2(vv[10], vv[11]); o.z = pk2(vv[12], vv[13]); o.w = pk2(vv[14], vv[15]); *(LAS v4u*)(VT + col * 144 + seg * 32 + 16) = o; }
    const bf16* RQ = (const bf16*)(ws + WS_RQ) + (size_t)r0 * 512 + 64 * h; const bf16* RK = (const bf16*)(ws + WS_RK) + (size_t)r0 * 512 + 64 * h;
    const bf16x8 q0 = *(const bf16x8*)(RQ + (unsigned)(t * 512 + 8 * l4)), q1 = *(const bf16x8*)(RQ + (unsigned)(t * 512 + 32 + 8 * l4));
#pragma unroll
    for (int jj = 0; jj < 2; ++jj) { const int j = 2 * (w & 1) + jj; f32x4 acc = (f32x4){0.f, 0.f, 0.f, 0.f};
        if (j <= i) { acc = mfma16(*(const bf16x8*)(RK + (unsigned)((16 * j + l15) * 512 + 8 * l4)), q0, acc); acc = mfma16(*(const bf16x8*)(RK + (unsigned)((16 * j + l15) * 512 + 32 + 8 * l4)), q1, acc); }
#pragma unroll
        for (int e = 0; e < 4; ++e) { const int s = 16 * j + 4 * l4 + e; acc[e] = (j <= i && s <= t) ? acc[e] * __expf((float)(t - s) * lg) : 0.f; }
        *(LAS v2u*)(ATT + t * 144 + (16 * j + 4 * l4) * 2) = pk4(acc); }
    LBAR();
    const float inner = __expf((float)(t + 1) * lg);
    f32x4 O[4]; float ssq = 0.f;
#pragma unroll
    for (int b4 = 0; b4 < 4; ++b4) { const int vb = 4 * (w & 1) + b4; f32x4 acc = (f32x4){0.f, 0.f, 0.f, 0.f}, acs = (f32x4){0.f, 0.f, 0.f, 0.f};
        acc = mfma16(ldsfrag(VT, 16 * vb + l15, 144, 8 * l4), ldsfrag(ATT, t, 144, 8 * l4), acc);
        if (i >= 2) acc = mfma16(ldsfrag(VT, 16 * vb + l15, 144, 32 + 8 * l4), ldsfrag(ATT, t, 144, 32 + 8 * l4), acc);
        acs = mfma16(ldsfrag(ST, 16 * vb + l15, 144, 8 * l4), q0, acs); acs = mfma16(ldsfrag(ST, 16 * vb + l15, 144, 32 + 8 * l4), q1, acs);
        acc = acc + acs * inner;
        O[b4] = acc; ssq += (acc[0] * acc[0] + acc[1] * acc[1]) + (acc[2] * acc[2] + acc[3] * acc[3]); }
    ssq += __shfl_xor(ssq, 16); ssq += __shfl_xor(ssq, 32); if (l4 == 0) SSQ[(w & 1) * 64 + t] = ssq;
    LBAR();
    {   bf16* BR = (bf16*)(ws + WS_BR) + ((size_t)2 * MP + r0) * 1024 + 128 * h;
        const float rs = rsqrtf((SSQ[t] + SSQ[64 + t]) * (1.0f / 128.0f) + EPS);
#pragma unroll
        for (int b4 = 0; b4 < 4; ++b4) { const int v0 = 16 * (4 * (w & 1) + b4) + 4 * l4; const v2u gg = ggs[b4];
            const f32x4 gt = (f32x4){bflo(gg.x), bfhi(gg.x), bflo(gg.y), bfhi(gg.y)};
            *(v2u*)(BR + (unsigned)(t * 1024 + v0)) = pk4(O[b4] * rs * gt); }
    }
}

#ifndef REPI_M3_SSD
#define REPI_M3_SSD 1
#endif
#ifndef REPI_M3_HG
#define REPI_M3_HG 1
#endif
#ifndef REPI_M3_RET
#define REPI_M3_RET 1
#endif
__device__ __forceinline__ unsigned m3_prefetch(const Ctx& C, int l, int it) {
    constexpr int N_SSD = NCH * 2, N_HG = NCH * 8; unsigned char* ws = C.ws; const int tid = C.tid; unsigned pf = 0;
    if (it < N_SSD) { const int c = it >> 1, g = it & 1, r0 = 64 * c;
        if (c < NCHP) { const bf16* SB = (const bf16*)(ws + WS_SB) + (size_t)c * STATE_N + ST_SSD + (size_t)g * 65536;
#pragma unroll
            for (int q = 0; q < 2; ++q) pf ^= *(const unsigned*)(SB + (tid + 512 * q) * 64); }
        pf ^= *(const unsigned*)((const bf16*)(ws + WS_XTG) + ((size_t)c * 1024 + 512 * g + tid) * 64);
        pf ^= *(const unsigned*)((const bf16*)(ws + WS_ZS) + (size_t)(r0 + (tid >> 3)) * 1024 + 512 * g + 64 * (tid & 7));
        if (tid < 256) pf ^= *(const unsigned*)((const bf16*)(ws + WS_BCG) + (size_t)(r0 + (tid >> 2)) * 512 + 256 * g + 64 * (tid & 3)); }
    else if (it < N_SSD + N_HG) { const int j = it - N_SSD, c = j >> 3, h = j & 7, row = tid >> 3, p = tid & 7; const size_t b = (size_t)(64 * c + row) * 1024 + 128 * h;
        if (p < 4) pf ^= *(const unsigned*)((const bf16*)(ws + WS_LG) + b + 32 * p); else if (p < 6) pf ^= *(const unsigned*)((const bf16*)(ws + WS_KK) + b + 64 * (p - 4)); else pf ^= *(const unsigned*)((const bf16*)(ws + WS_HV) + b + 64 * (p - 6));
        if (p < 2) pf ^= *(const unsigned*)((const bf16*)(ws + WS_HQ) + b + 64 * p); else if (p < 4) pf ^= *(const unsigned*)((const bf16*)(ws + WS_HG) + b + 64 * (p - 2));
        else if (c < NCHP && tid >= 256) pf ^= *(const unsigned*)((const bf16*)(ws + WS_SB) + (size_t)c * STATE_N + ST_HG + (size_t)h * 16384 + (tid - 256) * 64); }
    else { const int j = it - N_SSD - N_HG, c = j >> 3, h = j & 7, row = tid >> 3, p = tid & 7; const size_t b = (size_t)(64 * c + row) * 1024 + 128 * h;
        if (p < 2) pf ^= *(const unsigned*)((const bf16*)(ws + WS_RV) + b + 64 * p); else if (p < 4) pf ^= *(const unsigned*)((const bf16*)(ws + WS_RG) + b + 64 * (p - 2));
        else if (p == 4) pf ^= *(const unsigned*)((const bf16*)(ws + WS_RQ) + (size_t)(64 * c + row) * 512 + 64 * h); else if (p == 5) pf ^= *(const unsigned*)((const bf16*)(ws + WS_RK) + (size_t)(64 * c + row) * 512 + 64 * h);
        else if (c < NCHP && tid < 128 * 8) { const int k = (row * 2 + (p - 6)); if (k < 128) pf ^= *(const unsigned*)((const bf16*)(ws + WS_SB) + (size_t)c * STATE_N + ST_RET + (size_t)h * 8192 + k * 64); } }
    return pf;
}
__device__ __forceinline__ void m3_phase(const Ctx& C0, int l, int mask = 7) {
    constexpr int N_SSD = NCH * 2, N_HG = NCH * 8, N_IT = NCH * 18;
    unsigned* cnt = (unsigned*)(C0.ws + WS_CTL) + CW_QUEUE + 64 * (l * 8 + 1 * 4 + (mask == 7 ? 0 : 1));
    volatile LAS int* slot = (volatile LAS int*)(C0.lds + LDSCTL_OFF + 64);
    int n2 = 0;
    if (C0.tid == 0) { slot[0] = (int)__hip_atomic_fetch_add(cnt, 1u, __ATOMIC_RELAXED, __HIP_MEMORY_SCOPE_AGENT); slot[1] = (int)__hip_atomic_fetch_add(cnt, 1u, __ATOMIC_RELAXED, __HIP_MEMORY_SCOPE_AGENT); }
    LBAR();
    int it = slot[0], nx = slot[1];
    LBAR();
    while (it < N_IT) {
        if (C0.tid == 0) n2 = (int)__hip_atomic_fetch_add(cnt, 1u, __ATOMIC_RELAXED, __HIP_MEMORY_SCOPE_AGENT);
        Ctx C = C0; { int t_ = C0.tid; asm volatile("" : "+v"(t_)); C.tid = t_; C.lane = t_ & 63; C.wave = __builtin_amdgcn_readfirstlane(t_ >> 6); }
        unsigned pf = 0; if (MK_PREFETCH && nx < N_IT && mask == 7) pf = m3_prefetch(C, l, nx);
        if (it < N_SSD) { if (mask & 1) m3_ssd(C, l, it >> 1, it & 1); }
        else if (it < N_SSD + N_HG) { if (mask & 2) { const int j = it - N_SSD; m3_hg(C, l, j >> 3, j & 7); } }
        else { if (mask & 4) { const int j = it - N_SSD - N_HG; m3_ret(C, l, j >> 3, j & 7); } }
        if (pf == 0x7fc1abcdu) ((unsigned*)(C0.ws + WS_CTL))[16] = pf;
        LBAR();
        if (C0.tid == 0) slot[0] = n2;
        LBAR();
        it = nx; nx = slot[0];
    }
}


enum { PH_GEMM1 = 0, PH_M1, PH_M2, PH_M3, PH_GEMM2, PH_GEMM3, PH_GU, PH_DOWN, PH_N };

__device__ __forceinline__ void stagger(int bx, int ticks) {
    if ((bx & 1) && ticks > 0) { const unsigned long long t0 = wall_clock64(); while (wall_clock64() - t0 < (unsigned long long)ticks) __builtin_amdgcn_s_sleep(32); }
}
#ifndef PROBE_G2_MODE
#define PROBE_G2_MODE 0
#endif
#ifndef PROBE_G2_NOSPLIT
#define PROBE_G2_NOSPLIT 0
#endif
#ifndef PROBE_G2_REAL
#define PROBE_G2_REAL 0
#endif
#ifndef STAG_G2
#define STAG_G2 0
#endif
#ifndef STAG_G3
#define STAG_G3 0
#endif
#ifndef STAG_DN
#define STAG_DN 0
#endif
#ifndef STAG_G1
#define STAG_G1 0
#endif
#ifndef STAG_GU
#define STAG_GU 0
#endif
#ifndef REP_P0
#define REP_P0 1
#endif
#ifndef REP_NORM
#define REP_NORM 1
#endif
#ifndef REP_G1
#define REP_G1 1
#endif
#ifndef REP_M1
#define REP_M1 1
#endif
#ifndef REP_M2
#define REP_M2 1
#endif
#ifndef REP_M3
#define REP_M3 1
#endif
#ifndef REP_G2
#define REP_G2 1
#endif
#ifndef REP_G3
#define REP_G3 1
#endif
#ifndef REP_GU
#define REP_GU 1
#endif
#ifndef REP_DN
#define REP_DN 1
#endif
#ifndef PROBE_MASK
#define PROBE_MASK 7
#endif
#ifndef G1_ALIGN
#define G1_ALIGN true
#endif
#ifndef REP_DT
#define REP_DT 1
#endif
#ifndef MK_G2_HANDOFF
#define MK_G2_HANDOFF 1
#endif
#ifndef REP_BAR
#define REP_BAR 1
#endif
__global__ void __launch_bounds__(NTHR, 2) trunk_fwd(Args args) {
    extern __shared__ __attribute__((aligned(16))) unsigned char lds_raw[];
    Ctx C; C.lds = (LAS unsigned char*)lds_raw; C.tid = threadIdx.x; C.lane = C.tid & 63; C.wave = __builtin_amdgcn_readfirstlane(C.tid >> 6);
    const int wave0 = C.wave;
    C.G = gridDim.x; { const int bx = blockIdx.x; C.vcu = (C.G % 8 == 0) ? (bx % 8) * (C.G / 8) + bx / 8 : bx; }
    ArgsP ap = (ArgsP)__builtin_amdgcn_kernarg_segment_ptr();
    C.a = ap; C.ws = ap->ws;
    unsigned char* ws = ap->ws; const int use_bar = ap->use_bar;
    for (int u = C.tid; u < (LDS_BYTES - LDSCTL_OFF) / 4; u += NTHR) ((LAS unsigned*)(C.lds + LDSCTL_OFF))[u] = 0u;
    __syncthreads();
    XcdBarrier bar; bar.bar = (unsigned*)(ws + WS_CTL) + CW_BAR; bar.x = 0; bar.st = nullptr;
    if (use_bar) bar = xcd_barrier_post((unsigned*)(ws + WS_CTL) + CW_BAR, (volatile LAS unsigned*)(C.lds + LDSCTL_OFF));
#define GRID_BAR() do { if (use_bar) for (int rb_ = 0; rb_ < REP_BAR; ++rb_) { bar.bar = (unsigned*)(ws + WS_CTL) + CW_BAR; xcd_barrier(bar); } } while (0)
#define FRESH() do { int w0_ = wave0; asm volatile("" : "+s"(w0_)); unsigned z_ = 0u; asm volatile("" : "+v"(z_)); int t_ = w0_ * 64 + (int)__builtin_amdgcn_mbcnt_hi(~0u, __builtin_amdgcn_mbcnt_lo(~0u, z_)); asm volatile("" : "+v"(t_)); C.tid = t_; C.lane = t_ & 63; C.wave = __builtin_amdgcn_readfirstlane(t_ >> 6); \
        int g_ = gridDim.x; asm volatile("" : "+s"(g_)); C.G = g_; int b_ = blockIdx.x; asm volatile("" : "+s"(b_)); bx = b_; C.vcu = (C.G % 8 == 0) ? (b_ % 8) * (C.G / 8) + b_ / 8 : b_; \
        ArgsP a_ = (ArgsP)__builtin_amdgcn_kernarg_segment_ptr(); asm volatile("" : "+s"(a_)); ap = a_; C.a = a_; unsigned char* w_ = a_->ws; ws = w_; C.ws = w_; X = (bf16*)(ws + WS_X); H = (bf16*)(ws + WS_H); lw = ws + WS_W + (size_t)l * LW_SIZE; } while (0)
#define IN(k) (ap->ph_lo <= (k) && (k) < ap->ph_hi)

    if (ap->do_pro) { for (int r_ = 0; r_ < REP_P0; ++r_) p0_prologue(C); GRID_BAR(); }

    bf16* X = (bf16*)(ws + WS_X); bf16* H = (bf16*)(ws + WS_H); int bx = blockIdx.x; unsigned char* lw = ws;
    const int l_hi = ap->l_hi;
    for (int l = ap->l_lo; l < l_hi; ++l) {
        if (IN(PH_GEMM1)) for (int r_ = 0; r_ < REP_G1; ++r_) { asm volatile("; MARK_PH_GEMM1"); FRESH(); stagger(bx, STAG_G1);
            pg8::Gemm g{X, (const bf16*)(lw + LW_IN), MP, NPROJ, D, 0, 0}; pg8::StaticOrder S; S.init(MP, NPROJ, C.G, bx, D);
            if (r_ == 0) { EpiProj E{ws, l};
            pg8::gemm_phase<EpiProj, pg8::StaticOrder, G1_ALIGN, true>(C.lds, g, S, E, C.tid); for (int q_ = 0; q_ < REP_DT; ++q_) { dt_rows(C, l); LBAR(); } }
            else { S.sametile = 1; EpiNull E{(float*)(ws + WS_TMP)}; pg8::gemm_phase<EpiNull, pg8::StaticOrder, G1_ALIGN, true>(C.lds, g, S, E, C.tid); }
            GRID_BAR();
        }
        if (IN(PH_M1)) for (int r_ = 0; r_ < REP_M1; ++r_) { asm volatile("; MARK_PH_M1"); FRESH(); m1_phase(C, l, r_ == 0 ? 7 : PROBE_MASK); GRID_BAR(); }
        if (IN(PH_M2)) for (int r_ = 0; r_ < REP_M2; ++r_) { asm volatile("; MARK_PH_M2"); FRESH(); m2_phase(C, l); GRID_BAR(); }
        if (IN(PH_M3)) for (int r_ = 0; r_ < REP_M3; ++r_) { asm volatile("; MARK_PH_M3"); FRESH(); m3_phase(C, l, r_ == 0 ? 7 : PROBE_MASK); GRID_BAR(); }
        if (IN(PH_GEMM2)) for (int r_ = 0; r_ < REP_G2; ++r_) { asm volatile("; MARK_PH_GEMM2"); FRESH(); stagger(bx, STAG_G2);
            pg8::Gemm g{(const bf16*)(ws + WS_BR), (const bf16*)(lw + LW_BR), MP, D, 1024, (size_t)MP * 1024 * 2, (size_t)D * 1024 * 2}; BranchOrder S; S.init(MP, D, C.G, bx, 1024);
            EpiBranch E{(bf16*)(ws + WS_TMP), (bf16*)(ws + WS_MIX), (const bf16*)(ws + WS_GT), (float*)(ws + WS_SLAB), (unsigned*)(ws + WS_CTL) + CW_G2 + 64 * (64 * (l * REP_G2 + r_)), (unsigned*)(ws + WS_CTL) + CW_TMO, (S.dep && REP_G2 == 1 && MK_G2_HANDOFF) ? (unsigned*)(ws + WS_CTL) + CW_RDY + (2 * l) * 64 * 32 : nullptr};
            if (r_ == 0 || PROBE_G2_REAL) pg8::gemm_phase<EpiBranch, BranchOrder, true, true>(C.lds, g, S, E, C.tid);
            else if (PROBE_G2_MODE) { EpiBranchT<PROBE_G2_MODE> E2{(bf16*)(ws + WS_HID), (bf16*)(ws + WS_HID) + (size_t)MP * D, (const bf16*)(ws + WS_GT), (float*)(ws + WS_SLAB) + (size_t)256 * 65536, (unsigned*)(ws + WS_CTL) + CW_G2 + 64 * 64 * 7, (unsigned*)(ws + WS_CTL) + CW_TMO}; S.rem = 0; S.R = (S.S.nwg + S.S.G - 1) / S.S.G; pg8::gemm_phase<EpiBranchT<PROBE_G2_MODE>, BranchOrder, true, true>(C.lds, g, S, E2, C.tid); }
            else { if (PROBE_G2_NOSPLIT) { S.rem = 0; S.R = (S.S.nwg + S.S.G - 1) / S.S.G; } EpiNull EN{(float*)(ws + WS_TMP)}; pg8::gemm_phase<EpiNull, BranchOrder, true, true>(C.lds, g, S, EN, C.tid); }
            if (!(S.dep && REP_G2 == 1 && MK_G2_HANDOFF)) GRID_BAR();
        }
        if (IN(PH_GEMM3)) for (int r_ = 0; r_ < REP_G3; ++r_) { asm volatile("; MARK_PH_GEMM3"); FRESH(); stagger(bx, STAG_G3);
            pg8::Gemm g{(const bf16*)(ws + WS_MIX), (const bf16*)(lw + LW_OUT), MP, D, D, 0, 0}; G3Order S; S.init(MP, D, C.G, bx, D, (REP_G2 == 1 && !MK_G2_NOSPLIT && MK_G2_HANDOFF) ? (const unsigned*)(ws + WS_CTL) + CW_RDY + (2 * l) * 64 * 32 : nullptr, (unsigned*)(ws + WS_CTL) + CW_TMO);
            const int ep = 2 * l + 0;
            EpiResid E{r_ == 0 ? X : (bf16*)(ws + WS_TMP), (float*)(ws + WS_SLAB) + (size_t)(ep & 1) * 256 * 65536, (unsigned*)(ws + WS_CTL) + CW_SK + (ep & 7) * 256 * 64, (unsigned*)(ws + WS_CTL) + CW_TMO,
                       r_ == 0 ? (u64*)((unsigned*)(ws + WS_CTL) + CW_RS) + (size_t)(2 * l + 1) * MP : nullptr, (r_ == 0 && S.dep) ? (unsigned*)(ws + WS_CTL) + CW_RDY + (2 * l + 1) * 64 * 32 : nullptr};
            pg8::gemm_phase<EpiResid, G3Order, true, true>(C.lds, g, S, E, C.tid);
            if (!S.dep) GRID_BAR();
        }
        if (IN(PH_GU)) for (int r_ = 0; r_ < REP_GU; ++r_) { asm volatile("; MARK_PH_GU"); FRESH(); stagger(bx, STAG_GU);
            pg8::Gemm g{X, (const bf16*)(lw + LW_GU), MP, 2 * FFN, D, 0, 0}; GuOrder S; S.init(MP, 2 * FFN, C.G, bx, D, (const unsigned*)(ws + WS_CTL) + CW_RDY + (2 * l + 1) * 64 * 32, (unsigned*)(ws + WS_CTL) + CW_TMO);
            EpiSwiglu E{(bf16*)(ws + WS_HID), (float*)(ws + WS_SLAB), (unsigned*)(ws + WS_CTL) + CW_SK + ((2 * l) & 7) * 256 * 64, (unsigned*)(ws + WS_CTL) + CW_TMO, (const u64*)((const unsigned*)(ws + WS_CTL) + CW_RS) + (size_t)(2 * l + 1) * MP};
            pg8::gemm_phase<EpiSwiglu, GuOrder, true, true>(C.lds, g, S, E, C.tid);
            GRID_BAR();
        }
        if (IN(PH_DOWN)) for (int r_ = 0; r_ < REP_DN; ++r_) { asm volatile("; MARK_PH_DOWN"); FRESH(); stagger(bx, STAG_DN);
            pg8::Gemm g{(const bf16*)(ws + WS_HID), (const bf16*)(lw + LW_DN), MP, D, FFN, 0, 0}; pg8::StreamOrder S; S.init(MP, D, C.G, C.vcu, FFN);
            const int ep = 2 * l + 1;
            EpiResid E{r_ == 0 ? X : (bf16*)(ws + WS_TMP), (float*)(ws + WS_SLAB) + (size_t)(ep & 1) * 256 * 65536, (unsigned*)(ws + WS_CTL) + CW_SK + (ep & 7) * 256 * 64, (unsigned*)(ws + WS_CTL) + CW_TMO,
                       (r_ == 0 && l + 1 < NL) ? (u64*)((unsigned*)(ws + WS_CTL) + CW_RS) + (size_t)(2 * l + 2) * MP : nullptr};
            pg8::gemm_phase<EpiResid, pg8::StreamOrder, true, true>(C.lds, g, S, E, C.tid);
            GRID_BAR();
        }
    }
    if (ap->do_fin) { const int l = 0; FRESH(); final_phase(C, X, ap->in[I_NFIN], ap->out); }
#undef IN
#undef GRID_BAR
#undef FRESH
}


__global__ void probe_dump(const unsigned short* src, size_t n_src, float* out, size_t n_out) {
    for (size_t i = (size_t)blockIdx.x * blockDim.x + threadIdx.x; i < n_out; i += (size_t)gridDim.x * blockDim.x) {
        const size_t j = (i * 4 + (i & 3)) % n_src; out[i] = __builtin_bit_cast(float, ((unsigned)src[j]) << 16) * 1e-3f + 1.0f; }
}
#ifndef MK_REPS
#define MK_REPS 1
#endif
#ifndef MK_ONE_LAUNCH
#define MK_ONE_LAUNCH 1
#endif
extern "C" void kernel_launch(void* const* d_in, const int* in_sizes, int n_in, void* d_out, int out_size, void* d_ws, size_t ws_size, hipStream_t stream) {
    static int grid = 0;
    if (grid == 0) {
        if (n_in != 24 || (size_t)out_size != O_END || ws_size < WS_END) { fprintf(stderr, "kernel_launch: unexpected shapes (n_in %d, out %d, ws %zu, need %zu)\n", n_in, out_size, ws_size, (size_t)WS_END); grid = -1; return; }
        int dev = 0, cus = 0, per_cu = 0;
        if (hipGetDevice(&dev) != hipSuccess || hipDeviceGetAttribute(&cus, hipDeviceAttributeMultiprocessorCount, dev) != hipSuccess) { grid = -1; return; }
        if (hipFuncSetAttribute((const void*)trunk_fwd, hipFuncAttributeMaxDynamicSharedMemorySize, LDS_BYTES) != hipSuccess) { fprintf(stderr, "kernel_launch: hipFuncSetAttribute failed\n"); grid = -1; return; }
        if (hipOccupancyMaxActiveBlocksPerMultiprocessor(&per_cu, (const void*)trunk_fwd, NTHR, LDS_BYTES) != hipSuccess || per_cu < 1) fprintf(stderr, "kernel_launch: occupancy query reports %d\n", per_cu);
        (void)hipGetLastError();
        grid = cus;
    }
    if (grid < 0) return;
    (void)hipMemsetAsync((char*)d_ws + WS_CTL, 0, CTL_ZERO_BYTES, stream);
    Args a{};
    for (int i = 0; i < 24; ++i) a.in[i] = (const float*)d_in[i];
    a.out = (float*)d_out; a.ws = (unsigned char*)d_ws;
#if MK_ONE_LAUNCH
    a.l_lo = 0; a.l_hi = NL; a.ph_lo = 0; a.ph_hi = PH_N; a.do_pro = 1; a.do_fin = 1; a.use_bar = 1; a.pad = 0;
    hipLaunchKernelGGL(trunk_fwd, dim3(grid), dim3(NTHR), LDS_BYTES, stream, a);
#else
    for (int rep = 0; rep < MK_REPS; ++rep) {
    a.use_bar = 0; a.pad = 0;
    a.l_lo = 0; a.l_hi = 0; a.ph_lo = 0; a.ph_hi = 0; a.do_pro = 1; a.do_fin = 0;
    hipLaunchKernelGGL(trunk_fwd, dim3(grid), dim3(NTHR), LDS_BYTES, stream, a);
    a.do_pro = 0;
#ifdef PROBE_NPH
    { int cnt = 0; for (int l = 0; l < NL && cnt < PROBE_NPH; ++l) for (int ph = 0; ph < PH_N && cnt < PROBE_NPH; ++ph, ++cnt) { a.l_lo = l; a.l_hi = l + 1; a.ph_lo = ph; a.ph_hi = ph + 1; hipLaunchKernelGGL(trunk_fwd, dim3(grid), dim3(NTHR), LDS_BYTES, stream, a); } }
    probe_dump<<<2048, 256, 0, stream>>>((const unsigned short*)((char*)d_ws + PROBE_LO), (size_t)(PROBE_HI - PROBE_LO) / 2, (float*)d_out, (size_t)O_END);
    return;
#endif
    for (int l = 0; l < NL; ++l) for (int ph = 0; ph < PH_N; ++ph) { a.l_lo = l; a.l_hi = l + 1; a.ph_lo = ph; a.ph_hi = ph + 1; hipLaunchKernelGGL(trunk_fwd, dim3(grid), dim3(NTHR), LDS_BYTES, stream, a); }
    a.l_lo = 0; a.l_hi = 0; a.ph_lo = 0; a.ph_hi = 0; a.do_fin = 1;
    hipLaunchKernelGGL(trunk_fwd, dim3(grid), dim3(NTHR), LDS_BYTES, stream, a);
    }
#endif
    const hipError_t le = hipPeekAtLastError();
    if (le != hipSuccess) fprintf(stderr, "kernel_launch: launch failed: %s\n", hipGetErrorName(le));
}
```

```cpp
#include <hip/hip_runtime.h>
#include <cstdio>
#include <cstdint>
#ifndef PG8_WGM
#define PG8_WGM 8
#endif
namespace pg8 {
#define PG8_LAS __attribute__((address_space(3)))
typedef unsigned short bf16_t;
typedef short bf16x8 __attribute__((ext_vector_type(8)));
typedef float f32x4 __attribute__((ext_vector_type(4)));
typedef unsigned u32x4 __attribute__((ext_vector_type(4)));
constexpr int BM = 256, BK = 64, HALF = 128, HTB = HALF * BK * 2  , STAGE_BYTES = 8 * HTB, NXCD = 8, WGM = PG8_WGM;

__host__ __device__ __forceinline__ int lds_byte(int r, int c) { const int st = (r >> 4) * 2 + (c >> 5), rr = r & 15, cc = c & 31, ob = rr * 64 + cc * 2; return st * 1024 + (ob ^ (((ob >> 9) & 1) << 5)); }
__host__ __device__ __forceinline__ void stage_rc(int b, int& R, int& C) { const int st = b / 1024, sb = b % 1024, swz = sb ^ (((sb >> 9) & 1) << 5); R = (st >> 1) * 16 + swz / 64; C = (st & 1) * 32 + (swz % 64) / 2; }
__host__ __device__ __forceinline__ int perm32(int rho) { const int n = rho >> 4, i = rho & 15; return 8 * (i >> 2) + 4 * n + (i & 3); }

struct Unit { int pm, pn, pc, k0, nt, kind, slab; };
struct Gemm { const bf16_t* A; const bf16_t* Bt; int M, N, K; size_t csA, csB; };

struct StaticOrder {
    int nM, nN, nwg, G, c, ntk, sametile = 0;
    __host__ __device__ __forceinline__ void init(int M, int N, int G_, int c_, int K) { nM = M / BM; nN = N / BM; nwg = nM * nN; G = G_; c = c_; ntk = K / BK; }
    __host__ __device__ __forceinline__ void tile(int L, Unit& u) const {
        int wgid = L; { const int q = nwg / NXCD, r = nwg % NXCD, xcd = wgid % NXCD, off = wgid / NXCD; wgid = (xcd < r ? xcd * (q + 1) : r * (q + 1) + (xcd - r) * q) + off; }
        const int nig = WGM * nN, gid = wgid / nig, fm = gid * WGM, gsz = (nM - fm) < WGM ? (nM - fm) : WGM;
        u.pm = fm + ((wgid % nig) % gsz); u.pn = (wgid % nig) / gsz; u.pc = 0;
    }
    __host__ __device__ __forceinline__ void tile_seq(int wgid, Unit& u) const {
        const int nig = WGM * nN, gid = wgid / nig, fm = gid * WGM, gsz = (nM - fm) < WGM ? (nM - fm) : WGM;
        u.pm = fm + ((wgid % nig) % gsz); u.pn = (wgid % nig) / gsz; u.pc = 0;
    }
    __host__ __device__ __forceinline__ bool next(int i, Unit& u) const {
        const long L = (long)i * G + c; if (L >= nwg) return false;
        tile((int)L, u); u.k0 = 0; u.nt = ntk; u.kind = 0; u.slab = 0;
#ifdef PROBE_SAMETILE
        if (sametile) { u.pm = 0; u.pn = 0; }
#endif
        return true;
    }
    __device__ __forceinline__ void a_ready(const Unit&) const {}
    __device__ __forceinline__ void done(const Unit&) const {}
};
struct StreamOrder {
    StaticOrder S; int P, lo, hi, r;
    __host__ __device__ __forceinline__ void init(int M, int N, int G, int rank, int K) { S.init(M, N, G, 0, K); P = K / (2 * BK); r = rank; const long W = (long)S.nwg * P; lo = (int)((W * rank) / G); hi = (int)((W * (rank + 1)) / G); }
    __host__ __device__ __forceinline__ bool next(int i, Unit& u) const {
        const int tail = (lo % P) ? P - lo % P : 0, head = hi % P, t0 = (lo + tail) / P, nfull = (hi - head) / P - t0;
        int k = i;
        if (head) { if (k == 0) { S.tile_seq(hi / P, u); u.k0 = 0; u.nt = 2 * head; u.kind = 1; u.slab = r; return true; } --k; }
        if (k < nfull) { S.tile_seq(t0 + k, u); u.k0 = 0; u.nt = 2 * P; u.kind = 0; u.slab = 0; return true; }
        k -= nfull;
        if (tail && k == 0) { S.tile_seq(lo / P, u); u.k0 = 2 * (P - tail); u.nt = 2 * tail; u.kind = 2; u.slab = r - 1; return true; }
        return false;
    }
    __device__ __forceinline__ void a_ready(const Unit&) const {}
    __device__ __forceinline__ void done(const Unit&) const {}
};

__device__ __forceinline__ unsigned cvt_pk_bf16(float lo, float hi) { unsigned r; asm volatile("v_cvt_pk_bf16_f32 %0, %1, %2" : "=v"(r) : "v"(lo), "v"(hi)); return r; }

template <class Epi, class Sched, bool ALIGN_EPI = false, bool SP2 = false>
__device__ __forceinline__ void gemm_phase(PG8_LAS unsigned char* lds, const Gemm g, const Sched& S, const Epi& E, const int tid) {
    const int wid = __builtin_amdgcn_readfirstlane(tid >> 6), lane = tid & 63, wr = wid >> 2, wc = wid & 3, fr = lane & 15, fq = lane >> 4;
    const int K = g.K;
    unsigned voffA[2], voffB[2];
#pragma unroll
    for (int i = 0; i < 2; ++i) { int R, C; stage_rc(tid * 16 + i * 8192, R, C); const int Rb = Epi::PERM ? ((R & ~31) + perm32(R & 31)) : R;
        voffA[i] = (unsigned)(R * K + C) * 2u; voffB[i] = (unsigned)(Rb * K + C) * 2u; }
    const size_t kstep = (size_t)(BK * 2);
    const size_t hstep = (size_t)HALF * K * 2;
    const size_t tstep = 2 * hstep;
    const unsigned ldsw = (unsigned)wid * 1024u;
    const int aoff = lds_byte(wr * 64 + fr, fq * 8), boff = lds_byte(wc * 32 + fr, fq * 8);
#define PG8_SA(b, h) (((b) * 2 + (h)) * HTB)
#define PG8_SB(b, h) ((4 + (b) * 2 + (h)) * HTB)
#define PG8_STAGE(bufoff, gbase, voff) do { _Pragma("unroll") for (int _i = 0; _i < 2; ++_i) \
        __builtin_amdgcn_global_load_lds((const unsigned*)((const char*)(gbase) + (voff)[_i]), (PG8_LAS unsigned*)(lds + (bufoff) + ldsw + _i * 8192), 16, 0, 0); } while (0)
#define PG8_LDA(dst, b, h) do { _Pragma("unroll") for (int m = 0; m < 4; ++m) _Pragma("unroll") for (int k = 0; k < 2; ++k) dst[m][k] = *(const PG8_LAS bf16x8*)(lds + PG8_SA(b, h) + aoff + m * 2048 + k * 1024); } while (0)
#define PG8_LDB(dst, b, h) do { _Pragma("unroll") for (int n = 0; n < 2; ++n) _Pragma("unroll") for (int k = 0; k < 2; ++k) dst[n][k] = *(const PG8_LAS bf16x8*)(lds + PG8_SB(b, h) + boff + n * 2048 + k * 1024); } while (0)
#define PG8_MMA(ai, bj, At, Bt) do { __builtin_amdgcn_s_setprio(1); _Pragma("unroll") for (int m = 0; m < 4; ++m) _Pragma("unroll") for (int n = 0; n < 2; ++n) _Pragma("unroll") for (int k = 0; k < 2; ++k) \
        acc[ai][bj][m][n] = __builtin_amdgcn_mfma_f32_16x16x32_bf16(Bt[n][k], At[m][k], acc[ai][bj][m][n], 0, 0, 0); __builtin_amdgcn_s_setprio(0); } while (0)
#define PG8_WAIT_V(n) asm volatile("s_waitcnt vmcnt(" #n ")" ::: "memory")
#define PG8_WAIT_L(n) asm volatile("s_waitcnt lgkmcnt(" #n ")" ::: "memory")
#define PG8_BAR __builtin_amdgcn_s_barrier()
#define PG8_SCHED __builtin_amdgcn_sched_barrier(0)
    Unit cur, nxt; int ui = 0;
    if (!S.next(0, cur)) return;
    f32x4 acc[2][2][4][2];
#pragma unroll
    for (int a = 0; a < 2; ++a)
#pragma unroll
        for (int b = 0; b < 2; ++b)
#pragma unroll
            for (int m = 0; m < 4; ++m)
#pragma unroll
                for (int n = 0; n < 2; ++n) acc[a][b][m][n] = (f32x4){0.f, 0.f, 0.f, 0.f};
    bf16x8 At[4][2], B0[2][2], B1[2][2];
    const char* cA = (const char*)g.A + (size_t)cur.pm * tstep + (size_t)cur.pc * g.csA + (size_t)cur.k0 * kstep; const char* cB = (const char*)g.Bt + (size_t)cur.pn * tstep + (size_t)cur.pc * g.csB + (size_t)cur.k0 * kstep;
    S.a_ready(cur);
    if constexpr (SP2) {
        PG8_STAGE(PG8_SB(0, 0), cB, voffB); PG8_STAGE(PG8_SB(0, 1), cB + hstep, voffB); PG8_STAGE(PG8_SA(0, 0), cA, voffA); PG8_STAGE(PG8_SA(0, 1), cA + hstep, voffA);
        if (wr == 1) PG8_BAR;
        PG8_WAIT_V(2); PG8_BAR;
        PG8_STAGE(PG8_SB(1, 0), cB + kstep, voffB); PG8_STAGE(PG8_SA(1, 0), cA + kstep, voffA); PG8_STAGE(PG8_SB(1, 1), cB + hstep + kstep, voffB);
        PG8_WAIT_V(6); PG8_BAR;
    } else {
        PG8_STAGE(PG8_SB(0, 0), cB, voffB); PG8_STAGE(PG8_SA(0, 0), cA, voffA); PG8_STAGE(PG8_SB(0, 1), cB + hstep, voffB); PG8_STAGE(PG8_SA(0, 1), cA + hstep, voffA);
        if (wr == 1) PG8_BAR;
        PG8_WAIT_V(4); PG8_BAR;
        PG8_STAGE(PG8_SB(1, 0), cB + kstep, voffB); PG8_STAGE(PG8_SA(1, 0), cA + kstep, voffA); PG8_STAGE(PG8_SB(1, 1), cB + hstep + kstep, voffB);
        PG8_WAIT_V(6); PG8_BAR;
    }
    for (;;) {
        const bool has_next = S.next(ui + 1, nxt);
        const char* nA = has_next ? (const char*)g.A + (size_t)nxt.pm * tstep + (size_t)nxt.pc * g.csA + (size_t)nxt.k0 * kstep : cA; const char* nB = has_next ? (const char*)g.Bt + (size_t)nxt.pn * tstep + (size_t)nxt.pc * g.csB + (size_t)nxt.k0 * kstep : cB;
        const int nt = cur.nt;
        for (int t = 0; t < nt; t += 2) {
            const bool last = (t == nt - 2);
            const char* a1 = cA + (size_t)(t + 1) * kstep;
            const char* a2 = last ? nA : cA + (size_t)(t + 2) * kstep; const char* b2 = last ? nB : cB + (size_t)(t + 2) * kstep;
            const char* a3 = a2 + kstep; const char* b3 = b2 + kstep;
            if (last && has_next) S.a_ready(nxt);
            if constexpr (SP2) {
            PG8_LDB(B0, 0, 0); PG8_LDB(B1, 0, 1); PG8_SCHED; PG8_LDA(At, 0, 0); PG8_STAGE(PG8_SA(1, 1), a1 + hstep, voffA);
            PG8_WAIT_V(8); PG8_WAIT_L(0); PG8_BAR; PG8_MMA(0, 0, At, B0); PG8_MMA(0, 1, At, B1); PG8_BAR; PG8_SCHED;
            PG8_LDA(At, 0, 1); PG8_STAGE(PG8_SB(0, 0), b2, voffB); PG8_STAGE(PG8_SB(0, 1), b2 + hstep, voffB); PG8_STAGE(PG8_SA(0, 0), a2, voffA);
            PG8_WAIT_V(8); PG8_WAIT_L(0); PG8_BAR; PG8_MMA(1, 0, At, B0); PG8_MMA(1, 1, At, B1); PG8_BAR; PG8_SCHED;
            PG8_LDB(B0, 1, 0); PG8_LDB(B1, 1, 1); PG8_SCHED; PG8_LDA(At, 1, 0); PG8_STAGE(PG8_SA(0, 1), a2 + hstep, voffA);
            PG8_WAIT_V(8); PG8_WAIT_L(0); PG8_BAR; PG8_MMA(0, 0, At, B0); PG8_MMA(0, 1, At, B1); PG8_BAR; PG8_SCHED;
            PG8_LDA(At, 1, 1); PG8_STAGE(PG8_SB(1, 0), b3, voffB); PG8_STAGE(PG8_SB(1, 1), b3 + hstep, voffB); PG8_STAGE(PG8_SA(1, 0), a3, voffA);
            PG8_WAIT_V(8); PG8_WAIT_L(0); PG8_BAR; PG8_MMA(1, 0, At, B0); PG8_MMA(1, 1, At, B1); PG8_BAR; PG8_SCHED;
            } else {
            PG8_LDB(B0, 0, 0); PG8_SCHED; PG8_LDA(At, 0, 0); PG8_STAGE(PG8_SA(1, 1), a1 + hstep, voffA);
            PG8_WAIT_L(8); PG8_BAR; PG8_WAIT_L(0); PG8_MMA(0, 0, At, B0); PG8_BAR; PG8_SCHED;
            PG8_LDB(B1, 0, 1); PG8_STAGE(PG8_SB(0, 0), b2, voffB);
            PG8_BAR; PG8_WAIT_L(0); PG8_MMA(0, 1, At, B1); PG8_BAR;
            PG8_LDA(At, 0, 1); PG8_STAGE(PG8_SA(0, 0), a2, voffA);
            PG8_BAR; PG8_WAIT_L(0); PG8_MMA(1, 0, At, B0); PG8_BAR; PG8_SCHED;
            PG8_STAGE(PG8_SB(0, 1), b2 + hstep, voffB);
            PG8_WAIT_V(6); PG8_BAR; PG8_MMA(1, 1, At, B1); PG8_BAR;
            PG8_LDB(B0, 1, 0); PG8_SCHED; PG8_LDA(At, 1, 0); PG8_STAGE(PG8_SA(0, 1), a2 + hstep, voffA);
            PG8_WAIT_L(8); PG8_BAR; PG8_WAIT_L(0); PG8_MMA(0, 0, At, B0); PG8_BAR; PG8_SCHED;
            PG8_LDB(B1, 1, 1); PG8_STAGE(PG8_SB(1, 0), b3, voffB);
            PG8_BAR; PG8_WAIT_L(0); PG8_MMA(0, 1, At, B1); PG8_BAR;
            PG8_LDA(At, 1, 1); PG8_STAGE(PG8_SA(1, 0), a3, voffA);
            PG8_BAR; PG8_WAIT_L(0); PG8_MMA(1, 0, At, B0); PG8_BAR; PG8_SCHED;
            PG8_STAGE(PG8_SB(1, 1), b3 + hstep, voffB);
            PG8_WAIT_V(6); PG8_BAR; PG8_MMA(1, 1, At, B1); PG8_BAR;
            }
        }
        if constexpr (ALIGN_EPI) { if (wr == 0) PG8_BAR; }
        if constexpr (!Epi::AFTER_DRAIN) { E(acc, cur, wr, wc, fr, fq); S.done(cur); }
        if (!has_next) break;
#pragma unroll
        for (int a = 0; a < 2; ++a)
#pragma unroll
            for (int b = 0; b < 2; ++b)
#pragma unroll
                for (int m = 0; m < 4; ++m)
#pragma unroll
                    for (int n = 0; n < 2; ++n) acc[a][b][m][n] = (f32x4){0.f, 0.f, 0.f, 0.f};
        cur = nxt; cA = nA; cB = nB; ++ui;
        if constexpr (ALIGN_EPI) { if (wr == 1) PG8_BAR; }
    }
    PG8_WAIT_V(0);
    if constexpr (!ALIGN_EPI) { if (wr == 0) PG8_BAR; }
    PG8_BAR;
    if constexpr (Epi::AFTER_DRAIN) { E.fused(acc, cur, wr, wc, fr, fq, lds, wid, lane); S.done(cur); }
#undef PG8_SA
#undef PG8_SB
#undef PG8_STAGE
#undef PG8_LDA
#undef PG8_LDB
#undef PG8_MMA
#undef PG8_WAIT_V
#undef PG8_WAIT_L
#undef PG8_BAR
#undef PG8_SCHED
}
}


constexpr int D = 2048, NL = 4, FFN = 5632, NPROJ = 15872, INCOLS = 15888;
constexpr int MR = 9280, MP = 9472, NCH = 145, NCHP = 129;
constexpr int ROW_P0 = 64, ROW_S0 = 8256, NNULL = 48;
constexpr int STATE_N = 327680, ST_SSD = 0, ST_HG = 131072, ST_RET = 262144;
constexpr int GAM_N = 1040;
constexpr float EPS = 1e-6f;
constexpr size_t O_YP = 0, O_YS = 16777216, O_CONVP = O_YS + 2097152, O_SSMP = O_CONVP + 18432, O_HGP = O_SSMP + 524288, O_RETP = O_HGP + 524288,
                 O_CONVS = O_RETP + 262144, O_SSMS = O_CONVS + 294912, O_HGS = O_SSMS + 8388608, O_RETS = O_HGS + 8388608, O_END = O_RETS + 4194304;

constexpr size_t MiB = 1u << 20;
constexpr size_t al(size_t x) { return (x + MiB - 1) / MiB * MiB; }
constexpr size_t WS_CTL = 0, CTL_ZERO_BYTES = 2 * MiB;
constexpr size_t SZ_WIN = (size_t)NPROJ * D * 2, SZ_WBR = (size_t)3 * D * 1024 * 2, SZ_WOUT = (size_t)D * D * 2, SZ_WGU = (size_t)2 * FFN * D * 2, SZ_WDN = (size_t)D * FFN * 2, SZ_WDT = (size_t)16 * D * 2;
constexpr size_t LW_IN = 0, LW_BR = LW_IN + al(SZ_WIN), LW_OUT = LW_BR + al(SZ_WBR), LW_GU = LW_OUT + al(SZ_WOUT), LW_DN = LW_GU + al(SZ_WGU), LW_DT = LW_DN + al(SZ_WDN), LW_SIZE = LW_DT + al(SZ_WDT);
constexpr size_t WS_W = 2 * MiB;
constexpr size_t WS_X = WS_W + 4 * LW_SIZE;
constexpr size_t WS_H = WS_X + al((size_t)MP * D * 4);
constexpr size_t WS_ZS = WS_H + al((size_t)MP * D * 2);
constexpr size_t WS_XBC = WS_ZS + al((size_t)MP * 1024 * 2);
constexpr size_t WS_HQ = WS_XBC + al((size_t)MP * 1536 * 2);
constexpr size_t WS_LG = WS_HQ + al((size_t)MP * 1024 * 2);
constexpr size_t WS_KK = WS_LG + al((size_t)MP * 1024 * 4);
constexpr size_t WS_HV = WS_KK + al((size_t)MP * 1024 * 2);
constexpr size_t WS_HG = WS_HV + al((size_t)MP * 1024 * 2);
constexpr size_t WS_RQ = WS_HG + al((size_t)MP * 1024 * 2);
constexpr size_t WS_RK = WS_RQ + al((size_t)MP * 512 * 2);
constexpr size_t WS_RV = WS_RK + al((size_t)MP * 512 * 2);
constexpr size_t WS_RG = WS_RV + al((size_t)MP * 1024 * 2);
constexpr size_t WS_GT = WS_RG + al((size_t)MP * 1024 * 2);
constexpr size_t WS_DT = WS_GT + al((size_t)MP * 6144 * 2);
constexpr size_t WS_CUM = WS_DT + al((size_t)MP * 16 * 4);
constexpr size_t WS_U = WS_CUM + al((size_t)MP * 16 * 4);
constexpr size_t WS_SB = WS_U + al((size_t)NCH * STATE_N * 4);
constexpr size_t WS_GAM = WS_SB + al((size_t)NCH * STATE_N * 2);
constexpr size_t WS_BR = WS_GAM + al((size_t)NCH * GAM_N * 4);
constexpr size_t WS_TMP = WS_BR + al((size_t)3 * MP * 1024 * 2);
constexpr size_t WS_MIX = WS_TMP + al((size_t)MP * D * 4);
constexpr size_t WS_HID = WS_MIX + al((size_t)MP * D * 2);
constexpr size_t WS_ROPE = WS_HID + al((size_t)MP * FFN * 2);
constexpr size_t WS_LBS = WS_ROPE + al((size_t)MP * 32 * 8);
constexpr size_t WS_AV = WS_LBS + 1 * MiB;
constexpr size_t WS_XTG = WS_AV + al((size_t)MP * 16 * 4);
constexpr size_t WS_BCG = WS_XTG + al((size_t)NCH * 1024 * 64 * 2);
constexpr size_t WS_SLAB = WS_BCG + al((size_t)MP * 512 * 2);
constexpr size_t WS_END = WS_SLAB + (size_t)2 * 256 * 65536 * 4;
constexpr int CW_BAR = 4096, CW_QUEUE = 16384, CW_SK = 32768, CW_TMO = 8;
constexpr int CW_END = CW_SK + 8 * 256 * 64;
constexpr int CW_G2 = 163840;
constexpr int CW_RS = CW_G2 + 64 * 64 * 8;
constexpr int CW_RDY = 360448;
static_assert((size_t)CW_RS * 4 + (size_t)8 * MP * 8 <= (size_t)CW_RDY * 4 && (size_t)(CW_RDY + 8 * 64 * 32) * 4 <= ((size_t)2 << 20), "hand-off counters inside the memset region");
static_assert((size_t)CW_RS * 4 + (size_t)8 * MP * 8 <= (size_t)2 << 20, "control words inside the memset region");
typedef unsigned long long u64;
__device__ __forceinline__ float rs_to_rstd(u64 s) { return rsqrtf((float)s * (1.0f / 1048576.0f) * (1.0f / D) + EPS); }
__device__ __forceinline__ u64 ss_to_fix(float s) { return (u64)(s * 1048576.0f); }

constexpr int RING_BYTES = 131072;
constexpr int LDSCTL_OFF = 147456 - 512, LDS_BYTES = 147456;
constexpr int NWAVES = 8, NTHR = 512;

#define GAS __attribute__((address_space(1)))
#define LAS __attribute__((address_space(3)))
typedef unsigned short bf16;
typedef unsigned v4u __attribute__((ext_vector_type(4)));
typedef unsigned v2u __attribute__((ext_vector_type(2)));
typedef float f32x4 __attribute__((ext_vector_type(4)));
typedef float f32x2 __attribute__((ext_vector_type(2)));
typedef short bf16x8 __attribute__((ext_vector_type(8)));
typedef GAS unsigned gu32;
#define RLX_AGENT __ATOMIC_RELAXED, __HIP_MEMORY_SCOPE_AGENT

__device__ __forceinline__ unsigned f2bf(float f) { unsigned u = __builtin_bit_cast(unsigned, f); return (u + 0x7fffu + ((u >> 16) & 1u)) >> 16; }
typedef __bf16 bf16v2 __attribute__((ext_vector_type(2)));
__device__ __forceinline__ unsigned pk2(float lo, float hi) { const f32x2 v = {lo, hi}; return __builtin_bit_cast(unsigned, __builtin_convertvector(v, bf16v2)); }
__device__ __forceinline__ float bf2f(unsigned short b) { return __builtin_bit_cast(float, ((unsigned)b) << 16); }
__device__ __forceinline__ float bflo(unsigned w) { return __builtin_bit_cast(float, w << 16); }
__device__ __forceinline__ float bfhi(unsigned w) { return __builtin_bit_cast(float, w & 0xffff0000u); }
__device__ __forceinline__ float fsigmoid(float v) { return __builtin_amdgcn_rcpf(1.0f + __expf(-v)); }
__device__ __forceinline__ float fsilu(float v) { return v * fsigmoid(v); }
__device__ __forceinline__ f32x4 mfma16(bf16x8 a, bf16x8 b, f32x4 c) { return __builtin_amdgcn_mfma_f32_16x16x32_bf16(a, b, c, 0, 0, 0); }
__device__ __forceinline__ float wave_sum(float v) {
#pragma unroll
    for (int o = 1; o < 64; o <<= 1) v += __shfl_xor(v, o);
    return v;
}
#ifndef MK_G2_NOSPLIT
#define MK_G2_NOSPLIT 0
#endif
#ifndef MK_PREFETCH
#define MK_PREFETCH 0
#endif
__device__ __forceinline__ v2u pk4(const f32x4 v) { v2u w; w.x = pk2(v[0], v[1]); w.y = pk2(v[2], v[3]); return w; }
__device__ __forceinline__ f32x4 unpk4(const v2u w) { return (f32x4){bflo(w.x), bfhi(w.x), bflo(w.y), bfhi(w.y)}; }
#define LDS_WAIT() asm volatile("s_waitcnt lgkmcnt(0)" ::: "memory")
#define LBAR() do { asm volatile("s_waitcnt lgkmcnt(0)" ::: "memory"); __builtin_amdgcn_s_barrier(); asm volatile("" ::: "memory"); } while (0)
#define XB_TMO      128
#define XB_XCNT(j)  (256  + 64 * (j))
#define XB_XSUB(j)  (1280 + 64 * (j))
#define XB_XGEN(j)  (2304 + 64 * (j))
#define XB_TOP      3328
#define XB_TOPGEN   3392
#define XCD_BAR_WORDS 3456
#define XB_SPIN_CAP (1u << 18)

__device__ __forceinline__ unsigned xb_ld(unsigned* p)              { return __hip_atomic_load(p, __ATOMIC_RELAXED, __HIP_MEMORY_SCOPE_AGENT); }
__device__ __forceinline__ unsigned xb_add(unsigned* p, unsigned v) { return __hip_atomic_fetch_add(p, v, __ATOMIC_RELAXED, __HIP_MEMORY_SCOPE_AGENT); }
__device__ __forceinline__ unsigned xb_xcc_id() { return (unsigned)__builtin_amdgcn_s_getreg((3 << 11) | 20) & 0xFu; }
#define XB_SPIN(cond, bar) do { unsigned _sp = 0; while (cond) { __builtin_amdgcn_s_sleep(1); \
    if ((++_sp & 255u) == 0u) { if (xb_ld(&(bar)[XB_TMO])) break; if (_sp > XB_SPIN_CAP) { atomicAdd(&(bar)[XB_TMO], 1u); break; } } } } while (0)

struct XcdBarrier {
    unsigned* bar; unsigned x;
    volatile LAS unsigned* st;
};

__device__ __forceinline__ XcdBarrier xcd_barrier_post(unsigned* bar, volatile LAS unsigned* st) {
    XcdBarrier b; b.bar = bar; b.x = xb_xcc_id(); b.st = st;
    if (threadIdx.x == 0) (void)xb_add(&bar[XB_XCNT(b.x)], 1u);
    return b;
}
__device__ __forceinline__ void xcd_barrier_complete(unsigned* bar, unsigned x, unsigned& nloc, unsigned& nx) {
    const unsigned G = gridDim.x * gridDim.y * gridDim.z;
    unsigned sum, cnt, mine, sp = 0u;
    for (;;) {
        sum = 0u; cnt = 0u; mine = 0u;
#pragma unroll
        for (unsigned j = 0; j < 16; ++j) { const unsigned c = xb_ld(&bar[XB_XCNT(j)]); sum += c; cnt += (c > 0u) ? 1u : 0u; mine = (j == x) ? c : mine; }
        if (sum == G) break;
        __builtin_amdgcn_s_sleep(1);
        if ((++sp & 255u) == 0u) { if (xb_ld(&bar[XB_TMO])) break; if (sp > XB_SPIN_CAP) { atomicAdd(&bar[XB_TMO], 1u); break; } }
    }
    nloc = mine > 0u ? mine : 1u; nx = cnt > 0u ? cnt : 1u;
}

__device__ __forceinline__ void xcd_barrier(const XcdBarrier& b) {
    asm volatile("s_waitcnt vmcnt(0)" ::: "memory");
    __syncthreads();
    if (threadIdx.x == 0) {
        unsigned* bar = b.bar;
        __builtin_amdgcn_s_waitcnt(0);
        unsigned nloc = b.st[0], nx = b.st[1];
        if (nloc == 0u) { xcd_barrier_complete(bar, b.x, nloc, nx); b.st[0] = nloc; b.st[1] = nx; }
        const unsigned old = xb_add(&bar[XB_XSUB(b.x)], 1u);
        const unsigned gen = old / nloc;
        if (old + 1u == (gen + 1u) * nloc) {
            __builtin_amdgcn_fence(__ATOMIC_RELEASE, "agent");
            asm volatile("s_waitcnt vmcnt(0)" ::: "memory");
            const unsigned og = xb_add(&bar[XB_TOP], 1u);
            const unsigned tg = og / nx;
            if (og + 1u == (tg + 1u) * nx) xb_add(&bar[XB_TOPGEN], 1u);
            else XB_SPIN(xb_ld(&bar[XB_TOPGEN]) == tg, bar);
            __builtin_amdgcn_fence(__ATOMIC_ACQUIRE, "agent");
            xb_add(&bar[XB_XGEN(b.x)], 1u);
            asm volatile("s_waitcnt vmcnt(0)" ::: "memory");
        } else {
            XB_SPIN(xb_ld(&bar[XB_XGEN(b.x)]) == gen, bar);
            __builtin_amdgcn_fence(__ATOMIC_ACQUIRE, "agent");
            asm volatile("s_waitcnt vmcnt(0)" ::: "memory");
        }
    }
    __syncthreads();
}


typedef const f32x4 (&AccRef)[2][2][4][2];

struct EpiProj {
    static constexpr bool PERM = true, AFTER_DRAIN = false;
    unsigned char* ws; int layer;
    template <int T> __device__ __forceinline__ void run(AccRef acc, bf16* dst, int pitch, int row0, int col0, int ltid = 0) const {
        const float* lbs = (const float*)(ws + WS_LBS) + layer * 1024; bf16* LG = (bf16*)(ws + WS_LG); const f32x2* rope = (const f32x2*)(ws + WS_ROPE); const u64* RS = (const u64*)((const unsigned*)(ws + WS_CTL) + CW_RS) + (size_t)(2 * layer) * MP;
        f32x4 lb[2][2];
        if (T == 3) {
#pragma unroll
            for (int bj = 0; bj < 2; ++bj) { lb[bj][0] = *(const f32x4*)(lbs + col0 + bj * 128); lb[bj][1] = *(const f32x4*)(lbs + col0 + bj * 128 + 4); }
        }
#pragma unroll
        for (int ai = 0; ai < 2; ++ai)
#pragma unroll
            for (int m = 0; m < 4; ++m) {
                const int row = row0 + ai * 128 + m * 16; const float rsr = rs_to_rstd(RS[row]);
#pragma unroll
                for (int bj = 0; bj < 2; ++bj) {
                    const int col = col0 + bj * 128;
                    f32x4 v0 = acc[ai][bj][m][0] * rsr, v1 = acc[ai][bj][m][1] * rsr;
                    if (T == 1) {
#pragma unroll
                        for (int e = 0; e < 4; ++e) { v0[e] = fsilu(v0[e]); v1[e] = fsilu(v1[e]); }
                    }
                    if (T == 2) {
#pragma unroll
                        for (int e = 0; e < 4; ++e) { v0[e] = fsigmoid(v0[e]); v1[e] = fsigmoid(v1[e]); }
                    }
                    if (T == 3) {
                        f32x4 l0, l1;
#pragma unroll
                        for (int e = 0; e < 4; ++e) {
                            { const float b = lb[bj][0][e], fg = v0[e], s = fsigmoid(fg), sn = fsigmoid(-fg); l0[e] = __logf(fmaxf(b + (1.0f - b) * s, 1e-30f)); v0[e] = (1.0f - b) * sn; }
                            { const float b = lb[bj][1][e], fg = v1[e], s = fsigmoid(fg), sn = fsigmoid(-fg); l1[e] = __logf(fmaxf(b + (1.0f - b) * s, 1e-30f)); v1[e] = (1.0f - b) * sn; }
                        }
                        { v4u wl; wl.x = pk2(l0[0], l0[1]); wl.y = pk2(l0[2], l0[3]); wl.z = pk2(l1[0], l1[1]); wl.w = pk2(l1[2], l1[3]); *(v4u*)(LG + (size_t)row * 1024 + col) = wl; }
                    }
                    if (T == 4 || T == 5) {
                        const int j = (col & 63) >> 3;
                        const f32x4* rp = (const f32x4*)(rope + (size_t)row * 32 + 4 * j);
                        const f32x4 cs0 = rp[0], cs1 = rp[1];
                        const float c[4] = {cs0[0], cs0[2], cs1[0], cs1[2]}, s[4] = {cs0[1], cs0[3], cs1[1], cs1[3]};
                        const float sc = (T == 5) ? 0.125f : 1.0f;
#pragma unroll
                        for (int e = 0; e < 4; ++e) { const float a = v0[e], b = v1[e]; v0[e] = (a * c[e] - b * s[e]) * sc; v1[e] = (b * c[e] + a * s[e]) * sc; }
                    }
                    v4u w; w.x = pk2(v0[0], v0[1]); w.y = pk2(v0[2], v0[3]); w.z = pk2(v1[0], v1[1]); w.w = pk2(v1[2], v1[3]);
                    if (T == 2) *(v4u*)(dst + ((size_t)((ai * 4 + m) * 2 + bj) * 512 + ltid) * 8) = w;
                    else *(v4u*)(dst + (size_t)row * pitch + col) = w;
                }
            }
    }
    __device__ __forceinline__ void operator()(AccRef acc, const pg8::Unit& u, int wr, int wc, int fr, int fq) const {
        const int pn = u.pn, row0 = u.pm * 256 + wr * 64 + fr, cl = wc * 32 + 8 * fq;
        if (pn < 4) run<1>(acc, (bf16*)(ws + WS_ZS), 1024, row0, (pn - 0) * 256 + cl);
        else if (pn < 10) run<0>(acc, (bf16*)(ws + WS_XBC), 1536, row0, (pn - 4) * 256 + cl);
        else if (pn < 14) run<1>(acc, (bf16*)(ws + WS_HQ), 1024, row0, (pn - 10) * 256 + cl);
        else if (pn < 18) run<3>(acc, (bf16*)(ws + WS_KK), 1024, row0, (pn - 14) * 256 + cl);
        else if (pn < 22) run<0>(acc, (bf16*)(ws + WS_HV), 1024, row0, (pn - 18) * 256 + cl);
        else if (pn < 26) run<1>(acc, (bf16*)(ws + WS_HG), 1024, row0, (pn - 22) * 256 + cl);
        else if (pn < 28) run<4>(acc, (bf16*)(ws + WS_RQ), 512, row0, (pn - 26) * 256 + cl);
        else if (pn < 30) run<5>(acc, (bf16*)(ws + WS_RK), 512, row0, (pn - 28) * 256 + cl);
        else if (pn < 34) run<0>(acc, (bf16*)(ws + WS_RV), 1024, row0, (pn - 30) * 256 + cl);
        else if (pn < 38) run<1>(acc, (bf16*)(ws + WS_RG), 1024, row0, (pn - 34) * 256 + cl);
        else run<2>(acc, (bf16*)(ws + WS_GT) + (size_t)(u.pm * 24 + (pn - 38)) * 65536, 6144, row0, (pn - 38) * 256 + cl, (wr * 4 + wc) * 64 + fr + 16 * fq);
    }
};

template <int MODE = 0  > struct EpiBranchT {
    static constexpr bool PERM = true, AFTER_DRAIN = false;
    bf16* TMP; bf16* MIX; const bf16* GT; float* slabs; unsigned* cnt; unsigned* tmo; unsigned* rdy = nullptr;
    __device__ __forceinline__ void operator()(AccRef acc, const pg8::Unit& u, int wr, int wc, int fr, int fq) const {
        const int pc = u.pc; int row0 = u.pm * 256 + wr * 64 + fr; const int col0 = u.pn * 256 + wc * 32 + 8 * fq; asm volatile("" : "+v"(row0));
        int ltid = (wr * 4 + wc) * 64 + fr + 16 * fq; asm volatile("" : "+v"(ltid));
        if (u.kind == 3) {
            const int lane = fr + 16 * fq, wid = wr * 4 + wc; int tid = wid * 64 + lane; asm volatile("" : "+v"(tid));
            const int lt = u.slab;
            v4u vp[2][4][2];
#pragma unroll
            for (int ai = 0; ai < 2; ++ai) {
                v4u gq[4][2];
#pragma unroll
                for (int m = 0; m < 4; ++m)
#pragma unroll
                    for (int bj = 0; bj < 2; ++bj) gq[m][bj] = *(const v4u*)(GT + ((size_t)(u.pm * 24 + pc * 8 + u.pn) * 16 + (ai * 4 + m) * 2 + bj) * 4096 + (size_t)ltid * 8);
                __builtin_amdgcn_sched_barrier(0);
#pragma unroll
                for (int m = 0; m < 4; ++m)
#pragma unroll
                    for (int bj = 0; bj < 2; ++bj) { const v4u g = gq[m][bj]; const f32x4 a = acc[ai][bj][m][0] * (f32x4){bflo(g.x), bfhi(g.x), bflo(g.y), bfhi(g.y)}, b = acc[ai][bj][m][1] * (f32x4){bflo(g.z), bfhi(g.z), bflo(g.w), bfhi(g.w)};
                        v4u w; w.x = pk2(a[0], a[1]); w.y = pk2(a[2], a[3]); w.z = pk2(b[0], b[1]); w.w = pk2(b[2], b[3]); vp[ai][m][bj] = w; }
                __builtin_amdgcn_sched_barrier(0);
            }
            if (pc < 2) {
                __amdgpu_buffer_rsrc_t rsrc = __builtin_amdgcn_make_buffer_rsrc(slabs + (size_t)(lt * 3 + pc) * 65536, 0, 65536 * 4, 0x00020000);
#pragma unroll
                for (int ai = 0; ai < 2; ++ai)
#pragma unroll
                    for (int m = 0; m < 4; ++m)
#pragma unroll
                        for (int bj = 0; bj < 2; ++bj) { const int j = (ai * 4 + m) * 2 + bj; __builtin_amdgcn_raw_buffer_store_b128(vp[ai][m][bj], rsrc, (j * 512 + tid) * 16, 0, 16); }
                asm volatile("s_waitcnt vmcnt(0)" ::: "memory");
                if (lane == 0) __hip_atomic_fetch_add(cnt + 64 * lt, 1u, __ATOMIC_RELAXED, __HIP_MEMORY_SCOPE_AGENT);
            } else {
                unsigned sp = 0;
                while ((unsigned)__builtin_amdgcn_readfirstlane(__hip_atomic_load(cnt + 64 * lt, __ATOMIC_RELAXED, __HIP_MEMORY_SCOPE_AGENT)) < 16u) {
                    __builtin_amdgcn_s_sleep(2);
                    if ((++sp & 1023u) == 0u) { if (__hip_atomic_load(tmo, __ATOMIC_RELAXED, __HIP_MEMORY_SCOPE_AGENT) != 0u) break; if (sp > (1u << 22)) { if (lane == 0) __hip_atomic_store(tmo, 1u, __ATOMIC_RELAXED, __HIP_MEMORY_SCOPE_AGENT); break; } }
                }
                __builtin_amdgcn_fence(__ATOMIC_ACQUIRE, "agent");
                const v4u* s1 = (const v4u*)(slabs + (size_t)(lt * 3 + 0) * 65536) + tid; const v4u* s2 = (const v4u*)(slabs + (size_t)(lt * 3 + 1) * 65536) + tid;
#pragma unroll
                for (int ai = 0; ai < 2; ++ai) {
                    v4u q1[4][2], q2[4][2];
#pragma unroll
                    for (int m = 0; m < 4; ++m)
#pragma unroll
                        for (int bj = 0; bj < 2; ++bj) { const int j = (ai * 4 + m) * 2 + bj; q1[m][bj] = s1[j * 512]; q2[m][bj] = s2[j * 512]; }
                    __builtin_amdgcn_sched_barrier(0);
#pragma unroll
                    for (int m = 0; m < 4; ++m)
#pragma unroll
                        for (int bj = 0; bj < 2; ++bj) { const v4u a = vp[ai][m][bj], b = q1[m][bj], c = q2[m][bj]; v4u w;
                            w.x = pk2(bflo(a.x) + bflo(b.x) + bflo(c.x), bfhi(a.x) + bfhi(b.x) + bfhi(c.x)); w.y = pk2(bflo(a.y) + bflo(b.y) + bflo(c.y), bfhi(a.y) + bfhi(b.y) + bfhi(c.y));
                            w.z = pk2(bflo(a.z) + bflo(b.z) + bflo(c.z), bfhi(a.z) + bfhi(b.z) + bfhi(c.z)); w.w = pk2(bflo(a.w) + bflo(b.w) + bflo(c.w), bfhi(a.w) + bfhi(b.w) + bfhi(c.w));
                            if (rdy) __builtin_amdgcn_raw_buffer_store_b128(__builtin_bit_cast(pg8::u32x4, w), __builtin_amdgcn_make_buffer_rsrc(MIX, 0, MP * D * 2, 0x00020000), ((row0 + ai * 128 + m * 16) * D + col0 + bj * 128) * 2, 0, 16);
                            else *(v4u*)(MIX + (size_t)(row0 + ai * 128 + m * 16) * D + col0 + bj * 128) = w; }
                    __builtin_amdgcn_sched_barrier(0);
                }
                if (rdy) { asm volatile("s_waitcnt vmcnt(0)" ::: "memory"); if (lane == 0) __hip_atomic_fetch_add(rdy + 32 * u.pm, 1u, __ATOMIC_RELAXED, __HIP_MEMORY_SCOPE_AGENT); }
            }
            return;
        }
#pragma unroll
        for (int ai = 0; ai < 2; ++ai) {
            v4u gq[4][2];
#pragma unroll
            for (int m = 0; m < 4; ++m)
#pragma unroll
                for (int bj = 0; bj < 2; ++bj) gq[m][bj] = MODE == 2 ? (v4u){0x3f803f80u, 0x3f803f80u, 0x3f803f80u, 0x3f803f80u} : *(const v4u*)(GT + ((size_t)(u.pm * 24 + pc * 8 + u.pn) * 16 + (ai * 4 + m) * 2 + bj) * 4096 + (size_t)ltid * 8);
            v4u tq[4][2];
            if (pc > 0 && MODE != 1) {
#pragma unroll
                for (int m = 0; m < 4; ++m)
#pragma unroll
                    for (int bj = 0; bj < 2; ++bj) tq[m][bj] = *(const v4u*)(TMP + ((size_t)(u.pm * 8 + u.pn) * 16 + (ai * 4 + m) * 2 + bj) * 4096 + (size_t)ltid * 8);
            }
            __builtin_amdgcn_sched_barrier(0);
#pragma unroll
            for (int m = 0; m < 4; ++m) {
                const int row = row0 + ai * 128 + m * 16;
#pragma unroll
                for (int bj = 0; bj < 2; ++bj) {
                    const int col = col0 + bj * 128;
                    const v4u g = gq[m][bj];
                    f32x4 v0 = acc[ai][bj][m][0], v1 = acc[ai][bj][m][1];
                    v0[0] *= bflo(g.x); v0[1] *= bfhi(g.x); v0[2] *= bflo(g.y); v0[3] *= bfhi(g.y);
                    v1[0] *= bflo(g.z); v1[1] *= bfhi(g.z); v1[2] *= bflo(g.w); v1[3] *= bfhi(g.w);
                    bf16* tp = TMP + ((size_t)(u.pm * 8 + u.pn) * 16 + (ai * 4 + m) * 2 + bj) * 4096 + (size_t)ltid * 8;
                    if (pc > 0 && MODE != 1) { const v4u t = tq[m][bj]; v0[0] += bflo(t.x); v0[1] += bfhi(t.x); v0[2] += bflo(t.y); v0[3] += bfhi(t.y); v1[0] += bflo(t.z); v1[1] += bfhi(t.z); v1[2] += bflo(t.w); v1[3] += bfhi(t.w); }
                    if (pc < 2 && MODE != 1) { v4u w; w.x = pk2(v0[0], v0[1]); w.y = pk2(v0[2], v0[3]); w.z = pk2(v1[0], v1[1]); w.w = pk2(v1[2], v1[3]); *(v4u*)tp = w; }
                    else { v4u w; w.x = pk2(v0[0], v0[1]); w.y = pk2(v0[2], v0[3]); w.z = pk2(v1[0], v1[1]); w.w = pk2(v1[2], v1[3]);
                        if (rdy) __builtin_amdgcn_raw_buffer_store_b128(__builtin_bit_cast(pg8::u32x4, w), __builtin_amdgcn_make_buffer_rsrc(MIX, 0, MP * D * 2, 0x00020000), (row * D + col) * 2, 0, 16); else *(v4u*)(MIX + (size_t)row * D + col) = w; }
                }
            }
            __builtin_amdgcn_sched_barrier(0);
        }
        if (rdy && pc == 2) { asm volatile("s_waitcnt vmcnt(0)" ::: "memory"); if (fr + 16 * fq == 0) __hip_atomic_fetch_add(rdy + 32 * u.pm, 1u, __ATOMIC_RELAXED, __HIP_MEMORY_SCOPE_AGENT); }
    }
};
typedef EpiBranchT<0> EpiBranch;

struct EpiResid {
    static constexpr bool PERM = true, AFTER_DRAIN = false;
    bf16* X; float* slabs; unsigned* cnt; unsigned* tmo; u64* RSN; unsigned* rdy = nullptr;
    __device__ __forceinline__ void operator()(AccRef acc, const pg8::Unit& u, int wr, int wc, int fr, int fq) const {
        const int lane = fr + 16 * fq, wid = wr * 4 + wc; int tid = wid * 64 + lane; asm volatile("" : "+v"(tid));
        if (u.kind == 1) {
            __amdgpu_buffer_rsrc_t rsrc = __builtin_amdgcn_make_buffer_rsrc(slabs + (size_t)u.slab * 65536, 0, 65536 * 4, 0x00020000);
#pragma unroll
            for (int ai = 0; ai < 2; ++ai)
#pragma unroll
                for (int bj = 0; bj < 2; ++bj)
#pragma unroll
                    for (int m = 0; m < 4; ++m)
#pragma unroll
                        for (int n = 0; n < 2; ++n) { const int j = ((ai * 2 + bj) * 4 + m) * 2 + n; __builtin_amdgcn_raw_buffer_store_b128(__builtin_bit_cast(pg8::u32x4, acc[ai][bj][m][n]), rsrc, (j * 512 + tid) * 16, 0, 16); }
            asm volatile("s_waitcnt vmcnt(0)" ::: "memory");
            if (lane == 0) __hip_atomic_fetch_add(cnt + 64 * u.slab, 1u, __ATOMIC_RELAXED, __HIP_MEMORY_SCOPE_AGENT);
            return;
        }
        const f32x4* sl = (const f32x4*)(slabs + (size_t)u.slab * 65536);
        if (u.kind == 2) {
            unsigned sp = 0;
            while ((unsigned)__builtin_amdgcn_readfirstlane(__hip_atomic_load(cnt + 64 * u.slab, __ATOMIC_RELAXED, __HIP_MEMORY_SCOPE_AGENT)) < 8u) {
                __builtin_amdgcn_s_sleep(2);
                if ((++sp & 1023u) == 0u) { if (__hip_atomic_load(tmo, __ATOMIC_RELAXED, __HIP_MEMORY_SCOPE_AGENT) != 0u) break; if (sp > (1u << 22)) { if (lane == 0) __hip_atomic_store(tmo, 1u, __ATOMIC_RELAXED, __HIP_MEMORY_SCOPE_AGENT); break; } }
            }
            __builtin_amdgcn_fence(__ATOMIC_ACQUIRE, "agent");
        }
        int row0 = u.pm * 256 + wr * 64 + fr; const int col0 = u.pn * 256 + wc * 32 + 8 * fq; asm volatile("" : "+v"(row0));
        __amdgpu_buffer_rsrc_t xr = __builtin_amdgcn_make_buffer_rsrc(X, 0, MP * D * 2, 0x00020000);
#pragma unroll
        for (int ai = 0; ai < 2; ++ai) {
            v4u xq[4][2];
            float ssq[4] = {0.f, 0.f, 0.f, 0.f};
#pragma unroll
            for (int m = 0; m < 4; ++m)
#pragma unroll
                for (int bj = 0; bj < 2; ++bj) xq[m][bj] = *(const v4u*)(X + (size_t)(row0 + ai * 128 + m * 16) * D + col0 + bj * 128);
            __builtin_amdgcn_sched_barrier(0);
#pragma unroll
            for (int m = 0; m < 4; ++m)
#pragma unroll
                for (int bj = 0; bj < 2; ++bj) { const v4u x = xq[m][bj]; f32x4 a = acc[ai][bj][m][0] + (f32x4){bflo(x.x), bfhi(x.x), bflo(x.y), bfhi(x.y)}, b = acc[ai][bj][m][1] + (f32x4){bflo(x.z), bfhi(x.z), bflo(x.w), bfhi(x.w)};
                    if (u.kind == 2) { const int j0 = ((ai * 2 + bj) * 4 + m) * 2; a += sl[j0 * 512 + tid]; b += sl[(j0 + 1) * 512 + tid]; }
                    v4u w; w.x = pk2(a[0], a[1]); w.y = pk2(a[2], a[3]); w.z = pk2(b[0], b[1]); w.w = pk2(b[2], b[3]); if (rdy) __builtin_amdgcn_raw_buffer_store_b128(__builtin_bit_cast(pg8::u32x4, w), xr, ((row0 + ai * 128 + m * 16) * D + col0 + bj * 128) * 2, 0, 16); else *(v4u*)(X + (size_t)(row0 + ai * 128 + m * 16) * D + col0 + bj * 128) = w;
                    ssq[m] += ((a[0] * a[0] + a[1] * a[1]) + (a[2] * a[2] + a[3] * a[3])) + ((b[0] * b[0] + b[1] * b[1]) + (b[2] * b[2] + b[3] * b[3])); }
            if (RSN) {
#pragma unroll
                for (int m = 0; m < 4; ++m) { float s = ssq[m]; s += __shfl_xor(s, 16); s += __shfl_xor(s, 32); if (fq == 0) __hip_atomic_fetch_add(RSN + row0 + ai * 128 + m * 16, ss_to_fix(s), __ATOMIC_RELAXED, __HIP_MEMORY_SCOPE_AGENT); } }
            __builtin_amdgcn_sched_barrier(0);
        }
        if (rdy) { asm volatile("s_waitcnt vmcnt(0)" ::: "memory");
            if (lane == 0) __hip_atomic_fetch_add(rdy + 32 * u.pm, 1u, __ATOMIC_RELAXED, __HIP_MEMORY_SCOPE_AGENT); }
    }
};

struct EpiSwiglu {
    static constexpr bool PERM = true, AFTER_DRAIN = false;
    bf16* HID; float* slabs; unsigned* cnt; unsigned* tmo; const u64* RS;
    __device__ __forceinline__ void operator()(AccRef acc, const pg8::Unit& u, int wr, int wc, int fr, int fq) const {
        const int lane = fr + 16 * fq, wid = wr * 4 + wc; int tid = wid * 64 + lane; asm volatile("" : "+v"(tid));
        if (u.kind == 1) {
            __amdgpu_buffer_rsrc_t rsrc = __builtin_amdgcn_make_buffer_rsrc(slabs + (size_t)u.slab * 65536, 0, 65536 * 4, 0x00020000);
#pragma unroll
            for (int ai = 0; ai < 2; ++ai)
#pragma unroll
                for (int bj = 0; bj < 2; ++bj)
#pragma unroll
                    for (int m = 0; m < 4; ++m)
#pragma unroll
                        for (int n = 0; n < 2; ++n) { const int j = ((ai * 2 + bj) * 4 + m) * 2 + n; __builtin_amdgcn_raw_buffer_store_b128(__builtin_bit_cast(pg8::u32x4, acc[ai][bj][m][n]), rsrc, (j * 512 + tid) * 16, 0, 16); }
            asm volatile("s_waitcnt vmcnt(0)" ::: "memory");
            if (lane == 0) __hip_atomic_fetch_add(cnt + 64 * u.slab, 1u, __ATOMIC_RELAXED, __HIP_MEMORY_SCOPE_AGENT);
            return;
        }
        const f32x4* sl = (const f32x4*)(slabs + (size_t)u.slab * 65536);
        if (u.kind == 2) {
            unsigned sp = 0;
            while ((unsigned)__builtin_amdgcn_readfirstlane(__hip_atomic_load(cnt + 64 * u.slab, __ATOMIC_RELAXED, __HIP_MEMORY_SCOPE_AGENT)) < 8u) {
                __builtin_amdgcn_s_sleep(2);
                if ((++sp & 1023u) == 0u) { if (__hip_atomic_load(tmo, __ATOMIC_RELAXED, __HIP_MEMORY_SCOPE_AGENT) != 0u) break; if (sp > (1u << 22)) { if (lane == 0) __hip_atomic_store(tmo, 1u, __ATOMIC_RELAXED, __HIP_MEMORY_SCOPE_AGENT); break; } }
            }
            __builtin_amdgcn_fence(__ATOMIC_ACQUIRE, "agent");
        }
        int row0 = u.pm * 256 + wr * 64 + fr; const int col0 = u.pn * 128 + wc * 32 + 8 * fq; asm volatile("" : "+v"(row0));
#pragma unroll
        for (int ai = 0; ai < 2; ++ai)
#pragma unroll
            for (int m = 0; m < 4; ++m) {
                const int row = row0 + ai * 128 + m * 16;
                f32x4 g0 = acc[ai][0][m][0], g1 = acc[ai][0][m][1], u0 = acc[ai][1][m][0], u1 = acc[ai][1][m][1];
                if (u.kind == 2) { const int jg = ((ai * 2 + 0) * 4 + m) * 2, ju = ((ai * 2 + 1) * 4 + m) * 2; g0 += sl[jg * 512 + tid]; g1 += sl[(jg + 1) * 512 + tid]; u0 += sl[ju * 512 + tid]; u1 += sl[(ju + 1) * 512 + tid]; }
                { const float rsr = rs_to_rstd(RS[row]); g0 *= rsr; g1 *= rsr; u0 *= rsr; u1 *= rsr; }
#pragma unroll
                for (int e = 0; e < 4; ++e) { g0[e] = fsilu(g0[e]) * u0[e]; g1[e] = fsilu(g1[e]) * u1[e]; }
                v4u w; w.x = pk2(g0[0], g0[1]); w.y = pk2(g0[2], g0[3]); w.z = pk2(g1[0], g1[1]); w.w = pk2(g1[2], g1[3]);
                *(v4u*)(HID + (size_t)row * FFN + col0) = w;
            }
    }
};

struct BranchOrder {
    pg8::StaticOrder S; int R, rem, dep;
    __device__ __forceinline__ void init(int M, int N, int G, int c, int K) { S.init(M, N, G, c, K); R = S.nwg / G; rem = S.nwg - R * G; if (3 * rem > G || MK_G2_NOSPLIT) { R = (S.nwg + G - 1) / G; rem = 0; }
        dep = (G == 256 && S.nM == 37 && S.nN == 8 && pg8::WGM == 8 && R == 1 && rem == 40) ? 1 : 0; }
    __device__ __forceinline__ bool next(int i, pg8::Unit& u) const {
        const int t = i / 3, pc = i - 3 * t;
        if (dep) {
            const int x = S.c & 7, j = S.c >> 3, q = x == 6 ? 96 + j : 32 * (x - 3) + j;
            const bool full = t < 1, part = (i == 3) && ((x >= 3 && x <= 5) || (x == 6 && j < 24));
            if (!full && !part) return false;
            const int lt = q / 3;
            pg8::Unit v; S.tile_seq(full ? 32 * x + j : 256 + lt, v); v.pc = full ? pc : q - 3 * lt; v.k0 = 0; v.nt = S.ntk; v.kind = full ? 0 : 3; v.slab = full ? 0 : lt;
            u = v; return true;
        }
        if (t < R) { if (!S.next(t, u)) return false; u.pc = pc; return true; }
        if (i == 3 * R && S.c < 3 * rem) { const int lt = S.c / 3; S.tile(R * S.G + lt, u); u.pc = S.c - 3 * lt; u.k0 = 0; u.nt = S.ntk; u.kind = 3; u.slab = lt; return true; }
        return false;
    }
    __device__ __forceinline__ void a_ready(const pg8::Unit&) const {}
    __device__ __forceinline__ void done(const pg8::Unit&) const {}
};

struct EpiNull {
    static constexpr bool PERM = true, AFTER_DRAIN = false;
    float* sink;
    __device__ __forceinline__ void operator()(AccRef acc, const pg8::Unit& u, int wr, int wc, int fr, int fq) const {
        float s = 0.f;
#pragma unroll
        for (int ai = 0; ai < 2; ++ai)
#pragma unroll
            for (int bj = 0; bj < 2; ++bj)
#pragma unroll
                for (int m = 0; m < 4; ++m)
#pragma unroll
                    for (int n = 0; n < 2; ++n) s += acc[ai][bj][m][n][0] + acc[ai][bj][m][n][3];
        if (s == 12345.678f) sink[u.pm + wr + wc + fr + fq] = s;
    }
};

__device__ __forceinline__ void panel_wait(const unsigned* rdy, unsigned* tmo, unsigned long long& seen, int pm) {
    const unsigned long long bit = 1ull << pm;
    if (seen & bit) return;
    if (__builtin_amdgcn_readfirstlane(threadIdx.x >> 6) == 0) {
        const unsigned* p = rdy + 32 * pm; unsigned sp = 0; bool waited = false;
        while ((unsigned)__builtin_amdgcn_readfirstlane(__hip_atomic_load(p, __ATOMIC_RELAXED, __HIP_MEMORY_SCOPE_AGENT)) < 64u) {
            waited = true; __builtin_amdgcn_s_sleep(2);
            if ((++sp & 1023u) == 0u) { if (__hip_atomic_load(tmo, __ATOMIC_RELAXED, __HIP_MEMORY_SCOPE_AGENT) != 0u) break; if (sp > (1u << 22)) { __hip_atomic_store(tmo, 1u, __ATOMIC_RELAXED, __HIP_MEMORY_SCOPE_AGENT); break; } }
        }
        if (seen == 0ull || waited) __builtin_amdgcn_fence(__ATOMIC_ACQUIRE, "agent");
    }
    __builtin_amdgcn_s_barrier();
    seen |= bit;
}
struct G3Order {
    pg8::StaticOrder S; int dep; const unsigned* rdy; unsigned* tmo; mutable unsigned long long seen;
    __device__ __forceinline__ void init(int M, int N, int G, int c, int K, const unsigned* rdy_, unsigned* tmo_) { S.init(M, N, G, c, K); dep = (G == 256 && S.nM == 37 && S.nN == 8 && pg8::WGM == 8) ? 1 : 0; rdy = rdy_; tmo = tmo_; seen = 0ull; }
    __device__ __forceinline__ bool next(int i, pg8::Unit& u) const {
        if (!dep) return S.next(i, u);
        const int x = S.c & 7, j = S.c >> 3;
        if (!(i == 0 || (i == 1 && (x == 7 || (x == 6 && j >= 24))))) return false;
        pg8::Unit t; S.tile_seq(i == 0 ? 32 * x + j : 256 + (x == 7 ? j : 8 + j), t); t.k0 = 0; t.nt = S.ntk; t.kind = 0; t.slab = 0;
        u = t; return true;
    }
    __device__ __forceinline__ void a_ready(const pg8::Unit& u) const { if (dep && rdy) panel_wait(rdy, tmo, seen, u.pm); }
    __device__ __forceinline__ void done(const pg8::Unit&) const {}
};
struct GuOrder {
    pg8::StaticOrder S; int dep; const unsigned* rdy; unsigned* tmo; mutable unsigned long long seen;
    __device__ __forceinline__ void init(int M, int N, int G, int c, int K, const unsigned* rdy_, unsigned* tmo_) { S.init(M, N, G, c, K); dep = (G == 256 && S.nM == 37 && S.nN == 44 && pg8::WGM == 8) ? 1 : 0; rdy = rdy_; tmo = tmo_; seen = 0ull; }
    __device__ __forceinline__ bool next(int i, pg8::Unit& u) const {
        if (!dep) return S.next(i, u);
        const int x = S.c & 7, j = S.c >> 3, lp = 32 * i + j, st = x < 3 ? 224 * x : 668 + 192 * (x - 3), nx = x < 2 ? 224 : (x == 2 ? 220 : 192);
        if (lp >= nx) return false;
        pg8::Unit t; S.tile_seq(st + lp, t); t.k0 = 0; t.nt = S.ntk; t.kind = 0; t.slab = 0;
        u = t; return true;
    }
    __device__ __forceinline__ void a_ready(const pg8::Unit& u) const { if (dep) panel_wait(rdy, tmo, seen, u.pm); }
    __device__ __forceinline__ void done(const pg8::Unit&) const {}
};

struct Args { const float* in[24]; float* out; unsigned char* ws; int l_lo, l_hi, ph_lo, ph_hi, do_pro, do_fin, use_bar, pad; };
enum { I_XP = 0, I_XS, I_SCONV, I_SSSM, I_SHG, I_SRET, I_META, I_NMIX, I_WIN, I_CONVW, I_CONVB, I_DTB, I_ALOG, I_DSKIP, I_SSDN, I_HGLOW, I_HGN, I_WBR, I_WOUT, I_NFFN, I_WG, I_WU, I_WD, I_NFIN };

typedef const __attribute__((address_space(4))) Args* ArgsP;
#define AREF const __attribute__((address_space(4))) Args&
struct Ctx {
    LAS unsigned char* lds; int tid, lane, wave, vcu, G;
    ArgsP a; unsigned char* ws;
};

template <class F> __device__ __forceinline__ void tr_item(const float* W, int ldw, bf16* WT, int K, int k0, int n0, LAS float* scr, int lane, F srccol, const float* kscale = nullptr) {
    const int sc = srccol(n0 + (lane & 31));
#pragma unroll
    for (int i = 0; i < 32; ++i) { const int kk = 2 * i + (lane >> 5); scr[kk * 33 + (lane & 31)] = __builtin_nontemporal_load(W + (size_t)(k0 + kk) * ldw + sc); }
    LDS_WAIT(); asm volatile("" ::: "memory");
    const int c = lane & 7;
    f32x4 g0 = (f32x4){1.f, 1.f, 1.f, 1.f}, g1 = g0;
    if (kscale) { g0 = *(const f32x4*)(kscale + k0 + 8 * c); g1 = *(const f32x4*)(kscale + k0 + 8 * c + 4); }
#pragma unroll
    for (int j = 0; j < 4; ++j) { const int n = (lane >> 3) + 8 * j; const LAS float* s = scr + (8 * c) * 33 + n;
        v4u o; o.x = pk2(s[0 * 33] * g0[0], s[1 * 33] * g0[1]); o.y = pk2(s[2 * 33] * g0[2], s[3 * 33] * g0[3]); o.z = pk2(s[4 * 33] * g1[0], s[5 * 33] * g1[1]); o.w = pk2(s[6 * 33] * g1[2], s[7 * 33] * g1[3]);
        *(v4u*)(WT + (size_t)(n0 + n) * K + k0 + 8 * c) = o; }
    LDS_WAIT(); asm volatile("" ::: "memory");
}
__device__ __forceinline__ int win_src(int n) {
    if (n >= 6656 && n < 7680) { const int p = n & 63, j = p >> 3, nn = (p >> 2) & 1, e = p & 3; n = (n & ~63) + 32 * nn + 4 * j + e; }
    return n < 2560 ? n : n + 16;
}
__device__ __forceinline__ int ret_dim(int p) { return 32 * ((p >> 2) & 1) + 4 * (p >> 3) + (p & 3); }

__device__ __forceinline__ void p0_prologue(const Ctx& C) {
    AREF A = *C.a; unsigned char* ws = C.ws;
    LAS float* scr = (LAS float*)(C.lds + C.wave * 16384);
    const int gw = C.vcu * NWAVES + C.wave, NGW = C.G * NWAVES;
    constexpr int I_IN = 32 * 496, I_BR = 3 * 16 * 64, I_OUT = 32 * 64, I_GU = 32 * 352, I_DN = 88 * 64, I_L = I_IN + I_BR + I_OUT + I_GU + I_DN;
    for (int it = gw; it < NL * I_L; it += NGW) {
        const int l = it / I_L; int r = it - l * I_L; unsigned char* lw = ws + WS_W + (size_t)l * LW_SIZE;
        if (r < I_IN) { const int kb = r / 496, nb = r - kb * 496; tr_item(A.in[I_WIN] + (size_t)l * D * INCOLS, INCOLS, (bf16*)(lw + LW_IN), D, 64 * kb, 32 * nb, scr, C.lane, [](int n) { return win_src(n); }, A.in[I_NMIX] + (size_t)l * D); continue; } r -= I_IN;
        if (r < I_BR) { const int c = r / 1024, rr = r - c * 1024, kb = rr / 64, nb = rr - kb * 64;
            tr_item(A.in[I_WBR] + ((size_t)l * 3 + c) * 1024 * D, D, (bf16*)(lw + LW_BR) + (size_t)c * D * 1024, 1024, 64 * kb, 32 * nb, scr, C.lane, [](int n) { return n; }); continue; } r -= I_BR;
        if (r < I_OUT) { const int kb = r / 64, nb = r - kb * 64; tr_item(A.in[I_WOUT] + (size_t)l * D * D, D, (bf16*)(lw + LW_OUT), D, 64 * kb, 32 * nb, scr, C.lane, [](int n) { return n; }); continue; } r -= I_OUT;
        if (r < I_GU) { const int kb = r / 352, nb = r - kb * 352, n0 = 32 * nb, t = n0 >> 8, w = n0 & 255; const float* src = (w < 128 ? A.in[I_WG] : A.in[I_WU]) + (size_t)l * D * FFN; const int sbase = 128 * t + (w & 127) - n0;
            tr_item(src, FFN, (bf16*)(lw + LW_GU), D, 64 * kb, n0, scr, C.lane, [sbase](int n) { return n + sbase; }, A.in[I_NFFN] + (size_t)l * D); continue; } r -= I_GU;
        { const int kb = r / 64, nb = r - kb * 64; tr_item(A.in[I_WD] + (size_t)l * FFN * D, D, (bf16*)(lw + LW_DN), FFN, 64 * kb, 32 * nb, scr, C.lane, [](int n) { return n; }); }
    }
    const int gt = C.vcu * NTHR + C.tid, NGT = C.G * NTHR;
    for (int i = gt; i < NL * 16 * D; i += NGT) { const int l = i / (16 * D), r = i - l * 16 * D, h = r / D, k = r - h * D;
        ((bf16*)(ws + WS_W + (size_t)l * LW_SIZE + LW_DT))[r] = (bf16)f2bf(A.in[I_NMIX][l * D + k] * A.in[I_WIN][((size_t)l * D + k) * INCOLS + 2560 + h]); }
    for (int m = gw; m < MP; m += NGW) {
        const float* src = nullptr;
        if (m >= NNULL && m < ROW_P0) src = A.in[I_META] + (size_t)(m - NNULL) * D;
        else if (m >= ROW_P0 && m < ROW_S0) src = A.in[I_XP] + (size_t)(m - ROW_P0) * D;
        else if (m >= ROW_S0 && m < MR) src = A.in[I_XS] + (size_t)(m - ROW_S0) * D;
        v2u* dst = (v2u*)(ws + WS_X + (size_t)m * D * 2) + C.lane; float s = 0.f;
#pragma unroll
        for (int j = 0; j < 8; ++j) { const f32x4 v = src ? ((const f32x4*)src)[C.lane + 64 * j] : (f32x4){0.f, 0.f, 0.f, 0.f}; dst[64 * j] = pk4(v); s += (v[0] * v[0] + v[1] * v[1]) + (v[2] * v[2] + v[3] * v[3]); }
        s = wave_sum(s); if (C.lane == 0) ((u64*)((unsigned*)(ws + WS_CTL) + CW_RS))[m] = ss_to_fix(s);
    }
    for (int i = gt; i < MP * 32; i += NGT) {
        const int row = i >> 5, fi = i & 31;
        const int pos = row < ROW_S0 ? row - ROW_P0 : (row < MR ? 1024 + ((row - ROW_S0) & 63) : 0);
        const double inv = exp(-(double)fi * (9.210340371976184 / 32.0));
        const double ang = (double)pos * inv, n = rint(ang * 0.15915494309189535), r = fma(-n, 6.283185307179586, ang) - n * 2.4492935982947064e-16;
        const double r2 = r * r; double s = 0.0, c = 0.0;
#pragma unroll
        for (int k = 14; k >= 1; --k) { s = (s + 1.0) * (-r2 / (double)((2 * k) * (2 * k + 1))); c = (c + 1.0) * (-r2 / (double)((2 * k - 1) * (2 * k))); }
        ((f32x2*)(ws + WS_ROPE))[i] = (f32x2){(float)(c + 1.0), (float)((s + 1.0) * r)};
    }
    for (int i = gt; i < 1024; i += NGT) {
        const float* hl = A.in[I_HGLOW]; const float v0 = hl[i], v1 = hl[1024 + i], v2 = hl[2048 + i], v3 = hl[3072 + i], mx = fmaxf(fmaxf(v0, v1), fmaxf(v2, v3));
        const float e0 = expf(v0 - mx), e1 = expf(v1 - mx), e2 = expf(v2 - mx), e3 = expf(v3 - mx), inv = 1.0f / (e0 + e1 + e2 + e3);
        float* lb = (float*)(ws + WS_LBS); lb[i] = 0.f; lb[1024 + i] = e1 * inv; lb[2048 + i] = (e1 + e2) * inv; lb[3072 + i] = (e1 + e2 + e3) * inv;
    }
    for (int i = gt; i < 3 * (MP - MR) * 1024 / 8; i += NGT) { const int c = i / ((MP - MR) * 128), r = i - c * (MP - MR) * 128;
        ((v4u*)(ws + WS_BR + ((size_t)c * MP + MR) * 1024 * 2))[r] = (v4u){0u, 0u, 0u, 0u}; }
}

__device__ __forceinline__ float softplusf(float v) { return v > 20.0f ? v : log1pf(expf(v)); }
__device__ __forceinline__ void dt_rows(const Ctx& C, int l) {
    AREF A = *C.a; unsigned char* ws = C.ws; const int tid = C.tid, lane = C.lane, w = C.wave, l15 = lane & 15, l4 = lane >> 4;
    LAS float* DTP = (LAS float*)C.lds;
    const int rbase = 37 * C.vcu; const bf16* X = (const bf16*)(ws + WS_X); const bf16* WDT = (const bf16*)(ws + WS_W + (size_t)l * LW_SIZE + LW_DT);
    f32x4 acc[3];
#pragma unroll
    for (int rb = 0; rb < 3; ++rb) acc[rb] = (f32x4){0.f, 0.f, 0.f, 0.f};
#pragma unroll 2
    for (int ks = 0; ks < 8; ++ks) {
        const int ko = 256 * w + 32 * ks + 8 * l4;
        const bf16x8 bf = *(const bf16x8*)(WDT + (size_t)l15 * D + ko);
#pragma unroll
        for (int rb = 0; rb < 3; ++rb) { int row = rbase + 16 * rb + l15; row = row < MP ? row : MP - 1; acc[rb] = mfma16(*(const bf16x8*)(X + (size_t)row * D + ko), bf, acc[rb]); }
    }
#pragma unroll
    for (int rb = 0; rb < 3; ++rb)
#pragma unroll
        for (int e = 0; e < 4; ++e) DTP[(w * 48 + 16 * rb + 4 * l4 + e) * 16 + l15] = acc[rb][e];
    LBAR();
    const u64* RS = (const u64*)((const unsigned*)(ws + WS_CTL) + CW_RS) + (size_t)(2 * l) * MP;
    for (int i = tid; i < 37 * 16; i += NTHR) { const int r = i >> 4, hd = i & 15, m = rbase + r;
        if (m < MR) { float raw = 0.f;
#pragma unroll
            for (int ww = 0; ww < 8; ++ww) raw += DTP[(ww * 48 + r) * 16 + hd];
            float dt = softplusf(raw * rs_to_rstd(RS[m]) + A.in[I_DTB][l * 16 + hd]); if (m < NNULL) dt = 0.f;
            ((float*)(ws + WS_DT))[(size_t)m * 16 + hd] = dt; ((float*)(ws + WS_AV))[(size_t)m * 16 + hd] = -dt * expf(A.in[I_ALOG][l * 16 + hd]); } }
}
__device__ __forceinline__ void final_phase(const Ctx& C, const bf16* X, const float* gain, float* out) {
    const int gw = C.vcu * NWAVES + C.wave, NGW = C.G * NWAVES;
    f32x4 gn[8];
#pragma unroll
    for (int j = 0; j < 8; ++j) gn[j] = ((const f32x4*)gain)[C.lane + 64 * j];
    for (int m = ROW_P0 + gw; m < MR; m += NGW) {
        const v2u* xr = (const v2u*)(X + (size_t)m * D) + C.lane;
        f32x4 v[8]; float s = 0.f;
#pragma unroll
        for (int j = 0; j < 8; ++j) { v[j] = unpk4(xr[64 * j]); s += (v[j][0] * v[j][0] + v[j][1] * v[j][1]) + (v[j][2] * v[j][2] + v[j][3] * v[j][3]); }
        const float rs = rsqrtf(wave_sum(s) * (1.0f / D) + EPS);
        f32x4* o = (f32x4*)(out + (m < ROW_S0 ? O_YP + (size_t)(m - ROW_P0) * D : O_YS + (size_t)(m - ROW_S0) * D)) + C.lane;
#pragma unroll
        for (int j = 0; j < 8; ++j) o[64 * j] = v[j] * rs * gn[j];
    }
}

__device__ __forceinline__ bf16x8 ldsfrag(const LAS unsigned char* base, int row, int pitchB, int kel) { return *(const LAS bf16x8*)(base + row * pitchB + kel * 2); }
__device__ __forceinline__ float ret_lgam(int h) { return log1pf(-exp2f(-5.0f - (float)h)); }
struct ConvSrc {
    const bf16* XBC; const float* sconv; int c, r0;
    __device__ __forceinline__ float at(int t, int ch) const {
        if (t >= 0) return bf2f(XBC[(size_t)(r0 + t) * 1536 + ch]);
        if (c == 0) return 0.f;
        if (c < NCHP) return bf2f(XBC[(size_t)(r0 + t) * 1536 + ch]);
        return sconv[((size_t)(c - NCHP) * 3 + (3 + t)) * 1536 + ch];
    }
};

__device__ __forceinline__ void m1_ssd(const Ctx& C, int l, int c, int g, int skip = 0) {
    AREF A = *C.a; unsigned char* ws = C.ws; const int tid = C.tid, lane = C.lane, w = C.wave, r0 = 64 * c;
    LAS unsigned char* XT = C.lds; LAS unsigned char* BT = C.lds + 73728;
    LAS float* SDT = (LAS float*)(C.lds + 92160); LAS float* SCUM = (LAS float*)(C.lds + 94208);
    const int l15 = lane & 15, l4 = lane >> 4;
    const ConvSrc cs{(const bf16*)(ws + WS_XBC), A.in[I_SCONV] + (size_t)l * 16 * 3 * 1536, c, r0};
    const float* cw = A.in[I_CONVW] + (size_t)l * 4 * 1536; const float* cb = A.in[I_CONVB] + (size_t)l * 1536;
    LAS unsigned char* RX = C.lds; LAS unsigned char* RBC = C.lds + 96256;
    const int chx = 512 * g + tid;
    {   const bf16* XBC = (const bf16*)(ws + WS_XBC); const float* sc = A.in[I_SCONV] + (size_t)l * 16 * 3 * 1536 + (size_t)(c >= NCHP ? c - NCHP : 0) * 3 * 1536;
#pragma unroll
        for (int q = 0; q < 9; ++q) { const int chn = tid + 512 * q; if (chn < 67 * 64) { const int row = chn >> 6, c16 = chn & 63, t = row - 3, col = 512 * g + 8 * c16; v4u v = (v4u){0u, 0u, 0u, 0u};
                if (t >= 0 || (c > 0 && c < NCHP)) v = *(const v4u*)(XBC + (size_t)(r0 + t) * 1536 + col);
                else if (c >= NCHP) { const f32x4 a = *(const f32x4*)(sc + (3 + t) * 1536 + col), b = *(const f32x4*)(sc + (3 + t) * 1536 + col + 4); v.x = pk2(a[0], a[1]); v.y = pk2(a[2], a[3]); v.z = pk2(b[0], b[1]); v.w = pk2(b[2], b[3]); }
                *(LAS v4u*)(RX + row * 1040 + c16 * 16) = v; } }
#pragma unroll
        for (int q = 0; q < 5; ++q) { const int chn = tid + 512 * q; if (chn < 67 * 32) { const int row = chn >> 5, c16 = chn & 31, t = row - 3, col = (c16 < 16 ? 1024 + 128 * g : 1280 + 128 * g - 128) + 8 * c16; v4u v = (v4u){0u, 0u, 0u, 0u};
                if (t >= 0 || (c > 0 && c < NCHP)) v = *(const v4u*)(XBC + (size_t)(r0 + t) * 1536 + col);
                else if (c >= NCHP) { const f32x4 a = *(const f32x4*)(sc + (3 + t) * 1536 + col), b = *(const f32x4*)(sc + (3 + t) * 1536 + col + 4); v.x = pk2(a[0], a[1]); v.y = pk2(a[2], a[3]); v.z = pk2(b[0], b[1]); v.w = pk2(b[2], b[3]); }
                *(LAS v4u*)(RBC + row * 528 + c16 * 16) = v; } }
    }
    const float xw0 = cw[chx], xw1 = cw[1536 + chx], xw2 = cw[2 * 1536 + chx], xw3 = cw[3 * 1536 + chx], xbias = cb[chx];
    {
        const int hd = 8 * g + w; const float dt = ((const float*)(ws + WS_DT))[(r0 + lane) * 16 + hd]; float v = ((const float*)(ws + WS_AV))[(r0 + lane) * 16 + hd];
#pragma unroll
        for (int o = 1; o < 64; o <<= 1) { const float t = __shfl_up(v, o); if (lane >= o) v += t; }
        SDT[lane * 8 + w] = dt; SCUM[lane * 8 + w] = v; ((float*)(ws + WS_CUM))[(r0 + lane) * 16 + hd] = v;
        if (lane == 63) ((float*)(ws + WS_GAM))[(size_t)c * GAM_N + hd] = expf(v);
    }
    LBAR();
    float raw[67];
#pragma unroll
    for (int t = 0; t < 67; ++t) raw[t] = bf2f(*(const LAS bf16*)(RX + t * 1040 + tid * 2));
    LBAR();
    if (!(skip & 1)) {
        const int hh = tid >> 6; const float clast = SCUM[63 * 8 + hh];
        bf16* xg = (bf16*)(ws + WS_XTG) + ((size_t)c * 1024 + chx) * 64;
#pragma unroll
        for (int t0 = 0; t0 < 64; t0 += 8) {
            float val[8], vw[8];
#pragma unroll
            for (int tt = 0; tt < 8; ++tt) { const int t = t0 + tt; val[tt] = fsilu(xbias + xw0 * raw[t] + xw1 * raw[t + 1] + xw2 * raw[t + 2] + xw3 * raw[t + 3]);
                vw[tt] = val[tt] * (__expf(clast - SCUM[t * 8 + hh]) * SDT[t * 8 + hh]); }
            v4u o; o.x = pk2(val[0], val[1]); o.y = pk2(val[2], val[3]); o.z = pk2(val[4], val[5]); o.w = pk2(val[6], val[7]); *(v4u*)(xg + t0) = o;
            o.x = pk2(vw[0], vw[1]); o.y = pk2(vw[2], vw[3]); o.z = pk2(vw[4], vw[5]); o.w = pk2(vw[6], vw[7]); *(LAS v4u*)(XT + tid * 144 + t0 * 2) = o;
        }
    }
    if (!(skip & 2)) {
        const int col = tid & 255, seg = tid >> 8, t0 = 32 * seg, ch = col < 128 ? 1024 + 128 * g + col : 1280 + 128 * g + (col - 128);
        const float w0 = cw[ch], w1 = cw[1536 + ch], w2 = cw[2 * 1536 + ch], w3 = cw[3 * 1536 + ch], bias = cb[ch];
        float rb[35];
#pragma unroll
        for (int t = 0; t < 35; ++t) rb[t] = bf2f(*(const LAS bf16*)(RBC + (t0 + t) * 528 + col * 2));
        bf16* bg = (bf16*)(ws + WS_BCG) + (size_t)(r0 + t0) * 512 + 256 * g + col;
#pragma unroll
        for (int t8 = 0; t8 < 32; t8 += 8) { float val[8];
#pragma unroll
            for (int tt = 0; tt < 8; ++tt) { const int t = t8 + tt; val[tt] = fsilu(bias + w0 * rb[t] + w1 * rb[t + 1] + w2 * rb[t + 2] + w3 * rb[t + 3]); bg[(unsigned)(t * 512)] = (bf16)f2bf(val[tt]); }
            if (col < 128) { v4u o; o.x = pk2(val[0], val[1]); o.y = pk2(val[2], val[3]); o.z = pk2(val[4], val[5]); o.w = pk2(val[6], val[7]); *(LAS v4u*)(BT + col * 144 + (t0 + t8) * 2) = o; } }
    }
    LBAR();
    if (!(skip & 4)) {
        const int hd = 8 * g + w; bf16* U = (bf16*)(ws + WS_U) + (size_t)c * STATE_N + ST_SSD + (size_t)hd * 8192;
#pragma unroll 1
        for (int pi = 0; pi < 4; ++pi) {
            const bf16x8 a0 = ldsfrag(XT, 64 * w + 16 * pi + l15, 144, 8 * l4), a1 = ldsfrag(XT, 64 * w + 16 * pi + l15, 144, 32 + 8 * l4);
#pragma unroll
            for (int nj = 0; nj < 8; ++nj) {
                f32x4 acc = (f32x4){0.f, 0.f, 0.f, 0.f};
                acc = mfma16(ldsfrag(BT, 16 * nj + l15, 144, 8 * l4), a0, acc); acc = mfma16(ldsfrag(BT, 16 * nj + l15, 144, 32 + 8 * l4), a1, acc);
                *(v2u*)(U + (16 * pi + l15) * 128 + 16 * nj + 4 * l4) = pk4(acc);
            }
        }
    }
}

__device__ __forceinline__ void m1_hg(const Ctx& C, int l, int c, int h) {
    unsigned char* ws = C.ws; const int tid = C.tid, lane = C.lane, w = C.wave, r0 = 64 * c, l15 = lane & 15, l4 = lane >> 4;
    LAS unsigned char* KT = C.lds; LAS unsigned char* VT = C.lds + 18432; LAS float* SEG = (LAS float*)(C.lds + 36864);
    const int col = tid & 127, seg = tid >> 7;
    {
        LAS unsigned char* RAW = C.lds + 40960;
        const bf16* src0 = (const bf16*)(ws + WS_LG); const bf16* src1 = (const bf16*)(ws + WS_KK); const bf16* src2 = (const bf16*)(ws + WS_HV);
#pragma unroll
        for (int q = 0; q < 6; ++q) { const int chn = tid + 512 * q, arr = chn >> 10, rem = chn & 1023, row = rem >> 4, c16 = rem & 15;
            const bf16* s = (arr == 0 ? src0 : (arr == 1 ? src1 : src2)) + (size_t)(r0 + row) * 1024 + 128 * h + 8 * c16;
            *(LAS v4u*)(RAW + arr * 17408 + row * 272 + c16 * 16) = *(const v4u*)s; }
        LBAR();
    }
    float cum[16], kk[16], vv[16];
#pragma unroll
    for (int i = 0; i < 16; ++i) { const LAS unsigned char* p = C.lds + 40960 + (16 * seg + i) * 272 + col * 2; cum[i] = bf2f(*(const LAS bf16*)p); kk[i] = bf2f(*(const LAS bf16*)(p + 17408)); vv[i] = bf2f(*(const LAS bf16*)(p + 34816)); }
#pragma unroll
    for (int i = 1; i < 16; ++i) cum[i] += cum[i - 1];
    SEG[seg * 128 + col] = cum[15];
    LBAR();
    float off = 0.f, tot = 0.f;
#pragma unroll
    for (int s = 0; s < 4; ++s) { const float t = SEG[s * 128 + col]; tot += t; if (s < seg) off += t; }
#pragma unroll
    for (int i = 0; i < 16; ++i) kk[i] *= __expf(tot - (cum[i] + off));
    { v4u o; o.x = pk2(kk[0], kk[1]); o.y = pk2(kk[2], kk[3]); o.z = pk2(kk[4], kk[5]); o.w = pk2(kk[6], kk[7]); *(LAS v4u*)(KT + col * 144 + seg * 32) = o;
      o.x = pk2(kk[8], kk[9]); o.y = pk2(kk[10], kk[11]); o.z = pk2(kk[12], kk[13]); o.w = pk2(kk[14], kk[15]); *(LAS v4u*)(KT + col * 144 + seg * 32 + 16) = o;
      o.x = pk2(vv[0], vv[1]); o.y = pk2(vv[2], vv[3]); o.z = pk2(vv[4], vv[5]); o.w = pk2(vv[6], vv[7]); *(LAS v4u*)(VT + col * 144 + seg * 32) = o;
      o.x = pk2(vv[8], vv[9]); o.y = pk2(vv[10], vv[11]); o.z = pk2(vv[12], vv[13]); o.w = pk2(vv[14], vv[15]); *(LAS v4u*)(VT + col * 144 + seg * 32 + 16) = o; }
    if (seg == 0) ((float*)(ws + WS_GAM))[(size_t)c * GAM_N + 16 + 128 * h + col] = expf(tot);
    LBAR();
    {
        bf16* U = (bf16*)(ws + WS_U) + (size_t)c * STATE_N + ST_HG + (size_t)h * 16384;
        const bf16x8 a0 = ldsfrag(VT, 16 * w + l15, 144, 8 * l4), a1 = ldsfrag(VT, 16 * w + l15, 144, 32 + 8 * l4);
        const bool nat = c >= NCHP;
#pragma unroll
        for (int kj = 0; kj < 8; ++kj) {
            f32x4 acc = (f32x4){0.f, 0.f, 0.f, 0.f}; const bf16x8 k0 = ldsfrag(KT, 16 * kj + l15, 144, 8 * l4), k1 = ldsfrag(KT, 16 * kj + l15, 144, 32 + 8 * l4);
            if (!nat) { acc = mfma16(k0, a0, acc); acc = mfma16(k1, a1, acc); *(v2u*)(U + (16 * w + l15) * 128 + 16 * kj + 4 * l4) = pk4(acc); }
            else { acc = mfma16(a0, k0, acc); acc = mfma16(a1, k1, acc); *(v2u*)(U + (16 * kj + l15) * 128 + 16 * w + 4 * l4) = pk4(acc); }
        }
    }
}

__device__ __forceinline__ void m1_ret(const Ctx& C, int l, int c, int h) {
    unsigned char* ws = C.ws; const int tid = C.tid, lane = C.lane, w = C.wave, r0 = 64 * c, l15 = lane & 15, l4 = lane >> 4;
    LAS unsigned char* KT = C.lds; LAS unsigned char* VT = C.lds + 9216;
    const float lg = ret_lgam(h);
    {   const int kp = tid & 63, s8 = tid >> 6; const bf16* RK = (const bf16*)(ws + WS_RK) + (size_t)(r0 + 8 * s8) * 512 + 64 * h + kp; float v[8];
#pragma unroll
        for (int i = 0; i < 8; ++i) v[i] = bf2f(RK[(size_t)i * 512]) * __expf((float)(63 - (8 * s8 + i)) * lg);
        v4u o; o.x = pk2(v[0], v[1]); o.y = pk2(v[2], v[3]); o.z = pk2(v[4], v[5]); o.w = pk2(v[6], v[7]); *(LAS v4u*)(KT + kp * 144 + s8 * 16) = o; }
    {   const int col = tid & 127, seg = tid >> 7; const bf16* RV = (const bf16*)(ws + WS_RV) + (size_t)(r0 + 16 * seg) * 1024 + 128 * h + col; float vv[16];
#pragma unroll
        for (int i = 0; i < 16; ++i) vv[i] = bf2f(RV[(size_t)i * 1024]);
        v4u o; o.x = pk2(vv[0], vv[1]); o.y = pk2(vv[2], vv[3]); o.z = pk2(vv[4], vv[5]); o.w = pk2(vv[6], vv[7]); *(LAS v4u*)(VT + col * 144 + seg * 32) = o;
        o.x = pk2(vv[8], vv[9]); o.y = pk2(vv[10], vv[11]); o.z = pk2(vv[12], vv[13]); o.w = pk2(vv[14], vv[15]); *(LAS v4u*)(VT + col * 144 + seg * 32 + 16) = o; }
    LBAR();
    {   bf16* U = (bf16*)(ws + WS_U) + (size_t)c * STATE_N + ST_RET + (size_t)h * 8192;
        const bf16x8 a0 = ldsfrag(VT, 16 * w + l15, 144, 8 * l4), a1 = ldsfrag(VT, 16 * w + l15, 144, 32 + 8 * l4);
        const bool nat = c >= NCHP;
#pragma unroll
        for (int kj = 0; kj < 4; ++kj) {
            f32x4 acc = (f32x4){0.f, 0.f, 0.f, 0.f}; const bf16x8 k0 = ldsfrag(KT, 16 * kj + l15, 144, 8 * l4), k1 = ldsfrag(KT, 16 * kj + l15, 144, 32 + 8 * l4);
            if (!nat) { acc = mfma16(k0, a0, acc); acc = mfma16(k1, a1, acc); *(v2u*)(U + (16 * w + l15) * 64 + 16 * kj + 4 * l4) = pk4(acc); }
            else { acc = mfma16(a0, k0, acc); acc = mfma16(a1, k1, acc); *(v2u*)(U + (16 * kj + l15) * 128 + 16 * w + 4 * l4) = pk4(acc); }
        }
    }
}

#ifndef PROBE_SKIP
#define PROBE_SKIP 0
#endif
#ifndef REPI_M1_SSD
#define REPI_M1_SSD 1
#endif
#ifndef REPI_M1_HG
#define REPI_M1_HG 1
#endif
#ifndef REPI_M1_RET
#define REPI_M1_RET 1
#endif
__device__ __forceinline__ unsigned m1_prefetch(const Ctx& C, int l, int it) {
    constexpr int N_SSD = NCH * 2, N_HG = NCH * 8; unsigned char* ws = C.ws; const int tid = C.tid; unsigned pf = 0;
    if (it < N_SSD) { const int c = it >> 1, g = it & 1, r0 = 64 * c; const bf16* XBC = (const bf16*)(ws + WS_XBC);
#pragma unroll
        for (int q = 0; q < 2; ++q) { const int s = tid + 512 * q; if (s < 768) { const int row = s / 12, p = s - 12 * row; const int col = p < 8 ? 512 * g + 64 * p : (p < 10 ? 1024 + 128 * g + 64 * (p - 8) : 1280 + 128 * g + 64 * (p - 10));
            pf ^= *(const unsigned*)(XBC + (size_t)(r0 + row) * 1536 + col); } } }
    else if (it < N_SSD + N_HG) { const int j = it - N_SSD, c = j >> 3, h = j & 7, row = tid >> 3, p = tid & 7; const size_t b = (size_t)(64 * c + row) * 1024 + 128 * h;
        if (p < 4) pf ^= *(const unsigned*)((const bf16*)(ws + WS_LG) + b + 32 * p); else if (p < 6) pf ^= *(const unsigned*)((const bf16*)(ws + WS_KK) + b + 64 * (p - 4)); else pf ^= *(const unsigned*)((const bf16*)(ws + WS_HV) + b + 64 * (p - 6)); }
    else { const int j = it - N_SSD - N_HG, c = j >> 3, h = j & 7; if (tid < 192) { const int row = tid / 3, p = tid - 3 * row;
            if (p == 0) pf ^= *(const unsigned*)((const bf16*)(ws + WS_RK) + (size_t)(64 * c + row) * 512 + 64 * h); else pf ^= *(const unsigned*)((const bf16*)(ws + WS_RV) + (size_t)(64 * c + row) * 1024 + 128 * h + 64 * (p - 1)); } }
    return pf;
}
__device__ __forceinline__ void m1_phase(const Ctx& C0, int l, int mask = 7) {
    constexpr int N_SSD = NCH * 2, N_HG = NCH * 8, N_IT = NCH * 18;
    unsigned* cnt = (unsigned*)(C0.ws + WS_CTL) + CW_QUEUE + 64 * (l * 8 + 0 * 4 + (mask == 7 ? 0 : 1));
    volatile LAS int* slot = (volatile LAS int*)(C0.lds + LDSCTL_OFF + 64);
    int n2 = 0;
    if (C0.tid == 0) { slot[0] = (int)__hip_atomic_fetch_add(cnt, 1u, __ATOMIC_RELAXED, __HIP_MEMORY_SCOPE_AGENT); slot[1] = (int)__hip_atomic_fetch_add(cnt, 1u, __ATOMIC_RELAXED, __HIP_MEMORY_SCOPE_AGENT); }
    LBAR();
    int it = slot[0], nx = slot[1];
    LBAR();
    int par = 0;
    while (it < N_IT) {
        if (C0.tid == 0) n2 = (int)__hip_atomic_fetch_add(cnt, 1u, __ATOMIC_RELAXED, __HIP_MEMORY_SCOPE_AGENT);
        Ctx C = C0; { int t_ = C0.tid; asm volatile("" : "+v"(t_)); C.tid = t_; C.lane = t_ & 63; C.wave = __builtin_amdgcn_readfirstlane(t_ >> 6); }
        unsigned pf = 0; if (MK_PREFETCH && nx < N_IT && mask == 7) pf = m1_prefetch(C, l, nx);
        if (it < N_SSD) { if (mask & 1) m1_ssd(C, l, it >> 1, it & 1, mask == 7 ? 0 : PROBE_SKIP); }
        else if (it < N_SSD + N_HG) { if (mask & 2) { const int j = it - N_SSD; m1_hg(C, l, j >> 3, j & 7); } }
        else { if (mask & 4) { const int j = it - N_SSD - N_HG; m1_ret(C, l, j >> 3, j & 7); } }
        if (pf == 0x7fc1abcdu) ((unsigned*)(C0.ws + WS_CTL))[16] = pf;
        if (C0.tid == 0) slot[2 + par] = n2;
        LBAR();
        it = nx; nx = slot[2 + par]; par ^= 1;
    }
}

struct StIdx { int kind, h; size_t outoff; int ostride; };
__device__ __forceinline__ void m2_elem(int idx, int& kind, int& h, int& o0, int& ostr) {
    if (idx < ST_HG) { kind = 0; h = idx >> 13; o0 = idx; ostr = 1; }
    else if (idx < ST_RET) { const int r = idx - ST_HG; kind = 1; h = r >> 14; const int v = (r >> 7) & 127, k = r & 127; o0 = h * 16384 + k * 128 + v; ostr = 128; }
    else { const int r = idx - ST_RET; kind = 2; h = r >> 13; const int v = (r >> 6) & 127, kp = r & 63; o0 = h * 8192 + ret_dim(kp) * 128 + v; ostr = 128; }
}
__device__ __forceinline__ void m2_sample_item(AREF A, unsigned char* ws, int l, int j) {
    float* out = A.out; const bf16* U = (const bf16*)(ws + WS_U); const float* GAM = (const float*)(ws + WS_GAM);
    const int b = j / (STATE_N / 4), idx = 4 * (j - b * (STATE_N / 4)), c = NCHP + b;
    const f32x4 u = unpk4(*(const v2u*)(U + (size_t)c * STATE_N + idx));
    if (idx < ST_HG) { const int h = idx >> 13; const size_t o = ((size_t)l * 16 + b) * 131072 + idx; const float t = GAM[(size_t)c * GAM_N + h];
        *(f32x4*)(out + O_SSMS + o) = *(const f32x4*)(A.in[I_SSSM] + o) * t + u; }
    else if (idx < ST_RET) { const int r = idx - ST_HG, h = r >> 14, k = (r >> 7) & 127; const size_t o = ((size_t)l * 16 + b) * 131072 + r; const float t = GAM[(size_t)c * GAM_N + 16 + 128 * h + k];
        *(f32x4*)(out + O_HGS + o) = *(const f32x4*)(A.in[I_SHG] + o) * t + u; }
    else { const int r = idx - ST_RET, h = r >> 13, kp = (r >> 7) & 63, v = r & 127; const size_t o = ((size_t)l * 16 + b) * 65536 + h * 8192 + ret_dim(kp) * 128 + v; const float t = expf(64.0f * ret_lgam(h));
        *(f32x4*)(out + O_RETS + o) = *(const f32x4*)(A.in[I_SRET] + o) * t + u; }
}
__device__ __forceinline__ void m2_phase(const Ctx& C, int l) {
    AREF A = *C.a; unsigned char* ws = C.ws; float* out = A.out;
    const bf16* U = (const bf16*)(ws + WS_U); const float* GAM = (const float*)(ws + WS_GAM); bf16* SB = (bf16*)(ws + WS_SB);
    constexpr int CT = 320, ST = NTHR - CT, NSI = 16 * (STATE_N / 4);
    if (C.tid < CT) {
      for (int e4 = C.vcu * CT + C.tid; e4 < STATE_N / 4; e4 += C.G * CT) {
        const int idx = 4 * e4; int kind, h, o0, ostr; m2_elem(idx, kind, h, o0, ostr);
        const float gret = expf(64.0f * ret_lgam(h));
        const int goff = kind == 0 ? h : 16 + 128 * h + (idx & 127);
        f32x4 S = (f32x4){0.f, 0.f, 0.f, 0.f};
        const bf16* up = U + idx; const float* gp = GAM + goff; bf16* sp = SB + idx;
#pragma unroll 1
        for (int c0 = 0; c0 < 128; c0 += 16) {
            v2u u[16]; f32x4 gm[16];
#pragma unroll
            for (int q = 0; q < 16; ++q) { u[q] = *(const v2u*)(up + (size_t)(c0 + q) * STATE_N);
                if (kind == 0) { const float t = gp[(size_t)(c0 + q) * GAM_N]; gm[q] = (f32x4){t, t, t, t}; }
                else if (kind == 1) gm[q] = *(const f32x4*)(gp + (size_t)(c0 + q) * GAM_N);
                else gm[q] = (f32x4){gret, gret, gret, gret}; }
#pragma unroll
            for (int q = 0; q < 16; ++q) { *(v2u*)(sp + (size_t)(c0 + q) * STATE_N) = pk4(S); S = S * gm[q] + unpk4(u[q]); }
        }
        {   const int c = 128; const f32x4 u = unpk4(*(const v2u*)(up + (size_t)c * STATE_N)); f32x4 gm;
            if (kind == 0) { const float t = gp[(size_t)c * GAM_N]; gm = (f32x4){t, t, t, t}; } else if (kind == 1) gm = *(const f32x4*)(gp + (size_t)c * GAM_N); else gm = (f32x4){gret, gret, gret, gret};
            *(v2u*)(sp + (size_t)c * STATE_N) = pk4(S); S = S * gm + u; }
        float* o = out + (kind == 0 ? O_SSMP + (size_t)l * 131072 : kind == 1 ? O_HGP + (size_t)l * 131072 : O_RETP + (size_t)l * 65536);
        if (kind == 0) *(f32x4*)(o + o0) = S; else { o[o0] = S[0]; o[o0 + ostr] = S[1]; o[o0 + 2 * ostr] = S[2]; o[o0 + 3 * ostr] = S[3]; }
      }
    } else {
      const int st = C.vcu * ST + (C.tid - CT), nst = C.G * ST;
      for (int j = st; j < NSI; j += nst) m2_sample_item(A, ws, l, j);
      const bf16* XBC = (const bf16*)(ws + WS_XBC);
      for (int i = st; i < 17 * 4608; i += nst) {
        const int s = i / 4608, r = i - s * 4608, jrow = r / 1536, ch = r - jrow * 1536;
        if (s == 0) out[O_CONVP + (size_t)l * 4608 + r] = bf2f(XBC[(size_t)(ROW_S0 - 3 + jrow) * 1536 + ch]);
        else out[O_CONVS + ((size_t)l * 16 + (s - 1)) * 4608 + r] = bf2f(XBC[(size_t)(ROW_S0 + 64 * (s - 1) + 61 + jrow) * 1536 + ch]);
      }
    }
}


__device__ __forceinline__ void m3_ssd(const Ctx& C, int l, int c, int g) {
    AREF A = *C.a; unsigned char* ws = C.ws; const int tid = C.tid, lane = C.lane, w = C.wave, r0 = 64 * c, l15 = lane & 15, l4 = lane >> 4;
    LAS float* CBS = (LAS float*)C.lds; LAS float* SDT = (LAS float*)(C.lds + 17408); LAS float* SCUM = (LAS float*)(C.lds + 19456); LAS float* SSQ = (LAS float*)(C.lds + 21504);
    LAS unsigned char* CM = C.lds + 23552;
    LAS unsigned char* ZT = C.lds + 40960;
    const bf16* BCG = (const bf16*)(ws + WS_BCG) + (size_t)r0 * 512 + 256 * g;
    const int hd = 8 * g + w;
    const bf16* SB = (const bf16*)(ws + WS_SB) + (size_t)c * STATE_N + ST_SSD + (size_t)hd * 8192;
    const float* S0 = A.in[I_SSSM] + ((size_t)l * 16 + (c >= NCHP ? c - NCHP : 0)) * 131072 + (size_t)hd * 8192;
    const bf16* XTG = (const bf16*)(ws + WS_XTG) + ((size_t)c * 1024 + 512 * g + 64 * w) * 64;
#define M3S_LOAD(SF, XF, PB) do { _Pragma("unroll") for (int ks_ = 0; ks_ < 4; ++ks_) { \
            if (c < NCHP) SF[ks_] = *(const bf16x8*)(SB + (unsigned)((16 * (PB) + l15) * 128 + 32 * ks_ + 8 * l4)); \
            else { const float* sp_ = S0 + (unsigned)((16 * (PB) + l15) * 128 + 32 * ks_ + 8 * l4); const f32x4 s0_ = *(const f32x4*)sp_, s1_ = *(const f32x4*)(sp_ + 4); \
                v4u o_; o_.x = pk2(s0_[0], s0_[1]); o_.y = pk2(s0_[2], s0_[3]); o_.z = pk2(s1_[0], s1_[1]); o_.w = pk2(s1_[2], s1_[3]); SF[ks_] = __builtin_bit_cast(bf16x8, o_); } } \
        XF[0] = *(const bf16x8*)(XTG + (unsigned)((16 * (PB) + l15) * 64 + 8 * l4)); XF[1] = *(const bf16x8*)(XTG + (unsigned)((16 * (PB) + l15) * 64 + 32 + 8 * l4)); } while (0)
    bf16x8 sfA[4], xfA[2], sfB[4], xfB[2];
    M3S_LOAD(sfA, xfA, 0);
    { const int row = tid >> 3, hh = tid & 7; SDT[tid] = ((const float*)(ws + WS_DT))[(r0 + row) * 16 + 8 * g + hh]; SCUM[tid] = ((const float*)(ws + WS_CUM))[(r0 + row) * 16 + 8 * g + hh]; }
    {
        const bf16* ZS = (const bf16*)(ws + WS_ZS) + (size_t)r0 * 1024 + 512 * g;
#pragma unroll
        for (int q = 0; q < 2; ++q) { const int ch = tid + 512 * q, row = ch >> 4, c8 = ch & 15; *(LAS v4u*)(CM + row * 272 + c8 * 16) = *(const v4u*)(BCG + (unsigned)(row * 512 + 128 + c8 * 8)); }
#pragma unroll
        for (int q = 0; q < 8; ++q) { const int ch = tid + 512 * q, row = ch >> 6, c8 = ch & 63; *(LAS v4u*)(ZT + row * 1040 + c8 * 16) = *(const v4u*)(ZS + (unsigned)(row * 1024 + c8 * 8)); }
    }
    {
        const int i = w >> 1;
#pragma unroll
        for (int jj = 0; jj < 2; ++jj) { const int j = 2 * (w & 1) + jj;
            if (j <= i) { f32x4 acc = (f32x4){0.f, 0.f, 0.f, 0.f};
#pragma unroll
                for (int ks = 0; ks < 4; ++ks) acc = mfma16(*(const bf16x8*)(BCG + (unsigned)((16 * j + l15) * 512 + 32 * ks + 8 * l4)), *(const bf16x8*)(BCG + (unsigned)((16 * i + l15) * 512 + 128 + 32 * ks + 8 * l4)), acc);
                *(LAS f32x4*)(CBS + (16 * i + l15) * 68 + 16 * j + 4 * l4) = acc; } }
    }
    LBAR();
    const float dskip = A.in[I_DSKIP][l * 16 + hd];
    v2u Y[4][4]; float ssq[4], ec[4];
    bf16x8 att[4][2];
#pragma unroll
    for (int i = 0; i < 4; ++i) {
        const int t = 16 * i + l15; const float ct = SCUM[t * 8 + w]; ec[i] = __expf(ct); ssq[i] = 0.f;
#pragma unroll
        for (int ks = 0; ks < 2; ++ks) {
            if (ks == 1 && i < 2) { att[i][ks] = (bf16x8){0, 0, 0, 0, 0, 0, 0, 0}; continue; }
            float v[8];
#pragma unroll
            for (int jj = 0; jj < 8; ++jj) { const int s = 32 * ks + 8 * l4 + jj; const float x = CBS[t * 68 + s] * (__expf(ct - SCUM[s * 8 + w]) * SDT[s * 8 + w]); v[jj] = s < t ? x : (s == t ? x + dskip : 0.f); }
            v4u o; o.x = pk2(v[0], v[1]); o.y = pk2(v[2], v[3]); o.z = pk2(v[4], v[5]); o.w = pk2(v[6], v[7]); att[i][ks] = __builtin_bit_cast(bf16x8, o);
        }
    }
#define M3S_BLOCK(SF, XF, PB) do { _Pragma("unroll") for (int i = 0; i < 4; ++i) { const int t = 16 * i + l15; \
            f32x4 yi = (f32x4){0.f, 0.f, 0.f, 0.f}, yn = (f32x4){0.f, 0.f, 0.f, 0.f}; \
            yi = mfma16(XF[0], att[i][0], yi); if (i >= 2) yi = mfma16(XF[1], att[i][1], yi); \
            _Pragma("unroll") for (int ks = 0; ks < 4; ++ks) yn = mfma16(SF[ks], ldsfrag(CM, t, 272, 32 * ks + 8 * l4), yn); \
            const f32x4 z = unpk4(*(const LAS v2u*)(ZT + t * 1040 + (64 * w + 16 * (PB) + 4 * l4) * 2)); \
            const f32x4 y = (yi + yn * ec[i]) * z; ssq[i] += (y[0] * y[0] + y[1] * y[1]) + (y[2] * y[2] + y[3] * y[3]); Y[i][PB] = pk4(y); } } while (0)
    M3S_LOAD(sfB, xfB, 1); M3S_BLOCK(sfA, xfA, 0); __builtin_amdgcn_sched_barrier(0);
    M3S_LOAD(sfA, xfA, 2); M3S_BLOCK(sfB, xfB, 1); __builtin_amdgcn_sched_barrier(0);
    M3S_LOAD(sfB, xfB, 3); M3S_BLOCK(sfA, xfA, 2); __builtin_amdgcn_sched_barrier(0);
    M3S_BLOCK(sfB, xfB, 3);
#undef M3S_LOAD
#undef M3S_BLOCK
#pragma unroll
    for (int i = 0; i < 4; ++i) { float s = ssq[i]; s += __shfl_xor(s, 16); s += __shfl_xor(s, 32); if (l4 == 0) SSQ[w * 64 + 16 * i + l15] = s; }
    LBAR();
    {   const float* gn = A.in[I_SSDN] + (size_t)l * 1024 + 512 * g + 64 * w; bf16* BR = (bf16*)(ws + WS_BR) + (size_t)r0 * 1024 + 512 * g + 64 * w;
#pragma unroll
        for (int i = 0; i < 4; ++i) { const int t = 16 * i + l15; float tot = 0.f;
#pragma unroll
            for (int ww = 0; ww < 8; ++ww) tot += SSQ[ww * 64 + t];
            const float rs = rsqrtf(tot * (1.0f / 512.0f) + EPS);
#pragma unroll
            for (int pb = 0; pb < 4; ++pb) { const int p0 = 16 * pb + 4 * l4; const f32x4 gv = *(const f32x4*)(gn + p0); *(v2u*)(BR + (unsigned)(t * 1024 + p0)) = pk4(unpk4(Y[i][pb]) * rs * gv); } }
    }
}

__device__ __forceinline__ void m3_hg(const Ctx& C, int l, int c, int h) {
    AREF A = *C.a; unsigned char* ws = C.ws; const int tid = C.tid, lane = C.lane, w = C.wave, r0 = 64 * c, l15 = lane & 15, l4 = lane >> 4;
    LAS unsigned char* QT = C.lds; LAS unsigned char* KT = C.lds + 17408; LAS unsigned char* QH = C.lds + 34816; LAS unsigned char* VT = C.lds + 52224; LAS unsigned char* ATT = C.lds + 70656;
    LAS float* SEG = (LAS float*)(C.lds + 79872); LAS float* SSQ = (LAS float*)(C.lds + 83968);
    LAS unsigned char* ST = C.lds + 84480;
    const int i = w >> 1, t = 16 * i + l15;
    const float* gn = A.in[I_HGN] + (size_t)l * 1024 + 128 * h; const bf16* HG = (const bf16*)(ws + WS_HG) + (size_t)r0 * 1024 + 128 * h;
    if (c < NCHP) { const bf16* SB = (const bf16*)(ws + WS_SB) + (size_t)c * STATE_N + ST_HG + (size_t)h * 16384;
#pragma unroll
        for (int q = 0; q < 4; ++q) { const int ch = tid + 512 * q, v = ch >> 4, k8 = ch & 15; *(LAS v4u*)(ST + v * 272 + k8 * 16) = *(const v4u*)(SB + v * 128 + k8 * 8); } }
    else { const float* S0 = A.in[I_SHG] + ((size_t)l * 16 + (c - NCHP)) * 131072 + (size_t)h * 16384;
#pragma unroll
        for (int q = 0; q < 8; ++q) { const int ch = tid + 512 * q, k = ch >> 5, v4 = (ch & 31) * 4; const f32x4 s = *(const f32x4*)(S0 + k * 128 + v4);
#pragma unroll
            for (int e = 0; e < 4; ++e) *(LAS bf16*)(ST + (v4 + e) * 272 + k * 2) = (bf16)f2bf(s[e]); } }
    v2u ggs[4]; f32x4 gvs[4];
#pragma unroll
    for (int b4 = 0; b4 < 4; ++b4) { const int vb = 4 * (w & 1) + b4; ggs[b4] = *(const v2u*)(HG + (unsigned)(t * 1024 + 16 * vb + 4 * l4)); gvs[b4] = *(const f32x4*)(gn + 16 * vb + 4 * l4); }
    {
        const int cp = tid & 63, seg = tid >> 6; const size_t base = (size_t)(r0 + 8 * seg) * 1024 + 128 * h + 2 * cp;
        const bf16* LG = (const bf16*)(ws + WS_LG) + base; const bf16* KK = (const bf16*)(ws + WS_KK) + base; const bf16* HV = (const bf16*)(ws + WS_HV) + base; const bf16* HQ = (const bf16*)(ws + WS_HQ) + base;
        f32x2 cum[8]; unsigned kk[8], vv[8], qq[8];
#pragma unroll
        for (int r = 0; r < 8; ++r) { { const unsigned lw_ = *(const unsigned*)(LG + r * 1024); cum[r] = (f32x2){bflo(lw_), bfhi(lw_)}; } kk[r] = *(const unsigned*)(KK + r * 1024); vv[r] = *(const unsigned*)(HV + r * 1024); qq[r] = *(const unsigned*)(HQ + r * 1024); }
#pragma unroll
        for (int r = 1; r < 8; ++r) cum[r] = cum[r] + cum[r - 1];
        *(LAS f32x2*)(SEG + seg * 128 + 2 * cp) = cum[7];
        LBAR();
        f32x2 off = (f32x2){0.f, 0.f}, R = (f32x2){0.f, 0.f};
#pragma unroll
        for (int s = 0; s < 8; ++s) { const f32x2 sv = *(const LAS f32x2*)(SEG + s * 128 + 2 * cp); if (s < seg) off = off + sv; if (s < 4) R = R + sv; }
#pragma unroll
        for (int r = 0; r < 8; ++r) { const f32x2 cu = cum[r] + off; const int row = 8 * seg + r; const float q0 = bflo(qq[r]), q1 = bfhi(qq[r]), k0 = bflo(kk[r]), k1 = bfhi(kk[r]);
            *(LAS unsigned*)(QT + row * 272 + cp * 4) = pk2(q0 * __expf(fminf(cu[0] - R[0], 80.f)), q1 * __expf(fminf(cu[1] - R[1], 80.f)));
            *(LAS unsigned*)(KT + row * 272 + cp * 4) = pk2(k0 * __expf(fminf(R[0] - cu[0], 80.f)), k1 * __expf(fminf(R[1] - cu[1], 80.f)));
            *(LAS unsigned*)(QH + row * 272 + cp * 4) = pk2(q0 * __expf(cu[0]), q1 * __expf(cu[1])); }
        v4u o0, o1;
        o0.x = (vv[0] & 0xffffu) | (vv[1] << 16); o0.y = (vv[2] & 0xffffu) | (vv[3] << 16); o0.z = (vv[4] & 0xffffu) | (vv[5] << 16); o0.w = (vv[6] & 0xffffu) | (vv[7] << 16);
        o1.x = (vv[0] >> 16) | (vv[1] & 0xffff0000u); o1.y = (vv[2] >> 16) | (vv[3] & 0xffff0000u); o1.z = (vv[4] >> 16) | (vv[5] & 0xffff0000u); o1.w = (vv[6] >> 16) | (vv[7] & 0xffff0000u);
        *(LAS v4u*)(VT + (2 * cp) * 144 + seg * 16) = o0; *(LAS v4u*)(VT + (2 * cp + 1) * 144 + seg * 16) = o1;
    }
    LBAR();
#pragma unroll
    for (int jj = 0; jj < 2; ++jj) { const int j = 2 * (w & 1) + jj; f32x4 acc = (f32x4){0.f, 0.f, 0.f, 0.f};
        if (j <= i) {
#pragma unroll
            for (int ks = 0; ks < 4; ++ks) acc = mfma16(ldsfrag(KT, 16 * j + l15, 272, 32 * ks + 8 * l4), ldsfrag(QT, t, 272, 32 * ks + 8 * l4), acc); }
#pragma unroll
        for (int e = 0; e < 4; ++e) { const int s = 16 * j + 4 * l4 + e; acc[e] = (j <= i && s <= t) ? acc[e] : 0.f; }
        *(LAS v2u*)(ATT + t * 144 + (16 * j + 4 * l4) * 2) = pk4(acc); }
    LBAR();
    f32x4 O[4]; float ssq = 0.f;
#pragma unroll
    for (int b4 = 0; b4 < 4; ++b4) { const int vb = 4 * (w & 1) + b4; f32x4 acc = (f32x4){0.f, 0.f, 0.f, 0.f};
        acc = mfma16(ldsfrag(VT, 16 * vb + l15, 144, 8 * l4), ldsfrag(ATT, t, 144, 8 * l4), acc);
        if (i >= 2) acc = mfma16(ldsfrag(VT, 16 * vb + l15, 144, 32 + 8 * l4), ldsfrag(ATT, t, 144, 32 + 8 * l4), acc);
#pragma unroll
        for (int ks = 0; ks < 4; ++ks) acc = mfma16(ldsfrag(ST, 16 * vb + l15, 272, 32 * ks + 8 * l4), ldsfrag(QH, t, 272, 32 * ks + 8 * l4), acc);
        O[b4] = acc; ssq += (acc[0] * acc[0] + acc[1] * acc[1]) + (acc[2] * acc[2] + acc[3] * acc[3]); }
    ssq += __shfl_xor(ssq, 16); ssq += __shfl_xor(ssq, 32); if (l4 == 0) SSQ[(w & 1) * 64 + t] = ssq;
    LBAR();
    {   bf16* BR = (bf16*)(ws + WS_BR) + ((size_t)MP + r0) * 1024 + 128 * h;
        const float rs = rsqrtf((SSQ[t] + SSQ[64 + t]) * (1.0f / 128.0f) + EPS);
#pragma unroll
        for (int b4 = 0; b4 < 4; ++b4) { const int v0 = 16 * (4 * (w & 1) + b4) + 4 * l4; const v2u gg = ggs[b4];
            const f32x4 gt = (f32x4){bflo(gg.x), bfhi(gg.x), bflo(gg.y), bfhi(gg.y)};
            *(v2u*)(BR + (unsigned)(t * 1024 + v0)) = pk4(O[b4] * rs * gvs[b4] * gt); }
    }
}

__device__ __forceinline__ void m3_ret(const Ctx& C, int l, int c, int h) {
    AREF A = *C.a; unsigned char* ws = C.ws; const int tid = C.tid, lane = C.lane, w = C.wave, r0 = 64 * c, l15 = lane & 15, l4 = lane >> 4;
    LAS unsigned char* VT = C.lds; LAS unsigned char* ATT = C.lds + 18432; LAS float* SSQ = (LAS float*)(C.lds + 27648);
    const float lg = ret_lgam(h);
    const int i = w >> 1, t = 16 * i + l15;
    const bf16* RG = (const bf16*)(ws + WS_RG) + (size_t)r0 * 1024 + 128 * h;
    LAS unsigned char* ST = C.lds + 28160;
    if (c < NCHP) { const bf16* SB = (const bf16*)(ws + WS_SB) + (size_t)c * STATE_N + ST_RET + (size_t)h * 8192;
#pragma unroll
        for (int q = 0; q < 2; ++q) { const int ch = tid + 512 * q, v = ch >> 3, k8 = ch & 7; *(LAS v4u*)(ST + v * 144 + k8 * 16) = *(const v4u*)(SB + v * 64 + k8 * 8); } }
    else { const float* S0 = A.in[I_SRET] + ((size_t)l * 16 + (c - NCHP)) * 65536 + (size_t)h * 8192;
#pragma unroll
        for (int q = 0; q < 4; ++q) { const int ch = tid + 512 * q, d = ch >> 5, v4 = (ch & 31) * 4, kp = 8 * ((d & 31) >> 2) + 4 * (d >> 5) + (d & 3); const f32x4 s = *(const f32x4*)(S0 + d * 128 + v4);
#pragma unroll
            for (int e = 0; e < 4; ++e) *(LAS bf16*)(ST + (v4 + e) * 144 + kp * 2) = (bf16)f2bf(s[e]); } }
    v2u ggs[4];
#pragma unroll
    for (int b4 = 0; b4 < 4; ++b4) { const int vb = 4 * (w & 1) + b4; ggs[b4] = *(const v2u*)(RG + (unsigned)(t * 1024 + 16 * vb + 4 * l4)); }
    {   const int col = tid & 127, seg = tid >> 7; const bf16* RV = (const bf16*)(ws + WS_RV) + (size_t)(r0 + 16 * seg) * 1024 + 128 * h + col; float vv[16];
#pragma unroll
        for (int i = 0; i < 16; ++i) vv[i] = bf2f(RV[i * 1024]);
        v4u o; o.x = pk2(vv[0], vv[1]); o.y = pk2(vv[2], vv[3]); o.z = pk2(vv[4], vv[5]); o.w = pk2(vv[6], vv[7]); *(LAS v4u*)(VT + col * 144 + seg * 32) = o;
        o.x = pk2(vv[8], vv[9]); o.y = pk2(vv[10], vv[11]); o.z = pk2(vv[12], vv[13]); o.w = pk2(vv[14], vv[15]); *(LAS v4u*)(VT + col * 144 + seg * 32 + 16) = o; }
    const bf16* RQ = (const bf16*)(ws + WS_RQ) + (size_t)r0 * 512 + 64 * h; const bf16* RK = (const bf16*)(ws + WS_RK) + (size_t)r0 * 512 + 64 * h;
    const bf16x8 q0 = *(const bf16x8*)(RQ + (unsigned)(t * 512 + 8 * l4)), q1 = *(const bf16x8*)(RQ + (unsigned)(t * 512 + 32 + 8 * l4));
#pragma unroll
    for (int jj = 0; jj < 2; ++jj) { const int j = 2 * (w & 1) + jj; f32x4 acc = (f32x4){0.f, 0.f, 0.f, 0.f};
        if (j <= i) { acc = mfma16(*(const bf16x8*)(RK + (unsigned)((16 * j + l15) * 512 + 8 * l4)), q0, acc); acc = mfma16(*(const bf16x8*)(RK + (unsigned)((16 * j + l15) * 512 + 32 + 8 * l4)), q1, acc); }
#pragma unroll
        for (int e = 0; e < 4; ++e) { const int s = 16 * j + 4 * l4 + e; acc[e] = (j <= i && s <= t) ? acc[e] * __expf((float)(t - s) * lg) : 0.f; }
        *(LAS v2u*)(ATT + t * 144 + (16 * j + 4 * l4) * 2) = pk4(acc); }
    LBAR();
    const float inner = __expf((float)(t + 1) * lg);
    f32x4 O[4]; float ssq = 0.f;
#pragma unroll
    for (int b4 = 0; b4 < 4; ++b4) { const int vb = 4 * (w & 1) + b4; f32x4 acc = (f32x4){0.f, 0.f, 0.f, 0.f}, acs = (f32x4){0.f, 0.f, 0.f, 0.f};
        acc = mfma16(ldsfrag(VT, 16 * vb + l15, 144, 8 * l4), ldsfrag(ATT, t, 144, 8 * l4), acc);
        if (i >= 2) acc = mfma16(ldsfrag(VT, 16 * vb + l15, 144, 32 + 8 * l4), ldsfrag(ATT, t, 144, 32 + 8 * l4), acc);
        acs = mfma16(ldsfrag(ST, 16 * vb + l15, 144, 8 * l4), q0, acs); acs = mfma16(ldsfrag(ST, 16 * vb + l15, 144, 32 + 8 * l4), q1, acs);
        acc = acc + acs * inner;
        O[b4] = acc; ssq += (acc[0] * acc[0] + acc[1] * acc[1]) + (acc[2] * acc[2] + acc[3] * acc[3]); }
    ssq += __shfl_xor(ssq, 16); ssq += __shfl_xor(ssq, 32); if (l4 == 0) SSQ[(w & 1) * 64 + t] = ssq;
    LBAR();
    {   bf16* BR = (bf16*)(ws + WS_BR) + ((size_t)2 * MP + r0) * 1024 + 128 * h;
        const float rs = rsqrtf((SSQ[t] + SSQ[64 + t]) * (1.0f / 128.0f) + EPS);
#pragma unroll
        for (int b4 = 0; b4 < 4; ++b4) { const int v0 = 16 * (4 * (w & 1) + b4) + 4 * l4; const v2u gg = ggs[b4];
            const f32x4 gt = (f32x4){bflo(gg.x), bfhi(gg.x), bflo(gg.y), bfhi(gg.y)};
            *(v2u*)(BR + (unsigned)(t * 1024 + v0)) = pk4(O[b4] * rs * gt); }
    }
}

#ifndef REPI_M3_SSD
#define REPI_M3_SSD 1
#endif
#ifndef REPI_M3_HG
#define REPI_M3_HG 1
#endif
#ifndef REPI_M3_RET
#define REPI_M3_RET 1
#endif
__device__ __forceinline__ unsigned m3_prefetch(const Ctx& C, int l, int it) {
    constexpr int N_SSD = NCH * 2, N_HG = NCH * 8; unsigned char* ws = C.ws; const int tid = C.tid; unsigned pf = 0;
    if (it < N_SSD) { const int c = it >> 1, g = it & 1, r0 = 64 * c;
        if (c < NCHP) { const bf16* SB = (const bf16*)(ws + WS_SB) + (size_t)c * STATE_N + ST_SSD + (size_t)g * 65536;
#pragma unroll
            for (int q = 0; q < 2; ++q) pf ^= *(const unsigned*)(SB + (tid + 512 * q) * 64); }
        pf ^= *(const unsigned*)((const bf16*)(ws + WS_XTG) + ((size_t)c * 1024 + 512 * g + tid) * 64);
        pf ^= *(const unsigned*)((const bf16*)(ws + WS_ZS) + (size_t)(r0 + (tid >> 3)) * 1024 + 512 * g + 64 * (tid & 7));
        if (tid < 256) pf ^= *(const unsigned*)((const bf16*)(ws + WS_BCG) + (size_t)(r0 + (tid >> 2)) * 512 + 256 * g + 64 * (tid & 3)); }
    else if (it < N_SSD + N_HG) { const int j = it - N_SSD, c = j >> 3, h = j & 7, row = tid >> 3, p = tid & 7; const size_t b = (size_t)(64 * c + row) * 1024 + 128 * h;
        if (p < 4) pf ^= *(const unsigned*)((const bf16*)(ws + WS_LG) + b + 32 * p); else if (p < 6) pf ^= *(const unsigned*)((const bf16*)(ws + WS_KK) + b + 64 * (p - 4)); else pf ^= *(const unsigned*)((const bf16*)(ws + WS_HV) + b + 64 * (p - 6));
        if (p < 2) pf ^= *(const unsigned*)((const bf16*)(ws + WS_HQ) + b + 64 * p); else if (p < 4) pf ^= *(const unsigned*)((const bf16*)(ws + WS_HG) + b + 64 * (p - 2));
        else if (c < NCHP && tid >= 256) pf ^= *(const unsigned*)((const bf16*)(ws + WS_SB) + (size_t)c * STATE_N + ST_HG + (size_t)h * 16384 + (tid - 256) * 64); }
    else { const int j = it - N_SSD - N_HG, c = j >> 3, h = j & 7, row = tid >> 3, p = tid & 7; const size_t b = (size_t)(64 * c + row) * 1024 + 128 * h;
        if (p < 2) pf ^= *(const unsigned*)((const bf16*)(ws + WS_RV) + b + 64 * p); else if (p < 4) pf ^= *(const unsigned*)((const bf16*)(ws + WS_RG) + b + 64 * (p - 2));
        else if (p == 4) pf ^= *(const unsigned*)((const bf16*)(ws + WS_RQ) + (size_t)(64 * c + row) * 512 + 64 * h); else if (p == 5) pf ^= *(const unsigned*)((const bf16*)(ws + WS_RK) + (size_t)(64 * c + row) * 512 + 64 * h);
        else if (c < NCHP && tid < 128 * 8) { const int k = (row * 2 + (p - 6)); if (k < 128) pf ^= *(const unsigned*)((const bf16*)(ws + WS_SB) + (size_t)c * STATE_N + ST_RET + (size_t)h * 8192 + k * 64); } }
    return pf;
}
__device__ __forceinline__ void m3_phase(const Ctx& C0, int l, int mask = 7) {
    constexpr int N_SSD = NCH * 2, N_HG = NCH * 8, N_IT = NCH * 18;
    unsigned* cnt = (unsigned*)(C0.ws + WS_CTL) + CW_QUEUE + 64 * (l * 8 + 1 * 4 + (mask == 7 ? 0 : 1));
    volatile LAS int* slot = (volatile LAS int*)(C0.lds + LDSCTL_OFF + 64);
    int n2 = 0;
    if (C0.tid == 0) { slot[0] = (int)__hip_atomic_fetch_add(cnt, 1u, __ATOMIC_RELAXED, __HIP_MEMORY_SCOPE_AGENT); slot[1] = (int)__hip_atomic_fetch_add(cnt, 1u, __ATOMIC_RELAXED, __HIP_MEMORY_SCOPE_AGENT); }
    LBAR();
    int it = slot[0], nx = slot[1];
    LBAR();
    int par = 0;
    while (it < N_IT) {
        if (C0.tid == 0) n2 = (int)__hip_atomic_fetch_add(cnt, 1u, __ATOMIC_RELAXED, __HIP_MEMORY_SCOPE_AGENT);
        Ctx C = C0; { int t_ = C0.tid; asm volatile("" : "+v"(t_)); C.tid = t_; C.lane = t_ & 63; C.wave = __builtin_amdgcn_readfirstlane(t_ >> 6); }
        unsigned pf = 0; if (MK_PREFETCH && nx < N_IT && mask == 7) pf = m3_prefetch(C, l, nx);
        if (it < N_SSD) { if (mask & 1) m3_ssd(C, l, it >> 1, it & 1); }
        else if (it < N_SSD + N_HG) { if (mask & 2) { const int j = it - N_SSD; m3_hg(C, l, j >> 3, j & 7); } }
        else { if (mask & 4) { const int j = it - N_SSD - N_HG; m3_ret(C, l, j >> 3, j & 7); } }
        if (pf == 0x7fc1abcdu) ((unsigned*)(C0.ws + WS_CTL))[16] = pf;
        if (C0.tid == 0) slot[2 + par] = n2;
        LBAR();
        it = nx; nx = slot[2 + par]; par ^= 1;
    }
}


enum { PH_GEMM1 = 0, PH_M1, PH_M2, PH_M3, PH_GEMM2, PH_GEMM3, PH_GU, PH_DOWN, PH_N };

__device__ __forceinline__ void stagger(int bx, int ticks) {
    if ((bx & 1) && ticks > 0) { const unsigned long long t0 = wall_clock64(); while (wall_clock64() - t0 < (unsigned long long)ticks) __builtin_amdgcn_s_sleep(32); }
}
#ifndef PROBE_G2_MODE
#define PROBE_G2_MODE 0
#endif
#ifndef PROBE_G2_NOSPLIT
#define PROBE_G2_NOSPLIT 0
#endif
#ifndef PROBE_G2_REAL
#define PROBE_G2_REAL 0
#endif
#ifndef STAG_G2
#define STAG_G2 0
#endif
#ifndef STAG_G3
#define STAG_G3 0
#endif
#ifndef STAG_DN
#define STAG_DN 0
#endif
#ifndef STAG_G1
#define STAG_G1 0
#endif
#ifndef STAG_GU
#define STAG_GU 0
#endif
#ifndef REP_P0
#define REP_P0 1
#endif
#ifndef REP_NORM
#define REP_NORM 1
#endif
#ifndef REP_G1
#define REP_G1 1
#endif
#ifndef REP_M1
#define REP_M1 1
#endif
#ifndef REP_M2
#define REP_M2 1
#endif
#ifndef REP_M3
#define REP_M3 1
#endif
#ifndef REP_G2
#define REP_G2 1
#endif
#ifndef REP_G3
#define REP_G3 1
#endif
#ifndef REP_GU
#define REP_GU 1
#endif
#ifndef REP_DN
#define REP_DN 1
#endif
#ifndef PROBE_MASK
#define PROBE_MASK 7
#endif
#ifndef G1_ALIGN
#define G1_ALIGN true
#endif
#ifndef REP_DT
#define REP_DT 1
#endif
#ifndef MK_G2_HANDOFF
#define MK_G2_HANDOFF 1
#endif
#ifndef REP_BAR
#define REP_BAR 1
#endif
__global__ void __launch_bounds__(NTHR, 2) trunk_fwd(Args args) {
    extern __shared__ __attribute__((aligned(16))) unsigned char lds_raw[];
    Ctx C; C.lds = (LAS unsigned char*)lds_raw; C.tid = threadIdx.x; C.lane = C.tid & 63; C.wave = __builtin_amdgcn_readfirstlane(C.tid >> 6);
    const int wave0 = C.wave;
    C.G = gridDim.x; { const int bx = blockIdx.x; C.vcu = (C.G % 8 == 0) ? (bx % 8) * (C.G / 8) + bx / 8 : bx; }
    ArgsP ap = (ArgsP)__builtin_amdgcn_kernarg_segment_ptr();
    C.a = ap; C.ws = ap->ws;
    unsigned char* ws = ap->ws; const int use_bar = ap->use_bar;
    for (int u = C.tid; u < (LDS_BYTES - LDSCTL_OFF) / 4; u += NTHR) ((LAS unsigned*)(C.lds + LDSCTL_OFF))[u] = 0u;
    __syncthreads();
    XcdBarrier bar; bar.bar = (unsigned*)(ws + WS_CTL) + CW_BAR; bar.x = 0; bar.st = nullptr;
    if (use_bar) bar = xcd_barrier_post((unsigned*)(ws + WS_CTL) + CW_BAR, (volatile LAS unsigned*)(C.lds + LDSCTL_OFF));
#define GRID_BAR() do { if (use_bar) for (int rb_ = 0; rb_ < REP_BAR; ++rb_) { bar.bar = (unsigned*)(ws + WS_CTL) + CW_BAR; xcd_barrier(bar); } } while (0)
#define FRESH() do { int w0_ = wave0; asm volatile("" : "+s"(w0_)); unsigned z_ = 0u; asm volatile("" : "+v"(z_)); int t_ = w0_ * 64 + (int)__builtin_amdgcn_mbcnt_hi(~0u, __builtin_amdgcn_mbcnt_lo(~0u, z_)); asm volatile("" : "+v"(t_)); C.tid = t_; C.lane = t_ & 63; C.wave = __builtin_amdgcn_readfirstlane(t_ >> 6); \
        int g_ = gridDim.x; asm volatile("" : "+s"(g_)); C.G = g_; int b_ = blockIdx.x; asm volatile("" : "+s"(b_)); bx = b_; C.vcu = (C.G % 8 == 0) ? (b_ % 8) * (C.G / 8) + b_ / 8 : b_; \
        ArgsP a_ = (ArgsP)__builtin_amdgcn_kernarg_segment_ptr(); asm volatile("" : "+s"(a_)); ap = a_; C.a = a_; unsigned char* w_ = a_->ws; ws = w_; C.ws = w_; X = (bf16*)(ws + WS_X); H = (bf16*)(ws + WS_H); lw = ws + WS_W + (size_t)l * LW_SIZE; } while (0)
#define IN(k) (ap->ph_lo <= (k) && (k) < ap->ph_hi)

    if (ap->do_pro) { for (int r_ = 0; r_ < REP_P0; ++r_) p0_prologue(C); GRID_BAR(); }

    bf16* X = (bf16*)(ws + WS_X); bf16* H = (bf16*)(ws + WS_H); int bx = blockIdx.x; unsigned char* lw = ws;
    const int l_hi = ap->l_hi;
    for (int l = ap->l_lo; l < l_hi; ++l) {
        if (IN(PH_GEMM1)) for (int r_ = 0; r_ < REP_G1; ++r_) { asm volatile("; MARK_PH_GEMM1"); FRESH(); stagger(bx, STAG_G1);
            pg8::Gemm g{X, (const bf16*)(lw + LW_IN), MP, NPROJ, D, 0, 0}; pg8::StaticOrder S; S.init(MP, NPROJ, C.G, bx, D);
            if (r_ == 0) { EpiProj E{ws, l};
            pg8::gemm_phase<EpiProj, pg8::StaticOrder, G1_ALIGN, true>(C.lds, g, S, E, C.tid); for (int q_ = 0; q_ < REP_DT; ++q_) { dt_rows(C, l); LBAR(); } }
            else { S.sametile = 1; EpiNull E{(float*)(ws + WS_TMP)}; pg8::gemm_phase<EpiNull, pg8::StaticOrder, G1_ALIGN, true>(C.lds, g, S, E, C.tid); }
            GRID_BAR();
        }
        if (IN(PH_M1)) for (int r_ = 0; r_ < REP_M1; ++r_) { asm volatile("; MARK_PH_M1"); FRESH(); m1_phase(C, l, r_ == 0 ? 7 : PROBE_MASK); GRID_BAR(); }
        if (IN(PH_M2)) for (int r_ = 0; r_ < REP_M2; ++r_) { asm volatile("; MARK_PH_M2"); FRESH(); m2_phase(C, l); GRID_BAR(); }
        if (IN(PH_M3)) for (int r_ = 0; r_ < REP_M3; ++r_) { asm volatile("; MARK_PH_M3"); FRESH(); m3_phase(C, l, r_ == 0 ? 7 : PROBE_MASK); GRID_BAR(); }
        if (IN(PH_GEMM2)) for (int r_ = 0; r_ < REP_G2; ++r_) { asm volatile("; MARK_PH_GEMM2"); FRESH(); stagger(bx, STAG_G2);
            pg8::Gemm g{(const bf16*)(ws + WS_BR), (const bf16*)(lw + LW_BR), MP, D, 1024, (size_t)MP * 1024 * 2, (size_t)D * 1024 * 2}; BranchOrder S; S.init(MP, D, C.G, bx, 1024);
            EpiBranch E{(bf16*)(ws + WS_TMP), (bf16*)(ws + WS_MIX), (const bf16*)(ws + WS_GT), (float*)(ws + WS_SLAB), (unsigned*)(ws + WS_CTL) + CW_G2 + 64 * (64 * (l * REP_G2 + r_)), (unsigned*)(ws + WS_CTL) + CW_TMO, (S.dep && REP_G2 == 1 && MK_G2_HANDOFF) ? (unsigned*)(ws + WS_CTL) + CW_RDY + (2 * l) * 64 * 32 : nullptr};
            if (r_ == 0 || PROBE_G2_REAL) pg8::gemm_phase<EpiBranch, BranchOrder, true, true>(C.lds, g, S, E, C.tid);
            else if (PROBE_G2_MODE) { EpiBranchT<PROBE_G2_MODE> E2{(bf16*)(ws + WS_HID), (bf16*)(ws + WS_HID) + (size_t)MP * D, (const bf16*)(ws + WS_GT), (float*)(ws + WS_SLAB) + (size_t)256 * 65536, (unsigned*)(ws + WS_CTL) + CW_G2 + 64 * 64 * 7, (unsigned*)(ws + WS_CTL) + CW_TMO}; S.rem = 0; S.R = (S.S.nwg + S.S.G - 1) / S.S.G; pg8::gemm_phase<EpiBranchT<PROBE_G2_MODE>, BranchOrder, true, true>(C.lds, g, S, E2, C.tid); }
            else { if (PROBE_G2_NOSPLIT) { S.rem = 0; S.R = (S.S.nwg + S.S.G - 1) / S.S.G; } EpiNull EN{(float*)(ws + WS_TMP)}; pg8::gemm_phase<EpiNull, BranchOrder, true, true>(C.lds, g, S, EN, C.tid); }
            if (!(S.dep && REP_G2 == 1 && MK_G2_HANDOFF)) GRID_BAR();
        }
        if (IN(PH_GEMM3)) for (int r_ = 0; r_ < REP_G3; ++r_) { asm volatile("; MARK_PH_GEMM3"); FRESH(); stagger(bx, STAG_G3);
            pg8::Gemm g{(const bf16*)(ws + WS_MIX), (const bf16*)(lw + LW_OUT), MP, D, D, 0, 0}; G3Order S; S.init(MP, D, C.G, bx, D, (REP_G2 == 1 && !MK_G2_NOSPLIT && MK_G2_HANDOFF) ? (const unsigned*)(ws + WS_CTL) + CW_RDY + (2 * l) * 64 * 32 : nullptr, (unsigned*)(ws + WS_CTL) + CW_TMO);
            const int ep = 2 * l + 0;
            EpiResid E{r_ == 0 ? X : (bf16*)(ws + WS_TMP), (float*)(ws + WS_SLAB) + (size_t)(ep & 1) * 256 * 65536, (unsigned*)(ws + WS_CTL) + CW_SK + (ep & 7) * 256 * 64, (unsigned*)(ws + WS_CTL) + CW_TMO,
                       r_ == 0 ? (u64*)((unsigned*)(ws + WS_CTL) + CW_RS) + (size_t)(2 * l + 1) * MP : nullptr, (r_ == 0 && S.dep) ? (unsigned*)(ws + WS_CTL) + CW_RDY + (2 * l + 1) * 64 * 32 : nullptr};
            pg8::gemm_phase<EpiResid, G3Order, true, true>(C.lds, g, S, E, C.tid);
            if (!S.dep) GRID_BAR();
        }
        if (IN(PH_GU)) for (int r_ = 0; r_ < REP_GU; ++r_) { asm volatile("; MARK_PH_GU"); FRESH(); stagger(bx, STAG_GU);
            pg8::Gemm g{X, (const bf16*)(lw + LW_GU), MP, 2 * FFN, D, 0, 0}; GuOrder S; S.init(MP, 2 * FFN, C.G, bx, D, (const unsigned*)(ws + WS_CTL) + CW_RDY + (2 * l + 1) * 64 * 32, (unsigned*)(ws + WS_CTL) + CW_TMO);
            EpiSwiglu E{(bf16*)(ws + WS_HID), (float*)(ws + WS_SLAB), (unsigned*)(ws + WS_CTL) + CW_SK + ((2 * l) & 7) * 256 * 64, (unsigned*)(ws + WS_CTL) + CW_TMO, (const u64*)((const unsigned*)(ws + WS_CTL) + CW_RS) + (size_t)(2 * l + 1) * MP};
            pg8::gemm_phase<EpiSwiglu, GuOrder, true, true>(C.lds, g, S, E, C.tid);
            GRID_BAR();
        }
        if (IN(PH_DOWN)) for (int r_ = 0; r_ < REP_DN; ++r_) { asm volatile("; MARK_PH_DOWN"); FRESH(); stagger(bx, STAG_DN);
            pg8::Gemm g{(const bf16*)(ws + WS_HID), (const bf16*)(lw + LW_DN), MP, D, FFN, 0, 0}; pg8::StreamOrder S; S.init(MP, D, C.G, C.vcu, FFN);
            const int ep = 2 * l + 1;
            EpiResid E{r_ == 0 ? X : (bf16*)(ws + WS_TMP), (float*)(ws + WS_SLAB) + (size_t)(ep & 1) * 256 * 65536, (unsigned*)(ws + WS_CTL) + CW_SK + (ep & 7) * 256 * 64, (unsigned*)(ws + WS_CTL) + CW_TMO,
                       (r_ == 0 && l + 1 < NL) ? (u64*)((unsigned*)(ws + WS_CTL) + CW_RS) + (size_t)(2 * l + 2) * MP : nullptr};
            pg8::gemm_phase<EpiResid, pg8::StreamOrder, true, true>(C.lds, g, S, E, C.tid);
            GRID_BAR();
        }
    }
    if (ap->do_fin) { const int l = 0; FRESH(); final_phase(C, X, ap->in[I_NFIN], ap->out); }
#undef IN
#undef GRID_BAR
#undef FRESH
}


__global__ void probe_dump(const unsigned short* src, size_t n_src, float* out, size_t n_out) {
    for (size_t i = (size_t)blockIdx.x * blockDim.x + threadIdx.x; i < n_out; i += (size_t)gridDim.x * blockDim.x) {
        const size_t j = (i * 4 + (i & 3)) % n_src; out[i] = __builtin_bit_cast(float, ((unsigned)src[j]) << 16) * 1e-3f + 1.0f; }
}
#ifndef MK_REPS
#define MK_REPS 1
#endif
#ifndef MK_ONE_LAUNCH
#define MK_ONE_LAUNCH 1
#endif
extern "C" void kernel_launch(void* const* d_in, const int* in_sizes, int n_in, void* d_out, int out_size, void* d_ws, size_t ws_size, hipStream_t stream) {
    static int grid = 0;
    if (grid == 0) {
        if (n_in != 24 || (size_t)out_size != O_END || ws_size < WS_END) { fprintf(stderr, "kernel_launch: unexpected shapes (n_in %d, out %d, ws %zu, need %zu)\n", n_in, out_size, ws_size, (size_t)WS_END); grid = -1; return; }
        int dev = 0, cus = 0, per_cu = 0;
        if (hipGetDevice(&dev) != hipSuccess || hipDeviceGetAttribute(&cus, hipDeviceAttributeMultiprocessorCount, dev) != hipSuccess) { grid = -1; return; }
        if (hipFuncSetAttribute((const void*)trunk_fwd, hipFuncAttributeMaxDynamicSharedMemorySize, LDS_BYTES) != hipSuccess) { fprintf(stderr, "kernel_launch: hipFuncSetAttribute failed\n"); grid = -1; return; }
        if (hipOccupancyMaxActiveBlocksPerMultiprocessor(&per_cu, (const void*)trunk_fwd, NTHR, LDS_BYTES) != hipSuccess || per_cu < 1) fprintf(stderr, "kernel_launch: occupancy query reports %d\n", per_cu);
        (void)hipGetLastError();
        grid = cus;
    }
    if (grid < 0) return;
    (void)hipMemsetAsync((char*)d_ws + WS_CTL, 0, CTL_ZERO_BYTES, stream);
    Args a{};
    for (int i = 0; i < 24; ++i) a.in[i] = (const float*)d_in[i];
    a.out = (float*)d_out; a.ws = (unsigned char*)d_ws;
#if MK_ONE_LAUNCH
    a.l_lo = 0; a.l_hi = NL; a.ph_lo = 0; a.ph_hi = PH_N; a.do_pro = 1; a.do_fin = 1; a.use_bar = 1; a.pad = 0;
    hipLaunchKernelGGL(trunk_fwd, dim3(grid), dim3(NTHR), LDS_BYTES, stream, a);
#else
    for (int rep = 0; rep < MK_REPS; ++rep) {
    a.use_bar = 0; a.pad = 0;
    a.l_lo = 0; a.l_hi = 0; a.ph_lo = 0; a.ph_hi = 0; a.do_pro = 1; a.do_fin = 0;
    hipLaunchKernelGGL(trunk_fwd, dim3(grid), dim3(NTHR), LDS_BYTES, stream, a);
    a.do_pro = 0;
#ifdef PROBE_NPH
    { int cnt = 0; for (int l = 0; l < NL && cnt < PROBE_NPH; ++l) for (int ph = 0; ph < PH_N && cnt < PROBE_NPH; ++ph, ++cnt) { a.l_lo = l; a.l_hi = l + 1; a.ph_lo = ph; a.ph_hi = ph + 1; hipLaunchKernelGGL(trunk_fwd, dim3(grid), dim3(NTHR), LDS_BYTES, stream, a); } }
    probe_dump<<<2048, 256, 0, stream>>>((const unsigned short*)((char*)d_ws + PROBE_LO), (size_t)(PROBE_HI - PROBE_LO) / 2, (float*)d_out, (size_t)O_END);
    return;
#endif
    for (int l = 0; l < NL; ++l) for (int ph = 0; ph < PH_N; ++ph) { a.l_lo = l; a.l_hi = l + 1; a.ph_lo = ph; a.ph_hi = ph + 1; hipLaunchKernelGGL(trunk_fwd, dim3(grid), dim3(NTHR), LDS_BYTES, stream, a); }
    a.l_lo = 0; a.l_hi = 0; a.ph_lo = 0; a.ph_hi = 0; a.do_fin = 1;
    hipLaunchKernelGGL(trunk_fwd, dim3(grid), dim3(NTHR), LDS_BYTES, stream, a);
    }
#endif
    const hipError_t le = hipPeekAtLastError();
    if (le != hipSuccess) fprintf(stderr, "kernel_launch: launch failed: %s\n", hipGetErrorName(le));
}
```
